# Optimizing an MI355X kernel written in HIP

```python
import jax
import jax.numpy as jnp
from jax import lax
import numpy as np

D_MODEL = 2048
BATCH = 1
SEQ = 16384
DEPTH = 2

MLA_HEADS = D_MODEL // 256
MLA_NOPE_DIM = 128
MLA_ROPE_DIM = 64
MLA_V_DIM = 128
Q_LORA = D_MODEL // 4
KV_LORA = D_MODEL // 8
SWA_HEADS = D_MODEL // 256
SWA_KV_HEADS = SWA_HEADS // 4
SWA_HEAD_DIM = 128
WINDOW = 128
Q_BLOCK = 128
ROPE_THETA = 10000.0
MLA_OUT = MLA_HEADS * MLA_V_DIM
SWA_OUT = SWA_HEADS * SWA_HEAD_DIM
D_MIX = MLA_OUT + SWA_OUT
C_Q_END = Q_LORA
C_KV_END = C_Q_END + KV_LORA
K_PE_END = C_KV_END + MLA_ROPE_DIM
Q_S_END = K_PE_END + SWA_HEADS * SWA_HEAD_DIM
K_S_END = Q_S_END + SWA_KV_HEADS * SWA_HEAD_DIM
IN_COLS = K_S_END + SWA_KV_HEADS * SWA_HEAD_DIM
D_FF_DENSE = 5632
N_EXPERTS = 8
TOP_K = 2
D_FF_EXPERT = 7168
MOE_BLOCK = 512
N_DENSE = (DEPTH + 1) // 2
N_MOE = DEPTH // 2
ALPHA = (2 * DEPTH) ** 0.25
BETA = (8 * DEPTH) ** -0.25
LN_EPS = 1e-5
RMS_EPS = 1e-6
NEG_INF = -1e30

kernel_name = 'hybrid_mla_swa_moe_deepnorm_encoder'


def layer_norm(x, g, b):
    xf = x.astype(jnp.float32)
    mu = jnp.mean(xf, axis=-1, keepdims=True)
    var = jnp.mean(jnp.square(xf - mu), axis=-1, keepdims=True)
    y = (xf - mu) * lax.rsqrt(var + LN_EPS) * g.astype(jnp.float32) + b.astype(jnp.float32)
    return y.astype(x.dtype)


def rms_norm(x, g):
    xf = x.astype(jnp.float32)
    y = xf * lax.rsqrt(jnp.mean(jnp.square(xf), axis=-1, keepdims=True) + RMS_EPS) * g.astype(jnp.float32)
    return y.astype(x.dtype)


def rope_tables(seq, dim):
    inv_freq = ROPE_THETA ** (-jnp.arange(0, dim, 2, dtype=jnp.float32) / dim)
    ang = jnp.arange(seq, dtype=jnp.float32)[:, None] * inv_freq[None, :]
    return jnp.cos(ang), jnp.sin(ang)


def apply_rope(t, cos, sin):
    tf = t.astype(jnp.float32)
    t1, t2 = jnp.split(tf, 2, axis=-1)
    c = cos[None, :, None, :]
    s = sin[None, :, None, :]
    return jnp.concatenate([t1 * c - t2 * s, t2 * c + t1 * s], axis=-1).astype(t.dtype)


def mla_attention(q_nope, q_pe, k_nope, k_pe, v):
    B, S, H, _ = q_nope.shape
    nb = S // Q_BLOCK
    scale = (MLA_NOPE_DIM + MLA_ROPE_DIM) ** -0.5
    qn = q_nope.reshape(B, nb, Q_BLOCK, H, MLA_NOPE_DIM).transpose(1, 0, 2, 3, 4)
    qp = q_pe.reshape(B, nb, Q_BLOCK, H, MLA_ROPE_DIM).transpose(1, 0, 2, 3, 4)

    def one_block(args):
        qn_b, qp_b = args
        s = (jnp.einsum('bqhd,bkhd->bhqk', qn_b, k_nope, preferred_element_type=jnp.float32)
             + jnp.einsum('bqhr,bkr->bhqk', qp_b, k_pe, preferred_element_type=jnp.float32)) * scale
        p = jax.nn.softmax(s, axis=-1).astype(v.dtype)
        return jnp.einsum('bhqk,bkhv->bqhv', p, v)

    o = lax.map(one_block, (qn, qp))
    return o.transpose(1, 0, 2, 3, 4).reshape(B, S, H, MLA_V_DIM)


def windowed_sink_gqa(q, k, v, sink):
    B, S, Hq, D = q.shape
    Hkv = k.shape[2]
    G = Hq // Hkv
    nb = S // Q_BLOCK
    qb = q.reshape(B, nb, Q_BLOCK, Hkv, G, D)
    pad = ((0, 0), (Q_BLOCK, Q_BLOCK), (0, 0), (0, 0))
    kp = jnp.pad(k, pad).reshape(B, nb + 2, Q_BLOCK, Hkv, D)
    vp = jnp.pad(v, pad).reshape(B, nb + 2, Q_BLOCK, Hkv, D)
    kb = jnp.concatenate([kp[:, :-2], kp[:, 1:-1], kp[:, 2:]], axis=2)
    vb = jnp.concatenate([vp[:, :-2], vp[:, 1:-1], vp[:, 2:]], axis=2)
    blk = jnp.arange(nb)[:, None] * Q_BLOCK
    qpos = blk + jnp.arange(Q_BLOCK)[None, :]
    kpos = blk - Q_BLOCK + jnp.arange(3 * Q_BLOCK)[None, :]
    mask = ((jnp.abs(qpos[:, :, None] - kpos[:, None, :]) <= WINDOW)
            & (kpos[:, None, :] >= 0) & (kpos[:, None, :] < S))
    s = jnp.einsum('bnqhgd,bnkhd->bnhgqk', qb, kb, preferred_element_type=jnp.float32) * (D ** -0.5)
    s = jnp.where(mask[None, :, None, None, :, :], s, NEG_INF)
    sink_f = sink.astype(jnp.float32).reshape(Hkv, G)[None, None, :, :, None, None]
    m = jnp.maximum(jnp.max(s, axis=-1, keepdims=True), sink_f)
    e = jnp.exp(s - m)
    p = (e / (jnp.sum(e, axis=-1, keepdims=True) + jnp.exp(sink_f - m))).astype(v.dtype)
    o = jnp.einsum('bnhgqk,bnkhd->bnqhgd', p, vb)
    return o.reshape(B, S, Hq, D)


def token_mixer(x, w_in, g_cq, w_qb, g_ckv, w_kvb, sink, g_out_mla, g_out_swa, w_out,
                cos_m, sin_m, cos_s, sin_s):
    B, S, _ = x.shape
    proj = x @ w_in
    c_q, c_kv, k_pe, q_s, k_s, v_s = jnp.split(
        proj, [C_Q_END, C_KV_END, K_PE_END, Q_S_END, K_S_END], axis=-1)
    q = (rms_norm(c_q, g_cq) @ w_qb).reshape(B, S, MLA_HEADS, MLA_NOPE_DIM + MLA_ROPE_DIM)
    q_nope = q[..., :MLA_NOPE_DIM]
    q_pe = apply_rope(q[..., MLA_NOPE_DIM:], cos_m, sin_m)
    kv = (rms_norm(c_kv, g_ckv) @ w_kvb).reshape(B, S, MLA_HEADS, MLA_NOPE_DIM + MLA_V_DIM)
    k_nope = kv[..., :MLA_NOPE_DIM]
    v_m = kv[..., MLA_NOPE_DIM:]
    k_pe = apply_rope(k_pe[:, :, None, :], cos_m, sin_m)[:, :, 0, :]
    o_mla = mla_attention(q_nope, q_pe, k_nope, k_pe, v_m).reshape(B, S, MLA_OUT)
    q_s = apply_rope(q_s.reshape(B, S, SWA_HEADS, SWA_HEAD_DIM), cos_s, sin_s)
    k_s = apply_rope(k_s.reshape(B, S, SWA_KV_HEADS, SWA_HEAD_DIM), cos_s, sin_s)
    v_s = v_s.reshape(B, S, SWA_KV_HEADS, SWA_HEAD_DIM)
    o_swa = windowed_sink_gqa(q_s, k_s, v_s, sink).reshape(B, S, SWA_OUT)
    merged = jnp.concatenate([rms_norm(o_mla, g_out_mla), rms_norm(o_swa, g_out_swa)], axis=-1)
    return merged @ w_out


def swiglu(x, wg, wu, wd):
    return (jax.nn.silu(x @ wg) * (x @ wu)) @ wd


def moe_swiglu(x, w_router, wg, wu, wd):
    B, S, D = x.shape
    N = B * S
    NK = N * TOP_K
    xf = x.reshape(N, D)
    logits = (xf @ w_router).astype(jnp.float32)
    top_l, top_e = lax.top_k(logits, TOP_K)
    gates = jax.nn.softmax(top_l, axis=-1).astype(x.dtype)
    flat_e = top_e.reshape(-1)
    flat_tok = jnp.repeat(jnp.arange(N, dtype=jnp.int32), TOP_K)
    flat_g = gates.reshape(-1)
    order = jnp.argsort(flat_e)
    se, stok, sg = flat_e[order], flat_tok[order], flat_g[order]
    counts = jnp.bincount(flat_e, length=N_EXPERTS)
    offs = jnp.cumsum(counts) - counts
    padded = (counts + MOE_BLOCK - 1) // MOE_BLOCK * MOE_BLOCK
    pad_end = jnp.cumsum(padded)
    pad_offs = pad_end - padded
    dest = pad_offs[se] + jnp.arange(NK, dtype=jnp.int32) - offs[se]
    cap = -(-NK // MOE_BLOCK) * MOE_BLOCK + N_EXPERTS * MOE_BLOCK
    n_blk = cap // MOE_BLOCK
    tok_buf = jnp.zeros((cap,), jnp.int32).at[dest].set(stok)
    gate_buf = jnp.zeros((cap,), x.dtype).at[dest].set(sg)
    blk_e = jnp.minimum(jnp.searchsorted(pad_end, jnp.arange(n_blk) * MOE_BLOCK, side='right'),
                        N_EXPERTS - 1).astype(jnp.int32)
    xs = xf[tok_buf].reshape(n_blk, MOE_BLOCK, D)

    def expert_block(args):
        xb, e = args
        return (jax.nn.silu(xb @ wg[e]) * (xb @ wu[e])) @ wd[e]

    ys = lax.map(expert_block, (xs, blk_e)).reshape(cap, D)
    out = jnp.zeros((N, D), x.dtype).at[tok_buf].add(ys * gate_buf[:, None])
    return out.reshape(B, S, D)


def setup_inputs(seed: int = 0) -> dict:
    key = jax.random.key(seed)
    ks = jax.random.split(key, 24)

    def nrm(k, shape, scale):
        return jax.random.normal(k, shape, jnp.float32) * scale

    def gain(k, shape):
        return 1.0 + 0.02 * jax.random.normal(k, shape, jnp.float32)

    x = jax.random.normal(ks[0], (BATCH, SEQ, D_MODEL), jnp.float32)
    v_cols = SWA_KV_HEADS * SWA_HEAD_DIM
    in_scale = jnp.concatenate([jnp.ones((IN_COLS - v_cols,), jnp.float32),
                                jnp.full((v_cols,), BETA, jnp.float32)])
    w_in = nrm(ks[1], (DEPTH, D_MODEL, IN_COLS), D_MODEL ** -0.5) * in_scale
    g_cq = gain(ks[2], (DEPTH, Q_LORA))
    w_qb = nrm(ks[3], (DEPTH, Q_LORA, MLA_HEADS * (MLA_NOPE_DIM + MLA_ROPE_DIM)), Q_LORA ** -0.5)
    g_ckv = gain(ks[4], (DEPTH, KV_LORA))
    kv_scale = jnp.tile(jnp.concatenate([jnp.ones((MLA_NOPE_DIM,), jnp.float32),
                                         jnp.full((MLA_V_DIM,), BETA, jnp.float32)]), MLA_HEADS)
    w_kvb = nrm(ks[5], (DEPTH, KV_LORA, MLA_HEADS * (MLA_NOPE_DIM + MLA_V_DIM)), KV_LORA ** -0.5) * kv_scale
    sink = nrm(ks[6], (DEPTH, SWA_HEADS), 0.5)
    g_out_mla = gain(ks[7], (DEPTH, MLA_OUT))
    g_out_swa = gain(ks[8], (DEPTH, SWA_OUT))
    w_out = nrm(ks[9], (DEPTH, D_MIX, D_MODEL), D_MIX ** -0.5 * BETA)
    ln1_g = gain(ks[10], (DEPTH, D_MODEL))
    ln1_b = nrm(ks[11], (DEPTH, D_MODEL), 0.02)
    dense_wg = nrm(ks[12], (N_DENSE, D_MODEL, D_FF_DENSE), D_MODEL ** -0.5 * BETA)
    dense_wu = nrm(ks[13], (N_DENSE, D_MODEL, D_FF_DENSE), D_MODEL ** -0.5 * BETA)
    dense_wd = nrm(ks[14], (N_DENSE, D_FF_DENSE, D_MODEL), D_FF_DENSE ** -0.5 * BETA)
    router_w = nrm(ks[15], (N_MOE, D_MODEL, N_EXPERTS), D_MODEL ** -0.5)
    moe_wg = nrm(ks[16], (N_MOE, N_EXPERTS, D_MODEL, D_FF_EXPERT), D_MODEL ** -0.5 * BETA)
    moe_wu = nrm(ks[17], (N_MOE, N_EXPERTS, D_MODEL, D_FF_EXPERT), D_MODEL ** -0.5 * BETA)
    moe_wd = nrm(ks[18], (N_MOE, N_EXPERTS, D_FF_EXPERT, D_MODEL), D_FF_EXPERT ** -0.5 * BETA)
    ln2_g = gain(ks[19], (DEPTH, D_MODEL))
    ln2_b = nrm(ks[20], (DEPTH, D_MODEL), 0.02)
    return {'x': x, 'w_in': w_in, 'g_cq': g_cq, 'w_qb': w_qb, 'g_ckv': g_ckv, 'w_kvb': w_kvb,
            'sink': sink, 'g_out_mla': g_out_mla, 'g_out_swa': g_out_swa, 'w_out': w_out,
            'ln1_g': ln1_g, 'ln1_b': ln1_b, 'dense_wg': dense_wg, 'dense_wu': dense_wu,
            'dense_wd': dense_wd, 'router_w': router_w, 'moe_wg': moe_wg, 'moe_wu': moe_wu,
            'moe_wd': moe_wd, 'ln2_g': ln2_g, 'ln2_b': ln2_b}


def reference(x, w_in, g_cq, w_qb, g_ckv, w_kvb, sink, g_out_mla, g_out_swa, w_out,
              ln1_g, ln1_b, dense_wg, dense_wu, dense_wd, router_w, moe_wg, moe_wu, moe_wd,
              ln2_g, ln2_b):
    S = x.shape[1]
    cos_m, sin_m = rope_tables(S, MLA_ROPE_DIM)
    cos_s, sin_s = rope_tables(S, SWA_HEAD_DIM)
    for l in range(DEPTH):
        mix = token_mixer(x, w_in[l], g_cq[l], w_qb[l], g_ckv[l], w_kvb[l], sink[l],
                          g_out_mla[l], g_out_swa[l], w_out[l], cos_m, sin_m, cos_s, sin_s)
        x = layer_norm(ALPHA * x + mix, ln1_g[l], ln1_b[l])
        j = l // 2
        if l % 2 == 0:
            ffn = swiglu(x, dense_wg[j], dense_wu[j], dense_wd[j])
        else:
            ffn = moe_swiglu(x, router_w[j], moe_wg[j], moe_wu[j], moe_wd[j])
        x = layer_norm(ALPHA * x + ffn, ln2_g[l], ln2_b[l])
    return x
```

```cpp
#include <hip/hip_runtime.h>
#include <cstdio>
#include <cstdint>

#define LAS __attribute__((address_space(3)))
#define GAS __attribute__((address_space(1)))
typedef unsigned short bf16_t;
typedef short bf16x8 __attribute__((ext_vector_type(8)));
typedef short s16x4 __attribute__((ext_vector_type(4)));
typedef float f32x4 __attribute__((ext_vector_type(4)));
typedef float f32x16 __attribute__((ext_vector_type(16)));
typedef unsigned u32x4 __attribute__((ext_vector_type(4)));
typedef unsigned u32x2 __attribute__((ext_vector_type(2)));

constexpr int S = 16384, D = 2048, DEPTH = 2;
constexpr int IN_COLS = 2368, IN_PAD = 2560, QCOLS = 1536, KVCOLS = 2048, QLORA = 512, KVLORA = 256;
constexpr int FF = 5632, FFE = 7168, NE = 8;
constexpr int MOE_ROWS = 34816;
constexpr float ALPHA = 1.41421356237309515f, LN_EPS = 1e-5f, RMS_EPS = 1e-6f;
constexpr float SCALE_MLA = 0.07216878364870322f, SCALE_SWA = 0.08838834764831845f;

__device__ __forceinline__ unsigned cvt_pk_bf16(float lo, float hi) { unsigned r; asm volatile("v_cvt_pk_bf16_f32 %0, %1, %2" : "=v"(r) : "v"(lo), "v"(hi)); return r; }

__device__ __forceinline__ unsigned pk_fp8x4(float a, float b, float c, float d) { int w = 0; w = __builtin_amdgcn_cvt_pk_fp8_f32(a, b, w, false); w = __builtin_amdgcn_cvt_pk_fp8_f32(c, d, w, true); return (unsigned)w; }
typedef int v6i32 __attribute__((ext_vector_type(6)));
typedef unsigned u32x6 __attribute__((ext_vector_type(6)));
__device__ __forceinline__ u32x6 mx6_block(const f32x16 lo, const f32x16 hi, unsigned& sb) {
    float am = 0.f;
#pragma unroll
    for (int i = 0; i < 16; ++i) am = fmaxf(am, fmaxf(fabsf(lo[i]), fabsf(hi[i])));
    const unsigned bits = __float_as_uint(am);
    int e = (int)((bits >> 23) & 255u) - 126 - (((bits & 0x7fffffu) <= 0x700000u) ? 3 : 2);
    e = e < -120 ? -120 : e;
    const float scale = __uint_as_float((unsigned)(e + 127) << 23);
    sb = (unsigned)(e + 127) * 0x01010101u;
    u32x6 q;
    asm("v_cvt_scalef32_2xpk16_fp6_f32 %0, %1, %2, %3" : "=&v"(q) : "v"(lo), "v"(hi), "v"(scale));
    return q;
}
constexpr float X8_SCALE = 4.f, W8UP_SCALE = 64.f, W8DN_SCALE = 128.f, H8_SCALE = 16.f;
__device__ __forceinline__ int tid_opaque() { int t = threadIdx.x; asm volatile("" : "+v"(t)); return t; }

constexpr size_t MiB = 1u << 20;
constexpr size_t WS_CTL = 0, CTL_ZERO_BYTES = 1 * MiB;
constexpr size_t WS_COSM = 1 * MiB, WS_SINM = 3 * MiB, WS_COSS = 5 * MiB, WS_SINS = 9 * MiB;
constexpr size_t WS_PARTQ = 13 * MiB, WS_PARTKV = 14 * MiB, WS_PARTO = 15 * MiB;
constexpr size_t WS_SEL = 16 * MiB, WS_GATE = WS_SEL + 128 * 1024, WS_DEST = WS_GATE + 128 * 1024, WS_WGCNT = WS_DEST + 128 * 1024, WS_MOEMETA = WS_WGCNT + 32 * 1024, WS_ST1 = WS_MOEMETA + 4096, WS_ST2 = WS_ST1 + 128 * 1024;
constexpr size_t WS_W = 17 * MiB;
constexpr size_t SZ_WIN = (size_t)IN_PAD * D * 2, SZ_WQ = (size_t)QCOLS * QLORA * 2, SZ_WKV = (size_t)KVCOLS * KVLORA * 2, SZ_WOUT = (size_t)D * D * 2;
constexpr size_t WS_WIN = WS_W, WS_WQ = WS_WIN + 2 * SZ_WIN, WS_WKV = WS_WQ + 2 * SZ_WQ, WS_WOUT = WS_WKV + 2 * SZ_WKV;
constexpr size_t WS_WGU = WS_WOUT + 2 * SZ_WOUT, WS_WD = WS_WGU + (size_t)2 * FF * D, WS_WMGU = WS_WD + (size_t)D * FF;
constexpr size_t WS_WMD = WS_WMGU + (size_t)NE * 2 * FFE * D, WS_XA = WS_WMD + (size_t)NE * D * FFE;
constexpr size_t WS_XB = WS_XA + (size_t)S * D * 4, WS_X8 = WS_XB + (size_t)S * D * 2, WS_SCR = WS_X8 + (size_t)S * D;
constexpr size_t WS_CQ = WS_SCR, WS_CKV = WS_CQ + (size_t)S * 512 * 2, WS_KPE = WS_CKV + (size_t)S * 256 * 2, WS_QS = WS_KPE + (size_t)S * 64 * 2;
constexpr size_t WS_KS = WS_QS + (size_t)S * 1024 * 2, WS_VS = WS_KS + (size_t)S * 256 * 2, WS_Q = WS_VS + (size_t)S * 256 * 2, WS_KV = WS_Q + (size_t)S * QCOLS * 2;
constexpr size_t WS_OBUF = WS_KV + (size_t)S * KVCOLS * 2, WS_ATT_END = WS_OBUF + (size_t)S * D * 2;
constexpr size_t WS_XS = WS_SCR, WS_H = WS_XS + (size_t)MOE_ROWS * D * 2, WS_END0 = WS_H + (size_t)MOE_ROWS * FFE, WS_END = WS_END0 > WS_ATT_END ? WS_END0 : WS_ATT_END;
constexpr size_t WS_YP = (WS_END + 255) / 256 * 256, WS_END2 = WS_YP + (size_t)7 * 128 * 65536 * 2;
constexpr size_t WS_TAILMAP = WS_CTL + 512 * 1024;
static_assert(WS_H + (size_t)S * FF <= WS_END, "scratch union");
static_assert(WS_WIN % 256 == 0 && WS_XA % 256 == 0 && WS_H % 256 == 0 && WS_Q % 256 == 0, "alignment");
constexpr int CW_TMO = 0, CW_BAR = 4096;

#define XB_TMO      128
#define XB_XCNT(j)  (256  + 64 * (j))
#define XB_XSUB(j)  (1280 + 64 * (j))
#define XB_XGEN(j)  (2304 + 64 * (j))
#define XB_TOP      3328
#define XB_TOPGEN   3392
#define XCD_BAR_WORDS 3456
#define XB_SPIN_CAP (1u << 18)
__device__ __forceinline__ unsigned xb_ld(unsigned* p)              { return __hip_atomic_load(p, __ATOMIC_RELAXED, __HIP_MEMORY_SCOPE_AGENT); }
__device__ __forceinline__ unsigned xb_add(unsigned* p, unsigned v) { return __hip_atomic_fetch_add(p, v, __ATOMIC_RELAXED, __HIP_MEMORY_SCOPE_AGENT); }
__device__ __forceinline__ unsigned xb_xcc_id() { return (unsigned)__builtin_amdgcn_s_getreg((3 << 11) | 20) & 0xFu; }
#define XB_SPIN(cond, bar) do { unsigned _sp = 0; while (cond) { __builtin_amdgcn_s_sleep(1); \
    if ((++_sp & 255u) == 0u) { if (xb_ld(&(bar)[XB_TMO])) break; if (_sp > XB_SPIN_CAP) { atomicAdd(&(bar)[XB_TMO], 1u); break; } } } } while (0)
struct XcdBarrier { unsigned* bar; unsigned x; volatile LAS unsigned* st; };
__device__ __forceinline__ XcdBarrier xcd_barrier_post(unsigned* bar, volatile LAS unsigned* st) {
    XcdBarrier b; b.bar = bar; b.x = xb_xcc_id(); b.st = st;
    if (threadIdx.x == 0) (void)xb_add(&bar[XB_XCNT(b.x)], 1u);
    return b;
}
__device__ __forceinline__ void xcd_barrier_complete(unsigned* bar, unsigned x, unsigned& nloc, unsigned& nx) {
    const unsigned G = gridDim.x * gridDim.y * gridDim.z;
    unsigned sum, cnt, mine, sp = 0u;
    for (;;) {
        sum = 0u; cnt = 0u; mine = 0u;
#pragma unroll
        for (unsigned j = 0; j < 16; ++j) { const unsigned c = xb_ld(&bar[XB_XCNT(j)]); sum += c; cnt += (c > 0u) ? 1u : 0u; mine = (j == x) ? c : mine; }
        if (sum == G) break;
        __builtin_amdgcn_s_sleep(1);
        if ((++sp & 255u) == 0u) { if (xb_ld(&bar[XB_TMO])) break; if (sp > XB_SPIN_CAP) { atomicAdd(&bar[XB_TMO], 1u); break; } }
    }
    nloc = mine > 0u ? mine : 1u; nx = cnt > 0u ? cnt : 1u;
}
__device__ __forceinline__ void xcd_barrier(const XcdBarrier& b) {
    asm volatile("s_waitcnt vmcnt(0)" ::: "memory");
    __syncthreads();
    if (threadIdx.x == 0) {
        unsigned* bar = b.bar;
        __builtin_amdgcn_s_waitcnt(0);
        unsigned nloc = b.st[0], nx = b.st[1];
        if (nloc == 0u) { xcd_barrier_complete(bar, b.x, nloc, nx); b.st[0] = nloc; b.st[1] = nx; }
        const unsigned old = xb_add(&bar[XB_XSUB(b.x)], 1u);
        const unsigned gen = old / nloc;
        if (old + 1u == (gen + 1u) * nloc) {
            __builtin_amdgcn_fence(__ATOMIC_RELEASE, "agent");
            asm volatile("s_waitcnt vmcnt(0)" ::: "memory");
            const unsigned og = xb_add(&bar[XB_TOP], 1u);
            const unsigned tg = og / nx;
            if (og + 1u == (tg + 1u) * nx) xb_add(&bar[XB_TOPGEN], 1u);
            else XB_SPIN(xb_ld(&bar[XB_TOPGEN]) == tg, bar);
            __builtin_amdgcn_fence(__ATOMIC_ACQUIRE, "agent");
            xb_add(&bar[XB_XGEN(b.x)], 1u);
            asm volatile("s_waitcnt vmcnt(0)" ::: "memory");
        } else {
            XB_SPIN(xb_ld(&bar[XB_XGEN(b.x)]) == gen, bar);
            __builtin_amdgcn_fence(__ATOMIC_ACQUIRE, "agent");
            asm volatile("s_waitcnt vmcnt(0)" ::: "memory");
        }
    }
    __syncthreads();
}

namespace pg8 {
constexpr int BM = 256, BK = 64, HALF = 128, HTB = HALF * BK * 2, STAGE_BYTES = 8 * HTB, NXCD = 8, WGM = 8;
__host__ __device__ __forceinline__ int lds_byte(int r, int c) { const int st = (r >> 4) * 2 + (c >> 5), rr = r & 15, cc = c & 31, ob = rr * 64 + cc * 2; return st * 1024 + (ob ^ (((ob >> 9) & 1) << 5)); }
__host__ __device__ __forceinline__ void stage_rc(int b, int& R, int& C) { const int st = b / 1024, sb = b % 1024, swz = sb ^ (((sb >> 9) & 1) << 5); R = (st >> 1) * 16 + swz / 64; C = (st & 1) * 32 + (swz % 64) / 2; }
__host__ __device__ __forceinline__ int perm32(int rho) { const int n = rho >> 4, i = rho & 15; return 8 * (i >> 2) + 4 * n + (i & 3); }
struct Unit { int pm, pn, aux, kx; };
struct Gemm { const bf16_t* A; const bf16_t* Bt; int K; };
struct StaticOrder {
    static constexpr bool KSPLIT = false;
    int nM, nN, nwg, G, c;
    __device__ void init(int M, int N, int G_, int c_) { nM = M / BM; nN = N / BM; nwg = nM * nN; G = G_; c = c_; }
    __device__ bool next(int i, Unit& u) const {
        const long L = (long)i * G + c; if (L >= nwg) return false;
        int wgid = (int)L; { const int q = nwg / NXCD, r = nwg % NXCD, xcd = wgid % NXCD, off = wgid / NXCD; wgid = (xcd < r ? xcd * (q + 1) : r * (q + 1) + (xcd - r) * q) + off; }
        const int nig = WGM * nN, gid = wgid / nig, fm = gid * WGM, gsz = (nM - fm) < WGM ? (nM - fm) : WGM;
        u.pm = fm + ((wgid % nig) % gsz); u.pn = (wgid % nig) / gsz; u.aux = u.pn; return true;
    }
};
struct MoeOrder {
    static constexpr bool KSPLIT = false;
    int pb[9], NT, G, c, nwg;
    __device__ __forceinline__ bool next(int i, Unit& u) const { return at((long)i * G + c, u); }
    __device__ __forceinline__ bool at(long L, Unit& u) const {
        if (L >= nwg) return false;
        int wgid = (int)L; { const int q = nwg / NXCD, r = nwg % NXCD, xcd = wgid % NXCD, off = wgid / NXCD; wgid = (xcd < r ? xcd * (q + 1) : r * (q + 1) + (xcd - r) * q) + off; }
        int e = 0;
#pragma unroll
        for (int k = 1; k < 8; ++k) e += (wgid >= pb[k] * NT) ? 1 : 0;
        int pbe = pb[0], pbn = pb[1];
#pragma unroll
        for (int k = 1; k < 8; ++k) { if (e == k) { pbe = pb[k]; pbn = pb[k + 1]; } }
        const int l = wgid - pbe * NT, Pe = pbn - pbe;
        const int nig = WGM * NT, gid = l / nig, fm = gid * WGM, gsz = (Pe - fm) < WGM ? (Pe - fm) : WGM;
        u.pm = pbe + fm + ((l % nig) % gsz); const int pn = (l % nig) / gsz; u.pn = e * NT + pn; u.aux = pn; return true;
    }
};

struct TableOrder {
    static constexpr bool KSPLIT = false;
    const LAS int* tab; int n;
    __device__ __forceinline__ bool next(int i, Unit& u) const {
        if (i >= n) return false;
        u.pm = __builtin_amdgcn_readfirstlane(tab[4 * i]); u.pn = __builtin_amdgcn_readfirstlane(tab[4 * i + 1]); u.aux = __builtin_amdgcn_readfirstlane(tab[4 * i + 2]); return true;
    }
};
struct TableOrderK {
    static constexpr bool KSPLIT = true;
    const LAS int* tab; int n;
    __device__ __forceinline__ bool next(int i, Unit& u) const {
        if (i >= n) return false;
        u.pm = __builtin_amdgcn_readfirstlane(tab[4 * i]); u.pn = __builtin_amdgcn_readfirstlane(tab[4 * i + 1]); u.aux = __builtin_amdgcn_readfirstlane(tab[4 * i + 2]); u.kx = __builtin_amdgcn_readfirstlane(tab[4 * i + 3]); return true;
    }
};
typedef int v8i32 __attribute__((ext_vector_type(8)));
template <class Epi, class Sched, bool ALIGN_EPI, bool SP2, int FMT = 0>
__device__ __forceinline__ void gemm_phase(LAS unsigned char* lds, const Gemm g, const Sched& S, const Epi& E) {
    const int tid = tid_opaque(), wid = __builtin_amdgcn_readfirstlane(tid >> 6), lane = tid & 63, wr = wid >> 2, wc = wid & 3, fr = lane & 15, fq = lane >> 4;
    constexpr bool F8 = (FMT != 0);
    const int K = g.K, RB = F8 ? K : 2 * K, nt = RB / 128;
    unsigned voffA, voffB;
    { int R, C; stage_rc(tid * 16, R, C); const int Rb = Epi::PERM ? ((R & ~31) + perm32(R & 31)) : R; voffA = (unsigned)(R * RB + C * 2); voffB = (unsigned)(Rb * RB + C * 2); }
    const size_t rstep = (size_t)64 * RB;
    const size_t kstep = (size_t)(BK * 2);
    const size_t hstep = (size_t)HALF * RB;
    const size_t tstep = 2 * hstep;
    const unsigned ldsw = (unsigned)wid * 1024u;
    const int aoff = lds_byte(wr * 64 + fr, fq * 8), boff = lds_byte(wc * 32 + fr, fq * 8);
#define PG8_SA(b, h) (((b) * 2 + (h)) * HTB)
#define PG8_SB(b, h) ((4 + (b) * 2 + (h)) * HTB)
#define PG8_STAGE(bufoff, gbase, voff) do { _Pragma("unroll") for (int _i = 0; _i < 2; ++_i) \
        __builtin_amdgcn_global_load_lds((const unsigned*)((const char*)(gbase) + _i * rstep + (voff)), (LAS unsigned*)(lds + (bufoff) + ldsw + _i * 8192), 16, 0, 0); } while (0)
#define PG8_LDA(dst, b, h) do { _Pragma("unroll") for (int m = 0; m < 4; ++m) _Pragma("unroll") for (int k = 0; k < 2; ++k) dst[m][k] = *(const LAS bf16x8*)(lds + PG8_SA(b, h) + aoff + m * 2048 + k * 1024); } while (0)
#define PG8_LDB(dst, b, h) do { _Pragma("unroll") for (int n = 0; n < 2; ++n) _Pragma("unroll") for (int k = 0; k < 2; ++k) dst[n][k] = *(const LAS bf16x8*)(lds + PG8_SB(b, h) + boff + n * 2048 + k * 1024); } while (0)
#define PG8_CAT(x) __builtin_shufflevector(__builtin_bit_cast(u32x4, x[0]), __builtin_bit_cast(u32x4, x[1]), 0, 1, 2, 3, 4, 5, 6, 7)
#define PG8_D6(x) __builtin_bit_cast(v6i32, __builtin_shufflevector(__builtin_bit_cast(u32x4, x[0]), __builtin_bit_cast(u32x4, x[1]), 0, 1, 2, 3, 4, 5))
#define PG8_S6(x) ((int)__builtin_bit_cast(u32x4, x[1])[2])
#define PG8_MMA(ai, bj, At, Bt) do { __builtin_amdgcn_s_setprio(1); if constexpr (FMT == 1) { _Pragma("unroll") for (int m = 0; m < 4; ++m) _Pragma("unroll") for (int n = 0; n < 2; ++n) \
        asm volatile("v_mfma_f32_16x16x128_f8f6f4 %0, %1, %2, %0" : "+v"(acc[ai][bj][m][n]) : "v"(__builtin_bit_cast(v8i32, PG8_CAT(Bt[n]))), "v"(__builtin_bit_cast(v8i32, PG8_CAT(At[m])))); } \
        else if constexpr (FMT == 2) { _Pragma("unroll") for (int m = 0; m < 4; ++m) _Pragma("unroll") for (int n = 0; n < 2; ++n) \
        acc[ai][bj][m][n] = __builtin_amdgcn_mfma_scale_f32_16x16x128_f8f6f4(__builtin_bit_cast(v8i32, PG8_CAT(Bt[n])), __builtin_bit_cast(v8i32, PG8_CAT(At[m])), acc[ai][bj][m][n], 2, 2, 0, PG8_S6(Bt[n]), 0, PG8_S6(At[m])); } \
        else { _Pragma("unroll") for (int m = 0; m < 4; ++m) _Pragma("unroll") for (int n = 0; n < 2; ++n) _Pragma("unroll") for (int k = 0; k < 2; ++k) \
        acc[ai][bj][m][n] = __builtin_amdgcn_mfma_f32_16x16x32_bf16(Bt[n][k], At[m][k], acc[ai][bj][m][n], 0, 0, 0); } __builtin_amdgcn_s_setprio(0); } while (0)
#define PG8_WAIT_V(n) asm volatile("s_waitcnt vmcnt(" #n ")" ::: "memory")
#define PG8_WAIT_L(n) asm volatile("s_waitcnt lgkmcnt(" #n ")" ::: "memory")
#define PG8_BAR __builtin_amdgcn_s_barrier()
#define PG8_SCHED __builtin_amdgcn_sched_barrier(0)
    Unit cur, nxt; int ui = 0;
    if (!S.next(0, cur)) return;
    constexpr bool KS = Sched::KSPLIT;
    auto k_off = [&](const Unit& u) -> size_t { if constexpr (KS) { if (u.kx) return (size_t)((u.kx >> 8) & 255) * (size_t)(nt / (u.kx >> 16)) * 128; } return 0; };
    auto k_cnt = [&](const Unit& u) -> int { if constexpr (KS) { if (u.kx) return nt / (u.kx >> 16); } return nt; };
    int ntc = k_cnt(cur);
    f32x4 acc[2][2][4][2];
#pragma unroll
    for (int a = 0; a < 2; ++a)
#pragma unroll
        for (int b = 0; b < 2; ++b)
#pragma unroll
            for (int m = 0; m < 4; ++m)
#pragma unroll
                for (int n = 0; n < 2; ++n) acc[a][b][m][n] = (f32x4){0.f, 0.f, 0.f, 0.f};
    bf16x8 At[4][2], B0[2][2], B1[2][2];
    const char* cA = (const char*)g.A + (size_t)cur.pm * tstep + k_off(cur); const char* cB = (const char*)g.Bt + (size_t)cur.pn * tstep + k_off(cur);
    if constexpr (SP2) {
        PG8_STAGE(PG8_SB(0, 0), cB, voffB); PG8_STAGE(PG8_SB(0, 1), cB + hstep, voffB); PG8_STAGE(PG8_SA(0, 0), cA, voffA); PG8_STAGE(PG8_SA(0, 1), cA + hstep, voffA);
        if (wr == 1) PG8_BAR;
        PG8_WAIT_V(2); PG8_BAR;
        PG8_STAGE(PG8_SB(1, 0), cB + kstep, voffB); PG8_STAGE(PG8_SA(1, 0), cA + kstep, voffA); PG8_STAGE(PG8_SB(1, 1), cB + hstep + kstep, voffB);
        PG8_WAIT_V(6); PG8_BAR;
    } else {
        PG8_STAGE(PG8_SB(0, 0), cB, voffB); PG8_STAGE(PG8_SA(0, 0), cA, voffA); PG8_STAGE(PG8_SB(0, 1), cB + hstep, voffB); PG8_STAGE(PG8_SA(0, 1), cA + hstep, voffA);
        if (wr == 1) PG8_BAR;
        PG8_WAIT_V(4); PG8_BAR;
        PG8_STAGE(PG8_SB(1, 0), cB + kstep, voffB); PG8_STAGE(PG8_SA(1, 0), cA + kstep, voffA); PG8_STAGE(PG8_SB(1, 1), cB + hstep + kstep, voffB);
        PG8_WAIT_V(6); PG8_BAR;
    }
    for (;;) {
        const bool has_next = S.next(ui + 1, nxt);
        const char* nA = has_next ? (const char*)g.A + (size_t)nxt.pm * tstep + k_off(nxt) : cA; const char* nB = has_next ? (const char*)g.Bt + (size_t)nxt.pn * tstep + k_off(nxt) : cB;
        for (int t = 0; t < ntc; t += 2) {
            if constexpr (Epi::MID_T >= 0) { if (t == Epi::MID_T) { const int l2 = tid_opaque() & 63; E.mid(acc, cur, wr, wc, l2 & 15, l2 >> 4); } }
            const bool last = (t == ntc - 2);
            const char* a1 = cA + (size_t)(t + 1) * kstep;
            const char* a2 = last ? nA : cA + (size_t)(t + 2) * kstep; const char* b2 = last ? nB : cB + (size_t)(t + 2) * kstep;
            const char* a3 = a2 + kstep; const char* b3 = b2 + kstep;
            if constexpr (SP2) {
            PG8_LDB(B0, 0, 0); PG8_LDB(B1, 0, 1); PG8_SCHED; PG8_LDA(At, 0, 0); PG8_STAGE(PG8_SA(1, 1), a1 + hstep, voffA);
            PG8_WAIT_V(8); PG8_WAIT_L(0); PG8_BAR; PG8_MMA(0, 0, At, B0); PG8_MMA(0, 1, At, B1); PG8_BAR; PG8_SCHED;
            PG8_LDA(At, 0, 1); PG8_STAGE(PG8_SB(0, 0), b2, voffB); PG8_STAGE(PG8_SB(0, 1), b2 + hstep, voffB); PG8_STAGE(PG8_SA(0, 0), a2, voffA);
            PG8_WAIT_V(8); PG8_WAIT_L(0); PG8_BAR; PG8_MMA(1, 0, At, B0); PG8_MMA(1, 1, At, B1); PG8_BAR; PG8_SCHED;
            PG8_LDB(B0, 1, 0); PG8_LDB(B1, 1, 1); PG8_SCHED; PG8_LDA(At, 1, 0); PG8_STAGE(PG8_SA(0, 1), a2 + hstep, voffA);
            PG8_WAIT_V(8); PG8_WAIT_L(0); PG8_BAR; PG8_MMA(0, 0, At, B0); PG8_MMA(0, 1, At, B1); PG8_BAR; PG8_SCHED;
            PG8_LDA(At, 1, 1); PG8_STAGE(PG8_SB(1, 0), b3, voffB); PG8_STAGE(PG8_SB(1, 1), b3 + hstep, voffB); PG8_STAGE(PG8_SA(1, 0), a3, voffA);
            PG8_WAIT_V(8); PG8_WAIT_L(0); PG8_BAR; PG8_MMA(1, 0, At, B0); PG8_MMA(1, 1, At, B1); PG8_BAR; PG8_SCHED;
            } else {
            PG8_LDB(B0, 0, 0); PG8_SCHED; PG8_LDA(At, 0, 0); PG8_STAGE(PG8_SA(1, 1), a1 + hstep, voffA);
            PG8_WAIT_L(8); PG8_BAR; PG8_WAIT_L(0); PG8_MMA(0, 0, At, B0); PG8_BAR; PG8_SCHED;
            PG8_LDB(B1, 0, 1); PG8_STAGE(PG8_SB(0, 0), b2, voffB);
            PG8_BAR; PG8_WAIT_L(0); PG8_MMA(0, 1, At, B1); PG8_BAR;
            PG8_LDA(At, 0, 1); PG8_STAGE(PG8_SA(0, 0), a2, voffA);
            PG8_BAR; PG8_WAIT_L(0); PG8_MMA(1, 0, At, B0); PG8_BAR; PG8_SCHED;
            PG8_STAGE(PG8_SB(0, 1), b2 + hstep, voffB);
            PG8_WAIT_V(6); PG8_BAR; PG8_MMA(1, 1, At, B1); PG8_BAR;
            PG8_LDB(B0, 1, 0); PG8_SCHED; PG8_LDA(At, 1, 0); PG8_STAGE(PG8_SA(0, 1), a2 + hstep, voffA);
            PG8_WAIT_L(8); PG8_BAR; PG8_WAIT_L(0); PG8_MMA(0, 0, At, B0); PG8_BAR; PG8_SCHED;
            PG8_LDB(B1, 1, 1); PG8_STAGE(PG8_SB(1, 0), b3, voffB);
            PG8_BAR; PG8_WAIT_L(0); PG8_MMA(0, 1, At, B1); PG8_BAR;
            PG8_LDA(At, 1, 1); PG8_STAGE(PG8_SA(1, 0), a3, voffA);
            PG8_BAR; PG8_WAIT_L(0); PG8_MMA(1, 0, At, B0); PG8_BAR; PG8_SCHED;
            PG8_STAGE(PG8_SB(1, 1), b3 + hstep, voffB);
            PG8_WAIT_V(6); PG8_BAR; PG8_MMA(1, 1, At, B1); PG8_BAR;
            }
        }
        if constexpr (ALIGN_EPI) { if (wr == 0) PG8_BAR; }
        if constexpr (F8) asm volatile("s_nop 15\n\ts_nop 15" ::: "memory");
        { const int l2 = tid_opaque() & 63; E(acc, cur, wr, wc, l2 & 15, l2 >> 4); }
        if (!has_next) break;
#pragma unroll
        for (int a = 0; a < 2; ++a)
#pragma unroll
            for (int b = 0; b < 2; ++b)
#pragma unroll
                for (int m = 0; m < 4; ++m)
#pragma unroll
                    for (int n = 0; n < 2; ++n) acc[a][b][m][n] = (f32x4){0.f, 0.f, 0.f, 0.f};
        cur = nxt; cA = nA; cB = nB; ++ui; ntc = k_cnt(cur);
        if constexpr (ALIGN_EPI) { if (wr == 1) PG8_BAR; }
    }
    PG8_WAIT_V(0);
    if constexpr (!ALIGN_EPI) { if (wr == 0) PG8_BAR; }
    PG8_BAR;
#undef PG8_SA
#undef PG8_SB
#undef PG8_STAGE
#undef PG8_LDA
#undef PG8_LDB
#undef PG8_MMA
#undef PG8_CAT
#undef PG8_D6
#undef PG8_S6
#undef PG8_WAIT_V
#undef PG8_WAIT_L
#undef PG8_BAR
#undef PG8_SCHED
}

__device__ __forceinline__ u32x4 pack8(const f32x4 a, const f32x4 b) { u32x4 w; w.x = cvt_pk_bf16(a[0], a[1]); w.y = cvt_pk_bf16(a[2], a[3]); w.z = cvt_pk_bf16(b[0], b[1]); w.w = cvt_pk_bf16(b[2], b[3]); return w; }
__device__ __forceinline__ u32x2 pack4(const f32x4 a) { u32x2 w; w.x = cvt_pk_bf16(a[0], a[1]); w.y = cvt_pk_bf16(a[2], a[3]); return w; }

struct EpiInProj {
    static constexpr int MID_T = -1;
    static constexpr bool PERM = true;
    bf16_t *cq, *ckv, *kpe, *qs, *ks, *vs; float *partq, *partkv; const float *cosm, *sinm, *coss, *sins;
    __device__ __forceinline__ void operator()(const f32x4 (&acc)[2][2][4][2], const Unit& u, int wr, int wc, int fr, int fq) const {
        const int row0 = u.pm * BM + wr * 64 + fr;
#pragma unroll
        for (int bj = 0; bj < 2; ++bj) {
            const int tc0 = u.aux * BM + bj * HALF + wc * 32 + fq * 8;
            if (tc0 < 768) {
                bf16_t* base; float* part; int ld, col, ps;
                if (tc0 < 512) { base = cq; ld = 512; col = tc0; part = partq; ps = 16; } else { base = ckv; ld = 256; col = tc0 - 512; part = partkv; ps = 8; }
#pragma unroll
                for (int ai = 0; ai < 2; ++ai)
#pragma unroll
                    for (int m = 0; m < 4; ++m) { const int row = row0 + ai * HALF + m * 16; const f32x4 v0 = acc[ai][bj][m][0], v1 = acc[ai][bj][m][1];
                        *(u32x4*)(base + (size_t)row * ld + col) = pack8(v0, v1);
                        float ss = (v0[0] * v0[0] + v0[1] * v0[1]) + (v0[2] * v0[2] + v0[3] * v0[3]) + (v1[0] * v1[0] + v1[1] * v1[1]) + (v1[2] * v1[2] + v1[3] * v1[3]);
                        ss += __shfl_xor(ss, 16); ss += __shfl_xor(ss, 32);
                        if (fq == 0) part[(size_t)row * ps + (col >> 5)] = ss; }
            } else if (tc0 < 2112) {
                bf16_t* base; const float *ct, *st; int ld, col, half, tw, g;
                if (tc0 < 832) { g = (tc0 - 768) >> 3; base = kpe; ld = 64; col = 4 * g; half = 32; ct = cosm; st = sinm; tw = 32; }
                else if (tc0 < 1856) { const int j = tc0 - 832; g = (j & 127) >> 3; base = qs; ld = 1024; col = (j >> 7) * 128 + 4 * g; half = 64; ct = coss; st = sins; tw = 64; }
                else { const int j = tc0 - 1856; g = (j & 127) >> 3; base = ks; ld = 256; col = (j >> 7) * 128 + 4 * g; half = 64; ct = coss; st = sins; tw = 64; }
#pragma unroll
                for (int ai = 0; ai < 2; ++ai)
#pragma unroll
                    for (int m = 0; m < 4; ++m) { const int row = row0 + ai * HALF + m * 16; const f32x4 x1 = acc[ai][bj][m][0], x2 = acc[ai][bj][m][1];
                        const f32x4 c = *(const f32x4*)(ct + (size_t)row * tw + 4 * g), s = *(const f32x4*)(st + (size_t)row * tw + 4 * g);
                        const f32x4 o1 = x1 * c - x2 * s, o2 = x2 * c + x1 * s;
                        *(u32x2*)(base + (size_t)row * ld + col) = pack4(o1); *(u32x2*)(base + (size_t)row * ld + col + half) = pack4(o2); }
            } else if (tc0 < 2368) {
                const int col = tc0 - 2112;
#pragma unroll
                for (int ai = 0; ai < 2; ++ai)
#pragma unroll
                    for (int m = 0; m < 4; ++m) { const int row = row0 + ai * HALF + m * 16; *(u32x4*)(vs + (size_t)row * 256 + col) = pack8(acc[ai][bj][m][0], acc[ai][bj][m][1]); }
            }
        }
    }
};
struct EpiQ {
    static constexpr int MID_T = -1;
    static constexpr bool PERM = true;
    bf16_t* q; const float *partq, *cosm, *sinm;
    __device__ __forceinline__ void operator()(const f32x4 (&acc)[2][2][4][2], const Unit& u, int wr, int wc, int fr, int fq) const {
        const int row0 = u.pm * BM + wr * 64 + fr;
        float rs[2][4];
#pragma unroll
        for (int ai = 0; ai < 2; ++ai)
#pragma unroll
            for (int m = 0; m < 4; ++m) { const f32x4* p = (const f32x4*)(partq + (size_t)(row0 + ai * HALF + m * 16) * 16); const f32x4 s = (p[0] + p[1]) + (p[2] + p[3]);
                rs[ai][m] = 1.0f / sqrtf(((s[0] + s[1]) + (s[2] + s[3])) * (1.0f / 512.0f) + RMS_EPS); }
#pragma unroll
        for (int bj = 0; bj < 2; ++bj) {
            const int tc0 = u.aux * BM + bj * HALF + wc * 32 + fq * 8, head = tc0 / 192, j = tc0 - head * 192;
            if (j < 128) {
#pragma unroll
                for (int ai = 0; ai < 2; ++ai)
#pragma unroll
                    for (int m = 0; m < 4; ++m) { const int row = row0 + ai * HALF + m * 16; *(u32x4*)(q + (size_t)row * QCOLS + tc0) = pack8(acc[ai][bj][m][0] * rs[ai][m], acc[ai][bj][m][1] * rs[ai][m]); }
            } else {
                const int g = (j - 128) >> 3, col = head * 192 + 128 + 4 * g;
#pragma unroll
                for (int ai = 0; ai < 2; ++ai)
#pragma unroll
                    for (int m = 0; m < 4; ++m) { const int row = row0 + ai * HALF + m * 16; const f32x4 x1 = acc[ai][bj][m][0] * rs[ai][m], x2 = acc[ai][bj][m][1] * rs[ai][m];
                        const f32x4 c = *(const f32x4*)(cosm + (size_t)row * 32 + 4 * g), s = *(const f32x4*)(sinm + (size_t)row * 32 + 4 * g);
                        *(u32x2*)(q + (size_t)row * QCOLS + col) = pack4(x1 * c - x2 * s); *(u32x2*)(q + (size_t)row * QCOLS + col + 32) = pack4(x2 * c + x1 * s); }
            }
        }
    }
};
struct EpiKV {
    static constexpr int MID_T = -1;
    static constexpr bool PERM = true;
    bf16_t* kv; const float* partkv;
    __device__ __forceinline__ void operator()(const f32x4 (&acc)[2][2][4][2], const Unit& u, int wr, int wc, int fr, int fq) const {
        const int row0 = u.pm * BM + wr * 64 + fr;
#pragma unroll
        for (int ai = 0; ai < 2; ++ai)
#pragma unroll
            for (int m = 0; m < 4; ++m) { const int row = row0 + ai * HALF + m * 16; const f32x4* p = (const f32x4*)(partkv + (size_t)row * 8); const f32x4 s = p[0] + p[1];
                const float rs = 1.0f / sqrtf(((s[0] + s[1]) + (s[2] + s[3])) * (1.0f / 256.0f) + RMS_EPS);
#pragma unroll
                for (int bj = 0; bj < 2; ++bj) { const int col = u.aux * BM + bj * HALF + wc * 32 + fq * 8; *(u32x4*)(kv + (size_t)row * KVCOLS + col) = pack8(acc[ai][bj][m][0] * rs, acc[ai][bj][m][1] * rs); } }
    }
};
struct EpiResid {
    static constexpr int MID_T = -1;
    static constexpr bool PERM = true;
    const float* xin; float* y; float sc;
    __device__ __forceinline__ void operator()(const f32x4 (&acc)[2][2][4][2], const Unit& u, int wr, int wc, int fr, int fq) const {
        const int row0 = u.pm * BM + wr * 64 + fr;
#pragma unroll
        for (int ai = 0; ai < 2; ++ai)
#pragma unroll
            for (int m = 0; m < 4; ++m) { const size_t ro = (size_t)(row0 + ai * HALF + m * 16) * D;
#pragma unroll
                for (int bj = 0; bj < 2; ++bj) { const size_t o = ro + u.aux * BM + bj * HALF + wc * 32 + fq * 8;
                    const f32x4 a0 = *(const f32x4*)(xin + o), a1 = *(const f32x4*)(xin + o + 4);
                    *(f32x4*)(y + o) = a0 * ALPHA + acc[ai][bj][m][0] * sc; *(f32x4*)(y + o + 4) = a1 * ALPHA + acc[ai][bj][m][1] * sc; }
                asm volatile("" ::: "memory"); }
    }
};
struct EpiResidLN {
    static constexpr int MID_T = -1;
    static constexpr bool PERM = true, PROBE2 = false;
    const float* yin; float* y; float sc; const float* st; const float* g; const float* b;
    __device__ __forceinline__ void operator()(const f32x4 (&acc)[2][2][4][2], const Unit& u, int wr, int wc, int fr, int fq) const {
        const int row0 = u.pm * BM + wr * 64 + fr, col0 = u.aux * BM + wc * 32 + fq * 8;
        f32x4 gg[2][2], bb[2][2];
#pragma unroll
        for (int bj = 0; bj < 2; ++bj)
#pragma unroll
            for (int n = 0; n < 2; ++n) { gg[bj][n] = *(const f32x4*)(g + col0 + bj * HALF + 4 * n); bb[bj][n] = *(const f32x4*)(b + col0 + bj * HALF + 4 * n); }
#pragma unroll
        for (int ai = 0; ai < 2; ++ai)
#pragma unroll
            for (int m = 0; m < 4; ++m) { const int row = row0 + ai * HALF + m * 16; const size_t ro = (size_t)row * D; const float mu = st[2 * row], rs = st[2 * row + 1];
#pragma unroll
                for (int bj = 0; bj < 2; ++bj) { const size_t o = ro + col0 + bj * HALF;
                    const f32x4 a0 = *(const f32x4*)(yin + o), a1 = *(const f32x4*)(yin + o + 4);
                    const f32x4 x0 = (a0 - mu) * rs * gg[bj][0] + bb[bj][0], x1 = (a1 - mu) * rs * gg[bj][1] + bb[bj][1];
                    *(f32x4*)(y + o) = x0 * ALPHA + acc[ai][bj][m][0] * sc; *(f32x4*)(y + o + 4) = x1 * ALPHA + acc[ai][bj][m][1] * sc; }
                asm volatile("" ::: "memory"); }
    }
};
template <bool LNIN> struct EpiOutProj {
    static constexpr bool PERM = true, PROBE2 = false; static constexpr int MID_T = 16;
    const float* xin; float* y; const float* parto; const float* st; const float* g; const float* b;
    __device__ __forceinline__ void sums(int row, float& a, float& c) const { const f32x4* p = (const f32x4*)(parto + (size_t)row * 16); const f32x4 u = p[0] + p[1], v = p[2] + p[3];
        a = ((u[0] + u[1]) + (u[2] + u[3])) * (1.0f / 1024.0f) + RMS_EPS; c = ((v[0] + v[1]) + (v[2] + v[3])) * (1.0f / 1024.0f) + RMS_EPS; }
    __device__ __forceinline__ void mid(f32x4 (&acc)[2][2][4][2], const Unit& u, int wr, int wc, int fr, int fq) const {
        const int row0 = u.pm * BM + wr * 64 + fr;
#pragma unroll
        for (int ai = 0; ai < 2; ++ai)
#pragma unroll
            for (int m = 0; m < 4; ++m) { float a, c; sums(row0 + ai * HALF + m * 16, a, c); const float r = sqrtf(c / a);
#pragma unroll
                for (int bj = 0; bj < 2; ++bj) { acc[ai][bj][m][0] *= r; acc[ai][bj][m][1] *= r; } }
    }
    __device__ __forceinline__ void operator()(const f32x4 (&acc)[2][2][4][2], const Unit& u, int wr, int wc, int fr, int fq) const {
        const int row0 = u.pm * BM + wr * 64 + fr, col0 = u.aux * BM + wc * 32 + fq * 8;
        f32x4 gg[2][2], bb[2][2];
        if (LNIN) {
#pragma unroll
            for (int bj = 0; bj < 2; ++bj)
#pragma unroll
                for (int n = 0; n < 2; ++n) { gg[bj][n] = *(const f32x4*)(g + col0 + bj * HALF + 4 * n); bb[bj][n] = *(const f32x4*)(b + col0 + bj * HALF + 4 * n); }
        }
#pragma unroll
        for (int ai = 0; ai < 2; ++ai)
#pragma unroll
            for (int m = 0; m < 4; ++m) { const int row = row0 + ai * HALF + m * 16; const size_t ro = (size_t)row * D; float a, c; sums(row, a, c); const float rsw = 1.0f / sqrtf(c);
                float mu = 0.f, rs = 1.f; if (LNIN) { mu = st[2 * row]; rs = st[2 * row + 1]; }
#pragma unroll
                for (int bj = 0; bj < 2; ++bj) { const size_t o = ro + col0 + bj * HALF;
                    f32x4 x0 = *(const f32x4*)(xin + o), x1 = *(const f32x4*)(xin + o + 4);
                    if (LNIN) { x0 = (x0 - mu) * rs * gg[bj][0] + bb[bj][0]; x1 = (x1 - mu) * rs * gg[bj][1] + bb[bj][1]; }
                    *(f32x4*)(y + o) = x0 * ALPHA + acc[ai][bj][m][0] * rsw; *(f32x4*)(y + o + 4) = x1 * ALPHA + acc[ai][bj][m][1] * rsw; }
                asm volatile("" ::: "memory"); }
    }
};
struct EpiSwiglu8 {
    static constexpr int MID_T = -1;
    static constexpr bool PERM = true;
    unsigned char* h; int ldh; float sc;
    __device__ __forceinline__ void operator()(const f32x4 (&acc)[2][2][4][2], const Unit& u, int wr, int wc, int fr, int fq) const {
        const int row0 = u.pm * BM + wr * 64 + fr, col = u.aux * HALF + wc * 32 + fq * 8;
#pragma unroll
        for (int ai = 0; ai < 2; ++ai)
#pragma unroll
            for (int m = 0; m < 4; ++m) { f32x4 r0, r1;
#pragma unroll
                for (int k = 0; k < 4; ++k) { const float g0 = acc[ai][0][m][0][k] * sc, g1 = acc[ai][0][m][1][k] * sc;
                    r0[k] = __builtin_amdgcn_fmed3f(g0 * __builtin_amdgcn_rcpf(1.0f + __builtin_amdgcn_exp2f(-1.4426950408889634f * g0)) * (acc[ai][1][m][0][k] * (sc * H8_SCALE)), -448.f, 448.f);
                    r1[k] = __builtin_amdgcn_fmed3f(g1 * __builtin_amdgcn_rcpf(1.0f + __builtin_amdgcn_exp2f(-1.4426950408889634f * g1)) * (acc[ai][1][m][1][k] * (sc * H8_SCALE)), -448.f, 448.f); }
                u32x2 w; w.x = pk_fp8x4(r0[0], r0[1], r0[2], r0[3]); w.y = pk_fp8x4(r1[0], r1[1], r1[2], r1[3]);
                *(u32x2*)(h + (size_t)(row0 + ai * HALF + m * 16) * ldh + col) = w; }
    }
};
struct EpiSwiglu6 {
    static constexpr bool PERM = true, PROBE2 = false; static constexpr int MID_T = -1;
    unsigned char* h; int ldh;
    __device__ __forceinline__ void operator()(const f32x4 (&acc)[2][2][4][2], const Unit& u, int wr, int wc, int fr, int fq) const {
#pragma unroll
        for (int ai = 0; ai < 2; ++ai) {
            float v[4][8];
#pragma unroll
            for (int m = 0; m < 4; ++m)
#pragma unroll
                for (int c = 0; c < 8; ++c) { const float g = acc[ai][0][m][c >> 2][c & 3], uu = acc[ai][1][m][c >> 2][c & 3];
                    v[m][c] = g * __builtin_amdgcn_rcpf(1.0f + __builtin_amdgcn_exp2f(-1.4426950408889634f * g)) * uu; }
            float s1[2][2][8];
#pragma unroll
            for (int mm = 0; mm < 2; ++mm)
#pragma unroll
                for (int c = 0; c < 8; ++c) { auto r = __builtin_amdgcn_permlane32_swap(__float_as_uint(v[mm][c]), __float_as_uint(v[mm + 2][c]), false, false);
                    s1[mm][0][c] = __uint_as_float(r[0]); s1[mm][1][c] = __uint_as_float(r[1]); }
            f32x16 lo, hi;
#pragma unroll
            for (int hh = 0; hh < 2; ++hh)
#pragma unroll
                for (int c = 0; c < 8; ++c) { auto r = __builtin_amdgcn_permlane16_swap(__float_as_uint(s1[0][hh][c]), __float_as_uint(s1[1][hh][c]), false, false);
                    if (hh == 0) { lo[c] = __uint_as_float(r[0]); lo[8 + c] = __uint_as_float(r[1]); } else { hi[c] = __uint_as_float(r[0]); hi[8 + c] = __uint_as_float(r[1]); } }
            unsigned sb; const u32x6 q = mx6_block(lo, hi, sb);
            unsigned char* o = h + (size_t)(u.pm * BM + ai * HALF + wr * 64 + fq * 16 + fr) * ldh + u.aux * 128 + 16 * wc;
            *(u32x4*)o = (u32x4){q[0], q[1], q[2], q[3]}; *(u32x4*)(o + 64) = (u32x4){q[4], q[5], sb, 0u};
        }
    }
};
struct EpiBf16Out {
    static constexpr int MID_T = -1;
    static constexpr bool PERM = true;
    bf16_t* o; int ld; float sc;
    __device__ __forceinline__ void operator()(const f32x4 (&acc)[2][2][4][2], const Unit& u, int wr, int wc, int fr, int fq) const {
        const int row0 = u.pm * BM + wr * 64 + fr;
#pragma unroll
        for (int ai = 0; ai < 2; ++ai)
#pragma unroll
            for (int m = 0; m < 4; ++m)
#pragma unroll
                for (int bj = 0; bj < 2; ++bj) *(u32x4*)(o + (size_t)(row0 + ai * HALF + m * 16) * ld + u.aux * BM + bj * HALF + wc * 32 + fq * 8) = pack8(acc[ai][bj][m][0] * sc, acc[ai][bj][m][1] * sc);
    }
};
struct EpiBf16OutK {
    static constexpr int MID_T = -1;
    static constexpr bool PERM = true;
    bf16_t* o; bf16_t* yp;
    __device__ __forceinline__ void operator()(const f32x4 (&acc)[2][2][4][2], const Unit& u, int wr, int wc, int fr, int fq) const {
        bf16_t* base; int ld;
        if (u.kx) { base = yp + ((size_t)(((u.kx >> 8) & 255) * 128 + (u.kx & 255) - 1) * 256 + wr * 64 + fr) * 256; ld = 256; }
        else { base = o + (size_t)(u.pm * BM + wr * 64 + fr) * D + u.aux * BM; ld = D; }
#pragma unroll
        for (int ai = 0; ai < 2; ++ai)
#pragma unroll
            for (int m = 0; m < 4; ++m)
#pragma unroll
                for (int bj = 0; bj < 2; ++bj) *(u32x4*)(base + (size_t)(ai * HALF + m * 16) * ld + bj * HALF + wc * 32 + fq * 8) = pack8(acc[ai][bj][m][0], acc[ai][bj][m][1]);
    }
};
}

namespace att {
constexpr int NW = 8, QBLK = 32, KVBLK = 64;
constexpr float THR = 8.f;
constexpr int SHM_V = KVBLK * 128 * 2, SHM_K = KVBLK * 272, SHM_P = KVBLK * 144;
constexpr int OFF_V = 0, OFF_K = 3 * SHM_V, OFF_P = OFF_K + 2 * SHM_K,     OFF_WS = OFF_P + 2 * SHM_P, OFF_QP = OFF_WS + NW * 64 * 4, SHM_ATTN = OFF_QP + NW * 4096;
typedef LAS const char* lptr;
typedef short v4i16_t __attribute__((ext_vector_type(4)));
#define SBAR() __builtin_amdgcn_sched_barrier(0)
#define PIN(x) asm volatile("" : "+v"(x))
__device__ __forceinline__ int crow(int r, int hi) { return (r & 3) + 8 * (r >> 2) + 4 * hi; }
__device__ __forceinline__ bf16x8 ldk(lptr p) { return *(const LAS bf16x8*)p; }
__device__ __forceinline__ s16x4 vtr(lptr p) { return __builtin_bit_cast(s16x4, __builtin_amdgcn_ds_read_tr16_b64_v4i16((LAS v4i16_t*)p)); }
__device__ __forceinline__ int v_st(int k, int c) { const int kk = (k & ~0xC) | ((k & 4) << 1) | ((k & 8) >> 1); return ((kk >> 3) * 4 + (c >> 5)) * 512 + ((kk & 7) * 32 + (c & 31)) * 2; }
__device__ __forceinline__ int v_rd_base(int lane) { return ((lane & 3) << 3) | (((lane >> 2) & 3) << 6) | (((lane >> 4) & 1) << 5) | (((lane >> 5) & 1) << 8); }
__device__ __forceinline__ bf16x8 pk4(float a0, float a1, float a2, float a3, float a4, float a5, float a6, float a7) {
  const unsigned x0 = cvt_pk_bf16(a0, a1), x1 = cvt_pk_bf16(a2, a3), y0 = cvt_pk_bf16(a4, a5), y1 = cvt_pk_bf16(a6, a7);
  auto r0 = __builtin_amdgcn_permlane32_swap(x0, y0, false, false); auto r1 = __builtin_amdgcn_permlane32_swap(x1, y1, false, false);
  u32x4 w = {r0[0], r1[0], r0[1], r1[1]}; return __builtin_bit_cast(bf16x8, w);
}
constexpr int PD = 4;
template <int NQ>
__device__ __forceinline__ bf16x8 kfrag(lptr kb, lptr pb, int n) { const int d0 = n >> 1, h = n & 1; return d0 < 8 ? ldk(kb + h * (32 * 272) + d0 * 32) : ldk(pb + h * (32 * 144) + (d0 - 8) * 32); }
template <int NQ, bool DO_QK, bool DO_FIN>
__device__ __forceinline__ void phaseA(f32x16& C0, f32x16& C1, const f32x16& P0, const f32x16& P1, float alphaP, float& l_reg, bf16x8 (&pa)[4],
                                       lptr kb, lptr pb, lptr qp, const bf16x8 (&qr)[8]) {
  constexpr int NF = 2 * NQ;
  float s0 = 0.f, s1 = 0.f, s2 = 0.f, s3 = 0.f;
  bf16x8 f[NF + PD]; bf16x8 qx[NQ > 8 ? NQ - 8 : 1];
  if (DO_QK) {
#pragma unroll
    for (int n = 0; n < PD; ++n) f[n] = kfrag<NQ>(kb, pb, n);
  }
#pragma unroll
  for (int n = 0; n < NF; ++n) {
    if (DO_QK) {
      const int d0 = n >> 1;
      if (n + PD < NF) f[n + PD] = kfrag<NQ>(kb, pb, n + PD);
      if (NQ > 8) { const int dq = (n + PD) >> 1; if (((n + PD) & 1) == 0 && dq >= 8 && dq < NQ) qx[dq - 8 < 0 ? 0 : dq - 8] = ldk(qp + (dq - 8) * 1024); }
      const bf16x8 qf = (d0 < 8) ? qr[d0 < 8 ? d0 : 0] : qx[d0 >= 8 ? d0 - 8 : 0];
      if (n == 0)            C0 = __builtin_amdgcn_mfma_f32_32x32x16_bf16(f[n], qf, f32x16{}, 0, 0, 0);
      else if (n == 1)       C1 = __builtin_amdgcn_mfma_f32_32x32x16_bf16(f[n], qf, f32x16{}, 0, 0, 0);
      else if ((n & 1) == 0) C0 = __builtin_amdgcn_mfma_f32_32x32x16_bf16(f[n], qf, C0, 0, 0, 0);
      else                   C1 = __builtin_amdgcn_mfma_f32_32x32x16_bf16(f[n], qf, C1, 0, 0, 0);
    }
    if (DO_FIN) {
#pragma unroll
      for (int e = n * 32 / NF; e < (n + 1) * 32 / NF; ++e) { const float v = e < 16 ? P0[e & 15] : P1[e & 15]; if ((e & 3) == 0) s0 += v; else if ((e & 3) == 1) s1 += v; else if ((e & 3) == 2) s2 += v; else s3 += v; }
      PIN(s0); PIN(s1); PIN(s2); PIN(s3);
      if (n == NF / 8)     { pa[0] = pk4(P0[0], P0[1], P0[2], P0[3], P0[4], P0[5], P0[6], P0[7]); PIN(pa[0]); }
      if (n == 3 * NF / 8) { pa[1] = pk4(P0[8], P0[9], P0[10], P0[11], P0[12], P0[13], P0[14], P0[15]); PIN(pa[1]); }
      if (n == 5 * NF / 8) { pa[2] = pk4(P1[0], P1[1], P1[2], P1[3], P1[4], P1[5], P1[6], P1[7]); PIN(pa[2]); }
      if (n == 7 * NF / 8) { pa[3] = pk4(P1[8], P1[9], P1[10], P1[11], P1[12], P1[13], P1[14], P1[15]); PIN(pa[3]); }
    }
    SBAR();
  }
  if (DO_FIN) { float ps = (s0 + s1) + (s2 + s3); auto rr = __builtin_amdgcn_permlane32_swap(__float_as_uint(ps), __float_as_uint(ps), false, false);
    ps = __uint_as_float(rr[0]) + __uint_as_float(rr[1]); l_reg = l_reg * alphaP + ps; }
}
template <bool MASK, bool DO_PV, bool DO_SM>
__device__ __forceinline__ void phaseB(f32x16 (&o)[4], const bf16x8 (&pa)[4], f32x16& C0, f32x16& C1, float& m_reg, float& alpha, lptr vb, float Cs, float thr_raw, int qi, int k0, int hi) {
  s16x4 vl[16 + PD], vh[16 + PD];
  if (DO_PV) {
#pragma unroll
    for (int n = 0; n < PD; ++n) { const int d0 = n & 3, ks = n >> 2; vl[n] = vtr(vb + d0 * 512 + ks * 4096); vh[n] = vtr(vb + d0 * 512 + ks * 4096 + 2048); }
  }
  float mx = -3.0e38f, mnC = 0.f;
#pragma unroll
  for (int n = 0; n < 16; ++n) {
    if (DO_PV) {
      const int d0 = n & 3, ks = n >> 2;
      if (n + PD < 16) { const int d1 = (n + PD) & 3, k1 = (n + PD) >> 2; vl[n + PD] = vtr(vb + d1 * 512 + k1 * 4096); vh[n + PD] = vtr(vb + d1 * 512 + k1 * 4096 + 2048); }
      const bf16x8 vf = (bf16x8){vl[n][0], vl[n][1], vl[n][2], vl[n][3], vh[n][0], vh[n][1], vh[n][2], vh[n][3]};
      o[d0] = __builtin_amdgcn_mfma_f32_32x32x16_bf16(pa[ks], vf, o[d0], 0, 0, 0);
    }
    if (DO_SM) {
      if (n < 4) {
#pragma unroll
        for (int e = n * 8; e < n * 8 + 8; ++e) {
          if (MASK) { const int d = qi - (k0 + (e < 16 ? 0 : 32) + crow(e & 15, hi)); if (d > 128 || d < -128) { if (e < 16) C0[e & 15] = -1e30f; else C1[e & 15] = -1e30f; } }
          mx = fmaxf(mx, e < 16 ? C0[e & 15] : C1[e & 15]); }
        PIN(mx);
      } else if (n == 4) {
        auto rr = __builtin_amdgcn_permlane32_swap(__float_as_uint(mx), __float_as_uint(mx), false, false);
        const float pmax = fmaxf(__uint_as_float(rr[0]), __uint_as_float(rr[1]));
        const bool keep = __all(pmax - m_reg <= thr_raw);
        const float mn = keep ? m_reg : fmaxf(m_reg, pmax);
        alpha = __builtin_amdgcn_exp2f((m_reg - mn) * Cs); m_reg = mn; mnC = -mn * Cs; PIN(alpha); PIN(mnC);
      } else {
#pragma unroll
        for (int e = (n - 5) * 32 / 11; e < (n - 4) * 32 / 11; ++e) {
          if (e < 16) C0[e] = __builtin_amdgcn_exp2f(fmaf(C0[e], Cs, mnC)); else C1[e - 16] = __builtin_amdgcn_exp2f(fmaf(C1[e - 16], Cs, mnC)); }
        if ((n - 5) * 32 / 11 < 16) PIN(C0); if ((n - 4) * 32 / 11 > 16) PIN(C1);
      }
    }
    SBAR();
  }
}

template <int DQK, bool MASK, int LDQ, int LDK, int LDP, int LDV, int LDO>
__device__ __forceinline__ void attn_body(const bf16_t* __restrict__ Qb, const bf16_t* __restrict__ Kb, const bf16_t* __restrict__ Pb, const bf16_t* __restrict__ Vb,
                                          bf16_t* __restrict__ Ob, float* __restrict__ ssq, int q0, int kstart, int NT, float scale, float sink_raw, LAS char* lds) {
  constexpr int NQ = DQK / 16;
  const float Cs = scale * 1.4426950408889634f, thr_raw = THR / scale;
  const int tid = tid_opaque(), wid = tid >> 6, lane = tid & 63, r32 = lane & 31, hi = lane >> 5;
  LAS char* V_lds = lds + OFF_V; LAS char* K_lds = lds + OFF_K; LAS char* P_lds = lds + OFF_P;
  LAS float* ws = (LAS float*)(lds + OFF_WS) + wid * 64; LAS float* li_l = ws; LAS float* al_l = ws + 32;
  float m_reg = MASK ? sink_raw : -1e30f, l_reg = MASK ? 1.f : 0.f; f32x16 o[4] = {}; bf16x8 qr[8];
  const bf16_t* Qw = Qb + (long)(wid * QBLK + r32) * LDQ + hi * 8;
  LAS char* Qp = lds + OFF_QP + wid * 4096 + lane * 16;
#pragma unroll
  for (int d0 = 0; d0 < 8; ++d0) qr[d0] = *reinterpret_cast<const bf16x8*>(Qw + d0 * 16);
  if (NQ > 8) {
#pragma unroll
    for (int d0 = 0; d0 < NQ - 8; ++d0) *(LAS bf16x8*)(Qp + d0 * 1024) = *reinterpret_cast<const bf16x8*>(Qw + 128 + d0 * 16);
  }
  const int sr = tid >> 4, sc = (tid & 15) * 8, vst0 = v_st(sr, sc), vst1 = v_st(32 + sr, sc);
  const int pr = tid >> 3, pc = (tid & 7) * 8;
  const lptr kb0 = (lptr)K_lds + r32 * 272 + hi * 16, pb0 = (lptr)P_lds + r32 * 144 + hi * 16, vb0 = (lptr)V_lds + v_rd_base(lane);
  const int qi = q0 + wid * QBLK + r32;
  bf16x8 vs0, vs1, ks0, ks1, ps0;
  const unsigned voff0 = sr * LDV + sc, voff1 = (32 + sr) * LDV + sc, koff0 = sr * LDK + sc, koff1 = (32 + sr) * LDK + sc, poff = pr * LDP + pc;
#define SLOAD(k0) do { const bf16_t* Vt = Vb + (long)(k0) * LDV; const bf16_t* Kt = Kb + (long)(k0) * LDK; \
    vs0 = *reinterpret_cast<const bf16x8*>(Vt + voff0); vs1 = *reinterpret_cast<const bf16x8*>(Vt + voff1); \
    ks0 = *reinterpret_cast<const bf16x8*>(Kt + koff0); ks1 = *reinterpret_cast<const bf16x8*>(Kt + koff1); \
    if (NQ > 8) { const bf16_t* Pt = Pb + (long)(k0) * LDP; ps0 = *reinterpret_cast<const bf16x8*>(Pt + poff); } } while (0)
#define SWRITE(kb_, vo_) do { *(LAS bf16x8*)(V_lds + (vo_) + vst0) = vs0; *(LAS bf16x8*)(V_lds + (vo_) + vst1) = vs1; \
    *(LAS bf16x8*)(K_lds + (kb_) * SHM_K + sr * 272 + sc * 2) = ks0; *(LAS bf16x8*)(K_lds + (kb_) * SHM_K + (32 + sr) * 272 + sc * 2) = ks1; \
    if (NQ > 8) *(LAS bf16x8*)(P_lds + (kb_) * SHM_P + pr * 144 + pc * 2) = ps0; } while (0)
#define SWAIT() asm volatile("s_waitcnt vmcnt(0)" ::: "memory")
#define RESC(a) do { if (__any((a) < 1.f)) { if (hi == 0) al_l[r32] = (a); asm volatile("s_waitcnt lgkmcnt(0)" ::: "memory"); \
    _Pragma("unroll") for (int d = 0; d < 4; ++d) _Pragma("unroll") for (int r = 0; r < 16; ++r) o[d][r] *= al_l[crow(r, hi)]; } } while (0)
#define ROTV() do { const int t_ = vprev; vprev = vcur; vcur = vnext; vnext = t_; } while (0)
  f32x16 pA0, pA1, pB0, pB1; float alA = 1.f, alB = 1.f; bf16x8 pa[4];
  int vprev = 0, vcur = SHM_V, vnext = 2 * SHM_V;
  SLOAD(kstart); SWAIT(); SWRITE(0, 0); __syncthreads();
  SLOAD(kstart + KVBLK);
  phaseA<NQ, true, false>(pA0, pA1, pA0, pA1, 1.f, l_reg, pa, kb0, pb0, (lptr)Qp, qr);
  SWAIT(); SWRITE(1, SHM_V);
  phaseB<MASK, false, true>(o, pa, pA0, pA1, m_reg, alA, vb0, Cs, thr_raw, qi, kstart, hi);
  __syncthreads();
  for (int j = 1; j + 1 < NT; j += 2) {
    SBAR(); SLOAD(kstart + (j + 1) * KVBLK); SBAR();
    phaseA<NQ, true, true>(pB0, pB1, pA0, pA1, alA, l_reg, pa, kb0 + SHM_K, pb0 + SHM_P, (lptr)Qp, qr);
    SWAIT(); SWRITE(0, vnext);
    phaseB<MASK, true, true>(o, pa, pB0, pB1, m_reg, alB, vb0 + vprev, Cs, thr_raw, qi, kstart + j * KVBLK, hi);
    RESC(alB); ROTV(); __syncthreads();
    SBAR(); if (j + 2 < NT) SLOAD(kstart + (j + 2) * KVBLK); SBAR();
    phaseA<NQ, true, true>(pA0, pA1, pB0, pB1, alB, l_reg, pa, kb0, pb0, (lptr)Qp, qr);
    if (j + 2 < NT) { SWAIT(); SWRITE(1, vnext); }
    phaseB<MASK, true, true>(o, pa, pA0, pA1, m_reg, alA, vb0 + vprev, Cs, thr_raw, qi, kstart + (j + 1) * KVBLK, hi);
    RESC(alA); ROTV(); __syncthreads();
  }
  SBAR(); phaseA<NQ, true, true>(pB0, pB1, pA0, pA1, alA, l_reg, pa, kb0 + SHM_K, pb0 + SHM_P, (lptr)Qp, qr);
  phaseB<MASK, true, true>(o, pa, pB0, pB1, m_reg, alB, vb0 + vprev, Cs, thr_raw, qi, kstart + (NT - 1) * KVBLK, hi);
  RESC(alB); ROTV();
  phaseA<NQ, false, true>(pA0, pA1, pB0, pB1, alB, l_reg, pa, kb0, pb0, (lptr)Qp, qr);
  phaseB<MASK, true, false>(o, pa, pA0, pA1, m_reg, alA, vb0 + vprev, Cs, thr_raw, qi, 0, hi);
  if (hi == 0) li_l[r32] = l_reg; asm volatile("s_waitcnt lgkmcnt(0)" ::: "memory");
  bf16_t* Ow = Ob + (long)(wid * QBLK) * LDO;
#pragma unroll
  for (int r = 0; r < 16; ++r) { const int orow = crow(r, hi); const float rl = __builtin_amdgcn_rcpf(li_l[orow]); float sq = 0.f;
#pragma unroll
    for (int d0 = 0; d0 < 4; ++d0) { const float v = o[d0][r] * rl; sq += v * v; Ow[(long)orow * LDO + d0 * 32 + r32] = (bf16_t)(cvt_pk_bf16(v, v) & 0xffffu); }
#pragma unroll
    for (int s = 1; s < 32; s <<= 1) sq += __shfl_xor(sq, s);
    if (r32 == 0) ssq[(long)(wid * QBLK + orow) * 16] = sq; }
  __syncthreads();
#undef SLOAD
#undef SWRITE
#undef SWAIT
#undef RESC
#undef ROTV
}
#undef SBAR
#undef PIN
}

constexpr int NWAVES = 8;
#ifndef PROBE_ATT
#define PROBE_ATT 1
#endif
#ifndef PROBE_PRO
#define PROBE_PRO 1
#endif
#ifndef PROBE_MOEUP
#define PROBE_MOEUP 1
#endif
constexpr int RING_BYTES = 133120;
constexpr int MISC_OFF = 139264, LDS_BYTES = 147456;
static_assert(att::SHM_ATTN <= MISC_OFF && RING_BYTES <= MISC_OFF, "LDS map");
constexpr int NPHASE = 21;

__device__ const float INVF[64] = {
 1.000000000e+00f, 8.659643531e-01f, 7.498942018e-01f, 6.493816376e-01f, 5.623413324e-01f, 4.869675338e-01f, 4.216965139e-01f, 3.651741147e-01f, 3.162277639e-01f, 2.738419771e-01f, 2.371373773e-01f, 2.053525001e-01f, 1.778279394e-01f, 1.539926529e-01f, 1.333521456e-01f, 1.154781953e-01f,
 1.000000015e-01f, 8.659642935e-02f, 7.498942316e-02f, 6.493816525e-02f, 5.623413250e-02f, 4.869675264e-02f, 4.216964915e-02f, 3.651741147e-02f, 3.162277490e-02f, 2.738419548e-02f, 2.371373773e-02f, 2.053525113e-02f, 1.778279431e-02f, 1.539926510e-02f, 1.333521400e-02f, 1.154781971e-02f,
 9.999999776e-03f, 8.659643121e-03f, 7.498942316e-03f, 6.493816152e-03f, 5.623413250e-03f, 4.869675264e-03f, 4.216964822e-03f, 3.651741194e-03f, 3.162277630e-03f, 2.738419687e-03f, 2.371373819e-03f, 2.053525066e-03f, 1.778279431e-03f, 1.539926510e-03f, 1.333521446e-03f, 1.154782018e-03f,
 1.000000047e-03f, 8.659643354e-04f, 7.498941850e-04f, 6.493816036e-04f, 5.623413017e-04f, 4.869675322e-04f, 4.216965172e-04f, 3.651741135e-04f, 3.162277571e-04f, 2.738419571e-04f, 2.371373703e-04f, 2.053525095e-04f, 1.778279402e-04f, 1.539926598e-04f, 1.333521504e-04f, 1.154782003e-04f };

struct Args { const float* in[21]; float* out; unsigned char* ws; int ph_lo, ph_hi; };

__device__ __forceinline__ float wave_sum(float v) {
#pragma unroll
    for (int o = 1; o < 64; o <<= 1) v += __shfl_xor(v, o);
    return v;
}
__device__ __forceinline__ void sincos_acc(float ang, float& sn, float& cs) {
    const double a = (double)ang;
    const double n = __builtin_rint(a * 0.63661977236758134308);
    double r = __builtin_fma(-n, 1.57079632679489655800, a); r = __builtin_fma(-n, 6.12323399573676603587e-17, r);
    const double r2 = r * r;
    double sp = 1.0 / 6227020800.0; sp = __builtin_fma(sp, r2, -1.0 / 39916800.0); sp = __builtin_fma(sp, r2, 1.0 / 362880.0); sp = __builtin_fma(sp, r2, -1.0 / 5040.0);
    sp = __builtin_fma(sp, r2, 1.0 / 120.0); sp = __builtin_fma(sp, r2, -1.0 / 6.0); sp = __builtin_fma(sp * r2, r, r);
    double cp = 1.0 / 479001600.0; cp = __builtin_fma(cp, r2, -1.0 / 3628800.0); cp = __builtin_fma(cp, r2, 1.0 / 40320.0); cp = __builtin_fma(cp, r2, -1.0 / 720.0);
    cp = __builtin_fma(cp, r2, 1.0 / 24.0); cp = __builtin_fma(cp, r2, -0.5); cp = __builtin_fma(cp, r2, 1.0);
    const int q = ((int)n) & 3;
    const double s_ = (q & 1) ? cp : sp, c_ = (q & 1) ? sp : cp;
    sn = (float)((q & 2) ? -s_ : s_); cs = (float)(((q + 1) & 2) ? -c_ : c_);
}

__device__ __forceinline__ int src_quad(int kind, int n, int coff) {
    if (kind == 0) return coff + n;
    if (kind == 1) {
        if (n < 768 || (n >= 2112 && n < 2368)) return n;
        if (n >= 2368) return -1;
        int base, half, j;
        if (n < 832) { base = 768; half = 32; j = n - 768; } else if (n < 1856) { j = (n - 832) & 127; base = n - j; half = 64; } else { j = (n - 1856) & 127; base = n - j; half = 64; }
        const int g = j >> 3, e = j & 7; return base + (e < 4 ? 4 * g : half + 4 * g);
    }
    { const int head = n / 192, j = n - head * 192; if (j < 128) return n; const int jj = j - 128, g = jj >> 3, e = jj & 7; return head * 192 + 128 + (e < 4 ? 4 * g : 32 + 4 * g); }
}
__device__ __forceinline__ void tr_item(const float* __restrict__ src, int Nsrc, int K, bf16_t* __restrict__ dst, int k0, int n0, int kind, int coff,
                                        const float* __restrict__ gain, const float* __restrict__ gain2, LAS unsigned* scr, int lane) {
    const int nl = 4 * (lane & 15), ks = lane >> 4;
    const int sq = src_quad(kind, n0 + nl, coff);
#pragma unroll 4
    for (int r = 0; r < 16; ++r) {
        const int k = k0 + 8 * r + 2 * ks;
        f32x4 a = (f32x4){0.f, 0.f, 0.f, 0.f}, b = a;
        if (sq >= 0) { a = *(const f32x4*)(src + (size_t)k * Nsrc + sq); b = *(const f32x4*)(src + (size_t)(k + 1) * Nsrc + sq); }
        if (gain) { const float ga = (gain2 && k >= 1024) ? gain2[k - 1024] : gain[k], gb = (gain2 && k + 1 >= 1024) ? gain2[k + 1 - 1024] : gain[k + 1]; a *= ga; b *= gb; }
#pragma unroll
        for (int j = 0; j < 4; ++j) scr[(nl + j) * 65 + 4 * r + ks] = cvt_pk_bf16(a[j], b[j]);
    }
    asm volatile("s_waitcnt lgkmcnt(0)" ::: "memory");
#pragma unroll 4
    for (int it = 0; it < 16; ++it) {
        const int row = it * 4 + (lane >> 4), ch = lane & 15;
        const LAS unsigned* p = scr + row * 65 + 4 * ch;
        u32x4 w; w.x = p[0]; w.y = p[1]; w.z = p[2]; w.w = p[3];
        *(u32x4*)(dst + (size_t)(n0 + row) * K + k0 + 8 * ch) = w;
    }
    asm volatile("s_waitcnt lgkmcnt(0)" ::: "memory");
}
__device__ __forceinline__ void tr_item8(const float* __restrict__ src, int Nsrc, int K, unsigned char* __restrict__ dst, int k0, int n0, int scol, float scale, LAS unsigned* scr, int lane) {
    const int nl = 4 * (lane & 15), ks = lane >> 4;
#pragma unroll 4
    for (int r = 0; r < 16; ++r) {
        const int k = k0 + 16 * r + 4 * ks; const float* p = src + (size_t)k * Nsrc + scol + nl;
        const f32x4 a = *(const f32x4*)p * scale, b = *(const f32x4*)(p + Nsrc) * scale, c = *(const f32x4*)(p + 2 * (size_t)Nsrc) * scale, d = *(const f32x4*)(p + 3 * (size_t)Nsrc) * scale;
#pragma unroll
        for (int j = 0; j < 4; ++j) scr[(nl + j) * 65 + 4 * r + ks] = pk_fp8x4(a[j], b[j], c[j], d[j]);
    }
    asm volatile("s_waitcnt lgkmcnt(0)" ::: "memory");
#pragma unroll 4
    for (int it = 0; it < 16; ++it) {
        const int row = it * 4 + (lane >> 4), ch = lane & 15;
        const LAS unsigned* p = scr + row * 65 + 4 * ch;
        u32x4 w; w.x = p[0]; w.y = p[1]; w.z = p[2]; w.w = p[3];
        *(u32x4*)(dst + (size_t)(n0 + row) * K + k0 + 16 * ch) = w;
    }
    asm volatile("s_waitcnt lgkmcnt(0)" ::: "memory");
}
__device__ __forceinline__ void tr_item6(const float* __restrict__ src, int Nsrc, unsigned char* __restrict__ dst, int t, int n0, int scol, LAS unsigned* scr, int lane) {
    const int nl = 4 * (lane & 15), ks = lane >> 4;
    f32x4 a[16], b[16];
#pragma unroll
    for (int r = 0; r < 16; ++r) {
        const int kk = 8 * r + 2 * ks, k = 16 * t + 256 * (kk >> 4) + (kk & 15); const float* p = src + (size_t)k * Nsrc + scol + nl;
        a[r] = __builtin_nontemporal_load((const f32x4*)p); b[r] = __builtin_nontemporal_load((const f32x4*)(p + Nsrc));
    }
#pragma unroll
    for (int r = 0; r < 16; ++r) {
#pragma unroll
        for (int j = 0; j < 4; ++j) scr[(nl + j) * 65 + 4 * r + ks] = cvt_pk_bf16(a[r][j], b[r][j]);
    }
    asm volatile("s_waitcnt lgkmcnt(0)" ::: "memory");
#pragma unroll 1
    for (int it = 0; it < 4; ++it) {
        const int pidx = it * 64 + lane, n = pidx >> 2, g = pidx & 3;
        const LAS unsigned* p = scr + n * 65 + 2 * g;
        f32x16 lo, hi;
#pragma unroll
        for (int j = 0; j < 8; ++j) { const unsigned d0 = p[8 * j], d1 = p[8 * j + 1];
            const float x0 = __uint_as_float(d0 << 16), x1 = __uint_as_float(d0 & 0xffff0000u), x2 = __uint_as_float(d1 << 16), x3 = __uint_as_float(d1 & 0xffff0000u);
            if (j < 4) { lo[4 * j] = x0; lo[4 * j + 1] = x1; lo[4 * j + 2] = x2; lo[4 * j + 3] = x3; } else { hi[4 * (j - 4)] = x0; hi[4 * (j - 4) + 1] = x1; hi[4 * (j - 4) + 2] = x2; hi[4 * (j - 4) + 3] = x3; } }
        unsigned sb; const u32x6 q = mx6_block(lo, hi, sb);
        unsigned char* o = dst + (size_t)(n0 + n) * 2048 + t * 128 + 16 * g;
        *(u32x4*)o = (u32x4){q[0], q[1], q[2], q[3]}; *(u32x4*)(o + 64) = (u32x4){q[4], q[5], sb, 0u};
    }
    asm volatile("s_waitcnt lgkmcnt(0)" ::: "memory");
}
__device__ __forceinline__ void tr_item6c(const float* __restrict__ src, int Nsrc, int K, unsigned char* __restrict__ dst, int t, int n0, LAS unsigned* scr, int lane) {
    const int nl = 4 * (lane & 15), ks = lane >> 4;
    f32x4 a[16], b[16];
#pragma unroll
    for (int r = 0; r < 16; ++r) {
        const int k = 128 * t + 8 * r + 2 * ks; const float* p = src + (size_t)k * Nsrc + n0 + nl;
        a[r] = __builtin_nontemporal_load((const f32x4*)p); b[r] = __builtin_nontemporal_load((const f32x4*)(p + Nsrc));
    }
#pragma unroll
    for (int r = 0; r < 16; ++r) {
#pragma unroll
        for (int j = 0; j < 4; ++j) scr[(nl + j) * 65 + 4 * r + ks] = cvt_pk_bf16(a[r][j], b[r][j]);
    }
    asm volatile("s_waitcnt lgkmcnt(0)" ::: "memory");
#pragma unroll 1
    for (int it = 0; it < 4; ++it) {
        const int pidx = it * 64 + lane, n = pidx >> 2, g = pidx & 3;
        const LAS unsigned* p = scr + n * 65 + 16 * g;
        f32x16 lo, hi;
#pragma unroll
        for (int j = 0; j < 8; ++j) { const unsigned d0 = p[j], d1 = p[8 + j];
            lo[2 * j] = __uint_as_float(d0 << 16); lo[2 * j + 1] = __uint_as_float(d0 & 0xffff0000u); hi[2 * j] = __uint_as_float(d1 << 16); hi[2 * j + 1] = __uint_as_float(d1 & 0xffff0000u); }
        unsigned sb; const u32x6 q = mx6_block(lo, hi, sb);
        unsigned char* o = dst + (size_t)(n0 + n) * K + t * 128 + 16 * g;
        *(u32x4*)o = (u32x4){q[0], q[1], q[2], q[3]}; *(u32x4*)(o + 64) = (u32x4){q[4], q[5], sb, 0u};
    }
    asm volatile("s_waitcnt lgkmcnt(0)" ::: "memory");
}
__device__ __forceinline__ void tr_matrix6c(const float* src, int Nsrc, int K, unsigned char* dst, int Ndst, LAS unsigned* scr, int lane, int gw, int NGW, int& cursor) {
    const int nb = Ndst / 64, items = (K / 128) * nb;
    int it = (gw - (cursor % NGW) + NGW) % NGW;
    for (; it < items; it += NGW) tr_item6c(src, Nsrc, K, dst, it / nb, (it % nb) * 64, scr, lane);
    cursor += items;
}
__device__ __forceinline__ void tr_matrix6(const float* src, const float* src2, int Nsrc, unsigned char* dst, int Ndst, LAS unsigned* scr, int lane, int gw, int NGW, int& cursor) {
    const int nb = Ndst / 64, items = 16 * nb;
    int it = (gw - (cursor % NGW) + NGW) % NGW;
    for (; it < items; it += NGW) {
        const int t = it / nb, n0 = (it % nb) * 64, tile = n0 >> 8, j0 = n0 & 255;
        tr_item6(j0 < 128 ? src : src2, Nsrc, dst, t, n0, 128 * tile + (j0 & 127), scr, lane);
    }
    cursor += items;
}
__device__ __forceinline__ void tr_matrix8(const float* src, const float* src2, int Nsrc, int K, unsigned char* dst, int Ndst, int inter, float scale, LAS unsigned* scr, int lane, int gw, int NGW, int& cursor) {
    const int nb = Ndst / 64, items = (K / 256) * nb;
    int it = (gw - (cursor % NGW) + NGW) % NGW;
    for (; it < items; it += NGW) {
        const int kb = it / nb, n0 = (it % nb) * 64;
        if (inter) { const int tile = n0 >> 8, j0 = n0 & 255; tr_item8(j0 < 128 ? src : src2, Nsrc, K, dst, kb * 256, n0, 128 * tile + (j0 & 127), scale, scr, lane); }
        else tr_item8(src, Nsrc, K, dst, kb * 256, n0, n0, scale, scr, lane);
    }
    cursor += items;
}
__device__ __forceinline__ void tr_matrix(const float* src, const float* src2, int Nsrc, int K, bf16_t* dst, int Ndst, int kind, const float* gain, const float* gain2,
                                          LAS unsigned* scr, int lane, int gw, int NGW, int& cursor) {
    const int nb = Ndst / 64, items = (K / 128) * nb;
    int it = (gw - (cursor % NGW) + NGW) % NGW;
    for (; it < items; it += NGW) {
        const int kb = it / nb, n0 = (it % nb) * 64;
        if (kind == 3) { const int tile = n0 >> 8, j0 = n0 & 255; tr_item(j0 < 128 ? src : src2, Nsrc, K, dst, kb * 128, n0, 0, 128 * tile + (j0 & 127) - n0, nullptr, nullptr, scr, lane); }
        else tr_item(src, Nsrc, K, dst, kb * 128, n0, kind, 0, gain, gain2, scr, lane);
    }
    cursor += items;
}

constexpr int MOE_GU_ITEMS = 16 * (2 * FFE / 64), MOE_D_ITEMS = (FFE / 128) * (D / 64), MOE_E_ITEMS = MOE_GU_ITEMS + MOE_D_ITEMS, MOE_ITEMS = NE * MOE_E_ITEMS;
__device__ __forceinline__ void moe_conv_item(const Args& args, int j, LAS unsigned* scr, int lane) {
    const int e = j / MOE_E_ITEMS, r = j - e * MOE_E_ITEMS;
    if (r < MOE_GU_ITEMS) {
        constexpr int nb = 2 * FFE / 64;
        const int t = r / nb, n0 = (r % nb) * 64, tile = n0 >> 8, j0 = n0 & 255;
        tr_item6((j0 < 128 ? args.in[16] : args.in[17]) + (size_t)e * D * FFE, FFE, args.ws + WS_WMGU + (size_t)e * 2 * FFE * D, t, n0, 128 * tile + (j0 & 127), scr, lane);
    } else {
        const int r2 = r - MOE_GU_ITEMS, t = r2 / (D / 64), n0 = (r2 % (D / 64)) * 64;
        tr_item6c(args.in[18] + (size_t)e * FFE * D, D, FFE, args.ws + WS_WMD + (size_t)e * D * FFE, t, n0, scr, lane);
    }
}
__device__ __forceinline__ void moe_conv_burst(const Args& args, LAS unsigned char* lds, int part, int nparts) {
    const int tid = tid_opaque(), lane = tid & 63, wave = tid >> 6, gw = blockIdx.x * NWAVES + wave, NGW = gridDim.x * NWAVES;
    LAS unsigned* scr = (LAS unsigned*)(lds + wave * 16640);
    const int per = (MOE_ITEMS + NGW - 1) / NGW, i0 = per * part / nparts, i1 = per * (part + 1) / nparts;
    __syncthreads();
    for (int i = i0; i < i1; ++i) { const int j = gw + i * NGW; if (j < MOE_ITEMS) moe_conv_item(args, j, scr, lane); }
    __syncthreads();
}

__device__ __forceinline__ void ln_row(f32x4 (&v)[8], const float* __restrict__ g, const float* __restrict__ b, int lane, float& mean_o, float& rstd_o) {
    float s = 0.f;
#pragma unroll
    for (int j = 0; j < 8; ++j) s += (v[j][0] + v[j][1]) + (v[j][2] + v[j][3]);
    const float mean = wave_sum(s) * (1.f / D); float s2 = 0.f;
#pragma unroll
    for (int j = 0; j < 8; ++j) { v[j] = v[j] - mean; s2 += (v[j][0] * v[j][0] + v[j][1] * v[j][1]) + (v[j][2] * v[j][2] + v[j][3] * v[j][3]); }
    const float rstd = 1.f / sqrtf(wave_sum(s2) * (1.f / D) + LN_EPS); mean_o = mean; rstd_o = rstd;
#pragma unroll
    for (int j = 0; j < 8; ++j) { const f32x4 gg = *((const f32x4*)g + lane + 64 * j), bb = *((const f32x4*)b + lane + 64 * j); v[j] = v[j] * rstd * gg + bb; }
}

#define WSP(T, off) ((T*)(args.ws + (off)))
#define IN(k) (lo <= (k) && (k) < hi)
#define SEAM(k) do { if (IN(k) && IN((k) + 1)) { XcdBarrier b_; b_.bar = WSP(unsigned, WS_CTL) + CW_BAR; b_.x = xb_xcc_id(); b_.st = (volatile LAS unsigned*)(lds + MISC_OFF) + 8; xcd_barrier(b_); } } while (0)

__device__ __forceinline__ int moe_unit_table(const int* moemeta, int NT, LAS int* utab) {
    const int tid = tid_opaque();
    pg8::MoeOrder Mo;
#pragma unroll
    for (int e = 0; e <= NE; ++e) Mo.pb[e] = moemeta[e];
    Mo.NT = NT; Mo.G = gridDim.x; Mo.c = blockIdx.x; Mo.nwg = Mo.pb[NE] * NT;
    if (tid < 64) { pg8::Unit u; u.pm = 0; u.pn = 0; u.aux = 0; Mo.next(tid, u); utab[4 * tid] = u.pm; utab[4 * tid + 1] = u.pn; utab[4 * tid + 2] = u.aux; }
    __syncthreads();
    const int left = Mo.nwg - Mo.c; int n = left <= 0 ? 0 : (left + Mo.G - 1) / Mo.G;
    return __builtin_amdgcn_readfirstlane(n < 64 ? n : 64);
}
__device__ __forceinline__ f32x4 tail_sum(const bf16_t* yp, int t, int d, int lane, int SK) {
    f32x4 acc = {0.f, 0.f, 0.f, 0.f};
    for (int q = 0; q < SK; ++q) { const u32x2 a = *((const u32x2*)(yp + ((size_t)(q * 128 + t - 1) * 256 + (d & 255)) * 256) + lane);
        acc += (f32x4){__uint_as_float(a.x << 16), __uint_as_float(a.x & 0xffff0000u), __uint_as_float(a.y << 16), __uint_as_float(a.y & 0xffff0000u)}; }
    return acc;
}
__device__ __forceinline__ int moe_tail_split(int nwg, int G, int& Rf, int& Tn) {
    Rf = nwg / G; Tn = nwg - Rf * G;
    return Tn == 0 ? 1 : (Tn * 7 <= G ? 7 : (Tn * 4 <= G ? 4 : (Tn * 2 <= G ? 2 : 1)));
}
__device__ __forceinline__ int moe_unit_table_k(const int* moemeta, int NT, LAS int* utab, unsigned char* tailmap) {
    const int tid = tid_opaque();
    pg8::MoeOrder Mo;
#pragma unroll
    for (int e = 0; e <= NE; ++e) Mo.pb[e] = moemeta[e];
    Mo.NT = NT; Mo.G = gridDim.x; Mo.c = blockIdx.x; Mo.nwg = Mo.pb[NE] * NT;
    int Rf, Tn; const int SK = moe_tail_split(Mo.nwg, Mo.G, Rf, Tn);
    const int R = Rf < 63 ? Rf : 63;
    const bool piece = SK > 1 ? (Mo.c < Tn * SK) : (Mo.c < Tn);
    if (tid < 64) {
        long Lq = -1; int kx = 0, mark = 0;
        if (tid < R) Lq = (long)tid * Mo.G + Mo.c;
        else if (tid == R && piece) {
            if (SK == 1) Lq = (long)Rf * Mo.G + Mo.c;
            else { const int j = Mo.c / SK, q = Mo.c - j * SK; Lq = (long)Rf * Mo.G + j; kx = (1 + j) | (q << 8) | (SK << 16); mark = (q == 0) ? 1 + j : 0; }
        }
        pg8::Unit u; u.pm = 0; u.pn = 0; u.aux = 0; u.kx = 0;
        if (Lq >= 0) Mo.at(Lq, u);
        if (mark) tailmap[u.pm * 8 + u.aux] = (unsigned char)mark;
        utab[4 * tid] = u.pm; utab[4 * tid + 1] = u.pn; utab[4 * tid + 2] = u.aux; utab[4 * tid + 3] = kx;
    }
    __syncthreads();
    return __builtin_amdgcn_readfirstlane(R + (piece ? 1 : 0));
}
template <int L>
__device__ __forceinline__ void layer_phases(const Args& args, LAS unsigned char* lds, char* lds_gen, int lo, int hi) {
    constexpr int pb = 1 + 10 * L;
    if (IN(pb + 0)) {
        const int G = gridDim.x, bx = blockIdx.x;
        pg8::Gemm g{WSP(const bf16_t, WS_XB), WSP(const bf16_t, WS_WIN + L * SZ_WIN), D}; pg8::StaticOrder So; So.init(S, 2048, G, bx);
        pg8::EpiInProj E{WSP(bf16_t, WS_CQ), WSP(bf16_t, WS_CKV), WSP(bf16_t, WS_KPE), WSP(bf16_t, WS_QS), WSP(bf16_t, WS_KS), WSP(bf16_t, WS_VS), WSP(float, WS_PARTQ), WSP(float, WS_PARTKV),
                         WSP(const float, WS_COSM), WSP(const float, WS_SINM), WSP(const float, WS_COSS), WSP(const float, WS_SINS)};
        pg8::gemm_phase<pg8::EpiInProj, pg8::StaticOrder, true, true>(lds, g, So, E);
    }
    SEAM(pb + 0);
    if (IN(pb + 1)) {
        const int G = gridDim.x, bx = blockIdx.x;
        LAS int* utab = (LAS int*)(lds + MISC_OFF + 1024);
        LAS int* ucnt = (LAS int*)(lds + MISC_OFF + 1024 + 3072);
        if (tid_opaque() == 0) {
            int nl = 0, nq = 0, nk = 0;
            if (G == 256) {
                if (bx < 128) { utab[0] = bx >> 1; utab[1] = 8 + (bx & 1); utab[2] = 8 + (bx & 1); nl = 1; utab[128] = bx >> 3; utab[129] = bx & 7; utab[130] = bx & 7; nk = 1; }
                else { const int c = bx - 128;
                    for (int i = 0; i < 3; ++i) { const int u = 3 * c + i; utab[64 + 4 * i] = u / 6; utab[65 + 4 * i] = u % 6; utab[66 + 4 * i] = u % 6; }
                    nq = 3;
                    for (int i = 0; i < 3; ++i) { const int u = 128 + 3 * c + i; utab[128 + 4 * i] = u >> 3; utab[129 + 4 * i] = u & 7; utab[130 + 4 * i] = u & 7; }
                    nk = 3; }
            } else {
                for (int u = bx; u < 128 && nl < 16; u += G, ++nl) { utab[4 * nl] = u >> 1; utab[4 * nl + 1] = 8 + (u & 1); utab[4 * nl + 2] = 8 + (u & 1); }
                for (int u = bx; u < 384 && nq < 16; u += G, ++nq) { utab[64 + 4 * nq] = u / 6; utab[65 + 4 * nq] = u % 6; utab[66 + 4 * nq] = u % 6; }
                for (int u = bx; u < 512 && nk < 16; u += G, ++nk) { utab[128 + 4 * nk] = u >> 3; utab[129 + 4 * nk] = u & 7; utab[130 + 4 * nk] = u & 7; }
            }
            ucnt[0] = nl; ucnt[1] = nq; ucnt[2] = nk;
        }
        __syncthreads();
        { pg8::TableOrder To{utab, __builtin_amdgcn_readfirstlane(ucnt[0])};
          pg8::Gemm g{WSP(const bf16_t, WS_XB), WSP(const bf16_t, WS_WIN + L * SZ_WIN), D};
          pg8::EpiInProj E{WSP(bf16_t, WS_CQ), WSP(bf16_t, WS_CKV), WSP(bf16_t, WS_KPE), WSP(bf16_t, WS_QS), WSP(bf16_t, WS_KS), WSP(bf16_t, WS_VS), WSP(float, WS_PARTQ), WSP(float, WS_PARTKV),
                           WSP(const float, WS_COSM), WSP(const float, WS_SINM), WSP(const float, WS_COSS), WSP(const float, WS_SINS)};
          pg8::gemm_phase<pg8::EpiInProj, pg8::TableOrder, true, true>(lds, g, To, E); }
        { pg8::TableOrder To{utab + 64, __builtin_amdgcn_readfirstlane(ucnt[1])};
          pg8::Gemm g{WSP(const bf16_t, WS_CQ), WSP(const bf16_t, WS_WQ + L * SZ_WQ), QLORA};
          pg8::EpiQ E{WSP(bf16_t, WS_Q), WSP(const float, WS_PARTQ), WSP(const float, WS_COSM), WSP(const float, WS_SINM)};
          pg8::gemm_phase<pg8::EpiQ, pg8::TableOrder, true, true>(lds, g, To, E); }
        { pg8::TableOrder To{utab + 128, __builtin_amdgcn_readfirstlane(ucnt[2])};
          pg8::Gemm g{WSP(const bf16_t, WS_CKV), WSP(const bf16_t, WS_WKV + L * SZ_WKV), KVLORA};
          pg8::EpiKV E{WSP(bf16_t, WS_KV), WSP(const float, WS_PARTKV)};
          pg8::gemm_phase<pg8::EpiKV, pg8::TableOrder, true, true>(lds, g, To, E); }
    }
    SEAM(pb + 1);
    if (IN(pb + 2)) {
        const int G = gridDim.x, bx = blockIdx.x;
        const int slot = bx % 3; bool pending = true;
        for (int step = 0; ; ++step) {
            const int u = bx + step * G; const bool more = u < 512;
            if (pending && (step == slot || !more)) { moe_conv_burst(args, lds, L, DEPTH); pending = false; }
            if (!more) break;
            const int r = u / 256, c = u % 256, head = 4 * r + ((c & 7) >> 1), qblk = (c >> 3) + 32 * (c & 1);
            att::attn_body<192, false, QCOLS, KVCOLS, 64, KVCOLS, D>(WSP(const bf16_t, WS_Q) + (size_t)qblk * 256 * QCOLS + head * 192, WSP(const bf16_t, WS_KV) + head * 256, WSP(const bf16_t, WS_KPE),
                WSP(const bf16_t, WS_KV) + head * 256 + 128, WSP(bf16_t, WS_OBUF) + (size_t)qblk * 256 * D + head * 128, WSP(float, WS_PARTO) + (size_t)qblk * 256 * 16 + head, qblk * 256, 0, S / 64, SCALE_MLA, 0.f, (LAS char*)lds);
        }
        for (int u = bx; u < 512; u += G) {
            const int head = u >> 6, qblk = u & 63;
            int t0 = 4 * qblk - 2, t1 = 4 * qblk + 5; if (t0 < 0) t0 = 0; if (t1 > S / 64 - 1) t1 = S / 64 - 1;
            const float sk = (args.in[6] + L * 8)[head];
            att::attn_body<128, true, 1024, 256, 64, 256, D>(WSP(const bf16_t, WS_QS) + (size_t)qblk * 256 * 1024 + head * 128, WSP(const bf16_t, WS_KS) + (head >> 2) * 128, nullptr, WSP(const bf16_t, WS_VS) + (head >> 2) * 128,
                WSP(bf16_t, WS_OBUF) + (size_t)qblk * 256 * D + 1024 + head * 128, WSP(float, WS_PARTO) + (size_t)qblk * 256 * 16 + 8 + head, qblk * 256, t0 * 64, t1 - t0 + 1, SCALE_SWA, sk / SCALE_SWA, (LAS char*)lds);
        }
    }
    SEAM(pb + 2);
    if (IN(pb + 4)) {
        const int G = gridDim.x, bx = blockIdx.x;
        pg8::Gemm g{WSP(const bf16_t, WS_OBUF), WSP(const bf16_t, WS_WOUT + L * SZ_WOUT), D}; pg8::StaticOrder So; So.init(S, D, G, bx);
        if constexpr (L == 0) { pg8::EpiOutProj<false> E{args.in[0], WSP(float, WS_XA), WSP(const float, WS_PARTO), nullptr, nullptr, nullptr}; pg8::gemm_phase<pg8::EpiOutProj<false>, pg8::StaticOrder, true, true>(lds, g, So, E); }
        else { pg8::EpiOutProj<true> E{WSP(const float, WS_XA), WSP(float, WS_XA), WSP(const float, WS_PARTO), WSP(const float, WS_ST2), args.in[19] + (L - 1) * D, args.in[20] + (L - 1) * D};
               pg8::gemm_phase<pg8::EpiOutProj<true>, pg8::StaticOrder, true, true>(lds, g, So, E); }
    }
    SEAM(pb + 4);
    if (IN(pb + 5)) {
        const int tid = tid_opaque(), lane = tid & 63, wave = tid >> 6, G = gridDim.x, bx = blockIdx.x;
        const float* lg = args.in[10] + L * D; const float* lb = args.in[11] + L * D;
        float* XA = WSP(float, WS_XA); unsigned* X8 = WSP(unsigned, WS_X8);
        const int RPW = (S + G - 1) / G, r0 = bx * RPW, r1 = (r0 + RPW < S) ? r0 + RPW : S;
        LAS float* wr_l = (LAS float*)lds; LAS int* hist = (LAS int*)(lds + 65536);
        if (L == 1) { const float* wrg = args.in[15]; for (int i = tid; i < D * NE; i += 512) wr_l[i] = wrg[i]; if (tid < NE) hist[tid] = 0; __syncthreads(); }
        for (int row = r0 + wave; row < r1; row += NWAVES) {
            f32x4 v[8]; float* xr = XA + (size_t)row * D;
#pragma unroll
            for (int j = 0; j < 8; ++j) v[j] = *((const f32x4*)xr + lane + 64 * j);
            float mu_, rs_; ln_row(v, lg, lb, lane, mu_, rs_);
            if (lane == 0) { float* st = WSP(float, WS_ST1); st[2 * row] = mu_; st[2 * row + 1] = rs_; }
            if (L == 1) {
#pragma unroll
                for (int j = 0; j < 8; ++j) *((u32x2*)(WSP(bf16_t, WS_XB) + (size_t)row * D) + lane + 64 * j) = pg8::pack4(v[j]);
            }
            { f32x16 lo, hi;
#pragma unroll
              for (int j = 0; j < 4; ++j)
#pragma unroll
                  for (int c = 0; c < 4; ++c) { lo[4 * j + c] = v[j][c]; hi[4 * j + c] = v[4 + j][c]; }
              unsigned sb; const u32x6 q = mx6_block(lo, hi, sb);
              unsigned char* o = (unsigned char*)X8 + (size_t)row * D + (lane >> 2) * 128 + 16 * (lane & 3);
              *(u32x4*)o = (u32x4){q[0], q[1], q[2], q[3]}; *(u32x4*)(o + 64) = (u32x4){q[4], q[5], sb, 0u}; }
            if (L == 1) {
                float q0 = 0.f, q1 = 0.f, q2 = 0.f, q3 = 0.f, q4 = 0.f, q5 = 0.f, q6 = 0.f, q7 = 0.f;
#pragma unroll
                for (int j = 0; j < 8; ++j)
#pragma unroll
                    for (int k = 0; k < 4; ++k) { const LAS f32x4* w = (const LAS f32x4*)(wr_l + (size_t)(4 * (lane + 64 * j) + k) * NE); const f32x4 w0 = w[0], w1 = w[1]; const float xv = v[j][k];
                        q0 += xv * w0[0]; q1 += xv * w0[1]; q2 += xv * w0[2]; q3 += xv * w0[3]; q4 += xv * w1[0]; q5 += xv * w1[1]; q6 += xv * w1[2]; q7 += xv * w1[3]; }
                q0 = wave_sum(q0); q1 = wave_sum(q1); q2 = wave_sum(q2); q3 = wave_sum(q3); q4 = wave_sum(q4); q5 = wave_sum(q5); q6 = wave_sum(q6); q7 = wave_sum(q7);
                int e0 = 0; float l0 = q0;
                if (q1 > l0) { l0 = q1; e0 = 1; } if (q2 > l0) { l0 = q2; e0 = 2; } if (q3 > l0) { l0 = q3; e0 = 3; } if (q4 > l0) { l0 = q4; e0 = 4; } if (q5 > l0) { l0 = q5; e0 = 5; } if (q6 > l0) { l0 = q6; e0 = 6; } if (q7 > l0) { l0 = q7; e0 = 7; }
                int e1 = -1; float l1 = -3.0e38f;
                if (e0 != 0 && q0 > l1) { l1 = q0; e1 = 0; } if (e0 != 1 && q1 > l1) { l1 = q1; e1 = 1; } if (e0 != 2 && q2 > l1) { l1 = q2; e1 = 2; } if (e0 != 3 && q3 > l1) { l1 = q3; e1 = 3; }
                if (e0 != 4 && q4 > l1) { l1 = q4; e1 = 4; } if (e0 != 5 && q5 > l1) { l1 = q5; e1 = 5; } if (e0 != 6 && q6 > l1) { l1 = q6; e1 = 6; } if (e0 != 7 && q7 > l1) { l1 = q7; e1 = 7; }
                const float t = __expf(l1 - l0), g0 = 1.0f / (1.0f + t), g1 = t / (1.0f + t);
                if (lane == 0) { int* sel = WSP(int, WS_SEL); float* gate = WSP(float, WS_GATE); sel[2 * row] = e0; sel[2 * row + 1] = e1; gate[2 * row] = g0; gate[2 * row + 1] = g1;
                    __hip_atomic_fetch_add(hist + e0, 1, __ATOMIC_RELAXED, __HIP_MEMORY_SCOPE_WORKGROUP); __hip_atomic_fetch_add(hist + e1, 1, __ATOMIC_RELAXED, __HIP_MEMORY_SCOPE_WORKGROUP); }
            }
        }
        if (L == 1) { __syncthreads(); if (tid < NE) WSP(int, WS_WGCNT)[bx * NE + tid] = hist[tid]; }
    }
    SEAM(pb + 5);
    if constexpr (L == 0) {
        if (IN(pb + 7)) {
            const int G = gridDim.x, bx = blockIdx.x;
            pg8::Gemm g{WSP(const bf16_t, WS_X8), WSP(const bf16_t, WS_WGU), D}; pg8::StaticOrder So; So.init(S, 2 * FF, G, bx);
            pg8::EpiSwiglu6 E{WSP(unsigned char, WS_H), FF};
            pg8::gemm_phase<pg8::EpiSwiglu6, pg8::StaticOrder, true, true, 2>(lds, g, So, E);
        }
        SEAM(pb + 7);
        if (IN(pb + 8)) {
            const int G = gridDim.x, bx = blockIdx.x;
            pg8::Gemm g{WSP(const bf16_t, WS_H), WSP(const bf16_t, WS_WD), FF}; pg8::StaticOrder So; So.init(S, D, G, bx);
            pg8::EpiResidLN E{WSP(const float, WS_XA), WSP(float, WS_XA), 1.0f, WSP(const float, WS_ST1), args.in[10] + L * D, args.in[11] + L * D};
            pg8::gemm_phase<pg8::EpiResidLN, pg8::StaticOrder, true, true, 2>(lds, g, So, E);
        }
        SEAM(pb + 8);
        if (IN(pb + 9)) {
            const int tid = tid_opaque(), lane = tid & 63, gw = blockIdx.x * NWAVES + (tid >> 6), NGW = gridDim.x * NWAVES;
            const float* lg = args.in[19] + L * D; const float* lb = args.in[20] + L * D; float* XA = WSP(float, WS_XA); bf16_t* XB = WSP(bf16_t, WS_XB);
            for (int row = gw; row < S; row += NGW) {
                f32x4 v[8]; float* xr = XA + (size_t)row * D;
#pragma unroll
                for (int j = 0; j < 8; ++j) v[j] = *((const f32x4*)xr + lane + 64 * j);
                float mu_, rs_; ln_row(v, lg, lb, lane, mu_, rs_);
                if (lane == 0) { float* st = WSP(float, WS_ST2); st[2 * row] = mu_; st[2 * row + 1] = rs_; }
#pragma unroll
                for (int j = 0; j < 8; ++j) *((u32x2*)(XB + (size_t)row * D) + lane + 64 * j) = pg8::pack4(v[j]);
            }
        }
        SEAM(pb + 9);
    } else {
        if (IN(pb + 6)) {
            const int tid = tid_opaque(), lane = tid & 63, wave = tid >> 6, G = gridDim.x, bx = blockIdx.x;
            const int RPW = (S + G - 1) / G, r0 = bx * RPW, r1 = (r0 + RPW < S) ? r0 + RPW : S, na = 2 * (r1 - r0);
            LAS int* tab = (LAS int*)lds;
            LAS int* basee = (LAS int*)(lds + 32768);
            LAS int* asel = (LAS int*)(lds + 33024);
            LAS int* adst = (LAS int*)(lds + 35072);
            const int* wgcnt = WSP(const int, WS_WGCNT); const int* sel = WSP(const int, WS_SEL);
            for (int i = tid; i < G * NE; i += 512) tab[i] = wgcnt[i];
            for (int i = tid; i < na; i += 512) asel[i] = sel[2 * r0 + i];
            __syncthreads();
            if (tid < NE) { int tot = 0, pre = 0; for (int w = 0; w < G; ++w) { const int c = tab[w * NE + tid]; pre += (w < bx) ? c : 0; tot += c; } basee[32 + tid] = tot; basee[40 + tid] = pre; }
            __syncthreads();
            if (tid == 0) { int p = 0; for (int e = 0; e < NE; ++e) { basee[8 + e] = p; basee[e] = 256 * p + basee[40 + e]; p += (basee[32 + e] + 255) >> 8; } basee[16] = p;
                if (bx == 0) { int* moemeta = WSP(int, WS_MOEMETA); for (int e = 0; e <= NE; ++e) moemeta[e] = basee[8 + e]; } }
            __syncthreads();
            if (tid < NE) { int rk = basee[tid]; for (int i = 0; i < na; ++i) if (asel[i] == tid) adst[i] = rk++; }
            __syncthreads();
            int* dest = WSP(int, WS_DEST); const unsigned char* X8 = WSP(const unsigned char, WS_X8); unsigned char* xs = WSP(unsigned char, WS_XS);
            for (int i = tid; i < na; i += 512) dest[2 * r0 + i] = adst[i];
            if (bx < NE) {
                const int rb = 256 * basee[8 + bx] + basee[32 + bx], re = 256 * basee[9 + bx];
                for (int i = rb * 128 + tid; i < re * 128; i += 512) ((u32x4*)xs)[i] = (u32x4){0u, 0u, 0u, 0u};
            }
            for (int a = wave; a < na; a += NWAVES) { const u32x4* s4 = (const u32x4*)(X8 + (size_t)(r0 + (a >> 1)) * D); u32x4* d4 = (u32x4*)(xs + (size_t)adst[a] * D);
#pragma unroll
                for (int j = 0; j < 2; ++j) d4[lane + 64 * j] = s4[lane + 64 * j]; }
        }
        SEAM(pb + 6);
        if (IN(pb + 7)) {
            LAS int* utab = (LAS int*)(lds + MISC_OFF + 1024);
            const int nun = moe_unit_table(WSP(const int, WS_MOEMETA), 2 * FFE / 256, utab);
            pg8::TableOrder To{utab, nun};
            pg8::Gemm g{WSP(const bf16_t, WS_XS), WSP(const bf16_t, WS_WMGU), D};
            pg8::EpiSwiglu6 E{WSP(unsigned char, WS_H), FFE};
            for (int rep = 0; rep < PROBE_MOEUP; ++rep) pg8::gemm_phase<pg8::EpiSwiglu6, pg8::TableOrder, true, true, 2>(lds, g, To, E);
        }
        SEAM(pb + 7);
        if (IN(pb + 8)) {
            LAS int* utab = (LAS int*)(lds + MISC_OFF + 1024);
            const int nun = moe_unit_table_k(WSP(const int, WS_MOEMETA), D / 256, utab, WSP(unsigned char, WS_TAILMAP));
            pg8::TableOrderK To{utab, nun};
            pg8::Gemm g{WSP(const bf16_t, WS_H), WSP(const bf16_t, WS_WMD), FFE};
            pg8::EpiBf16OutK E{WSP(bf16_t, WS_XS), WSP(bf16_t, WS_YP)};
            pg8::gemm_phase<pg8::EpiBf16OutK, pg8::TableOrderK, true, true, 2>(lds, g, To, E);
        }
        SEAM(pb + 8);
        if (IN(pb + 9)) {
            const int tid = tid_opaque(), lane = tid & 63, gw = blockIdx.x * NWAVES + (tid >> 6), NGW = gridDim.x * NWAVES;
            const float* lg = args.in[19] + L * D; const float* lb = args.in[20] + L * D;
            const int* dest = WSP(const int, WS_DEST); const float* gate = WSP(const float, WS_GATE); const float* XA = WSP(const float, WS_XA); const bf16_t* ys = WSP(const bf16_t, WS_XS);
            const float* st1 = WSP(const float, WS_ST1); const float* g1p = args.in[10] + L * D; const float* b1p = args.in[11] + L * D;
            for (int row = gw; row < S; row += NGW) {
                const int d0 = dest[2 * row], d1 = dest[2 * row + 1]; const float g0 = gate[2 * row], g1 = gate[2 * row + 1]; const float mu1 = st1[2 * row], rs1 = st1[2 * row + 1];
                f32x4 v[8]; const float* xr = XA + (size_t)row * D; const u32x2* y0 = (const u32x2*)(ys + (size_t)d0 * D); const u32x2* y1 = (const u32x2*)(ys + (size_t)d1 * D);
                const u32x2 m0 = *(const u32x2*)(WSP(const unsigned char, WS_TAILMAP) + (d0 >> 8) * 8), m1 = *(const u32x2*)(WSP(const unsigned char, WS_TAILMAP) + (d1 >> 8) * 8);
                const bool anyt = (m0.x | m0.y | m1.x | m1.y) != 0u;
#pragma unroll
                for (int j = 0; j < 8; ++j) { const u32x2 xw = *((const u32x2*)(WSP(const bf16_t, WS_XB) + (size_t)row * D) + lane + 64 * j); const f32x4 x = {__uint_as_float(xw.x << 16), __uint_as_float(xw.x & 0xffff0000u), __uint_as_float(xw.y << 16), __uint_as_float(xw.y & 0xffff0000u)}; const u32x2 a = y0[lane + 64 * j], b = y1[lane + 64 * j];
                    f32x4 fa = {__uint_as_float(a.x << 16), __uint_as_float(a.x & 0xffff0000u), __uint_as_float(a.y << 16), __uint_as_float(a.y & 0xffff0000u)};
                    f32x4 fb = {__uint_as_float(b.x << 16), __uint_as_float(b.x & 0xffff0000u), __uint_as_float(b.y << 16), __uint_as_float(b.y & 0xffff0000u)};
                    if (anyt) {
                        const int t0 = (int)(((j < 4 ? m0.x : m0.y) >> (8 * (j & 3))) & 255u), t1 = (int)(((j < 4 ? m1.x : m1.y) >> (8 * (j & 3))) & 255u);
                        if (t0 | t1) {
                            const int nwg_ = WSP(const int, WS_MOEMETA)[NE] * (D / 256), G_ = gridDim.x, Tn_ = nwg_ - (nwg_ / G_) * G_, SK = Tn_ * 7 <= G_ ? 7 : (Tn_ * 4 <= G_ ? 4 : 2);
                            if (t0) fa = tail_sum(WSP(const bf16_t, WS_YP), t0, d0, lane, SK);
                            if (t1) fb = tail_sum(WSP(const bf16_t, WS_YP), t1, d1, lane, SK);
                        }
                    }
                    v[j] = x * ALPHA + (fa * g0 + fb * g1); }
                float mu_, rs_; ln_row(v, lg, lb, lane, mu_, rs_);
#pragma unroll
                for (int j = 0; j < 8; ++j) *((f32x4*)(args.out + (size_t)row * D) + lane + 64 * j) = v[j];
            }
        }
    }
}

__global__ void __launch_bounds__(NWAVES * 64, 2) fwd(Args args) {
    extern __shared__ __attribute__((aligned(16))) unsigned char lds_raw[];
    LAS unsigned char* lds = (LAS unsigned char*)lds_raw;
    volatile LAS unsigned* MISC = (volatile LAS unsigned*)(lds + MISC_OFF);
    for (int u = tid_opaque(); u < (LDS_BYTES - MISC_OFF) / 4; u += NWAVES * 64) MISC[u] = 0u;
    __syncthreads();
    (void)xcd_barrier_post(WSP(unsigned, WS_CTL) + CW_BAR, MISC + 8);
    const int lo = args.ph_lo, hi = args.ph_hi;

    if (IN(0)) {
        const int tid = tid_opaque(), lane = tid & 63, wave = tid >> 6, G = gridDim.x, bx = blockIdx.x, gw = bx * NWAVES + wave, NGW = G * NWAVES;
        unsigned char* ws = args.ws;
        LAS unsigned* scr = (LAS unsigned*)(lds + wave * 16640);
        for (int rep = 0; rep < PROBE_PRO; ++rep) {
        int cursor = 0;
        for (int l = 0; l < DEPTH; ++l) {
            tr_matrix(args.in[1] + (size_t)l * D * IN_COLS, nullptr, IN_COLS, D, (bf16_t*)(ws + WS_WIN + l * SZ_WIN), IN_PAD, 1, nullptr, nullptr, scr, lane, gw, NGW, cursor);
            tr_matrix(args.in[3] + (size_t)l * QLORA * QCOLS, nullptr, QCOLS, QLORA, (bf16_t*)(ws + WS_WQ + l * SZ_WQ), QCOLS, 2, args.in[2] + l * QLORA, nullptr, scr, lane, gw, NGW, cursor);
            tr_matrix(args.in[5] + (size_t)l * KVLORA * KVCOLS, nullptr, KVCOLS, KVLORA, (bf16_t*)(ws + WS_WKV + l * SZ_WKV), KVCOLS, 0, args.in[4] + l * KVLORA, nullptr, scr, lane, gw, NGW, cursor);
            tr_matrix(args.in[9] + (size_t)l * D * D, nullptr, D, D, (bf16_t*)(ws + WS_WOUT + l * SZ_WOUT), D, 0, args.in[7] + l * 1024, args.in[8] + l * 1024, scr, lane, gw, NGW, cursor);
        }
        tr_matrix6(args.in[12], args.in[13], FF, ws + WS_WGU, 2 * FF, scr, lane, gw, NGW, cursor);
        tr_matrix6c(args.in[14], D, FF, ws + WS_WD, D, scr, lane, gw, NGW, cursor);
        { const f32x4* x4 = (const f32x4*)args.in[0]; u32x2* o2 = (u32x2*)(ws + WS_XB);
          for (size_t i = (size_t)bx * 512 + tid; i < (size_t)S * D / 4; i += (size_t)G * 512) o2[i] = pg8::pack4(x4[i]); }
        { float* coss = (float*)(ws + WS_COSS); float* sins = (float*)(ws + WS_SINS); float* cosm = (float*)(ws + WS_COSM); float* sinm = (float*)(ws + WS_SINM);
          for (int i = bx * 512 + tid; i < S * 64; i += G * 512) { const int pos = i >> 6, k = i & 63; float sn, cs; sincos_acc((float)pos * INVF[k], sn, cs); coss[i] = cs; sins[i] = sn; }
          for (int i = bx * 512 + tid; i < S * 32; i += G * 512) { const int pos = i >> 5, k = i & 31; float sn, cs; sincos_acc((float)pos * INVF[2 * k], sn, cs); cosm[i] = cs; sinm[i] = sn; } }
        }
    }
    SEAM(0);
    layer_phases<0>(args, lds, (char*)lds_raw, lo, hi);
    layer_phases<1>(args, lds, (char*)lds_raw, lo, hi);
}
#undef IN
#undef SEAM

#ifndef MK_SPLIT
#define MK_SPLIT 0
#endif
extern "C" void kernel_launch(void* const* d_in, const int* in_sizes, int n_in, void* d_out, int out_size, void* d_ws, size_t ws_size, hipStream_t stream) {
    static int grid = 0;
    if (grid == 0) {
        if (n_in != 21 || out_size != S * D || ws_size < WS_END2) { fprintf(stderr, "kernel_launch: unexpected shapes: n_in %d out %d ws %zu (need %zu)\n", n_in, out_size, ws_size, (size_t)WS_END2); grid = -1; return; }
        int dev = 0, cus = 0, per_cu = 0;
        if (hipGetDevice(&dev) != hipSuccess || hipDeviceGetAttribute(&cus, hipDeviceAttributeMultiprocessorCount, dev) != hipSuccess) { grid = -1; return; }
        if (hipFuncSetAttribute((const void*)fwd, hipFuncAttributeMaxDynamicSharedMemorySize, LDS_BYTES) != hipSuccess) { fprintf(stderr, "kernel_launch: hipFuncSetAttribute failed\n"); grid = -1; return; }
        if (hipOccupancyMaxActiveBlocksPerMultiprocessor(&per_cu, (const void*)fwd, NWAVES * 64, LDS_BYTES) != hipSuccess || per_cu < 1) fprintf(stderr, "kernel_launch: occupancy query says %d\n", per_cu);
        (void)hipGetLastError();
        grid = cus;
    }
    if (grid < 0) return;
    (void)hipMemsetAsync((char*)d_ws + WS_CTL, 0, CTL_ZERO_BYTES, stream);
    Args a{};
    for (int i = 0; i < 21; ++i) a.in[i] = (const float*)d_in[i];
    a.out = (float*)d_out; a.ws = (unsigned char*)d_ws;
#if MK_SPLIT
    for (int p = 0; p < NPHASE; ++p) { a.ph_lo = p; a.ph_hi = p + 1; hipLaunchKernelGGL(fwd, dim3(grid), dim3(NWAVES * 64), LDS_BYTES, stream, a); }
#else
    a.ph_lo = 0; a.ph_hi = NPHASE; hipLaunchKernelGGL(fwd, dim3(grid), dim3(NWAVES * 64), LDS_BYTES, stream, a);
#endif
    const hipError_t le = hipPeekAtLastError();
    if (le != hipSuccess) fprintf(stderr, "kernel_launch: launch failed: %s\n", hipGetErrorName(le));
}
```

```cpp
#include <hip/hip_runtime.h>
#include <cstdio>
#include <cstdint>

#define LAS __attribute__((address_space(3)))
#define GAS __attribute__((address_space(1)))
typedef unsigned short bf16_t;
typedef short bf16x8 __attribute__((ext_vector_type(8)));
typedef short s16x4 __attribute__((ext_vector_type(4)));
typedef float f32x4 __attribute__((ext_vector_type(4)));
typedef float f32x16 __attribute__((ext_vector_type(16)));
typedef unsigned u32x4 __attribute__((ext_vector_type(4)));
typedef unsigned u32x2 __attribute__((ext_vector_type(2)));

constexpr int S = 16384, D = 2048, DEPTH = 2;
constexpr int IN_COLS = 2368, IN_PAD = 2560, QCOLS = 1536, KVCOLS = 2048, QLORA = 512, KVLORA = 256;
constexpr int FF = 5632, FFE = 7168, NE = 8;
constexpr int MOE_ROWS = 34816;
constexpr float ALPHA = 1.41421356237309515f, LN_EPS = 1e-5f, RMS_EPS = 1e-6f;
constexpr float SCALE_MLA = 0.07216878364870322f, SCALE_SWA = 0.08838834764831845f;

__device__ __forceinline__ unsigned cvt_pk_bf16(float lo, float hi) { unsigned r; asm volatile("v_cvt_pk_bf16_f32 %0, %1, %2" : "=v"(r) : "v"(lo), "v"(hi)); return r; }

__device__ __forceinline__ unsigned pk_fp8x4(float a, float b, float c, float d) { int w = 0; w = __builtin_amdgcn_cvt_pk_fp8_f32(a, b, w, false); w = __builtin_amdgcn_cvt_pk_fp8_f32(c, d, w, true); return (unsigned)w; }
typedef int v6i32 __attribute__((ext_vector_type(6)));
typedef unsigned u32x6 __attribute__((ext_vector_type(6)));
__device__ __forceinline__ u32x6 mx6_block(const f32x16 lo, const f32x16 hi, unsigned& sb) {
    float am = 0.f;
#pragma unroll
    for (int i = 0; i < 16; ++i) am = fmaxf(am, fmaxf(fabsf(lo[i]), fabsf(hi[i])));
    const unsigned bits = __float_as_uint(am);
    int e = (int)((bits >> 23) & 255u) - 126 - (((bits & 0x7fffffu) <= 0x700000u) ? 3 : 2);
    e = e < -120 ? -120 : e;
    const float scale = __uint_as_float((unsigned)(e + 127) << 23);
    sb = (unsigned)(e + 127) * 0x01010101u;
    u32x6 q;
    asm("v_cvt_scalef32_2xpk16_fp6_f32 %0, %1, %2, %3" : "=&v"(q) : "v"(lo), "v"(hi), "v"(scale));
    return q;
}
constexpr float X8_SCALE = 4.f, W8UP_SCALE = 64.f, W8DN_SCALE = 128.f, H8_SCALE = 16.f;
__device__ __forceinline__ int tid_opaque() { int t = threadIdx.x; asm volatile("" : "+v"(t)); return t; }

constexpr size_t MiB = 1u << 20;
constexpr size_t WS_CTL = 0, CTL_ZERO_BYTES = 1 * MiB;
constexpr size_t WS_COSM = 1 * MiB, WS_SINM = 3 * MiB, WS_COSS = 5 * MiB, WS_SINS = 9 * MiB;
constexpr size_t WS_PARTQ = 13 * MiB, WS_PARTKV = 14 * MiB, WS_PARTO = 15 * MiB;
constexpr size_t WS_SEL = 16 * MiB, WS_GATE = WS_SEL + 128 * 1024, WS_DEST = WS_GATE + 128 * 1024, WS_WGCNT = WS_DEST + 128 * 1024, WS_MOEMETA = WS_WGCNT + 32 * 1024, WS_ST1 = WS_MOEMETA + 4096, WS_ST2 = WS_ST1 + 128 * 1024;
constexpr size_t WS_W = 17 * MiB;
constexpr size_t SZ_WIN = (size_t)IN_PAD * D * 2, SZ_WQ = (size_t)QCOLS * QLORA * 2, SZ_WKV = (size_t)KVCOLS * KVLORA * 2, SZ_WOUT = (size_t)D * D * 2;
constexpr size_t WS_WIN = WS_W, WS_WQ = WS_WIN + 2 * SZ_WIN, WS_WKV = WS_WQ + 2 * SZ_WQ, WS_WOUT = WS_WKV + 2 * SZ_WKV;
constexpr size_t WS_WGU = WS_WOUT + 2 * SZ_WOUT, WS_WD = WS_WGU + (size_t)2 * FF * D, WS_WMGU = WS_WD + (size_t)D * FF;
constexpr size_t WS_WMD = WS_WMGU + (size_t)NE * 2 * FFE * D, WS_XA = WS_WMD + (size_t)NE * D * FFE;
constexpr size_t WS_XB = WS_XA + (size_t)S * D * 4, WS_X8 = WS_XB + (size_t)S * D * 2, WS_SCR = WS_X8 + (size_t)S * D;
constexpr size_t WS_CQ = WS_SCR, WS_CKV = WS_CQ + (size_t)S * 512 * 2, WS_KPE = WS_CKV + (size_t)S * 256 * 2, WS_QS = WS_KPE + (size_t)S * 64 * 2;
constexpr size_t WS_KS = WS_QS + (size_t)S * 1024 * 2, WS_VS = WS_KS + (size_t)S * 256 * 2, WS_Q = WS_VS + (size_t)S * 256 * 2, WS_KV = WS_Q + (size_t)S * QCOLS * 2;
constexpr size_t WS_OBUF = WS_KV + (size_t)S * KVCOLS * 2, WS_ATT_END = WS_OBUF + (size_t)S * D * 2;
constexpr size_t WS_XS = WS_SCR, WS_H = WS_XS + (size_t)MOE_ROWS * D * 2, WS_END0 = WS_H + (size_t)MOE_ROWS * FFE, WS_END = WS_END0 > WS_ATT_END ? WS_END0 : WS_ATT_END;
constexpr size_t WS_YP = (WS_END + 255) / 256 * 256, WS_END2 = WS_YP + (size_t)7 * 128 * 65536 * 2;
constexpr size_t WS_TAILMAP = WS_CTL + 512 * 1024;
static_assert(WS_H + (size_t)S * FF <= WS_END, "scratch union");
static_assert(WS_WIN % 256 == 0 && WS_XA % 256 == 0 && WS_H % 256 == 0 && WS_Q % 256 == 0, "alignment");
constexpr int CW_TMO = 0, CW_BAR = 4096;

#define XB_TMO      128
#define XB_XCNT(j)  (256  + 64 * (j))
#define XB_XSUB(j)  (1280 + 64 * (j))
#define XB_XGEN(j)  (2304 + 64 * (j))
#define XB_TOP      3328
#define XB_TOPGEN   3392
#define XCD_BAR_WORDS 3456
#define XB_SPIN_CAP (1u << 18)
__device__ __forceinline__ unsigned xb_ld(unsigned* p)              { return __hip_atomic_load(p, __ATOMIC_RELAXED, __HIP_MEMORY_SCOPE_AGENT); }
__device__ __forceinline__ unsigned xb_add(unsigned* p, unsigned v) { return __hip_atomic_fetch_add(p, v, __ATOMIC_RELAXED, __HIP_MEMORY_SCOPE_AGENT); }
__device__ __forceinline__ unsigned xb_xcc_id() { return (unsigned)__builtin_amdgcn_s_getreg((3 << 11) | 20) & 0xFu; }
#define XB_SPIN(cond, bar) do { unsigned _sp = 0; while (cond) { __builtin_amdgcn_s_sleep(1); \
    if ((++_sp & 255u) == 0u) { if (xb_ld(&(bar)[XB_TMO])) break; if (_sp > XB_SPIN_CAP) { atomicAdd(&(bar)[XB_TMO], 1u); break; } } } } while (0)
struct XcdBarrier { unsigned* bar; unsigned x; volatile LAS unsigned* st; };
__device__ __forceinline__ XcdBarrier xcd_barrier_post(unsigned* bar, volatile LAS unsigned* st) {
    XcdBarrier b; b.bar = bar; b.x = xb_xcc_id(); b.st = st;
    if (threadIdx.x == 0) (void)xb_add(&bar[XB_XCNT(b.x)], 1u);
    return b;
}
__device__ __forceinline__ void xcd_barrier_complete(unsigned* bar, unsigned x, unsigned& nloc, unsigned& nx) {
    const unsigned G = gridDim.x * gridDim.y * gridDim.z;
    unsigned sum, cnt, mine, sp = 0u;
    for (;;) {
        sum = 0u; cnt = 0u; mine = 0u;
#pragma unroll
        for (unsigned j = 0; j < 16; ++j) { const unsigned c = xb_ld(&bar[XB_XCNT(j)]); sum += c; cnt += (c > 0u) ? 1u : 0u; mine = (j == x) ? c : mine; }
        if (sum == G) break;
        __builtin_amdgcn_s_sleep(1);
        if ((++sp & 255u) == 0u) { if (xb_ld(&bar[XB_TMO])) break; if (sp > XB_SPIN_CAP) { atomicAdd(&bar[XB_TMO], 1u); break; } }
    }
    nloc = mine > 0u ? mine : 1u; nx = cnt > 0u ? cnt : 1u;
}
__device__ __forceinline__ void xcd_barrier(const XcdBarrier& b) {
    asm volatile("s_waitcnt vmcnt(0)" ::: "memory");
    __syncthreads();
    if (threadIdx.x == 0) {
        unsigned* bar = b.bar;
        __builtin_amdgcn_s_waitcnt(0);
        unsigned nloc = b.st[0], nx = b.st[1];
        if (nloc == 0u) { xcd_barrier_complete(bar, b.x, nloc, nx); b.st[0] = nloc; b.st[1] = nx; }
        const unsigned old = xb_add(&bar[XB_XSUB(b.x)], 1u);
        const unsigned gen = old / nloc;
        if (old + 1u == (gen + 1u) * nloc) {
            __builtin_amdgcn_fence(__ATOMIC_RELEASE, "agent");
            asm volatile("s_waitcnt vmcnt(0)" ::: "memory");
            const unsigned og = xb_add(&bar[XB_TOP], 1u);
            const unsigned tg = og / nx;
            if (og + 1u == (tg + 1u) * nx) xb_add(&bar[XB_TOPGEN], 1u);
            else XB_SPIN(xb_ld(&bar[XB_TOPGEN]) == tg, bar);
            __builtin_amdgcn_fence(__ATOMIC_ACQUIRE, "agent");
            xb_add(&bar[XB_XGEN(b.x)], 1u);
            asm volatile("s_waitcnt vmcnt(0)" ::: "memory");
        } else {
            XB_SPIN(xb_ld(&bar[XB_XGEN(b.x)]) == gen, bar);
            __builtin_amdgcn_fence(__ATOMIC_ACQUIRE, "agent");
            asm volatile("s_waitcnt vmcnt(0)" ::: "memory");
        }
    }
    __syncthreads();
}

namespace pg8 {
constexpr int BM = 256, BK = 64, HALF = 128, HTB = HALF * BK * 2, STAGE_BYTES = 8 * HTB, NXCD = 8, WGM = 8;
__host__ __device__ __forceinline__ int lds_byte(int r, int c) { const int st = (r >> 4) * 2 + (c >> 5), rr = r & 15, cc = c & 31, ob = rr * 64 + cc * 2; return st * 1024 + (ob ^ (((ob >> 9) & 1) << 5)); }
__host__ __device__ __forceinline__ void stage_rc(int b, int& R, int& C) { const int st = b / 1024, sb = b % 1024, swz = sb ^ (((sb >> 9) & 1) << 5); R = (st >> 1) * 16 + swz / 64; C = (st & 1) * 32 + (swz % 64) / 2; }
__host__ __device__ __forceinline__ int perm32(int rho) { const int n = rho >> 4, i = rho & 15; return 8 * (i >> 2) + 4 * n + (i & 3); }
struct Unit { int pm, pn, aux, kx; };
struct Gemm { const bf16_t* A; const bf16_t* Bt; int K; };
struct StaticOrder {
    static constexpr bool KSPLIT = false;
    int nM, nN, nwg, G, c;
    __device__ void init(int M, int N, int G_, int c_) { nM = M / BM; nN = N / BM; nwg = nM * nN; G = G_; c = c_; }
    __device__ bool next(int i, Unit& u) const {
        const long L = (long)i * G + c; if (L >= nwg) return false;
        int wgid = (int)L; { const int q = nwg / NXCD, r = nwg % NXCD, xcd = wgid % NXCD, off = wgid / NXCD; wgid = (xcd < r ? xcd * (q + 1) : r * (q + 1) + (xcd - r) * q) + off; }
        const int nig = WGM * nN, gid = wgid / nig, fm = gid * WGM, gsz = (nM - fm) < WGM ? (nM - fm) : WGM;
        u.pm = fm + ((wgid % nig) % gsz); u.pn = (wgid % nig) / gsz; u.aux = u.pn; return true;
    }
};
struct MoeOrder {
    static constexpr bool KSPLIT = false;
    int pb[9], NT, G, c, nwg;
    __device__ __forceinline__ bool next(int i, Unit& u) const { return at((long)i * G + c, u); }
    __device__ __forceinline__ bool at(long L, Unit& u) const {
        if (L >= nwg) return false;
        int wgid = (int)L; { const int q = nwg / NXCD, r = nwg % NXCD, xcd = wgid % NXCD, off = wgid / NXCD; wgid = (xcd < r ? xcd * (q + 1) : r * (q + 1) + (xcd - r) * q) + off; }
        int e = 0;
#pragma unroll
        for (int k = 1; k < 8; ++k) e += (wgid >= pb[k] * NT) ? 1 : 0;
        int pbe = pb[0], pbn = pb[1];
#pragma unroll
        for (int k = 1; k < 8; ++k) { if (e == k) { pbe = pb[k]; pbn = pb[k + 1]; } }
        const int l = wgid - pbe * NT, Pe = pbn - pbe;
        const int nig = WGM * NT, gid = l / nig, fm = gid * WGM, gsz = (Pe - fm) < WGM ? (Pe - fm) : WGM;
        u.pm = pbe + fm + ((l % nig) % gsz); const int pn = (l % nig) / gsz; u.pn = e * NT + pn; u.aux = pn; return true;
    }
};

struct TableOrder {
    static constexpr bool KSPLIT = false;
    const LAS int* tab; int n;
    __device__ __forceinline__ bool next(int i, Unit& u) const {
        if (i >= n) return false;
        u.pm = __builtin_amdgcn_readfirstlane(tab[4 * i]); u.pn = __builtin_amdgcn_readfirstlane(tab[4 * i + 1]); u.aux = __builtin_amdgcn_readfirstlane(tab[4 * i + 2]); return true;
    }
};
struct TableOrderK {
    static constexpr bool KSPLIT = true;
    const LAS int* tab; int n;
    __device__ __forceinline__ bool next(int i, Unit& u) const {
        if (i >= n) return false;
        u.pm = __builtin_amdgcn_readfirstlane(tab[4 * i]); u.pn = __builtin_amdgcn_readfirstlane(tab[4 * i + 1]); u.aux = __builtin_amdgcn_readfirstlane(tab[4 * i + 2]); u.kx = __builtin_amdgcn_readfirstlane(tab[4 * i + 3]); return true;
    }
};
typedef int v8i32 __attribute__((ext_vector_type(8)));
template <class Epi, class Sched, bool ALIGN_EPI, bool SP2, int FMT = 0>
__device__ __forceinline__ void gemm_phase(LAS unsigned char* lds, const Gemm g, const Sched& S, const Epi& E) {
    const int tid = tid_opaque(), wid = __builtin_amdgcn_readfirstlane(tid >> 6), lane = tid & 63, wr = wid >> 2, wc = wid & 3, fr = lane & 15, fq = lane >> 4;
    constexpr bool F8 = (FMT != 0);
    const int K = g.K, RB = F8 ? K : 2 * K, nt = RB / 128;
    unsigned voffA, voffB;
    { int R, C; stage_rc(tid * 16, R, C); const int Rb = Epi::PERM ? ((R & ~31) + perm32(R & 31)) : R; voffA = (unsigned)(R * RB + C * 2); voffB = (unsigned)(Rb * RB + C * 2); }
    const size_t rstep = (size_t)64 * RB;
    const size_t kstep = (size_t)(BK * 2);
    const size_t hstep = (size_t)HALF * RB;
    const size_t tstep = 2 * hstep;
    const unsigned ldsw = (unsigned)wid * 1024u;
    const int aoff = lds_byte(wr * 64 + fr, fq * 8), boff = lds_byte(wc * 32 + fr, fq * 8);
#define PG8_SA(b, h) (((b) * 2 + (h)) * HTB)
#define PG8_SB(b, h) ((4 + (b) * 2 + (h)) * HTB)
#define PG8_STAGE(bufoff, gbase, voff) do { _Pragma("unroll") for (int _i = 0; _i < 2; ++_i) \
        __builtin_amdgcn_global_load_lds((const unsigned*)((const char*)(gbase) + _i * rstep + (voff)), (LAS unsigned*)(lds + (bufoff) + ldsw + _i * 8192), 16, 0, 0); } while (0)
#define PG8_LDA(dst, b, h) do { _Pragma("unroll") for (int m = 0; m < 4; ++m) _Pragma("unroll") for (int k = 0; k < 2; ++k) dst[m][k] = *(const LAS bf16x8*)(lds + PG8_SA(b, h) + aoff + m * 2048 + k * 1024); } while (0)
#define PG8_LDB(dst, b, h) do { _Pragma("unroll") for (int n = 0; n < 2; ++n) _Pragma("unroll") for (int k = 0; k < 2; ++k) dst[n][k] = *(const LAS bf16x8*)(lds + PG8_SB(b, h) + boff + n * 2048 + k * 1024); } while (0)
#define PG8_CAT(x) __builtin_shufflevector(__builtin_bit_cast(u32x4, x[0]), __builtin_bit_cast(u32x4, x[1]), 0, 1, 2, 3, 4, 5, 6, 7)
#define PG8_D6(x) __builtin_bit_cast(v6i32, __builtin_shufflevector(__builtin_bit_cast(u32x4, x[0]), __builtin_bit_cast(u32x4, x[1]), 0, 1, 2, 3, 4, 5))
#define PG8_S6(x) ((int)__builtin_bit_cast(u32x4, x[1])[2])
#define PG8_MMA(ai, bj, At, Bt) do { __builtin_amdgcn_s_setprio(1); if constexpr (FMT == 1) { _Pragma("unroll") for (int m = 0; m < 4; ++m) _Pragma("unroll") for (int n = 0; n < 2; ++n) \
        asm volatile("v_mfma_f32_16x16x128_f8f6f4 %0, %1, %2, %0" : "+v"(acc[ai][bj][m][n]) : "v"(__builtin_bit_cast(v8i32, PG8_CAT(Bt[n]))), "v"(__builtin_bit_cast(v8i32, PG8_CAT(At[m])))); } \
        else if constexpr (FMT == 2) { _Pragma("unroll") for (int m = 0; m < 4; ++m) _Pragma("unroll") for (int n = 0; n < 2; ++n) \
        acc[ai][bj][m][n] = __builtin_amdgcn_mfma_scale_f32_16x16x128_f8f6f4(__builtin_bit_cast(v8i32, PG8_CAT(Bt[n])), __builtin_bit_cast(v8i32, PG8_CAT(At[m])), acc[ai][bj][m][n], 2, 2, 0, PG8_S6(Bt[n]), 0, PG8_S6(At[m])); } \
        else { _Pragma("unroll") for (int m = 0; m < 4; ++m) _Pragma("unroll") for (int n = 0; n < 2; ++n) _Pragma("unroll") for (int k = 0; k < 2; ++k) \
        acc[ai][bj][m][n] = __builtin_amdgcn_mfma_f32_16x16x32_bf16(Bt[n][k], At[m][k], acc[ai][bj][m][n], 0, 0, 0); } __builtin_amdgcn_s_setprio(0); } while (0)
#define PG8_WAIT_V(n) asm volatile("s_waitcnt vmcnt(" #n ")" ::: "memory")
#define PG8_WAIT_L(n) asm volatile("s_waitcnt lgkmcnt(" #n ")" ::: "memory")
#define PG8_BAR __builtin_amdgcn_s_barrier()
#define PG8_SCHED __builtin_amdgcn_sched_barrier(0)
    Unit cur, nxt; int ui = 0;
    if (!S.next(0, cur)) return;
    constexpr bool KS = Sched::KSPLIT;
    auto k_off = [&](const Unit& u) -> size_t { if constexpr (KS) { if (u.kx) return (size_t)((u.kx >> 8) & 255) * (size_t)(nt / (u.kx >> 16)) * 128; } return 0; };
    auto k_cnt = [&](const Unit& u) -> int { if constexpr (KS) { if (u.kx) return nt / (u.kx >> 16); } return nt; };
    int ntc = k_cnt(cur);
    f32x4 acc[2][2][4][2];
#pragma unroll
    for (int a = 0; a < 2; ++a)
#pragma unroll
        for (int b = 0; b < 2; ++b)
#pragma unroll
            for (int m = 0; m < 4; ++m)
#pragma unroll
                for (int n = 0; n < 2; ++n) acc[a][b][m][n] = (f32x4){0.f, 0.f, 0.f, 0.f};
    bf16x8 At[4][2], B0[2][2], B1[2][2];
    const char* cA = (const char*)g.A + (size_t)cur.pm * tstep + k_off(cur); const char* cB = (const char*)g.Bt + (size_t)cur.pn * tstep + k_off(cur);
    if constexpr (SP2) {
        PG8_STAGE(PG8_SB(0, 0), cB, voffB); PG8_STAGE(PG8_SB(0, 1), cB + hstep, voffB); PG8_STAGE(PG8_SA(0, 0), cA, voffA); PG8_STAGE(PG8_SA(0, 1), cA + hstep, voffA);
        if (wr == 1) PG8_BAR;
        PG8_WAIT_V(2); PG8_BAR;
        PG8_STAGE(PG8_SB(1, 0), cB + kstep, voffB); PG8_STAGE(PG8_SA(1, 0), cA + kstep, voffA); PG8_STAGE(PG8_SB(1, 1), cB + hstep + kstep, voffB);
        PG8_WAIT_V(6); PG8_BAR;
    } else {
        PG8_STAGE(PG8_SB(0, 0), cB, voffB); PG8_STAGE(PG8_SA(0, 0), cA, voffA); PG8_STAGE(PG8_SB(0, 1), cB + hstep, voffB); PG8_STAGE(PG8_SA(0, 1), cA + hstep, voffA);
        if (wr == 1) PG8_BAR;
        PG8_WAIT_V(4); PG8_BAR;
        PG8_STAGE(PG8_SB(1, 0), cB + kstep, voffB); PG8_STAGE(PG8_SA(1, 0), cA + kstep, voffA); PG8_STAGE(PG8_SB(1, 1), cB + hstep + kstep, voffB);
        PG8_WAIT_V(6); PG8_BAR;
    }
    for (;;) {
        const bool has_next = S.next(ui + 1, nxt);
        const char* nA = has_next ? (const char*)g.A + (size_t)nxt.pm * tstep + k_off(nxt) : cA; const char* nB = has_next ? (const char*)g.Bt + (size_t)nxt.pn * tstep + k_off(nxt) : cB;
        for (int t = 0; t < ntc; t += 2) {
            if constexpr (Epi::MID_T >= 0) { if (t == Epi::MID_T) { const int l2 = tid_opaque() & 63; E.mid(acc, cur, wr, wc, l2 & 15, l2 >> 4); } }
            const bool last = (t == ntc - 2);
            const char* a1 = cA + (size_t)(t + 1) * kstep;
            const char* a2 = last ? nA : cA + (size_t)(t + 2) * kstep; const char* b2 = last ? nB : cB + (size_t)(t + 2) * kstep;
            const char* a3 = a2 + kstep; const char* b3 = b2 + kstep;
            if constexpr (SP2) {
            PG8_LDB(B0, 0, 0); PG8_LDB(B1, 0, 1); PG8_SCHED; PG8_LDA(At, 0, 0); PG8_STAGE(PG8_SA(1, 1), a1 + hstep, voffA);
            PG8_WAIT_V(8); PG8_WAIT_L(0); PG8_BAR; PG8_MMA(0, 0, At, B0); PG8_MMA(0, 1, At, B1); PG8_BAR; PG8_SCHED;
            PG8_LDA(At, 0, 1); PG8_STAGE(PG8_SB(0, 0), b2, voffB); PG8_STAGE(PG8_SB(0, 1), b2 + hstep, voffB); PG8_STAGE(PG8_SA(0, 0), a2, voffA);
            PG8_WAIT_V(8); PG8_WAIT_L(0); PG8_BAR; PG8_MMA(1, 0, At, B0); PG8_MMA(1, 1, At, B1); PG8_BAR; PG8_SCHED;
            PG8_LDB(B0, 1, 0); PG8_LDB(B1, 1, 1); PG8_SCHED; PG8_LDA(At, 1, 0); PG8_STAGE(PG8_SA(0, 1), a2 + hstep, voffA);
            PG8_WAIT_V(8); PG8_WAIT_L(0); PG8_BAR; PG8_MMA(0, 0, At, B0); PG8_MMA(0, 1, At, B1); PG8_BAR; PG8_SCHED;
            PG8_LDA(At, 1, 1); PG8_STAGE(PG8_SB(1, 0), b3, voffB); PG8_STAGE(PG8_SB(1, 1), b3 + hstep, voffB); PG8_STAGE(PG8_SA(1, 0), a3, voffA);
            PG8_WAIT_V(8); PG8_WAIT_L(0); PG8_BAR; PG8_MMA(1, 0, At, B0); PG8_MMA(1, 1, At, B1); PG8_BAR; PG8_SCHED;
            } else {
            PG8_LDB(B0, 0, 0); PG8_SCHED; PG8_LDA(At, 0, 0); PG8_STAGE(PG8_SA(1, 1), a1 + hstep, voffA);
            PG8_WAIT_L(8); PG8_BAR; PG8_WAIT_L(0); PG8_MMA(0, 0, At, B0); PG8_BAR; PG8_SCHED;
            PG8_LDB(B1, 0, 1); PG8_STAGE(PG8_SB(0, 0), b2, voffB);
            PG8_BAR; PG8_WAIT_L(0); PG8_MMA(0, 1, At, B1); PG8_BAR;
            PG8_LDA(At, 0, 1); PG8_STAGE(PG8_SA(0, 0), a2, voffA);
            PG8_BAR; PG8_WAIT_L(0); PG8_MMA(1, 0, At, B0); PG8_BAR; PG8_SCHED;
            PG8_STAGE(PG8_SB(0, 1), b2 + hstep, voffB);
            PG8_WAIT_V(6); PG8_BAR; PG8_MMA(1, 1, At, B1); PG8_BAR;
            PG8_LDB(B0, 1, 0); PG8_SCHED; PG8_LDA(At, 1, 0); PG8_STAGE(PG8_SA(0, 1), a2 + hstep, voffA);
            PG8_WAIT_L(8); PG8_BAR; PG8_WAIT_L(0); PG8_MMA(0, 0, At, B0); PG8_BAR; PG8_SCHED;
            PG8_LDB(B1, 1, 1); PG8_STAGE(PG8_SB(1, 0), b3, voffB);
            PG8_BAR; PG8_WAIT_L(0); PG8_MMA(0, 1, At, B1); PG8_BAR;
            PG8_LDA(At, 1, 1); PG8_STAGE(PG8_SA(1, 0), a3, voffA);
            PG8_BAR; PG8_WAIT_L(0); PG8_MMA(1, 0, At, B0); PG8_BAR; PG8_SCHED;
            PG8_STAGE(PG8_SB(1, 1), b3 + hstep, voffB);
            PG8_WAIT_V(6); PG8_BAR; PG8_MMA(1, 1, At, B1); PG8_BAR;
            }
        }
        if constexpr (ALIGN_EPI) { if (wr == 0) PG8_BAR; }
        if constexpr (F8) asm volatile("s_nop 15\n\ts_nop 15" ::: "memory");
        { const int l2 = tid_opaque() & 63; E(acc, cur, wr, wc, l2 & 15, l2 >> 4); }
        if (!has_next) break;
#pragma unroll
        for (int a = 0; a < 2; ++a)
#pragma unroll
            for (int b = 0; b < 2; ++b)
#pragma unroll
                for (int m = 0; m < 4; ++m)
#pragma unroll
                    for (int n = 0; n < 2; ++n) acc[a][b][m][n] = (f32x4){0.f, 0.f, 0.f, 0.f};
        cur = nxt; cA = nA; cB = nB; ++ui; ntc = k_cnt(cur);
        if constexpr (ALIGN_EPI) { if (wr == 1) PG8_BAR; }
    }
    PG8_WAIT_V(0);
    if constexpr (!ALIGN_EPI) { if (wr == 0) PG8_BAR; }
    PG8_BAR;
#undef PG8_SA
#undef PG8_SB
#undef PG8_STAGE
#undef PG8_LDA
#undef PG8_LDB
#undef PG8_MMA
#undef PG8_CAT
#undef PG8_D6
#undef PG8_S6
#undef PG8_WAIT_V
#undef PG8_WAIT_L
#undef PG8_BAR
#undef PG8_SCHED
}

__device__ __forceinline__ u32x4 pack8(const f32x4 a, const f32x4 b) { u32x4 w; w.x = cvt_pk_bf16(a[0], a[1]); w.y = cvt_pk_bf16(a[2], a[3]); w.z = cvt_pk_bf16(b[0], b[1]); w.w = cvt_pk_bf16(b[2], b[3]); return w; }
__device__ __forceinline__ u32x2 pack4(const f32x4 a) { u32x2 w; w.x = cvt_pk_bf16(a[0], a[1]); w.y = cvt_pk_bf16(a[2], a[3]); return w; }

constexpr int RM_BITS = 4;
__device__ __forceinline__ f32x4 rmant(const f32x4 v) {
    f32x4 r;
#pragma unroll
    for (int i = 0; i < 4; ++i) r[i] = __uint_as_float((__float_as_uint(v[i]) + (1u << (22 - RM_BITS))) & ~((1u << (23 - RM_BITS)) - 1u));
    return r;
}
struct EpiInProj {
    static constexpr int MID_T = -1;
    static constexpr bool PERM = true;
    bf16_t *cq, *ckv, *kpe, *qs, *ks, *vs; float *partq, *partkv; const float *cosm, *sinm, *coss, *sins;
    __device__ __forceinline__ void operator()(const f32x4 (&acc)[2][2][4][2], const Unit& u, int wr, int wc, int fr, int fq) const {
        const int row0 = u.pm * BM + wr * 64 + fr;
#pragma unroll
        for (int bj = 0; bj < 2; ++bj) {
            const int tc0 = u.aux * BM + bj * HALF + wc * 32 + fq * 8;
            if (tc0 < 768) {
                bf16_t* base; float* part; int ld, col, ps;
                if (tc0 < 512) { base = cq; ld = 512; col = tc0; part = partq; ps = 16; } else { base = ckv; ld = 256; col = tc0 - 512; part = partkv; ps = 8; }
#pragma unroll
                for (int ai = 0; ai < 2; ++ai)
#pragma unroll
                    for (int m = 0; m < 4; ++m) { const int row = row0 + ai * HALF + m * 16; const f32x4 v0 = acc[ai][bj][m][0], v1 = acc[ai][bj][m][1];
                        *(u32x4*)(base + (size_t)row * ld + col) = pack8(v0, v1);
                        float ss = (v0[0] * v0[0] + v0[1] * v0[1]) + (v0[2] * v0[2] + v0[3] * v0[3]) + (v1[0] * v1[0] + v1[1] * v1[1]) + (v1[2] * v1[2] + v1[3] * v1[3]);
                        ss += __shfl_xor(ss, 16); ss += __shfl_xor(ss, 32);
                        if (fq == 0) part[(size_t)row * ps + (col >> 5)] = ss; }
            } else if (tc0 < 2112) {
                bf16_t* base; const float *ct, *st; int ld, col, half, tw, g;
                if (tc0 < 832) { g = (tc0 - 768) >> 3; base = kpe; ld = 64; col = 4 * g; half = 32; ct = cosm; st = sinm; tw = 32; }
                else if (tc0 < 1856) { const int j = tc0 - 832; g = (j & 127) >> 3; base = qs; ld = 1024; col = (j >> 7) * 128 + 4 * g; half = 64; ct = coss; st = sins; tw = 64; }
                else { const int j = tc0 - 1856; g = (j & 127) >> 3; base = ks; ld = 256; col = (j >> 7) * 128 + 4 * g; half = 64; ct = coss; st = sins; tw = 64; }
#pragma unroll
                for (int ai = 0; ai < 2; ++ai)
#pragma unroll
                    for (int m = 0; m < 4; ++m) { const int row = row0 + ai * HALF + m * 16; const f32x4 x1 = acc[ai][bj][m][0], x2 = acc[ai][bj][m][1];
                        const f32x4 c = *(const f32x4*)(ct + (size_t)row * tw + 4 * g), s = *(const f32x4*)(st + (size_t)row * tw + 4 * g);
                        f32x4 o1 = x1 * c - x2 * s, o2 = x2 * c + x1 * s;
                        if (tc0 < 832) { o1 = rmant(o1); o2 = rmant(o2); }
                        *(u32x2*)(base + (size_t)row * ld + col) = pack4(o1); *(u32x2*)(base + (size_t)row * ld + col + half) = pack4(o2); }
            } else if (tc0 < 2368) {
                const int col = tc0 - 2112;
#pragma unroll
                for (int ai = 0; ai < 2; ++ai)
#pragma unroll
                    for (int m = 0; m < 4; ++m) { const int row = row0 + ai * HALF + m * 16; *(u32x4*)(vs + (size_t)row * 256 + col) = pack8(acc[ai][bj][m][0], acc[ai][bj][m][1]); }
            }
        }
    }
};
struct EpiQ {
    static constexpr int MID_T = -1;
    static constexpr bool PERM = true;
    bf16_t* q; const float *partq, *cosm, *sinm;
    __device__ __forceinline__ void operator()(const f32x4 (&acc)[2][2][4][2], const Unit& u, int wr, int wc, int fr, int fq) const {
        const int row0 = u.pm * BM + wr * 64 + fr;
        float rs[2][4];
#pragma unroll
        for (int ai = 0; ai < 2; ++ai)
#pragma unroll
            for (int m = 0; m < 4; ++m) { const f32x4* p = (const f32x4*)(partq + (size_t)(row0 + ai * HALF + m * 16) * 16); const f32x4 s = (p[0] + p[1]) + (p[2] + p[3]);
                rs[ai][m] = 1.0f / sqrtf(((s[0] + s[1]) + (s[2] + s[3])) * (1.0f / 512.0f) + RMS_EPS); }
#pragma unroll
        for (int bj = 0; bj < 2; ++bj) {
            const int tc0 = u.aux * BM + bj * HALF + wc * 32 + fq * 8, head = tc0 / 192, j = tc0 - head * 192;
            if (j < 128) {
#pragma unroll
                for (int ai = 0; ai < 2; ++ai)
#pragma unroll
                    for (int m = 0; m < 4; ++m) { const int row = row0 + ai * HALF + m * 16; *(u32x4*)(q + (size_t)row * QCOLS + tc0) = pack8(rmant(acc[ai][bj][m][0] * rs[ai][m]), rmant(acc[ai][bj][m][1] * rs[ai][m])); }
            } else {
                const int g = (j - 128) >> 3, col = head * 192 + 128 + 4 * g;
#pragma unroll
                for (int ai = 0; ai < 2; ++ai)
#pragma unroll
                    for (int m = 0; m < 4; ++m) { const int row = row0 + ai * HALF + m * 16; const f32x4 x1 = acc[ai][bj][m][0] * rs[ai][m], x2 = acc[ai][bj][m][1] * rs[ai][m];
                        const f32x4 c = *(const f32x4*)(cosm + (size_t)row * 32 + 4 * g), s = *(const f32x4*)(sinm + (size_t)row * 32 + 4 * g);
                        *(u32x2*)(q + (size_t)row * QCOLS + col) = pack4(rmant(x1 * c - x2 * s)); *(u32x2*)(q + (size_t)row * QCOLS + col + 32) = pack4(rmant(x2 * c + x1 * s)); }
            }
        }
    }
};
struct EpiKV {
    static constexpr int MID_T = -1;
    static constexpr bool PERM = true;
    bf16_t* kv; const float* partkv;
    __device__ __forceinline__ void operator()(const f32x4 (&acc)[2][2][4][2], const Unit& u, int wr, int wc, int fr, int fq) const {
        const int row0 = u.pm * BM + wr * 64 + fr;
#pragma unroll
        for (int ai = 0; ai < 2; ++ai)
#pragma unroll
            for (int m = 0; m < 4; ++m) { const int row = row0 + ai * HALF + m * 16; const f32x4* p = (const f32x4*)(partkv + (size_t)row * 8); const f32x4 s = p[0] + p[1];
                const float rs = 1.0f / sqrtf(((s[0] + s[1]) + (s[2] + s[3])) * (1.0f / 256.0f) + RMS_EPS);
#pragma unroll
                for (int bj = 0; bj < 2; ++bj) { const int col = u.aux * BM + bj * HALF + wc * 32 + fq * 8; f32x4 k0 = acc[ai][bj][m][0] * rs, k1 = acc[ai][bj][m][1] * rs; k0 = rmant(k0); k1 = rmant(k1); *(u32x4*)(kv + (size_t)row * KVCOLS + col) = pack8(k0, k1); } }
    }
};
struct EpiResid {
    static constexpr int MID_T = -1;
    static constexpr bool PERM = true;
    const float* xin; float* y; float sc;
    __device__ __forceinline__ void operator()(const f32x4 (&acc)[2][2][4][2], const Unit& u, int wr, int wc, int fr, int fq) const {
        const int row0 = u.pm * BM + wr * 64 + fr;
#pragma unroll
        for (int ai = 0; ai < 2; ++ai)
#pragma unroll
            for (int m = 0; m < 4; ++m) { const size_t ro = (size_t)(row0 + ai * HALF + m * 16) * D;
#pragma unroll
                for (int bj = 0; bj < 2; ++bj) { const size_t o = ro + u.aux * BM + bj * HALF + wc * 32 + fq * 8;
                    const f32x4 a0 = *(const f32x4*)(xin + o), a1 = *(const f32x4*)(xin + o + 4);
                    *(f32x4*)(y + o) = a0 * ALPHA + acc[ai][bj][m][0] * sc; *(f32x4*)(y + o + 4) = a1 * ALPHA + acc[ai][bj][m][1] * sc; }
                asm volatile("" ::: "memory"); }
    }
};
struct EpiResidLN {
    static constexpr int MID_T = -1;
    static constexpr bool PERM = true, PROBE2 = false;
    const float* yin; float* y; float sc; const float* st; const float* g; const float* b;
    __device__ __forceinline__ void operator()(const f32x4 (&acc)[2][2][4][2], const Unit& u, int wr, int wc, int fr, int fq) const {
        const int row0 = u.pm * BM + wr * 64 + fr, col0 = u.aux * BM + wc * 32 + fq * 8;
        f32x4 gg[2][2], bb[2][2];
#pragma unroll
        for (int bj = 0; bj < 2; ++bj)
#pragma unroll
            for (int n = 0; n < 2; ++n) { gg[bj][n] = *(const f32x4*)(g + col0 + bj * HALF + 4 * n); bb[bj][n] = *(const f32x4*)(b + col0 + bj * HALF + 4 * n); }
#pragma unroll
        for (int ai = 0; ai < 2; ++ai)
#pragma unroll
            for (int m = 0; m < 4; ++m) { const int row = row0 + ai * HALF + m * 16; const size_t ro = (size_t)row * D; const float mu = st[2 * row], rs = st[2 * row + 1];
#pragma unroll
                for (int bj = 0; bj < 2; ++bj) { const size_t o = ro + col0 + bj * HALF;
                    const f32x4 a0 = *(const f32x4*)(yin + o), a1 = *(const f32x4*)(yin + o + 4);
                    const f32x4 x0 = (a0 - mu) * rs * gg[bj][0] + bb[bj][0], x1 = (a1 - mu) * rs * gg[bj][1] + bb[bj][1];
                    *(f32x4*)(y + o) = x0 * ALPHA + acc[ai][bj][m][0] * sc; *(f32x4*)(y + o + 4) = x1 * ALPHA + acc[ai][bj][m][1] * sc; }
                asm volatile("" ::: "memory"); }
    }
};
template <bool LNIN> struct EpiOutProj {
    static constexpr bool PERM = true, PROBE2 = false; static constexpr int MID_T = 16;
    const float* xin; float* y; const float* parto; const float* st; const float* g; const float* b;
    __device__ __forceinline__ void sums(int row, float& a, float& c) const { const f32x4* p = (const f32x4*)(parto + (size_t)row * 16); const f32x4 u = p[0] + p[1], v = p[2] + p[3];
        a = ((u[0] + u[1]) + (u[2] + u[3])) * (1.0f / 1024.0f) + RMS_EPS; c = ((v[0] + v[1]) + (v[2] + v[3])) * (1.0f / 1024.0f) + RMS_EPS; }
    __device__ __forceinline__ void mid(f32x4 (&acc)[2][2][4][2], const Unit& u, int wr, int wc, int fr, int fq) const {
        const int row0 = u.pm * BM + wr * 64 + fr;
#pragma unroll
        for (int ai = 0; ai < 2; ++ai)
#pragma unroll
            for (int m = 0; m < 4; ++m) { float a, c; sums(row0 + ai * HALF + m * 16, a, c); const float r = sqrtf(c / a);
#pragma unroll
                for (int bj = 0; bj < 2; ++bj) { acc[ai][bj][m][0] *= r; acc[ai][bj][m][1] *= r; } }
    }
    __device__ __forceinline__ void operator()(const f32x4 (&acc)[2][2][4][2], const Unit& u, int wr, int wc, int fr, int fq) const {
        const int row0 = u.pm * BM + wr * 64 + fr, col0 = u.aux * BM + wc * 32 + fq * 8;
        f32x4 gg[2][2], bb[2][2];
        if (LNIN) {
#pragma unroll
            for (int bj = 0; bj < 2; ++bj)
#pragma unroll
                for (int n = 0; n < 2; ++n) { gg[bj][n] = *(const f32x4*)(g + col0 + bj * HALF + 4 * n); bb[bj][n] = *(const f32x4*)(b + col0 + bj * HALF + 4 * n); }
        }
#pragma unroll
        for (int ai = 0; ai < 2; ++ai)
#pragma unroll
            for (int m = 0; m < 4; ++m) { const int row = row0 + ai * HALF + m * 16; const size_t ro = (size_t)row * D; float a, c; sums(row, a, c); const float rsw = 1.0f / sqrtf(c);
                float mu = 0.f, rs = 1.f; if (LNIN) { mu = st[2 * row]; rs = st[2 * row + 1]; }
#pragma unroll
                for (int bj = 0; bj < 2; ++bj) { const size_t o = ro + col0 + bj * HALF;
                    f32x4 x0 = *(const f32x4*)(xin + o), x1 = *(const f32x4*)(xin + o + 4);
                    if (LNIN) { x0 = (x0 - mu) * rs * gg[bj][0] + bb[bj][0]; x1 = (x1 - mu) * rs * gg[bj][1] + bb[bj][1]; }
                    *(f32x4*)(y + o) = x0 * ALPHA + acc[ai][bj][m][0] * rsw; *(f32x4*)(y + o + 4) = x1 * ALPHA + acc[ai][bj][m][1] * rsw; }
                asm volatile("" ::: "memory"); }
    }
};
struct EpiSwiglu8 {
    static constexpr int MID_T = -1;
    static constexpr bool PERM = true;
    unsigned char* h; int ldh; float sc;
    __device__ __forceinline__ void operator()(const f32x4 (&acc)[2][2][4][2], const Unit& u, int wr, int wc, int fr, int fq) const {
        const int row0 = u.pm * BM + wr * 64 + fr, col = u.aux * HALF + wc * 32 + fq * 8;
#pragma unroll
        for (int ai = 0; ai < 2; ++ai)
#pragma unroll
            for (int m = 0; m < 4; ++m) { f32x4 r0, r1;
#pragma unroll
                for (int k = 0; k < 4; ++k) { const float g0 = acc[ai][0][m][0][k] * sc, g1 = acc[ai][0][m][1][k] * sc;
                    r0[k] = __builtin_amdgcn_fmed3f(g0 * __builtin_amdgcn_rcpf(1.0f + __builtin_amdgcn_exp2f(-1.4426950408889634f * g0)) * (acc[ai][1][m][0][k] * (sc * H8_SCALE)), -448.f, 448.f);
                    r1[k] = __builtin_amdgcn_fmed3f(g1 * __builtin_amdgcn_rcpf(1.0f + __builtin_amdgcn_exp2f(-1.4426950408889634f * g1)) * (acc[ai][1][m][1][k] * (sc * H8_SCALE)), -448.f, 448.f); }
                u32x2 w; w.x = pk_fp8x4(r0[0], r0[1], r0[2], r0[3]); w.y = pk_fp8x4(r1[0], r1[1], r1[2], r1[3]);
                *(u32x2*)(h + (size_t)(row0 + ai * HALF + m * 16) * ldh + col) = w; }
    }
};
struct EpiSwiglu6 {
    static constexpr bool PERM = true, PROBE2 = false; static constexpr int MID_T = -1;
    unsigned char* h; int ldh;
    __device__ __forceinline__ void operator()(const f32x4 (&acc)[2][2][4][2], const Unit& u, int wr, int wc, int fr, int fq) const {
#pragma unroll
        for (int ai = 0; ai < 2; ++ai) {
            float v[4][8];
#pragma unroll
            for (int m = 0; m < 4; ++m)
#pragma unroll
                for (int c = 0; c < 8; ++c) { const float g = acc[ai][0][m][c >> 2][c & 3], uu = acc[ai][1][m][c >> 2][c & 3];
                    v[m][c] = g * __builtin_amdgcn_rcpf(1.0f + __builtin_amdgcn_exp2f(-1.4426950408889634f * g)) * uu; }
            float s1[2][2][8];
#pragma unroll
            for (int mm = 0; mm < 2; ++mm)
#pragma unroll
                for (int c = 0; c < 8; ++c) { auto r = __builtin_amdgcn_permlane32_swap(__float_as_uint(v[mm][c]), __float_as_uint(v[mm + 2][c]), false, false);
                    s1[mm][0][c] = __uint_as_float(r[0]); s1[mm][1][c] = __uint_as_float(r[1]); }
            f32x16 lo, hi;
#pragma unroll
            for (int hh = 0; hh < 2; ++hh)
#pragma unroll
                for (int c = 0; c < 8; ++c) { auto r = __builtin_amdgcn_permlane16_swap(__float_as_uint(s1[0][hh][c]), __float_as_uint(s1[1][hh][c]), false, false);
                    if (hh == 0) { lo[c] = __uint_as_float(r[0]); lo[8 + c] = __uint_as_float(r[1]); } else { hi[c] = __uint_as_float(r[0]); hi[8 + c] = __uint_as_float(r[1]); } }
            unsigned sb; const u32x6 q = mx6_block(lo, hi, sb);
            unsigned char* o = h + (size_t)(u.pm * BM + ai * HALF + wr * 64 + fq * 16 + fr) * ldh + u.aux * 128 + 16 * wc;
            *(u32x4*)o = (u32x4){q[0], q[1], q[2], q[3]}; *(u32x4*)(o + 64) = (u32x4){q[4], q[5], sb, 0u};
        }
    }
};
struct EpiBf16Out {
    static constexpr int MID_T = -1;
    static constexpr bool PERM = true;
    bf16_t* o; int ld; float sc;
    __device__ __forceinline__ void operator()(const f32x4 (&acc)[2][2][4][2], const Unit& u, int wr, int wc, int fr, int fq) const {
        const int row0 = u.pm * BM + wr * 64 + fr;
#pragma unroll
        for (int ai = 0; ai < 2; ++ai)
#pragma unroll
            for (int m = 0; m < 4; ++m)
#pragma unroll
                for (int bj = 0; bj < 2; ++bj) *(u32x4*)(o + (size_t)(row0 + ai * HALF + m * 16) * ld + u.aux * BM + bj * HALF + wc * 32 + fq * 8) = pack8(acc[ai][bj][m][0] * sc, acc[ai][bj][m][1] * sc);
    }
};
struct EpiBf16OutK {
    static constexpr int MID_T = -1;
    static constexpr bool PERM = true;
    bf16_t* o; bf16_t* yp;
    __device__ __forceinline__ void operator()(const f32x4 (&acc)[2][2][4][2], const Unit& u, int wr, int wc, int fr, int fq) const {
        bf16_t* base; int ld;
        if (u.kx) { base = yp + ((size_t)(((u.kx >> 8) & 255) * 128 + (u.kx & 255) - 1) * 256 + wr * 64 + fr) * 256; ld = 256; }
        else { base = o + (size_t)(u.pm * BM + wr * 64 + fr) * D + u.aux * BM; ld = D; }
#pragma unroll
        for (int ai = 0; ai < 2; ++ai)
#pragma unroll
            for (int m = 0; m < 4; ++m)
#pragma unroll
                for (int bj = 0; bj < 2; ++bj) *(u32x4*)(base + (size_t)(ai * HALF + m * 16) * ld + bj * HALF + wc * 32 + fq * 8) = pack8(acc[ai][bj][m][0], acc[ai][bj][m][1]);
    }
};
}

namespace att {
constexpr int NW = 8, QBLK = 32, KVBLK = 64;
constexpr float THR = 8.f;
constexpr int SHM_V = KVBLK * 128 * 2, SHM_K = KVBLK * 272, SHM_P = KVBLK * 144;
constexpr int OFF_V = 0, OFF_K = 3 * SHM_V, OFF_P = OFF_K + 2 * SHM_K,     OFF_WS = OFF_P + 2 * SHM_P, OFF_QP = OFF_WS + NW * 64 * 4, SHM_ATTN = OFF_QP + NW * 4096;
typedef LAS const char* lptr;
typedef short v4i16_t __attribute__((ext_vector_type(4)));
#define SBAR() __builtin_amdgcn_sched_barrier(0)
#define PIN(x) asm volatile("" : "+v"(x))
__device__ __forceinline__ int crow(int r, int hi) { return (r & 3) + 8 * (r >> 2) + 4 * hi; }
__device__ __forceinline__ bf16x8 ldk(lptr p) { return *(const LAS bf16x8*)p; }
__device__ __forceinline__ s16x4 vtr(lptr p) { return __builtin_bit_cast(s16x4, __builtin_amdgcn_ds_read_tr16_b64_v4i16((LAS v4i16_t*)p)); }
__device__ __forceinline__ int v_st(int k, int c) { const int kk = (k & ~0xC) | ((k & 4) << 1) | ((k & 8) >> 1); return ((kk >> 3) * 4 + (c >> 5)) * 512 + ((kk & 7) * 32 + (c & 31)) * 2; }
__device__ __forceinline__ int v_rd_base(int lane) { return ((lane & 3) << 3) | (((lane >> 2) & 3) << 6) | (((lane >> 4) & 1) << 5) | (((lane >> 5) & 1) << 8); }
__device__ __forceinline__ bf16x8 pk4(float a0, float a1, float a2, float a3, float a4, float a5, float a6, float a7) {
  const unsigned x0 = cvt_pk_bf16(a0, a1), x1 = cvt_pk_bf16(a2, a3), y0 = cvt_pk_bf16(a4, a5), y1 = cvt_pk_bf16(a6, a7);
  auto r0 = __builtin_amdgcn_permlane32_swap(x0, y0, false, false); auto r1 = __builtin_amdgcn_permlane32_swap(x1, y1, false, false);
  u32x4 w = {r0[0], r1[0], r0[1], r1[1]}; return __builtin_bit_cast(bf16x8, w);
}
constexpr int PD = 4;
template <int NQ>
__device__ __forceinline__ bf16x8 kfrag(lptr kb, lptr pb, int n) { const int d0 = n >> 1, h = n & 1; return d0 < 8 ? ldk(kb + h * (32 * 272) + d0 * 32) : ldk(pb + h * (32 * 144) + (d0 - 8) * 32); }
template <int NQ, bool DO_QK, bool DO_FIN>
__device__ __forceinline__ void phaseA(f32x16& C0, f32x16& C1, const f32x16& P0, const f32x16& P1, float alphaP, float& l_reg, bf16x8 (&pa)[4],
                                       lptr kb, lptr pb, lptr qp, const bf16x8 (&qr)[8]) {
  constexpr int NF = 2 * NQ;
  float s0 = 0.f, s1 = 0.f, s2 = 0.f, s3 = 0.f;
  bf16x8 f[NF + PD]; bf16x8 qx[NQ > 8 ? NQ - 8 : 1];
  if (DO_QK) {
#pragma unroll
    for (int n = 0; n < PD; ++n) f[n] = kfrag<NQ>(kb, pb, n);
  }
#pragma unroll
  for (int n = 0; n < NF; ++n) {
    if (DO_QK) {
      const int d0 = n >> 1;
      if (n + PD < NF) f[n + PD] = kfrag<NQ>(kb, pb, n + PD);
      if (NQ > 8) { const int dq = (n + PD) >> 1; if (((n + PD) & 1) == 0 && dq >= 8 && dq < NQ) qx[dq - 8 < 0 ? 0 : dq - 8] = ldk(qp + (dq - 8) * 1024); }
      const bf16x8 qf = (d0 < 8) ? qr[d0 < 8 ? d0 : 0] : qx[d0 >= 8 ? d0 - 8 : 0];
      if (n == 0)            C0 = __builtin_amdgcn_mfma_f32_32x32x16_bf16(f[n], qf, f32x16{}, 0, 0, 0);
      else if (n == 1)       C1 = __builtin_amdgcn_mfma_f32_32x32x16_bf16(f[n], qf, f32x16{}, 0, 0, 0);
      else if ((n & 1) == 0) C0 = __builtin_amdgcn_mfma_f32_32x32x16_bf16(f[n], qf, C0, 0, 0, 0);
      else                   C1 = __builtin_amdgcn_mfma_f32_32x32x16_bf16(f[n], qf, C1, 0, 0, 0);
    }
    if (DO_FIN) {
#pragma unroll
      for (int e = n * 32 / NF; e < (n + 1) * 32 / NF; ++e) { const float v = e < 16 ? P0[e & 15] : P1[e & 15]; if ((e & 3) == 0) s0 += v; else if ((e & 3) == 1) s1 += v; else if ((e & 3) == 2) s2 += v; else s3 += v; }
      PIN(s0); PIN(s1); PIN(s2); PIN(s3);
      if (n == NF / 8)     { pa[0] = pk4(P0[0], P0[1], P0[2], P0[3], P0[4], P0[5], P0[6], P0[7]); PIN(pa[0]); }
      if (n == 3 * NF / 8) { pa[1] = pk4(P0[8], P0[9], P0[10], P0[11], P0[12], P0[13], P0[14], P0[15]); PIN(pa[1]); }
      if (n == 5 * NF / 8) { pa[2] = pk4(P1[0], P1[1], P1[2], P1[3], P1[4], P1[5], P1[6], P1[7]); PIN(pa[2]); }
      if (n == 7 * NF / 8) { pa[3] = pk4(P1[8], P1[9], P1[10], P1[11], P1[12], P1[13], P1[14], P1[15]); PIN(pa[3]); }
    }
    SBAR();
  }
  if (DO_FIN) { float ps = (s0 + s1) + (s2 + s3); auto rr = __builtin_amdgcn_permlane32_swap(__float_as_uint(ps), __float_as_uint(ps), false, false);
    ps = __uint_as_float(rr[0]) + __uint_as_float(rr[1]); l_reg = l_reg * alphaP + ps; }
}
template <bool MASK, bool DO_PV, bool DO_SM>
__device__ __forceinline__ void phaseB(f32x16 (&o)[4], const bf16x8 (&pa)[4], f32x16& C0, f32x16& C1, float& m_reg, float& alpha, lptr vb, float Cs, float thr_raw, int qi, int k0, int hi) {
  s16x4 vl[16 + PD], vh[16 + PD];
  if (DO_PV) {
#pragma unroll
    for (int n = 0; n < PD; ++n) { const int d0 = n & 3, ks = n >> 2; vl[n] = vtr(vb + d0 * 512 + ks * 4096); vh[n] = vtr(vb + d0 * 512 + ks * 4096 + 2048); }
  }
  float mx = -3.0e38f, mnC = 0.f;
#pragma unroll
  for (int n = 0; n < 16; ++n) {
    if (DO_PV) {
      const int d0 = n & 3, ks = n >> 2;
      if (n + PD < 16) { const int d1 = (n + PD) & 3, k1 = (n + PD) >> 2; vl[n + PD] = vtr(vb + d1 * 512 + k1 * 4096); vh[n + PD] = vtr(vb + d1 * 512 + k1 * 4096 + 2048); }
      const bf16x8 vf = (bf16x8){vl[n][0], vl[n][1], vl[n][2], vl[n][3], vh[n][0], vh[n][1], vh[n][2], vh[n][3]};
      o[d0] = __builtin_amdgcn_mfma_f32_32x32x16_bf16(pa[ks], vf, o[d0], 0, 0, 0);
    }
    if (DO_SM) {
      if (n < 4) {
#pragma unroll
        for (int e = n * 8; e < n * 8 + 8; ++e) {
          if (MASK) { const int d = qi - (k0 + (e < 16 ? 0 : 32) + crow(e & 15, hi)); if (d > 128 || d < -128) { if (e < 16) C0[e & 15] = -1e30f; else C1[e & 15] = -1e30f; } }
          mx = fmaxf(mx, e < 16 ? C0[e & 15] : C1[e & 15]); }
        PIN(mx);
      } else if (n == 4) {
        auto rr = __builtin_amdgcn_permlane32_swap(__float_as_uint(mx), __float_as_uint(mx), false, false);
        const float pmax = fmaxf(__uint_as_float(rr[0]), __uint_as_float(rr[1]));
        const bool keep = __all(pmax - m_reg <= thr_raw);
        const float mn = keep ? m_reg : fmaxf(m_reg, pmax);
        alpha = __builtin_amdgcn_exp2f((m_reg - mn) * Cs); m_reg = mn; mnC = -mn * Cs; PIN(alpha); PIN(mnC);
      } else {
#pragma unroll
        for (int e = (n - 5) * 32 / 11; e < (n - 4) * 32 / 11; ++e) {
          if (e < 16) C0[e] = __builtin_amdgcn_exp2f(fmaf(C0[e], Cs, mnC)); else C1[e - 16] = __builtin_amdgcn_exp2f(fmaf(C1[e - 16], Cs, mnC)); }
        if ((n - 5) * 32 / 11 < 16) PIN(C0); if ((n - 4) * 32 / 11 > 16) PIN(C1);
      }
    }
    SBAR();
  }
}

template <int DQK, bool MASK, int LDQ, int LDK, int LDP, int LDV, int LDO>
__device__ __forceinline__ void attn_body(const bf16_t* __restrict__ Qb, const bf16_t* __restrict__ Kb, const bf16_t* __restrict__ Pb, const bf16_t* __restrict__ Vb,
                                          bf16_t* __restrict__ Ob, float* __restrict__ ssq, int q0, int kstart, int NT, float scale, float sink_raw, LAS char* lds) {
  constexpr int NQ = DQK / 16;
  const float Cs = scale * 1.4426950408889634f, thr_raw = THR / scale;
  const int tid = tid_opaque(), wid = tid >> 6, lane = tid & 63, r32 = lane & 31, hi = lane >> 5;
  LAS char* V_lds = lds + OFF_V; LAS char* K_lds = lds + OFF_K; LAS char* P_lds = lds + OFF_P;
  LAS float* ws = (LAS float*)(lds + OFF_WS) + wid * 64; LAS float* li_l = ws; LAS float* al_l = ws + 32;
  float m_reg = MASK ? sink_raw : -1e30f, l_reg = MASK ? 1.f : 0.f; f32x16 o[4] = {}; bf16x8 qr[8];
  const bf16_t* Qw = Qb + (long)(wid * QBLK + r32) * LDQ + hi * 8;
  LAS char* Qp = lds + OFF_QP + wid * 4096 + lane * 16;
#pragma unroll
  for (int d0 = 0; d0 < 8; ++d0) qr[d0] = *reinterpret_cast<const bf16x8*>(Qw + d0 * 16);
  if (NQ > 8) {
#pragma unroll
    for (int d0 = 0; d0 < NQ - 8; ++d0) *(LAS bf16x8*)(Qp + d0 * 1024) = *reinterpret_cast<const bf16x8*>(Qw + 128 + d0 * 16);
  }
  const int sr = tid >> 4, sc = (tid & 15) * 8, vst0 = v_st(sr, sc), vst1 = v_st(32 + sr, sc);
  const int pr = tid >> 3, pc = (tid & 7) * 8;
  const lptr kb0 = (lptr)K_lds + r32 * 272 + hi * 16, pb0 = (lptr)P_lds + r32 * 144 + hi * 16, vb0 = (lptr)V_lds + v_rd_base(lane);
  const int qi = q0 + wid * QBLK + r32;
  bf16x8 vs0, vs1, ks0, ks1, ps0;
  const unsigned voff0 = sr * LDV + sc, voff1 = (32 + sr) * LDV + sc, koff0 = sr * LDK + sc, koff1 = (32 + sr) * LDK + sc, poff = pr * LDP + pc;
#define SLOAD(k0) do { const bf16_t* Vt = Vb + (long)(k0) * LDV; const bf16_t* Kt = Kb + (long)(k0) * LDK; \
    vs0 = *reinterpret_cast<const bf16x8*>(Vt + voff0); vs1 = *reinterpret_cast<const bf16x8*>(Vt + voff1); \
    ks0 = *reinterpret_cast<const bf16x8*>(Kt + koff0); ks1 = *reinterpret_cast<const bf16x8*>(Kt + koff1); \
    if (NQ > 8) { const bf16_t* Pt = Pb + (long)(k0) * LDP; ps0 = *reinterpret_cast<const bf16x8*>(Pt + poff); } } while (0)
#define SWRITE(kb_, vo_) do { *(LAS bf16x8*)(V_lds + (vo_) + vst0) = vs0; *(LAS bf16x8*)(V_lds + (vo_) + vst1) = vs1; \
    *(LAS bf16x8*)(K_lds + (kb_) * SHM_K + sr * 272 + sc * 2) = ks0; *(LAS bf16x8*)(K_lds + (kb_) * SHM_K + (32 + sr) * 272 + sc * 2) = ks1; \
    if (NQ > 8) *(LAS bf16x8*)(P_lds + (kb_) * SHM_P + pr * 144 + pc * 2) = ps0; } while (0)
#define SWAIT() asm volatile("s_waitcnt vmcnt(0)" ::: "memory")
#define RESC(a) do { if (__any((a) < 1.f)) { if (hi == 0) al_l[r32] = (a); asm volatile("s_waitcnt lgkmcnt(0)" ::: "memory"); \
    _Pragma("unroll") for (int d = 0; d < 4; ++d) _Pragma("unroll") for (int r = 0; r < 16; ++r) o[d][r] *= al_l[crow(r, hi)]; } } while (0)
#define ROTV() do { const int t_ = vprev; vprev = vcur; vcur = vnext; vnext = t_; } while (0)
  f32x16 pA0, pA1, pB0, pB1; float alA = 1.f, alB = 1.f; bf16x8 pa[4];
  int vprev = 0, vcur = SHM_V, vnext = 2 * SHM_V;
  SLOAD(kstart); SWAIT(); SWRITE(0, 0); __syncthreads();
  SLOAD(kstart + KVBLK);
  phaseA<NQ, true, false>(pA0, pA1, pA0, pA1, 1.f, l_reg, pa, kb0, pb0, (lptr)Qp, qr);
  SWAIT(); SWRITE(1, SHM_V);
  phaseB<MASK, false, true>(o, pa, pA0, pA1, m_reg, alA, vb0, Cs, thr_raw, qi, kstart, hi);
  __syncthreads();
  for (int j = 1; j + 1 < NT; j += 2) {
    SBAR(); SLOAD(kstart + (j + 1) * KVBLK); SBAR();
    phaseA<NQ, true, true>(pB0, pB1, pA0, pA1, alA, l_reg, pa, kb0 + SHM_K, pb0 + SHM_P, (lptr)Qp, qr);
    SWAIT(); SWRITE(0, vnext);
    phaseB<MASK, true, true>(o, pa, pB0, pB1, m_reg, alB, vb0 + vprev, Cs, thr_raw, qi, kstart + j * KVBLK, hi);
    RESC(alB); ROTV(); __syncthreads();
    SBAR(); if (j + 2 < NT) SLOAD(kstart + (j + 2) * KVBLK); SBAR();
    phaseA<NQ, true, true>(pA0, pA1, pB0, pB1, alB, l_reg, pa, kb0, pb0, (lptr)Qp, qr);
    if (j + 2 < NT) { SWAIT(); SWRITE(1, vnext); }
    phaseB<MASK, true, true>(o, pa, pA0, pA1, m_reg, alA, vb0 + vprev, Cs, thr_raw, qi, kstart + (j + 1) * KVBLK, hi);
    RESC(alA); ROTV(); __syncthreads();
  }
  SBAR(); phaseA<NQ, true, true>(pB0, pB1, pA0, pA1, alA, l_reg, pa, kb0 + SHM_K, pb0 + SHM_P, (lptr)Qp, qr);
  phaseB<MASK, true, true>(o, pa, pB0, pB1, m_reg, alB, vb0 + vprev, Cs, thr_raw, qi, kstart + (NT - 1) * KVBLK, hi);
  RESC(alB); ROTV();
  phaseA<NQ, false, true>(pA0, pA1, pB0, pB1, alB, l_reg, pa, kb0, pb0, (lptr)Qp, qr);
  phaseB<MASK, true, false>(o, pa, pA0, pA1, m_reg, alA, vb0 + vprev, Cs, thr_raw, qi, 0, hi);
  if (hi == 0) li_l[r32] = l_reg; asm volatile("s_waitcnt lgkmcnt(0)" ::: "memory");
  bf16_t* Ow = Ob + (long)(wid * QBLK) * LDO;
#pragma unroll
  for (int r = 0; r < 16; ++r) { const int orow = crow(r, hi); const float rl = __builtin_amdgcn_rcpf(li_l[orow]); float sq = 0.f;
#pragma unroll
    for (int d0 = 0; d0 < 4; ++d0) { const float v = o[d0][r] * rl; sq += v * v; Ow[(long)orow * LDO + d0 * 32 + r32] = (bf16_t)(cvt_pk_bf16(v, v) & 0xffffu); }
#pragma unroll
    for (int s = 1; s < 32; s <<= 1) sq += __shfl_xor(sq, s);
    if (r32 == 0) ssq[(long)(wid * QBLK + orow) * 16] = sq; }
  __syncthreads();
#undef SLOAD
#undef SWRITE
#undef SWAIT
#undef RESC
#undef ROTV
}
#undef SBAR
#undef PIN
}

constexpr int NWAVES = 8;
#ifndef PROBE_ATT
#define PROBE_ATT 1
#endif
#ifndef PROBE_PRO
#define PROBE_PRO 1
#endif
#ifndef PROBE_MOEUP
#define PROBE_MOEUP 1
#endif
constexpr int RING_BYTES = 133120;
constexpr int MISC_OFF = 139264, LDS_BYTES = 147456;
static_assert(att::SHM_ATTN <= MISC_OFF && RING_BYTES <= MISC_OFF, "LDS map");
constexpr int NPHASE = 21;

__device__ const float INVF[64] = {
 1.000000000e+00f, 8.659643531e-01f, 7.498942018e-01f, 6.493816376e-01f, 5.623413324e-01f, 4.869675338e-01f, 4.216965139e-01f, 3.651741147e-01f, 3.162277639e-01f, 2.738419771e-01f, 2.371373773e-01f, 2.053525001e-01f, 1.778279394e-01f, 1.539926529e-01f, 1.333521456e-01f, 1.154781953e-01f,
 1.000000015e-01f, 8.659642935e-02f, 7.498942316e-02f, 6.493816525e-02f, 5.623413250e-02f, 4.869675264e-02f, 4.216964915e-02f, 3.651741147e-02f, 3.162277490e-02f, 2.738419548e-02f, 2.371373773e-02f, 2.053525113e-02f, 1.778279431e-02f, 1.539926510e-02f, 1.333521400e-02f, 1.154781971e-02f,
 9.999999776e-03f, 8.659643121e-03f, 7.498942316e-03f, 6.493816152e-03f, 5.623413250e-03f, 4.869675264e-03f, 4.216964822e-03f, 3.651741194e-03f, 3.162277630e-03f, 2.738419687e-03f, 2.371373819e-03f, 2.053525066e-03f, 1.778279431e-03f, 1.539926510e-03f, 1.333521446e-03f, 1.154782018e-03f,
 1.000000047e-03f, 8.659643354e-04f, 7.498941850e-04f, 6.493816036e-04f, 5.623413017e-04f, 4.869675322e-04f, 4.216965172e-04f, 3.651741135e-04f, 3.162277571e-04f, 2.738419571e-04f, 2.371373703e-04f, 2.053525095e-04f, 1.778279402e-04f, 1.539926598e-04f, 1.333521504e-04f, 1.154782003e-04f };

struct Args { const float* in[21]; float* out; unsigned char* ws; int ph_lo, ph_hi; };

__device__ __forceinline__ float wave_sum(float v) {
#pragma unroll
    for (int o = 1; o < 64; o <<= 1) v += __shfl_xor(v, o);
    return v;
}
__device__ __forceinline__ void sincos_acc(float ang, float& sn, float& cs) {
    const double a = (double)ang;
    const double n = __builtin_rint(a * 0.63661977236758134308);
    double r = __builtin_fma(-n, 1.57079632679489655800, a); r = __builtin_fma(-n, 6.12323399573676603587e-17, r);
    const double r2 = r * r;
    double sp = 1.0 / 6227020800.0; sp = __builtin_fma(sp, r2, -1.0 / 39916800.0); sp = __builtin_fma(sp, r2, 1.0 / 362880.0); sp = __builtin_fma(sp, r2, -1.0 / 5040.0);
    sp = __builtin_fma(sp, r2, 1.0 / 120.0); sp = __builtin_fma(sp, r2, -1.0 / 6.0); sp = __builtin_fma(sp * r2, r, r);
    double cp = 1.0 / 479001600.0; cp = __builtin_fma(cp, r2, -1.0 / 3628800.0); cp = __builtin_fma(cp, r2, 1.0 / 40320.0); cp = __builtin_fma(cp, r2, -1.0 / 720.0);
    cp = __builtin_fma(cp, r2, 1.0 / 24.0); cp = __builtin_fma(cp, r2, -0.5); cp = __builtin_fma(cp, r2, 1.0);
    const int q = ((int)n) & 3;
    const double s_ = (q & 1) ? cp : sp, c_ = (q & 1) ? sp : cp;
    sn = (float)((q & 2) ? -s_ : s_); cs = (float)(((q + 1) & 2) ? -c_ : c_);
}

__device__ __forceinline__ int src_quad(int kind, int n, int coff) {
    if (kind == 0) return coff + n;
    if (kind == 1) {
        if (n < 768 || (n >= 2112 && n < 2368)) return n;
        if (n >= 2368) return -1;
        int base, half, j;
        if (n < 832) { base = 768; half = 32; j = n - 768; } else if (n < 1856) { j = (n - 832) & 127; base = n - j; half = 64; } else { j = (n - 1856) & 127; base = n - j; half = 64; }
        const int g = j >> 3, e = j & 7; return base + (e < 4 ? 4 * g : half + 4 * g);
    }
    { const int head = n / 192, j = n - head * 192; if (j < 128) return n; const int jj = j - 128, g = jj >> 3, e = jj & 7; return head * 192 + 128 + (e < 4 ? 4 * g : 32 + 4 * g); }
}
__device__ __forceinline__ void tr_item(const float* __restrict__ src, int Nsrc, int K, bf16_t* __restrict__ dst, int k0, int n0, int kind, int coff,
                                        const float* __restrict__ gain, const float* __restrict__ gain2, LAS unsigned* scr, int lane) {
    const int nl = 4 * (lane & 15), ks = lane >> 4;
    const int sq = src_quad(kind, n0 + nl, coff);
#pragma unroll 4
    for (int r = 0; r < 16; ++r) {
        const int k = k0 + 8 * r + 2 * ks;
        f32x4 a = (f32x4){0.f, 0.f, 0.f, 0.f}, b = a;
        if (sq >= 0) { a = *(const f32x4*)(src + (size_t)k * Nsrc + sq); b = *(const f32x4*)(src + (size_t)(k + 1) * Nsrc + sq); }
        if (gain) { const float ga = (gain2 && k >= 1024) ? gain2[k - 1024] : gain[k], gb = (gain2 && k + 1 >= 1024) ? gain2[k + 1 - 1024] : gain[k + 1]; a *= ga; b *= gb; }
#pragma unroll
        for (int j = 0; j < 4; ++j) scr[(nl + j) * 65 + 4 * r + ks] = cvt_pk_bf16(a[j], b[j]);
    }
    asm volatile("s_waitcnt lgkmcnt(0)" ::: "memory");
#pragma unroll 4
    for (int it = 0; it < 16; ++it) {
        const int row = it * 4 + (lane >> 4), ch = lane & 15;
        const LAS unsigned* p = scr + row * 65 + 4 * ch;
        u32x4 w; w.x = p[0]; w.y = p[1]; w.z = p[2]; w.w = p[3];
        *(u32x4*)(dst + (size_t)(n0 + row) * K + k0 + 8 * ch) = w;
    }
    asm volatile("s_waitcnt lgkmcnt(0)" ::: "memory");
}
__device__ __forceinline__ void tr_item8(const float* __restrict__ src, int Nsrc, int K, unsigned char* __restrict__ dst, int k0, int n0, int scol, float scale, LAS unsigned* scr, int lane) {
    const int nl = 4 * (lane & 15), ks = lane >> 4;
#pragma unroll 4
    for (int r = 0; r < 16; ++r) {
        const int k = k0 + 16 * r + 4 * ks; const float* p = src + (size_t)k * Nsrc + scol + nl;
        const f32x4 a = *(const f32x4*)p * scale, b = *(const f32x4*)(p + Nsrc) * scale, c = *(const f32x4*)(p + 2 * (size_t)Nsrc) * scale, d = *(const f32x4*)(p + 3 * (size_t)Nsrc) * scale;
#pragma unroll
        for (int j = 0; j < 4; ++j) scr[(nl + j) * 65 + 4 * r + ks] = pk_fp8x4(a[j], b[j], c[j], d[j]);
    }
    asm volatile("s_waitcnt lgkmcnt(0)" ::: "memory");
#pragma unroll 4
    for (int it = 0; it < 16; ++it) {
        const int row = it * 4 + (lane >> 4), ch = lane & 15;
        const LAS unsigned* p = scr + row * 65 + 4 * ch;
        u32x4 w; w.x = p[0]; w.y = p[1]; w.z = p[2]; w.w = p[3];
        *(u32x4*)(dst + (size_t)(n0 + row) * K + k0 + 16 * ch) = w;
    }
    asm volatile("s_waitcnt lgkmcnt(0)" ::: "memory");
}
__device__ __forceinline__ void tr_item6(const float* __restrict__ src, int Nsrc, unsigned char* __restrict__ dst, int t, int n0, int scol, LAS unsigned* scr, int lane) {
    const int nl = 4 * (lane & 15), ks = lane >> 4;
    f32x4 a[16], b[16];
#pragma unroll
    for (int r = 0; r < 16; ++r) {
        const int kk = 8 * r + 2 * ks, k = 16 * t + 256 * (kk >> 4) + (kk & 15); const float* p = src + (size_t)k * Nsrc + scol + nl;
        a[r] = __builtin_nontemporal_load((const f32x4*)p); b[r] = __builtin_nontemporal_load((const f32x4*)(p + Nsrc));
    }
#pragma unroll
    for (int r = 0; r < 16; ++r) {
#pragma unroll
        for (int j = 0; j < 4; ++j) scr[(nl + j) * 65 + 4 * r + ks] = cvt_pk_bf16(a[r][j], b[r][j]);
    }
    asm volatile("s_waitcnt lgkmcnt(0)" ::: "memory");
#pragma unroll 1
    for (int it = 0; it < 4; ++it) {
        const int pidx = it * 64 + lane, n = pidx >> 2, g = pidx & 3;
        const LAS unsigned* p = scr + n * 65 + 2 * g;
        f32x16 lo, hi;
#pragma unroll
        for (int j = 0; j < 8; ++j) { const unsigned d0 = p[8 * j], d1 = p[8 * j + 1];
            const float x0 = __uint_as_float(d0 << 16), x1 = __uint_as_float(d0 & 0xffff0000u), x2 = __uint_as_float(d1 << 16), x3 = __uint_as_float(d1 & 0xffff0000u);
            if (j < 4) { lo[4 * j] = x0; lo[4 * j + 1] = x1; lo[4 * j + 2] = x2; lo[4 * j + 3] = x3; } else { hi[4 * (j - 4)] = x0; hi[4 * (j - 4) + 1] = x1; hi[4 * (j - 4) + 2] = x2; hi[4 * (j - 4) + 3] = x3; } }
        unsigned sb; const u32x6 q = mx6_block(lo, hi, sb);
        unsigned char* o = dst + (size_t)(n0 + n) * 2048 + t * 128 + 16 * g;
        *(u32x4*)o = (u32x4){q[0], q[1], q[2], q[3]}; *(u32x4*)(o + 64) = (u32x4){q[4], q[5], sb, 0u};
    }
    asm volatile("s_waitcnt lgkmcnt(0)" ::: "memory");
}
__device__ __forceinline__ void tr_item6c(const float* __restrict__ src, int Nsrc, int K, unsigned char* __restrict__ dst, int t, int n0, LAS unsigned* scr, int lane) {
    const int nl = 4 * (lane & 15), ks = lane >> 4;
    f32x4 a[16], b[16];
#pragma unroll
    for (int r = 0; r < 16; ++r) {
        const int k = 128 * t + 8 * r + 2 * ks; const float* p = src + (size_t)k * Nsrc + n0 + nl;
        a[r] = __builtin_nontemporal_load((const f32x4*)p); b[r] = __builtin_nontemporal_load((const f32x4*)(p + Nsrc));
    }
#pragma unroll
    for (int r = 0; r < 16; ++r) {
#pragma unroll
        for (int j = 0; j < 4; ++j) scr[(nl + j) * 65 + 4 * r + ks] = cvt_pk_bf16(a[r][j], b[r][j]);
    }
    asm volatile("s_waitcnt lgkmcnt(0)" ::: "memory");
#pragma unroll 1
    for (int it = 0; it < 4; ++it) {
        const int pidx = it * 64 + lane, n = pidx >> 2, g = pidx & 3;
        const LAS unsigned* p = scr + n * 65 + 16 * g;
        f32x16 lo, hi;
#pragma unroll
        for (int j = 0; j < 8; ++j) { const unsigned d0 = p[j], d1 = p[8 + j];
            lo[2 * j] = __uint_as_float(d0 << 16); lo[2 * j + 1] = __uint_as_float(d0 & 0xffff0000u); hi[2 * j] = __uint_as_float(d1 << 16); hi[2 * j + 1] = __uint_as_float(d1 & 0xffff0000u); }
        unsigned sb; const u32x6 q = mx6_block(lo, hi, sb);
        unsigned char* o = dst + (size_t)(n0 + n) * K + t * 128 + 16 * g;
        *(u32x4*)o = (u32x4){q[0], q[1], q[2], q[3]}; *(u32x4*)(o + 64) = (u32x4){q[4], q[5], sb, 0u};
    }
    asm volatile("s_waitcnt lgkmcnt(0)" ::: "memory");
}
__device__ __forceinline__ void tr_matrix6c(const float* src, int Nsrc, int K, unsigned char* dst, int Ndst, LAS unsigned* scr, int lane, int gw, int NGW, int& cursor) {
    const int nb = Ndst / 64, items = (K / 128) * nb;
    int it = (gw - (cursor % NGW) + NGW) % NGW;
    for (; it < items; it += NGW) tr_item6c(src, Nsrc, K, dst, it / nb, (it % nb) * 64, scr, lane);
    cursor += items;
}
__device__ __forceinline__ void tr_matrix6(const float* src, const float* src2, int Nsrc, unsigned char* dst, int Ndst, LAS unsigned* scr, int lane, int gw, int NGW, int& cursor) {
    const int nb = Ndst / 64, items = 16 * nb;
    int it = (gw - (cursor % NGW) + NGW) % NGW;
    for (; it < items; it += NGW) {
        const int t = it / nb, n0 = (it % nb) * 64, tile = n0 >> 8, j0 = n0 & 255;
        tr_item6(j0 < 128 ? src : src2, Nsrc, dst, t, n0, 128 * tile + (j0 & 127), scr, lane);
    }
    cursor += items;
}
__device__ __forceinline__ void tr_matrix8(const float* src, const float* src2, int Nsrc, int K, unsigned char* dst, int Ndst, int inter, float scale, LAS unsigned* scr, int lane, int gw, int NGW, int& cursor) {
    const int nb = Ndst / 64, items = (K / 256) * nb;
    int it = (gw - (cursor % NGW) + NGW) % NGW;
    for (; it < items; it += NGW) {
        const int kb = it / nb, n0 = (it % nb) * 64;
        if (inter) { const int tile = n0 >> 8, j0 = n0 & 255; tr_item8(j0 < 128 ? src : src2, Nsrc, K, dst, kb * 256, n0, 128 * tile + (j0 & 127), scale, scr, lane); }
        else tr_item8(src, Nsrc, K, dst, kb * 256, n0, n0, scale, scr, lane);
    }
    cursor += items;
}
__device__ __forceinline__ void tr_matrix(const float* src, const float* src2, int Nsrc, int K, bf16_t* dst, int Ndst, int kind, const float* gain, const float* gain2,
                                          LAS unsigned* scr, int lane, int gw, int NGW, int& cursor) {
    const int nb = Ndst / 64, items = (K / 128) * nb;
    int it = (gw - (cursor % NGW) + NGW) % NGW;
    for (; it < items; it += NGW) {
        const int kb = it / nb, n0 = (it % nb) * 64;
        if (kind == 3) { const int tile = n0 >> 8, j0 = n0 & 255; tr_item(j0 < 128 ? src : src2, Nsrc, K, dst, kb * 128, n0, 0, 128 * tile + (j0 & 127) - n0, nullptr, nullptr, scr, lane); }
        else tr_item(src, Nsrc, K, dst, kb * 128, n0, kind, 0, gain, gain2, scr, lane);
    }
    cursor += items;
}

constexpr int MOE_GU_ITEMS = 16 * (2 * FFE / 64), MOE_D_ITEMS = (FFE / 128) * (D / 64), MOE_E_ITEMS = MOE_GU_ITEMS + MOE_D_ITEMS, MOE_ITEMS = NE * MOE_E_ITEMS;
__device__ __forceinline__ void moe_conv_item(const Args& args, int j, LAS unsigned* scr, int lane) {
    const int e = j / MOE_E_ITEMS, r = j - e * MOE_E_ITEMS;
    if (r < MOE_GU_ITEMS) {
        constexpr int nb = 2 * FFE / 64;
        const int t = r / nb, n0 = (r % nb) * 64, tile = n0 >> 8, j0 = n0 & 255;
        tr_item6((j0 < 128 ? args.in[16] : args.in[17]) + (size_t)e * D * FFE, FFE, args.ws + WS_WMGU + (size_t)e * 2 * FFE * D, t, n0, 128 * tile + (j0 & 127), scr, lane);
    } else {
        const int r2 = r - MOE_GU_ITEMS, t = r2 / (D / 64), n0 = (r2 % (D / 64)) * 64;
        tr_item6c(args.in[18] + (size_t)e * FFE * D, D, FFE, args.ws + WS_WMD + (size_t)e * D * FFE, t, n0, scr, lane);
    }
}
__device__ __forceinline__ void moe_conv_burst(const Args& args, LAS unsigned char* lds, int part, int nparts) {
    const int tid = tid_opaque(), lane = tid & 63, wave = tid >> 6, gw = blockIdx.x * NWAVES + wave, NGW = gridDim.x * NWAVES;
    LAS unsigned* scr = (LAS unsigned*)(lds + wave * 16640);
    const int per = (MOE_ITEMS + NGW - 1) / NGW, i0 = per * part / nparts, i1 = per * (part + 1) / nparts;
    __syncthreads();
    for (int i = i0; i < i1; ++i) { const int j = gw + i * NGW; if (j < MOE_ITEMS) moe_conv_item(args, j, scr, lane); }
    __syncthreads();
}

__device__ __forceinline__ void ln_row(f32x4 (&v)[8], const float* __restrict__ g, const float* __restrict__ b, int lane, float& mean_o, float& rstd_o) {
    float s = 0.f;
#pragma unroll
    for (int j = 0; j < 8; ++j) s += (v[j][0] + v[j][1]) + (v[j][2] + v[j][3]);
    const float mean = wave_sum(s) * (1.f / D); float s2 = 0.f;
#pragma unroll
    for (int j = 0; j < 8; ++j) { v[j] = v[j] - mean; s2 += (v[j][0] * v[j][0] + v[j][1] * v[j][1]) + (v[j][2] * v[j][2] + v[j][3] * v[j][3]); }
    const float rstd = 1.f / sqrtf(wave_sum(s2) * (1.f / D) + LN_EPS); mean_o = mean; rstd_o = rstd;
#pragma unroll
    for (int j = 0; j < 8; ++j) { const f32x4 gg = *((const f32x4*)g + lane + 64 * j), bb = *((const f32x4*)b + lane + 64 * j); v[j] = v[j] * rstd * gg + bb; }
}

#define WSP(T, off) ((T*)(args.ws + (off)))
#define IN(k) (lo <= (k) && (k) < hi)
#define SEAM(k) do { if (IN(k) && IN((k) + 1)) { XcdBarrier b_; b_.bar = WSP(unsigned, WS_CTL) + CW_BAR; b_.x = xb_xcc_id(); b_.st = (volatile LAS unsigned*)(lds + MISC_OFF) + 8; xcd_barrier(b_); } } while (0)

__device__ __forceinline__ int moe_unit_table(const int* moemeta, int NT, LAS int* utab) {
    const int tid = tid_opaque();
    pg8::MoeOrder Mo;
#pragma unroll
    for (int e = 0; e <= NE; ++e) Mo.pb[e] = moemeta[e];
    Mo.NT = NT; Mo.G = gridDim.x; Mo.c = blockIdx.x; Mo.nwg = Mo.pb[NE] * NT;
    if (tid < 64) { pg8::Unit u; u.pm = 0; u.pn = 0; u.aux = 0; Mo.next(tid, u); utab[4 * tid] = u.pm; utab[4 * tid + 1] = u.pn; utab[4 * tid + 2] = u.aux; }
    __syncthreads();
    const int left = Mo.nwg - Mo.c; int n = left <= 0 ? 0 : (left + Mo.G - 1) / Mo.G;
    return __builtin_amdgcn_readfirstlane(n < 64 ? n : 64);
}
__device__ __forceinline__ f32x4 tail_sum(const bf16_t* yp, int t, int d, int lane, int SK) {
    f32x4 acc = {0.f, 0.f, 0.f, 0.f};
    for (int q = 0; q < SK; ++q) { const u32x2 a = *((const u32x2*)(yp + ((size_t)(q * 128 + t - 1) * 256 + (d & 255)) * 256) + lane);
        acc += (f32x4){__uint_as_float(a.x << 16), __uint_as_float(a.x & 0xffff0000u), __uint_as_float(a.y << 16), __uint_as_float(a.y & 0xffff0000u)}; }
    return acc;
}
__device__ __forceinline__ int moe_tail_split(int nwg, int G, int& Rf, int& Tn) {
    Rf = nwg / G; Tn = nwg - Rf * G;
    return Tn == 0 ? 1 : (Tn * 7 <= G ? 7 : (Tn * 4 <= G ? 4 : (Tn * 2 <= G ? 2 : 1)));
}
__device__ __forceinline__ int moe_unit_table_k(const int* moemeta, int NT, LAS int* utab, unsigned char* tailmap) {
    const int tid = tid_opaque();
    pg8::MoeOrder Mo;
#pragma unroll
    for (int e = 0; e <= NE; ++e) Mo.pb[e] = moemeta[e];
    Mo.NT = NT; Mo.G = gridDim.x; Mo.c = blockIdx.x; Mo.nwg = Mo.pb[NE] * NT;
    int Rf, Tn; const int SK = moe_tail_split(Mo.nwg, Mo.G, Rf, Tn);
    const int R = Rf < 63 ? Rf : 63;
    const bool piece = SK > 1 ? (Mo.c < Tn * SK) : (Mo.c < Tn);
    if (tid < 64) {
        long Lq = -1; int kx = 0, mark = 0;
        if (tid < R) Lq = (long)tid * Mo.G + Mo.c;
        else if (tid == R && piece) {
            if (SK == 1) Lq = (long)Rf * Mo.G + Mo.c;
            else { const int j = Mo.c / SK, q = Mo.c - j * SK; Lq = (long)Rf * Mo.G + j; kx = (1 + j) | (q << 8) | (SK << 16); mark = (q == 0) ? 1 + j : 0; }
        }
        pg8::Unit u; u.pm = 0; u.pn = 0; u.aux = 0; u.kx = 0;
        if (Lq >= 0) Mo.at(Lq, u);
        if (mark) tailmap[u.pm * 8 + u.aux] = (unsigned char)mark;
        utab[4 * tid] = u.pm; utab[4 * tid + 1] = u.pn; utab[4 * tid + 2] = u.aux; utab[4 * tid + 3] = kx;
    }
    __syncthreads();
    return __builtin_amdgcn_readfirstlane(R + (piece ? 1 : 0));
}
template <int L>
__device__ __forceinline__ void layer_phases(const Args& args, LAS unsigned char* lds, char* lds_gen, int lo, int hi) {
    constexpr int pb = 1 + 10 * L;
    if (IN(pb + 0)) {
        const int G = gridDim.x, bx = blockIdx.x;
        pg8::Gemm g{WSP(const bf16_t, WS_XB), WSP(const bf16_t, WS_WIN + L * SZ_WIN), D}; pg8::StaticOrder So; So.init(S, 2048, G, bx);
        pg8::EpiInProj E{WSP(bf16_t, WS_CQ), WSP(bf16_t, WS_CKV), WSP(bf16_t, WS_KPE), WSP(bf16_t, WS_QS), WSP(bf16_t, WS_KS), WSP(bf16_t, WS_VS), WSP(float, WS_PARTQ), WSP(float, WS_PARTKV),
                         WSP(const float, WS_COSM), WSP(const float, WS_SINM), WSP(const float, WS_COSS), WSP(const float, WS_SINS)};
        pg8::gemm_phase<pg8::EpiInProj, pg8::StaticOrder, true, true>(lds, g, So, E);
    }
    SEAM(pb + 0);
    if (IN(pb + 1)) {
        const int G = gridDim.x, bx = blockIdx.x;
        LAS int* utab = (LAS int*)(lds + MISC_OFF + 1024);
        LAS int* ucnt = (LAS int*)(lds + MISC_OFF + 1024 + 3072);
        if (tid_opaque() == 0) {
            int nl = 0, nq = 0, nk = 0;
            if (G == 256) {
                if (bx < 128) { utab[0] = bx >> 1; utab[1] = 8 + (bx & 1); utab[2] = 8 + (bx & 1); nl = 1; utab[128] = bx >> 3; utab[129] = bx & 7; utab[130] = bx & 7; nk = 1; }
                else { const int c = bx - 128;
                    for (int i = 0; i < 3; ++i) { const int u = 3 * c + i; utab[64 + 4 * i] = u / 6; utab[65 + 4 * i] = u % 6; utab[66 + 4 * i] = u % 6; }
                    nq = 3;
                    for (int i = 0; i < 3; ++i) { const int u = 128 + 3 * c + i; utab[128 + 4 * i] = u >> 3; utab[129 + 4 * i] = u & 7; utab[130 + 4 * i] = u & 7; }
                    nk = 3; }
            } else {
                for (int u = bx; u < 128 && nl < 16; u += G, ++nl) { utab[4 * nl] = u >> 1; utab[4 * nl + 1] = 8 + (u & 1); utab[4 * nl + 2] = 8 + (u & 1); }
                for (int u = bx; u < 384 && nq < 16; u += G, ++nq) { utab[64 + 4 * nq] = u / 6; utab[65 + 4 * nq] = u % 6; utab[66 + 4 * nq] = u % 6; }
                for (int u = bx; u < 512 && nk < 16; u += G, ++nk) { utab[128 + 4 * nk] = u >> 3; utab[129 + 4 * nk] = u & 7; utab[130 + 4 * nk] = u & 7; }
            }
            ucnt[0] = nl; ucnt[1] = nq; ucnt[2] = nk;
        }
        __syncthreads();
        { pg8::TableOrder To{utab, __builtin_amdgcn_readfirstlane(ucnt[0])};
          pg8::Gemm g{WSP(const bf16_t, WS_XB), WSP(const bf16_t, WS_WIN + L * SZ_WIN), D};
          pg8::EpiInProj E{WSP(bf16_t, WS_CQ), WSP(bf16_t, WS_CKV), WSP(bf16_t, WS_KPE), WSP(bf16_t, WS_QS), WSP(bf16_t, WS_KS), WSP(bf16_t, WS_VS), WSP(float, WS_PARTQ), WSP(float, WS_PARTKV),
                           WSP(const float, WS_COSM), WSP(const float, WS_SINM), WSP(const float, WS_COSS), WSP(const float, WS_SINS)};
          pg8::gemm_phase<pg8::EpiInProj, pg8::TableOrder, true, true>(lds, g, To, E); }
        { pg8::TableOrder To{utab + 64, __builtin_amdgcn_readfirstlane(ucnt[1])};
          pg8::Gemm g{WSP(const bf16_t, WS_CQ), WSP(const bf16_t, WS_WQ + L * SZ_WQ), QLORA};
          pg8::EpiQ E{WSP(bf16_t, WS_Q), WSP(const float, WS_PARTQ), WSP(const float, WS_COSM), WSP(const float, WS_SINM)};
          pg8::gemm_phase<pg8::EpiQ, pg8::TableOrder, true, true>(lds, g, To, E); }
        { pg8::TableOrder To{utab + 128, __builtin_amdgcn_readfirstlane(ucnt[2])};
          pg8::Gemm g{WSP(const bf16_t, WS_CKV), WSP(const bf16_t, WS_WKV + L * SZ_WKV), KVLORA};
          pg8::EpiKV E{WSP(bf16_t, WS_KV), WSP(const float, WS_PARTKV)};
          pg8::gemm_phase<pg8::EpiKV, pg8::TableOrder, true, true>(lds, g, To, E); }
    }
    SEAM(pb + 1);
    if (IN(pb + 2)) {
        const int G = gridDim.x, bx = blockIdx.x;
        const int slot = bx % 3; bool pending = true;
        for (int step = 0; ; ++step) {
            const int u = bx + step * G; const bool more = u < 512;
            if (pending && (step == slot || !more)) { moe_conv_burst(args, lds, L, DEPTH); pending = false; }
            if (!more) break;
            const int r = u / 256, c = u % 256, head = 4 * r + ((c & 7) >> 1), qblk = (c >> 3) + 32 * (c & 1);
            att::attn_body<192, false, QCOLS, KVCOLS, 64, KVCOLS, D>(WSP(const bf16_t, WS_Q) + (size_t)qblk * 256 * QCOLS + head * 192, WSP(const bf16_t, WS_KV) + head * 256, WSP(const bf16_t, WS_KPE),
                WSP(const bf16_t, WS_KV) + head * 256 + 128, WSP(bf16_t, WS_OBUF) + (size_t)qblk * 256 * D + head * 128, WSP(float, WS_PARTO) + (size_t)qblk * 256 * 16 + head, qblk * 256, 0, S / 64, SCALE_MLA, 0.f, (LAS char*)lds);
        }
        for (int u = bx; u < 512; u += G) {
            const int head = u >> 6, qblk = u & 63;
            int t0 = 4 * qblk - 2, t1 = 4 * qblk + 5; if (t0 < 0) t0 = 0; if (t1 > S / 64 - 1) t1 = S / 64 - 1;
            const float sk = (args.in[6] + L * 8)[head];
            att::attn_body<128, true, 1024, 256, 64, 256, D>(WSP(const bf16_t, WS_QS) + (size_t)qblk * 256 * 1024 + head * 128, WSP(const bf16_t, WS_KS) + (head >> 2) * 128, nullptr, WSP(const bf16_t, WS_VS) + (head >> 2) * 128,
                WSP(bf16_t, WS_OBUF) + (size_t)qblk * 256 * D + 1024 + head * 128, WSP(float, WS_PARTO) + (size_t)qblk * 256 * 16 + 8 + head, qblk * 256, t0 * 64, t1 - t0 + 1, SCALE_SWA, sk / SCALE_SWA, (LAS char*)lds);
        }
    }
    SEAM(pb + 2);
    if (IN(pb + 4)) {
        const int G = gridDim.x, bx = blockIdx.x;
        pg8::Gemm g{WSP(const bf16_t, WS_OBUF), WSP(const bf16_t, WS_WOUT + L * SZ_WOUT), D}; pg8::StaticOrder So; So.init(S, D, G, bx);
        if constexpr (L == 0) { pg8::EpiOutProj<false> E{args.in[0], WSP(float, WS_XA), WSP(const float, WS_PARTO), nullptr, nullptr, nullptr}; pg8::gemm_phase<pg8::EpiOutProj<false>, pg8::StaticOrder, true, true>(lds, g, So, E); }
        else { pg8::EpiOutProj<true> E{WSP(const float, WS_XA), WSP(float, WS_XA), WSP(const float, WS_PARTO), WSP(const float, WS_ST2), args.in[19] + (L - 1) * D, args.in[20] + (L - 1) * D};
               pg8::gemm_phase<pg8::EpiOutProj<true>, pg8::StaticOrder, true, true>(lds, g, So, E); }
    }
    SEAM(pb + 4);
    if (IN(pb + 5)) {
        const int tid = tid_opaque(), lane = tid & 63, wave = tid >> 6, G = gridDim.x, bx = blockIdx.x;
        const float* lg = args.in[10] + L * D; const float* lb = args.in[11] + L * D;
        float* XA = WSP(float, WS_XA); unsigned* X8 = WSP(unsigned, WS_X8);
        const int RPW = (S + G - 1) / G, r0 = bx * RPW, r1 = (r0 + RPW < S) ? r0 + RPW : S;
        LAS float* wr_l = (LAS float*)lds; LAS int* hist = (LAS int*)(lds + 65536);
        if (L == 1) { const float* wrg = args.in[15]; for (int i = tid; i < D * NE; i += 512) wr_l[i] = wrg[i]; if (tid < NE) hist[tid] = 0; __syncthreads(); }
        for (int row = r0 + wave; row < r1; row += NWAVES) {
            f32x4 v[8]; float* xr = XA + (size_t)row * D;
#pragma unroll
            for (int j = 0; j < 8; ++j) v[j] = *((const f32x4*)xr + lane + 64 * j);
            float mu_, rs_; ln_row(v, lg, lb, lane, mu_, rs_);
            if (lane == 0) { float* st = WSP(float, WS_ST1); st[2 * row] = mu_; st[2 * row + 1] = rs_; }
            { f32x16 lo, hi;
#pragma unroll
              for (int j = 0; j < 4; ++j)
#pragma unroll
                  for (int c = 0; c < 4; ++c) { lo[4 * j + c] = v[j][c]; hi[4 * j + c] = v[4 + j][c]; }
              unsigned sb; const u32x6 q = mx6_block(lo, hi, sb);
              unsigned char* o = (unsigned char*)X8 + (size_t)row * D + (lane >> 2) * 128 + 16 * (lane & 3);
              *(u32x4*)o = (u32x4){q[0], q[1], q[2], q[3]}; *(u32x4*)(o + 64) = (u32x4){q[4], q[5], sb, 0u}; }
            if (L == 1) {
                float q0 = 0.f, q1 = 0.f, q2 = 0.f, q3 = 0.f, q4 = 0.f, q5 = 0.f, q6 = 0.f, q7 = 0.f;
#pragma unroll
                for (int j = 0; j < 8; ++j)
#pragma unroll
                    for (int k = 0; k < 4; ++k) { const LAS f32x4* w = (const LAS f32x4*)(wr_l + (size_t)(4 * (lane + 64 * j) + k) * NE); const f32x4 w0 = w[0], w1 = w[1]; const float xv = v[j][k];
                        q0 += xv * w0[0]; q1 += xv * w0[1]; q2 += xv * w0[2]; q3 += xv * w0[3]; q4 += xv * w1[0]; q5 += xv * w1[1]; q6 += xv * w1[2]; q7 += xv * w1[3]; }
                q0 = wave_sum(q0); q1 = wave_sum(q1); q2 = wave_sum(q2); q3 = wave_sum(q3); q4 = wave_sum(q4); q5 = wave_sum(q5); q6 = wave_sum(q6); q7 = wave_sum(q7);
                int e0 = 0; float l0 = q0;
                if (q1 > l0) { l0 = q1; e0 = 1; } if (q2 > l0) { l0 = q2; e0 = 2; } if (q3 > l0) { l0 = q3; e0 = 3; } if (q4 > l0) { l0 = q4; e0 = 4; } if (q5 > l0) { l0 = q5; e0 = 5; } if (q6 > l0) { l0 = q6; e0 = 6; } if (q7 > l0) { l0 = q7; e0 = 7; }
                int e1 = -1; float l1 = -3.0e38f;
                if (e0 != 0 && q0 > l1) { l1 = q0; e1 = 0; } if (e0 != 1 && q1 > l1) { l1 = q1; e1 = 1; } if (e0 != 2 && q2 > l1) { l1 = q2; e1 = 2; } if (e0 != 3 && q3 > l1) { l1 = q3; e1 = 3; }
                if (e0 != 4 && q4 > l1) { l1 = q4; e1 = 4; } if (e0 != 5 && q5 > l1) { l1 = q5; e1 = 5; } if (e0 != 6 && q6 > l1) { l1 = q6; e1 = 6; } if (e0 != 7 && q7 > l1) { l1 = q7; e1 = 7; }
                const float t = __expf(l1 - l0), g0 = 1.0f / (1.0f + t), g1 = t / (1.0f + t);
                if (lane == 0) { int* sel = WSP(int, WS_SEL); float* gate = WSP(float, WS_GATE); sel[2 * row] = e0; sel[2 * row + 1] = e1; gate[2 * row] = g0; gate[2 * row + 1] = g1;
                    __hip_atomic_fetch_add(hist + e0, 1, __ATOMIC_RELAXED, __HIP_MEMORY_SCOPE_WORKGROUP); __hip_atomic_fetch_add(hist + e1, 1, __ATOMIC_RELAXED, __HIP_MEMORY_SCOPE_WORKGROUP); }
            }
        }
        if (L == 1) { __syncthreads(); if (tid < NE) WSP(int, WS_WGCNT)[bx * NE + tid] = hist[tid]; }
    }
    SEAM(pb + 5);
    if constexpr (L == 0) {
        if (IN(pb + 7)) {
            const int G = gridDim.x, bx = blockIdx.x;
            pg8::Gemm g{WSP(const bf16_t, WS_X8), WSP(const bf16_t, WS_WGU), D}; pg8::StaticOrder So; So.init(S, 2 * FF, G, bx);
            pg8::EpiSwiglu6 E{WSP(unsigned char, WS_H), FF};
            pg8::gemm_phase<pg8::EpiSwiglu6, pg8::StaticOrder, true, true, 2>(lds, g, So, E);
        }
        SEAM(pb + 7);
        if (IN(pb + 8)) {
            const int G = gridDim.x, bx = blockIdx.x;
            pg8::Gemm g{WSP(const bf16_t, WS_H), WSP(const bf16_t, WS_WD), FF}; pg8::StaticOrder So; So.init(S, D, G, bx);
            pg8::EpiResidLN E{WSP(const float, WS_XA), WSP(float, WS_XA), 1.0f, WSP(const float, WS_ST1), args.in[10] + L * D, args.in[11] + L * D};
            pg8::gemm_phase<pg8::EpiResidLN, pg8::StaticOrder, true, true, 2>(lds, g, So, E);
        }
        SEAM(pb + 8);
        if (IN(pb + 9)) {
            const int tid = tid_opaque(), lane = tid & 63, gw = blockIdx.x * NWAVES + (tid >> 6), NGW = gridDim.x * NWAVES;
            const float* lg = args.in[19] + L * D; const float* lb = args.in[20] + L * D; float* XA = WSP(float, WS_XA); bf16_t* XB = WSP(bf16_t, WS_XB);
            for (int row = gw; row < S; row += NGW) {
                f32x4 v[8]; float* xr = XA + (size_t)row * D;
#pragma unroll
                for (int j = 0; j < 8; ++j) v[j] = *((const f32x4*)xr + lane + 64 * j);
                float mu_, rs_; ln_row(v, lg, lb, lane, mu_, rs_);
                if (lane == 0) { float* st = WSP(float, WS_ST2); st[2 * row] = mu_; st[2 * row + 1] = rs_; }
#pragma unroll
                for (int j = 0; j < 8; ++j) *((u32x2*)(XB + (size_t)row * D) + lane + 64 * j) = pg8::pack4(v[j]);
            }
        }
        SEAM(pb + 9);
    } else {
        if (IN(pb + 6)) {
            const int tid = tid_opaque(), lane = tid & 63, wave = tid >> 6, G = gridDim.x, bx = blockIdx.x;
            const int RPW = (S + G - 1) / G, r0 = bx * RPW, r1 = (r0 + RPW < S) ? r0 + RPW : S, na = 2 * (r1 - r0);
            LAS int* tab = (LAS int*)lds;
            LAS int* basee = (LAS int*)(lds + 32768);
            LAS int* asel = (LAS int*)(lds + 33024);
            LAS int* adst = (LAS int*)(lds + 35072);
            const int* wgcnt = WSP(const int, WS_WGCNT); const int* sel = WSP(const int, WS_SEL);
            for (int i = tid; i < G * NE; i += 512) tab[i] = wgcnt[i];
            for (int i = tid; i < na; i += 512) asel[i] = sel[2 * r0 + i];
            __syncthreads();
            if (tid < NE) { int tot = 0, pre = 0; for (int w = 0; w < G; ++w) { const int c = tab[w * NE + tid]; pre += (w < bx) ? c : 0; tot += c; } basee[32 + tid] = tot; basee[40 + tid] = pre; }
            __syncthreads();
            if (tid == 0) { int p = 0; for (int e = 0; e < NE; ++e) { basee[8 + e] = p; basee[e] = 256 * p + basee[40 + e]; p += (basee[32 + e] + 255) >> 8; } basee[16] = p;
                if (bx == 0) { int* moemeta = WSP(int, WS_MOEMETA); for (int e = 0; e <= NE; ++e) moemeta[e] = basee[8 + e]; } }
            __syncthreads();
            if (tid < NE) { int rk = basee[tid]; for (int i = 0; i < na; ++i) if (asel[i] == tid) adst[i] = rk++; }
            __syncthreads();
            int* dest = WSP(int, WS_DEST); const unsigned char* X8 = WSP(const unsigned char, WS_X8); unsigned char* xs = WSP(unsigned char, WS_XS);
            for (int i = tid; i < na; i += 512) dest[2 * r0 + i] = adst[i];
            if (bx < NE) {
                const int rb = 256 * basee[8 + bx] + basee[32 + bx], re = 256 * basee[9 + bx];
                for (int i = rb * 128 + tid; i < re * 128; i += 512) ((u32x4*)xs)[i] = (u32x4){0u, 0u, 0u, 0u};
            }
            for (int a = wave; a < na; a += NWAVES) { const u32x4* s4 = (const u32x4*)(X8 + (size_t)(r0 + (a >> 1)) * D); u32x4* d4 = (u32x4*)(xs + (size_t)adst[a] * D);
#pragma unroll
                for (int j = 0; j < 2; ++j) d4[lane + 64 * j] = s4[lane + 64 * j]; }
        }
        SEAM(pb + 6);
        if (IN(pb + 7)) {
            LAS int* utab = (LAS int*)(lds + MISC_OFF + 1024);
            const int nun = moe_unit_table(WSP(const int, WS_MOEMETA), 2 * FFE / 256, utab);
            pg8::TableOrder To{utab, nun};
            pg8::Gemm g{WSP(const bf16_t, WS_XS), WSP(const bf16_t, WS_WMGU), D};
            pg8::EpiSwiglu6 E{WSP(unsigned char, WS_H), FFE};
            for (int rep = 0; rep < PROBE_MOEUP; ++rep) pg8::gemm_phase<pg8::EpiSwiglu6, pg8::TableOrder, true, true, 2>(lds, g, To, E);
        }
        SEAM(pb + 7);
        if (IN(pb + 8)) {
            LAS int* utab = (LAS int*)(lds + MISC_OFF + 1024);
            const int nun = moe_unit_table_k(WSP(const int, WS_MOEMETA), D / 256, utab, WSP(unsigned char, WS_TAILMAP));
            pg8::TableOrderK To{utab, nun};
            pg8::Gemm g{WSP(const bf16_t, WS_H), WSP(const bf16_t, WS_WMD), FFE};
            pg8::EpiBf16OutK E{WSP(bf16_t, WS_XS), WSP(bf16_t, WS_YP)};
            pg8::gemm_phase<pg8::EpiBf16OutK, pg8::TableOrderK, true, true, 2>(lds, g, To, E);
        }
        SEAM(pb + 8);
        if (IN(pb + 9)) {
            const int tid = tid_opaque(), lane = tid & 63, gw = blockIdx.x * NWAVES + (tid >> 6), NGW = gridDim.x * NWAVES;
            const float* lg = args.in[19] + L * D; const float* lb = args.in[20] + L * D;
            const int* dest = WSP(const int, WS_DEST); const float* gate = WSP(const float, WS_GATE); const float* XA = WSP(const float, WS_XA); const bf16_t* ys = WSP(const bf16_t, WS_XS);
            const float* st1 = WSP(const float, WS_ST1); const float* g1p = args.in[10] + L * D; const float* b1p = args.in[11] + L * D;
            for (int row = gw; row < S; row += NGW) {
                const int d0 = dest[2 * row], d1 = dest[2 * row + 1]; const float g0 = gate[2 * row], g1 = gate[2 * row + 1]; const float mu1 = st1[2 * row], rs1 = st1[2 * row + 1];
                f32x4 v[8]; const float* xr = XA + (size_t)row * D; const u32x2* y0 = (const u32x2*)(ys + (size_t)d0 * D); const u32x2* y1 = (const u32x2*)(ys + (size_t)d1 * D);
                const u32x2 m0 = *(const u32x2*)(WSP(const unsigned char, WS_TAILMAP) + (d0 >> 8) * 8), m1 = *(const u32x2*)(WSP(const unsigned char, WS_TAILMAP) + (d1 >> 8) * 8);
                const bool anyt = (m0.x | m0.y | m1.x | m1.y) != 0u;
#pragma unroll
                for (int j = 0; j < 8; ++j) { const f32x4 yv = *((const f32x4*)xr + lane + 64 * j); const f32x4 x = (yv - mu1) * rs1 * *((const f32x4*)g1p + lane + 64 * j) + *((const f32x4*)b1p + lane + 64 * j); const u32x2 a = y0[lane + 64 * j], b = y1[lane + 64 * j];
                    f32x4 fa = {__uint_as_float(a.x << 16), __uint_as_float(a.x & 0xffff0000u), __uint_as_float(a.y << 16), __uint_as_float(a.y & 0xffff0000u)};
                    f32x4 fb = {__uint_as_float(b.x << 16), __uint_as_float(b.x & 0xffff0000u), __uint_as_float(b.y << 16), __uint_as_float(b.y & 0xffff0000u)};
                    if (anyt) {
                        const int t0 = (int)(((j < 4 ? m0.x : m0.y) >> (8 * (j & 3))) & 255u), t1 = (int)(((j < 4 ? m1.x : m1.y) >> (8 * (j & 3))) & 255u);
                        if (t0 | t1) {
                            const int nwg_ = WSP(const int, WS_MOEMETA)[NE] * (D / 256), G_ = gridDim.x, Tn_ = nwg_ - (nwg_ / G_) * G_, SK = Tn_ * 7 <= G_ ? 7 : (Tn_ * 4 <= G_ ? 4 : 2);
                            if (t0) fa = tail_sum(WSP(const bf16_t, WS_YP), t0, d0, lane, SK);
                            if (t1) fb = tail_sum(WSP(const bf16_t, WS_YP), t1, d1, lane, SK);
                        }
                    }
                    v[j] = x * ALPHA + (fa * g0 + fb * g1); }
                float mu_, rs_; ln_row(v, lg, lb, lane, mu_, rs_);
#pragma unroll
                for (int j = 0; j < 8; ++j) *((f32x4*)(args.out + (size_t)row * D) + lane + 64 * j) = v[j];
            }
        }
    }
}

__global__ void __launch_bounds__(NWAVES * 64, 2) fwd(Args args) {
    extern __shared__ __attribute__((aligned(16))) unsigned char lds_raw[];
    LAS unsigned char* lds = (LAS unsigned char*)lds_raw;
    volatile LAS unsigned* MISC = (volatile LAS unsigned*)(lds + MISC_OFF);
    for (int u = tid_opaque(); u < (LDS_BYTES - MISC_OFF) / 4; u += NWAVES * 64) MISC[u] = 0u;
    __syncthreads();
    (void)xcd_barrier_post(WSP(unsigned, WS_CTL) + CW_BAR, MISC + 8);
    const int lo = args.ph_lo, hi = args.ph_hi;

    if (IN(0)) {
        const int tid = tid_opaque(), lane = tid & 63, wave = tid >> 6, G = gridDim.x, bx = blockIdx.x, gw = bx * NWAVES + wave, NGW = G * NWAVES;
        unsigned char* ws = args.ws;
        LAS unsigned* scr = (LAS unsigned*)(lds + wave * 16640);
        for (int rep = 0; rep < PROBE_PRO; ++rep) {
        int cursor = 0;
        for (int l = 0; l < DEPTH; ++l) {
            tr_matrix(args.in[1] + (size_t)l * D * IN_COLS, nullptr, IN_COLS, D, (bf16_t*)(ws + WS_WIN + l * SZ_WIN), IN_PAD, 1, nullptr, nullptr, scr, lane, gw, NGW, cursor);
            tr_matrix(args.in[3] + (size_t)l * QLORA * QCOLS, nullptr, QCOLS, QLORA, (bf16_t*)(ws + WS_WQ + l * SZ_WQ), QCOLS, 2, args.in[2] + l * QLORA, nullptr, scr, lane, gw, NGW, cursor);
            tr_matrix(args.in[5] + (size_t)l * KVLORA * KVCOLS, nullptr, KVCOLS, KVLORA, (bf16_t*)(ws + WS_WKV + l * SZ_WKV), KVCOLS, 0, args.in[4] + l * KVLORA, nullptr, scr, lane, gw, NGW, cursor);
            tr_matrix(args.in[9] + (size_t)l * D * D, nullptr, D, D, (bf16_t*)(ws + WS_WOUT + l * SZ_WOUT), D, 0, args.in[7] + l * 1024, args.in[8] + l * 1024, scr, lane, gw, NGW, cursor);
        }
        tr_matrix6(args.in[12], args.in[13], FF, ws + WS_WGU, 2 * FF, scr, lane, gw, NGW, cursor);
        tr_matrix6c(args.in[14], D, FF, ws + WS_WD, D, scr, lane, gw, NGW, cursor);
        { const f32x4* x4 = (const f32x4*)args.in[0]; u32x2* o2 = (u32x2*)(ws + WS_XB);
          for (size_t i = (size_t)bx * 512 + tid; i < (size_t)S * D / 4; i += (size_t)G * 512) o2[i] = pg8::pack4(x4[i]); }
        { float* coss = (float*)(ws + WS_COSS); float* sins = (float*)(ws + WS_SINS); float* cosm = (float*)(ws + WS_COSM); float* sinm = (float*)(ws + WS_SINM);
          for (int i = bx * 512 + tid; i < S * 64; i += G * 512) { const int pos = i >> 6, k = i & 63; float sn, cs; sincos_acc((float)pos * INVF[k], sn, cs); coss[i] = cs; sins[i] = sn; }
          for (int i = bx * 512 + tid; i < S * 32; i += G * 512) { const int pos = i >> 5, k = i & 31; float sn, cs; sincos_acc((float)pos * INVF[2 * k], sn, cs); cosm[i] = cs; sinm[i] = sn; } }
        }
    }
    SEAM(0);
    layer_phases<0>(args, lds, (char*)lds_raw, lo, hi);
    layer_phases<1>(args, lds, (char*)lds_raw, lo, hi);
}
#undef IN
#undef SEAM

#ifndef MK_SPLIT
#define MK_SPLIT 0
#endif
extern "C" void kernel_launch(void* const* d_in, const int* in_sizes, int n_in, void* d_out, int out_size, void* d_ws, size_t ws_size, hipStream_t stream) {
    static int grid = 0;
    if (grid == 0) {
        if (n_in != 21 || out_size != S * D || ws_size < WS_END2) { fprintf(stderr, "kernel_launch: unexpected shapes: n_in %d out %d ws %zu (need %zu)\n", n_in, out_size, ws_size, (size_t)WS_END2); grid = -1; return; }
        int dev = 0, cus = 0, per_cu = 0;
        if (hipGetDevice(&dev) != hipSuccess || hipDeviceGetAttribute(&cus, hipDeviceAttributeMultiprocessorCount, dev) != hipSuccess) { grid = -1; return; }
        if (hipFuncSetAttribute((const void*)fwd, hipFuncAttributeMaxDynamicSharedMemorySize, LDS_BYTES) != hipSuccess) { fprintf(stderr, "kernel_launch: hipFuncSetAttribute failed\n"); grid = -1; return; }
        if (hipOccupancyMaxActiveBlocksPerMultiprocessor(&per_cu, (const void*)fwd, NWAVES * 64, LDS_BYTES) != hipSuccess || per_cu < 1) fprintf(stderr, "kernel_launch: occupancy query says %d\n", per_cu);
        (void)hipGetLastError();
        grid = cus;
    }
    if (grid < 0) return;
    (void)hipMemsetAsync((char*)d_ws + WS_CTL, 0, CTL_ZERO_BYTES, stream);
    Args a{};
    for (int i = 0; i < 21; ++i) a.in[i] = (const float*)d_in[i];
    a.out = (float*)d_out; a.ws = (unsigned char*)d_ws;
#if MK_SPLIT
    for (int p = 0; p < NPHASE; ++p) { a.ph_lo = p; a.ph_hi = p + 1; hipLaunchKernelGGL(fwd, dim3(grid), dim3(NWAVES * 64), LDS_BYTES, stream, a); }
#else
    a.ph_lo = 0; a.ph_hi = NPHASE; hipLaunchKernelGGL(fwd, dim3(grid), dim3(NWAVES * 64), LDS_BYTES, stream, a);
#endif
    const hipError_t le = hipPeekAtLastError();
    if (le != hipSuccess) fprintf(stderr, "kernel_launch: launch failed: %s\n", hipGetErrorName(le));
}
```

```cpp
#include <hip/hip_runtime.h>
#include <cstdio>
#include <cstdint>

#define LAS __attribute__((address_space(3)))
#define GAS __attribute__((address_space(1)))
typedef unsigned short bf16_t;
typedef short bf16x8 __attribute__((ext_vector_type(8)));
typedef short s16x4 __attribute__((ext_vector_type(4)));
typedef float f32x4 __attribute__((ext_vector_type(4)));
typedef float f32x16 __attribute__((ext_vector_type(16)));
typedef unsigned u32x4 __attribute__((ext_vector_type(4)));
typedef unsigned u32x2 __attribute__((ext_vector_type(2)));

constexpr int S = 16384, D = 2048, DEPTH = 2;
constexpr int IN_COLS = 2368, IN_PAD = 2560, QCOLS = 1536, KVCOLS = 2048, QLORA = 512, KVLORA = 256;
constexpr int FF = 5632, FFE = 7168, NE = 8;
constexpr int MOE_ROWS = 34816;
constexpr float ALPHA = 1.41421356237309515f, LN_EPS = 1e-5f, RMS_EPS = 1e-6f;
constexpr float SCALE_MLA = 0.07216878364870322f, SCALE_SWA = 0.08838834764831845f;

__device__ __forceinline__ unsigned cvt_pk_bf16(float lo, float hi) { unsigned r; asm volatile("v_cvt_pk_bf16_f32 %0, %1, %2" : "=v"(r) : "v"(lo), "v"(hi)); return r; }

__device__ __forceinline__ unsigned pk_fp8x4(float a, float b, float c, float d) { int w = 0; w = __builtin_amdgcn_cvt_pk_fp8_f32(a, b, w, false); w = __builtin_amdgcn_cvt_pk_fp8_f32(c, d, w, true); return (unsigned)w; }
typedef int v6i32 __attribute__((ext_vector_type(6)));
typedef unsigned u32x6 __attribute__((ext_vector_type(6)));
__device__ __forceinline__ u32x6 mx6_block(const f32x16 lo, const f32x16 hi, unsigned& sb) {
    float am = 0.f;
#pragma unroll
    for (int i = 0; i < 16; ++i) am = fmaxf(am, fmaxf(fabsf(lo[i]), fabsf(hi[i])));
    const unsigned bits = __float_as_uint(am);
    int e = (int)((bits >> 23) & 255u) - 126 - (((bits & 0x7fffffu) <= 0x700000u) ? 3 : 2);
    e = e < -120 ? -120 : e;
    const float scale = __uint_as_float((unsigned)(e + 127) << 23);
    sb = (unsigned)(e + 127) * 0x01010101u;
    u32x6 q;
    asm("v_cvt_scalef32_2xpk16_fp6_f32 %0, %1, %2, %3" : "=&v"(q) : "v"(lo), "v"(hi), "v"(scale));
    return q;
}
constexpr float X8_SCALE = 4.f, W8UP_SCALE = 64.f, W8DN_SCALE = 128.f, H8_SCALE = 16.f;
__device__ __forceinline__ int tid_opaque() { int t = threadIdx.x; asm volatile("" : "+v"(t)); return t; }

constexpr size_t MiB = 1u << 20;
constexpr size_t WS_CTL = 0, CTL_ZERO_BYTES = 1 * MiB;
constexpr size_t WS_COSM = 1 * MiB, WS_SINM = 3 * MiB, WS_COSS = 5 * MiB, WS_SINS = 9 * MiB;
constexpr size_t WS_PARTQ = 13 * MiB, WS_PARTKV = 14 * MiB, WS_PARTO = 15 * MiB;
constexpr size_t WS_SEL = 16 * MiB, WS_GATE = WS_SEL + 128 * 1024, WS_DEST = WS_GATE + 128 * 1024, WS_WGCNT = WS_DEST + 128 * 1024, WS_MOEMETA = WS_WGCNT + 32 * 1024, WS_ST1 = WS_MOEMETA + 4096, WS_ST2 = WS_ST1 + 128 * 1024;
constexpr size_t WS_W = 17 * MiB;
constexpr size_t SZ_WIN = (size_t)IN_PAD * D * 2, SZ_WQ = (size_t)QCOLS * QLORA * 2, SZ_WKV = (size_t)KVCOLS * KVLORA * 2, SZ_WOUT = (size_t)D * D * 2;
constexpr size_t WS_WIN = WS_W, WS_WQ = WS_WIN + 2 * SZ_WIN, WS_WKV = WS_WQ + 2 * SZ_WQ, WS_WOUT = WS_WKV + 2 * SZ_WKV;
constexpr size_t WS_WGU = WS_WOUT + 2 * SZ_WOUT, WS_WD = WS_WGU + (size_t)2 * FF * D, WS_WMGU = WS_WD + (size_t)D * FF;
constexpr size_t WS_WMD = WS_WMGU + (size_t)NE * 2 * FFE * D, WS_XA = WS_WMD + (size_t)NE * D * FFE;
constexpr size_t WS_XB = WS_XA + (size_t)S * D * 4, WS_X8 = WS_XB + (size_t)S * D * 2, WS_SCR = WS_X8 + (size_t)S * D;
constexpr size_t WS_CQ = WS_SCR, WS_CKV = WS_CQ + (size_t)S * 512 * 2, WS_KPE = WS_CKV + (size_t)S * 256 * 2, WS_QS = WS_KPE + (size_t)S * 64 * 2;
constexpr size_t WS_KS = WS_QS + (size_t)S * 1024 * 2, WS_VS = WS_KS + (size_t)S * 256 * 2, WS_Q = WS_VS + (size_t)S * 256 * 2, WS_KV = WS_Q + (size_t)S * QCOLS * 2;
constexpr size_t WS_OBUF = WS_KV + (size_t)S * KVCOLS * 2, WS_ATT_END = WS_OBUF + (size_t)S * D * 2;
constexpr size_t WS_XS = WS_SCR, WS_H = WS_XS + (size_t)MOE_ROWS * D * 2, WS_END0 = WS_H + (size_t)MOE_ROWS * FFE, WS_END = WS_END0 > WS_ATT_END ? WS_END0 : WS_ATT_END;
constexpr size_t WS_YP = (WS_END + 255) / 256 * 256, WS_END2 = WS_YP + (size_t)7 * 128 * 65536 * 2;
constexpr size_t WS_TAILMAP = WS_CTL + 512 * 1024;
static_assert(WS_H + (size_t)S * FF <= WS_END, "scratch union");
static_assert(WS_WIN % 256 == 0 && WS_XA % 256 == 0 && WS_H % 256 == 0 && WS_Q % 256 == 0, "alignment");
constexpr int CW_TMO = 0, CW_BAR = 4096;

#define XB_TMO      128
#define XB_XCNT(j)  (256  + 64 * (j))
#define XB_XSUB(j)  (1280 + 64 * (j))
#define XB_XGEN(j)  (2304 + 64 * (j))
#define XB_TOP      3328
#define XB_TOPGEN   3392
#define XCD_BAR_WORDS 3456
#define XB_SPIN_CAP (1u << 18)
__device__ __forceinline__ unsigned xb_ld(unsigned* p)              { return __hip_atomic_load(p, __ATOMIC_RELAXED, __HIP_MEMORY_SCOPE_AGENT); }
__device__ __forceinline__ unsigned xb_add(unsigned* p, unsigned v) { return __hip_atomic_fetch_add(p, v, __ATOMIC_RELAXED, __HIP_MEMORY_SCOPE_AGENT); }
__device__ __forceinline__ unsigned xb_xcc_id() { return (unsigned)__builtin_amdgcn_s_getreg((3 << 11) | 20) & 0xFu; }
#define XB_SPIN(cond, bar) do { unsigned _sp = 0; while (cond) { __builtin_amdgcn_s_sleep(1); \
    if ((++_sp & 255u) == 0u) { if (xb_ld(&(bar)[XB_TMO])) break; if (_sp > XB_SPIN_CAP) { atomicAdd(&(bar)[XB_TMO], 1u); break; } } } } while (0)
struct XcdBarrier { unsigned* bar; unsigned x; volatile LAS unsigned* st; };
__device__ __forceinline__ XcdBarrier xcd_barrier_post(unsigned* bar, volatile LAS unsigned* st) {
    XcdBarrier b; b.bar = bar; b.x = xb_xcc_id(); b.st = st;
    if (threadIdx.x == 0) (void)xb_add(&bar[XB_XCNT(b.x)], 1u);
    return b;
}
__device__ __forceinline__ void xcd_barrier_complete(unsigned* bar, unsigned x, unsigned& nloc, unsigned& nx) {
    const unsigned G = gridDim.x * gridDim.y * gridDim.z;
    unsigned sum, cnt, mine, sp = 0u;
    for (;;) {
        sum = 0u; cnt = 0u; mine = 0u;
#pragma unroll
        for (unsigned j = 0; j < 16; ++j) { const unsigned c = xb_ld(&bar[XB_XCNT(j)]); sum += c; cnt += (c > 0u) ? 1u : 0u; mine = (j == x) ? c : mine; }
        if (sum == G) break;
        __builtin_amdgcn_s_sleep(1);
        if ((++sp & 255u) == 0u) { if (xb_ld(&bar[XB_TMO])) break; if (sp > XB_SPIN_CAP) { atomicAdd(&bar[XB_TMO], 1u); break; } }
    }
    nloc = mine > 0u ? mine : 1u; nx = cnt > 0u ? cnt : 1u;
}
__device__ __forceinline__ void xcd_barrier(const XcdBarrier& b) {
    asm volatile("s_waitcnt vmcnt(0)" ::: "memory");
    __syncthreads();
    if (threadIdx.x == 0) {
        unsigned* bar = b.bar;
        __builtin_amdgcn_s_waitcnt(0);
        unsigned nloc = b.st[0], nx = b.st[1];
        if (nloc == 0u) { xcd_barrier_complete(bar, b.x, nloc, nx); b.st[0] = nloc; b.st[1] = nx; }
        const unsigned old = xb_add(&bar[XB_XSUB(b.x)], 1u);
        const unsigned gen = old / nloc;
        if (old + 1u == (gen + 1u) * nloc) {
            __builtin_amdgcn_fence(__ATOMIC_RELEASE, "agent");
            asm volatile("s_waitcnt vmcnt(0)" ::: "memory");
            const unsigned og = xb_add(&bar[XB_TOP], 1u);
            const unsigned tg = og / nx;
            if (og + 1u == (tg + 1u) * nx) xb_add(&bar[XB_TOPGEN], 1u);
            else XB_SPIN(xb_ld(&bar[XB_TOPGEN]) == tg, bar);
            __builtin_amdgcn_fence(__ATOMIC_ACQUIRE, "agent");
            xb_add(&bar[XB_XGEN(b.x)], 1u);
            asm volatile("s_waitcnt vmcnt(0)" ::: "memory");
        } else {
            XB_SPIN(xb_ld(&bar[XB_XGEN(b.x)]) == gen, bar);
            __builtin_amdgcn_fence(__ATOMIC_ACQUIRE, "agent");
            asm volatile("s_waitcnt vmcnt(0)" ::: "memory");
        }
    }
    __syncthreads();
}

namespace pg8 {
constexpr int BM = 256, BK = 64, HALF = 128, HTB = HALF * BK * 2, STAGE_BYTES = 8 * HTB, NXCD = 8, WGM = 8;
__host__ __device__ __forceinline__ int lds_byte(int r, int c) { const int st = (r >> 4) * 2 + (c >> 5), rr = r & 15, cc = c & 31, ob = rr * 64 + cc * 2; return st * 1024 + (ob ^ (((ob >> 9) & 1) << 5)); }
__host__ __device__ __forceinline__ void stage_rc(int b, int& R, int& C) { const int st = b / 1024, sb = b % 1024, swz = sb ^ (((sb >> 9) & 1) << 5); R = (st >> 1) * 16 + swz / 64; C = (st & 1) * 32 + (swz % 64) / 2; }
__host__ __device__ __forceinline__ int perm32(int rho) { const int n = rho >> 4, i = rho & 15; return 8 * (i >> 2) + 4 * n + (i & 3); }
struct Unit { int pm, pn, aux, kx; };
struct Gemm { const bf16_t* A; const bf16_t* Bt; int K; };
struct StaticOrder {
    static constexpr bool KSPLIT = false;
    int nM, nN, nwg, G, c;
    __device__ void init(int M, int N, int G_, int c_) { nM = M / BM; nN = N / BM; nwg = nM * nN; G = G_; c = c_; }
    __device__ bool next(int i, Unit& u) const {
        const long L = (long)i * G + c; if (L >= nwg) return false;
        int wgid = (int)L; { const int q = nwg / NXCD, r = nwg % NXCD, xcd = wgid % NXCD, off = wgid / NXCD; wgid = (xcd < r ? xcd * (q + 1) : r * (q + 1) + (xcd - r) * q) + off; }
        const int nig = WGM * nN, gid = wgid / nig, fm = gid * WGM, gsz = (nM - fm) < WGM ? (nM - fm) : WGM;
        u.pm = fm + ((wgid % nig) % gsz); u.pn = (wgid % nig) / gsz; u.aux = u.pn; return true;
    }
};
struct MoeOrder {
    static constexpr bool KSPLIT = false;
    int pb[9], NT, G, c, nwg;
    __device__ __forceinline__ bool next(int i, Unit& u) const { return at((long)i * G + c, u); }
    __device__ __forceinline__ bool at(long L, Unit& u) const {
        if (L >= nwg) return false;
        int wgid = (int)L; { const int q = nwg / NXCD, r = nwg % NXCD, xcd = wgid % NXCD, off = wgid / NXCD; wgid = (xcd < r ? xcd * (q + 1) : r * (q + 1) + (xcd - r) * q) + off; }
        int e = 0;
#pragma unroll
        for (int k = 1; k < 8; ++k) e += (wgid >= pb[k] * NT) ? 1 : 0;
        int pbe = pb[0], pbn = pb[1];
#pragma unroll
        for (int k = 1; k < 8; ++k) { if (e == k) { pbe = pb[k]; pbn = pb[k + 1]; } }
        const int l = wgid - pbe * NT, Pe = pbn - pbe;
        const int nig = WGM * NT, gid = l / nig, fm = gid * WGM, gsz = (Pe - fm) < WGM ? (Pe - fm) : WGM;
        u.pm = pbe + fm + ((l % nig) % gsz); const int pn = (l % nig) / gsz; u.pn = e * NT + pn; u.aux = pn; return true;
    }
};

struct TableOrder {
    static constexpr bool KSPLIT = false;
    const LAS int* tab; int n;
    __device__ __forceinline__ bool next(int i, Unit& u) const {
        if (i >= n) return false;
        u.pm = __builtin_amdgcn_readfirstlane(tab[4 * i]); u.pn = __builtin_amdgcn_readfirstlane(tab[4 * i + 1]); u.aux = __builtin_amdgcn_readfirstlane(tab[4 * i + 2]); return true;
    }
};
struct TableOrderK {
    static constexpr bool KSPLIT = true;
    const LAS int* tab; int n;
    __device__ __forceinline__ bool next(int i, Unit& u) const {
        if (i >= n) return false;
        u.pm = __builtin_amdgcn_readfirstlane(tab[4 * i]); u.pn = __builtin_amdgcn_readfirstlane(tab[4 * i + 1]); u.aux = __builtin_amdgcn_readfirstlane(tab[4 * i + 2]); u.kx = __builtin_amdgcn_readfirstlane(tab[4 * i + 3]); return true;
    }
};
typedef int v8i32 __attribute__((ext_vector_type(8)));
template <class Epi, class Sched, bool ALIGN_EPI, bool SP2, int FMT = 0>
__device__ __forceinline__ void gemm_phase(LAS unsigned char* lds, const Gemm g, const Sched& S, const Epi& E) {
    const int tid = tid_opaque(), wid = __builtin_amdgcn_readfirstlane(tid >> 6), lane = tid & 63, wr = wid >> 2, wc = wid & 3, fr = lane & 15, fq = lane >> 4;
    constexpr bool F8 = (FMT != 0);
    const int K = g.K, RB = F8 ? K : 2 * K, nt = RB / 128;
    unsigned voffA, voffB;
    { int R, C; stage_rc(tid * 16, R, C); const int Rb = Epi::PERM ? ((R & ~31) + perm32(R & 31)) : R; voffA = (unsigned)(R * RB + C * 2); voffB = (unsigned)(Rb * RB + C * 2); }
    const size_t rstep = (size_t)64 * RB;
    const size_t kstep = (size_t)(BK * 2);
    const size_t hstep = (size_t)HALF * RB;
    const size_t tstep = 2 * hstep;
    const unsigned ldsw = (unsigned)wid * 1024u;
    const int aoff = lds_byte(wr * 64 + fr, fq * 8), boff = lds_byte(wc * 32 + fr, fq * 8);
#define PG8_SA(b, h) (((b) * 2 + (h)) * HTB)
#define PG8_SB(b, h) ((4 + (b) * 2 + (h)) * HTB)
#define PG8_STAGE(bufoff, gbase, voff) do { _Pragma("unroll") for (int _i = 0; _i < 2; ++_i) \
        __builtin_amdgcn_global_load_lds((const unsigned*)((const char*)(gbase) + _i * rstep + (voff)), (LAS unsigned*)(lds + (bufoff) + ldsw + _i * 8192), 16, 0, 0); } while (0)
#define PG8_LDA(dst, b, h) do { _Pragma("unroll") for (int m = 0; m < 4; ++m) _Pragma("unroll") for (int k = 0; k < 2; ++k) dst[m][k] = *(const LAS bf16x8*)(lds + PG8_SA(b, h) + aoff + m * 2048 + k * 1024); } while (0)
#define PG8_LDB(dst, b, h) do { _Pragma("unroll") for (int n = 0; n < 2; ++n) _Pragma("unroll") for (int k = 0; k < 2; ++k) dst[n][k] = *(const LAS bf16x8*)(lds + PG8_SB(b, h) + boff + n * 2048 + k * 1024); } while (0)
#define PG8_CAT(x) __builtin_shufflevector(__builtin_bit_cast(u32x4, x[0]), __builtin_bit_cast(u32x4, x[1]), 0, 1, 2, 3, 4, 5, 6, 7)
#define PG8_D6(x) __builtin_bit_cast(v6i32, __builtin_shufflevector(__builtin_bit_cast(u32x4, x[0]), __builtin_bit_cast(u32x4, x[1]), 0, 1, 2, 3, 4, 5))
#define PG8_S6(x) ((int)__builtin_bit_cast(u32x4, x[1])[2])
#define PG8_MMA(ai, bj, At, Bt) do { __builtin_amdgcn_s_setprio(1); if constexpr (FMT == 1) { _Pragma("unroll") for (int m = 0; m < 4; ++m) _Pragma("unroll") for (int n = 0; n < 2; ++n) \
        asm volatile("v_mfma_f32_16x16x128_f8f6f4 %0, %1, %2, %0" : "+v"(acc[ai][bj][m][n]) : "v"(__builtin_bit_cast(v8i32, PG8_CAT(Bt[n]))), "v"(__builtin_bit_cast(v8i32, PG8_CAT(At[m])))); } \
        else if constexpr (FMT == 2) { _Pragma("unroll") for (int m = 0; m < 4; ++m) _Pragma("unroll") for (int n = 0; n < 2; ++n) \
        acc[ai][bj][m][n] = __builtin_amdgcn_mfma_scale_f32_16x16x128_f8f6f4(__builtin_bit_cast(v8i32, PG8_CAT(Bt[n])), __builtin_bit_cast(v8i32, PG8_CAT(At[m])), acc[ai][bj][m][n], 2, 2, 0, PG8_S6(Bt[n]), 0, PG8_S6(At[m])); } \
        else { _Pragma("unroll") for (int m = 0; m < 4; ++m) _Pragma("unroll") for (int n = 0; n < 2; ++n) _Pragma("unroll") for (int k = 0; k < 2; ++k) \
        acc[ai][bj][m][n] = __builtin_amdgcn_mfma_f32_16x16x32_bf16(Bt[n][k], At[m][k], acc[ai][bj][m][n], 0, 0, 0); } __builtin_amdgcn_s_setprio(0); } while (0)
#define PG8_WAIT_V(n) asm volatile("s_waitcnt vmcnt(" #n ")" ::: "memory")
#define PG8_WAIT_L(n) asm volatile("s_waitcnt lgkmcnt(" #n ")" ::: "memory")
#define PG8_BAR __builtin_amdgcn_s_barrier()
#define PG8_SCHED __builtin_amdgcn_sched_barrier(0)
    Unit cur, nxt; int ui = 0;
    if (!S.next(0, cur)) return;
    constexpr bool KS = Sched::KSPLIT;
    auto k_off = [&](const Unit& u) -> size_t { if constexpr (KS) { if (u.kx) return (size_t)((u.kx >> 8) & 255) * (size_t)(nt / (u.kx >> 16)) * 128; } return 0; };
    auto k_cnt = [&](const Unit& u) -> int { if constexpr (KS) { if (u.kx) return nt / (u.kx >> 16); } return nt; };
    int ntc = k_cnt(cur);
    f32x4 acc[2][2][4][2];
#pragma unroll
    for (int a = 0; a < 2; ++a)
#pragma unroll
        for (int b = 0; b < 2; ++b)
#pragma unroll
            for (int m = 0; m < 4; ++m)
#pragma unroll
                for (int n = 0; n < 2; ++n) acc[a][b][m][n] = (f32x4){0.f, 0.f, 0.f, 0.f};
    bf16x8 At[4][2], B0[2][2], B1[2][2];
    const char* cA = (const char*)g.A + (size_t)cur.pm * tstep + k_off(cur); const char* cB = (const char*)g.Bt + (size_t)cur.pn * tstep + k_off(cur);
    if constexpr (SP2) {
        PG8_STAGE(PG8_SB(0, 0), cB, voffB); PG8_STAGE(PG8_SB(0, 1), cB + hstep, voffB); PG8_STAGE(PG8_SA(0, 0), cA, voffA); PG8_STAGE(PG8_SA(0, 1), cA + hstep, voffA);
        if (wr == 1) PG8_BAR;
        PG8_WAIT_V(2); PG8_BAR;
        PG8_STAGE(PG8_SB(1, 0), cB + kstep, voffB); PG8_STAGE(PG8_SA(1, 0), cA + kstep, voffA); PG8_STAGE(PG8_SB(1, 1), cB + hstep + kstep, voffB);
        PG8_WAIT_V(6); PG8_BAR;
    } else {
        PG8_STAGE(PG8_SB(0, 0), cB, voffB); PG8_STAGE(PG8_SA(0, 0), cA, voffA); PG8_STAGE(PG8_SB(0, 1), cB + hstep, voffB); PG8_STAGE(PG8_SA(0, 1), cA + hstep, voffA);
        if (wr == 1) PG8_BAR;
        PG8_WAIT_V(4); PG8_BAR;
        PG8_STAGE(PG8_SB(1, 0), cB + kstep, voffB); PG8_STAGE(PG8_SA(1, 0), cA + kstep, voffA); PG8_STAGE(PG8_SB(1, 1), cB + hstep + kstep, voffB);
        PG8_WAIT_V(6); PG8_BAR;
    }
    for (;;) {
        const bool has_next = S.next(ui + 1, nxt);
        const char* nA = has_next ? (const char*)g.A + (size_t)nxt.pm * tstep + k_off(nxt) : cA; const char* nB = has_next ? (const char*)g.Bt + (size_t)nxt.pn * tstep + k_off(nxt) : cB;
        for (int t = 0; t < ntc; t += 2) {
            if constexpr (Epi::MID_T >= 0) { if (t == Epi::MID_T) { const int l2 = tid_opaque() & 63; E.mid(acc, cur, wr, wc, l2 & 15, l2 >> 4); } }
            const bool last = (t == ntc - 2);
            const char* a1 = cA + (size_t)(t + 1) * kstep;
            const char* a2 = last ? nA : cA + (size_t)(t + 2) * kstep; const char* b2 = last ? nB : cB + (size_t)(t + 2) * kstep;
            const char* a3 = a2 + kstep; const char* b3 = b2 + kstep;
            if constexpr (SP2) {
            PG8_LDB(B0, 0, 0); PG8_LDB(B1, 0, 1); PG8_SCHED; PG8_LDA(At, 0, 0); PG8_STAGE(PG8_SA(1, 1), a1 + hstep, voffA);
            PG8_WAIT_V(8); PG8_WAIT_L(0); PG8_BAR; PG8_MMA(0, 0, At, B0); PG8_MMA(0, 1, At, B1); PG8_BAR; PG8_SCHED;
            PG8_LDA(At, 0, 1); PG8_STAGE(PG8_SB(0, 0), b2, voffB); PG8_STAGE(PG8_SB(0, 1), b2 + hstep, voffB); PG8_STAGE(PG8_SA(0, 0), a2, voffA);
            PG8_WAIT_V(8); PG8_WAIT_L(0); PG8_BAR; PG8_MMA(1, 0, At, B0); PG8_MMA(1, 1, At, B1); PG8_BAR; PG8_SCHED;
            PG8_LDB(B0, 1, 0); PG8_LDB(B1, 1, 1); PG8_SCHED; PG8_LDA(At, 1, 0); PG8_STAGE(PG8_SA(0, 1), a2 + hstep, voffA);
            PG8_WAIT_V(8); PG8_WAIT_L(0); PG8_BAR; PG8_MMA(0, 0, At, B0); PG8_MMA(0, 1, At, B1); PG8_BAR; PG8_SCHED;
            PG8_LDA(At, 1, 1); PG8_STAGE(PG8_SB(1, 0), b3, voffB); PG8_STAGE(PG8_SB(1, 1), b3 + hstep, voffB); PG8_STAGE(PG8_SA(1, 0), a3, voffA);
            PG8_WAIT_V(8); PG8_WAIT_L(0); PG8_BAR; PG8_MMA(1, 0, At, B0); PG8_MMA(1, 1, At, B1); PG8_BAR; PG8_SCHED;
            } else {
            PG8_LDB(B0, 0, 0); PG8_SCHED; PG8_LDA(At, 0, 0); PG8_STAGE(PG8_SA(1, 1), a1 + hstep, voffA);
            PG8_WAIT_L(8); PG8_BAR; PG8_WAIT_L(0); PG8_MMA(0, 0, At, B0); PG8_BAR; PG8_SCHED;
            PG8_LDB(B1, 0, 1); PG8_STAGE(PG8_SB(0, 0), b2, voffB);
            PG8_BAR; PG8_WAIT_L(0); PG8_MMA(0, 1, At, B1); PG8_BAR;
            PG8_LDA(At, 0, 1); PG8_STAGE(PG8_SA(0, 0), a2, voffA);
            PG8_BAR; PG8_WAIT_L(0); PG8_MMA(1, 0, At, B0); PG8_BAR; PG8_SCHED;
            PG8_STAGE(PG8_SB(0, 1), b2 + hstep, voffB);
            PG8_WAIT_V(6); PG8_BAR; PG8_MMA(1, 1, At, B1); PG8_BAR;
            PG8_LDB(B0, 1, 0); PG8_SCHED; PG8_LDA(At, 1, 0); PG8_STAGE(PG8_SA(0, 1), a2 + hstep, voffA);
            PG8_WAIT_L(8); PG8_BAR; PG8_WAIT_L(0); PG8_MMA(0, 0, At, B0); PG8_BAR; PG8_SCHED;
            PG8_LDB(B1, 1, 1); PG8_STAGE(PG8_SB(1, 0), b3, voffB);
            PG8_BAR; PG8_WAIT_L(0); PG8_MMA(0, 1, At, B1); PG8_BAR;
            PG8_LDA(At, 1, 1); PG8_STAGE(PG8_SA(1, 0), a3, voffA);
            PG8_BAR; PG8_WAIT_L(0); PG8_MMA(1, 0, At, B0); PG8_BAR; PG8_SCHED;
            PG8_STAGE(PG8_SB(1, 1), b3 + hstep, voffB);
            PG8_WAIT_V(6); PG8_BAR; PG8_MMA(1, 1, At, B1); PG8_BAR;
            }
        }
        if constexpr (ALIGN_EPI) { if (wr == 0) PG8_BAR; }
        if constexpr (F8) asm volatile("s_nop 15\n\ts_nop 15" ::: "memory");
        { const int l2 = tid_opaque() & 63; E(acc, cur, wr, wc, l2 & 15, l2 >> 4); }
        if (!has_next) break;
#pragma unroll
        for (int a = 0; a < 2; ++a)
#pragma unroll
            for (int b = 0; b < 2; ++b)
#pragma unroll
                for (int m = 0; m < 4; ++m)
#pragma unroll
                    for (int n = 0; n < 2; ++n) acc[a][b][m][n] = (f32x4){0.f, 0.f, 0.f, 0.f};
        cur = nxt; cA = nA; cB = nB; ++ui; ntc = k_cnt(cur);
        if constexpr (ALIGN_EPI) { if (wr == 1) PG8_BAR; }
    }
    PG8_WAIT_V(0);
    if constexpr (!ALIGN_EPI) { if (wr == 0) PG8_BAR; }
    PG8_BAR;
#undef PG8_SA
#undef PG8_SB
#undef PG8_STAGE
#undef PG8_LDA
#undef PG8_LDB
#undef PG8_MMA
#undef PG8_CAT
#undef PG8_D6
#undef PG8_S6
#undef PG8_WAIT_V
#undef PG8_WAIT_L
#undef PG8_BAR
#undef PG8_SCHED
}

__device__ __forceinline__ u32x4 pack8(const f32x4 a, const f32x4 b) { u32x4 w; w.x = cvt_pk_bf16(a[0], a[1]); w.y = cvt_pk_bf16(a[2], a[3]); w.z = cvt_pk_bf16(b[0], b[1]); w.w = cvt_pk_bf16(b[2], b[3]); return w; }
__device__ __forceinline__ u32x2 pack4(const f32x4 a) { u32x2 w; w.x = cvt_pk_bf16(a[0], a[1]); w.y = cvt_pk_bf16(a[2], a[3]); return w; }

constexpr int RM_BITS = 4;
__device__ __forceinline__ f32x4 rmant(const f32x4 v) {
    f32x4 r;
#pragma unroll
    for (int i = 0; i < 4; ++i) r[i] = __uint_as_float((__float_as_uint(v[i]) + (1u << (22 - RM_BITS))) & ~((1u << (23 - RM_BITS)) - 1u));
    return r;
}
struct EpiInProj {
    static constexpr int MID_T = -1;
    static constexpr bool PERM = true;
    bf16_t *cq, *ckv, *kpe, *qs, *ks, *vs; float *partq, *partkv; const float *cosm, *sinm, *coss, *sins;
    __device__ __forceinline__ void operator()(const f32x4 (&acc)[2][2][4][2], const Unit& u, int wr, int wc, int fr, int fq) const {
        const int row0 = u.pm * BM + wr * 64 + fr;
#pragma unroll
        for (int bj = 0; bj < 2; ++bj) {
            const int tc0 = u.aux * BM + bj * HALF + wc * 32 + fq * 8;
            if (tc0 < 768) {
                bf16_t* base; float* part; int ld, col, ps;
                if (tc0 < 512) { base = cq; ld = 512; col = tc0; part = partq; ps = 16; } else { base = ckv; ld = 256; col = tc0 - 512; part = partkv; ps = 8; }
#pragma unroll
                for (int ai = 0; ai < 2; ++ai)
#pragma unroll
                    for (int m = 0; m < 4; ++m) { const int row = row0 + ai * HALF + m * 16; const f32x4 v0 = acc[ai][bj][m][0], v1 = acc[ai][bj][m][1];
                        *(u32x4*)(base + (size_t)row * ld + col) = pack8(v0, v1);
                        float ss = (v0[0] * v0[0] + v0[1] * v0[1]) + (v0[2] * v0[2] + v0[3] * v0[3]) + (v1[0] * v1[0] + v1[1] * v1[1]) + (v1[2] * v1[2] + v1[3] * v1[3]);
                        ss += __shfl_xor(ss, 16); ss += __shfl_xor(ss, 32);
                        if (fq == 0) part[(size_t)row * ps + (col >> 5)] = ss; }
            } else if (tc0 < 2112) {
                bf16_t* base; const float *ct, *st; int ld, col, half, tw, g;
                if (tc0 < 832) { g = (tc0 - 768) >> 3; base = kpe; ld = 64; col = 4 * g; half = 32; ct = cosm; st = sinm; tw = 32; }
                else if (tc0 < 1856) { const int j = tc0 - 832; g = (j & 127) >> 3; base = qs; ld = 1024; col = (j >> 7) * 128 + 4 * g; half = 64; ct = coss; st = sins; tw = 64; }
                else { const int j = tc0 - 1856; g = (j & 127) >> 3; base = ks; ld = 256; col = (j >> 7) * 128 + 4 * g; half = 64; ct = coss; st = sins; tw = 64; }
#pragma unroll
                for (int ai = 0; ai < 2; ++ai)
#pragma unroll
                    for (int m = 0; m < 4; ++m) { const int row = row0 + ai * HALF + m * 16; const f32x4 x1 = acc[ai][bj][m][0], x2 = acc[ai][bj][m][1];
                        const f32x4 c = *(const f32x4*)(ct + (size_t)row * tw + 4 * g), s = *(const f32x4*)(st + (size_t)row * tw + 4 * g);
                        const f32x4 o1 = x1 * c - x2 * s, o2 = x2 * c + x1 * s;
                        if (tc0 < 832) { unsigned char* kp = (unsigned char*)kpe + (size_t)row * 64 + col;
                            *(unsigned*)kp = pk_fp8x4(o1[0], o1[1], o1[2], o1[3]); *(unsigned*)(kp + 32) = pk_fp8x4(o2[0], o2[1], o2[2], o2[3]); }
                        else { *(u32x2*)(base + (size_t)row * ld + col) = pack4(o1); *(u32x2*)(base + (size_t)row * ld + col + half) = pack4(o2); } }
            } else if (tc0 < 2368) {
                const int col = tc0 - 2112;
#pragma unroll
                for (int ai = 0; ai < 2; ++ai)
#pragma unroll
                    for (int m = 0; m < 4; ++m) { const int row = row0 + ai * HALF + m * 16; *(u32x4*)(vs + (size_t)row * 256 + col) = pack8(acc[ai][bj][m][0], acc[ai][bj][m][1]); }
            }
        }
    }
};
struct EpiQ {
    static constexpr int MID_T = -1;
    static constexpr bool PERM = true;
    bf16_t* q; const float *partq, *cosm, *sinm;
    __device__ __forceinline__ void operator()(const f32x4 (&acc)[2][2][4][2], const Unit& u, int wr, int wc, int fr, int fq) const {
        const int row0 = u.pm * BM + wr * 64 + fr;
        float rs[2][4];
#pragma unroll
        for (int ai = 0; ai < 2; ++ai)
#pragma unroll
            for (int m = 0; m < 4; ++m) { const f32x4* p = (const f32x4*)(partq + (size_t)(row0 + ai * HALF + m * 16) * 16); const f32x4 s = (p[0] + p[1]) + (p[2] + p[3]);
                rs[ai][m] = 1.0f / sqrtf(((s[0] + s[1]) + (s[2] + s[3])) * (1.0f / 512.0f) + RMS_EPS); }
#pragma unroll
        for (int bj = 0; bj < 2; ++bj) {
            const int tc0 = u.aux * BM + bj * HALF + wc * 32 + fq * 8, head = tc0 / 192, j = tc0 - head * 192;
            if (j < 128) {
#pragma unroll
                for (int ai = 0; ai < 2; ++ai)
#pragma unroll
                    for (int m = 0; m < 4; ++m) { const int row = row0 + ai * HALF + m * 16; *(u32x4*)(q + (size_t)row * QCOLS + tc0) = pack8(rmant(acc[ai][bj][m][0] * rs[ai][m]), rmant(acc[ai][bj][m][1] * rs[ai][m])); }
            } else {
                const int g = (j - 128) >> 3, col = head * 192 + 128 + 4 * g;
#pragma unroll
                for (int ai = 0; ai < 2; ++ai)
#pragma unroll
                    for (int m = 0; m < 4; ++m) { const int row = row0 + ai * HALF + m * 16; const f32x4 x1 = acc[ai][bj][m][0] * rs[ai][m], x2 = acc[ai][bj][m][1] * rs[ai][m];
                        const f32x4 c = *(const f32x4*)(cosm + (size_t)row * 32 + 4 * g), s = *(const f32x4*)(sinm + (size_t)row * 32 + 4 * g);
                        const f32x4 r1 = x1 * c - x2 * s, r2 = x2 * c + x1 * s; unsigned char* q8 = (unsigned char*)(q + (size_t)row * QCOLS + head * 192 + 128) + 4 * g;
                        *(unsigned*)q8 = pk_fp8x4(r1[0], r1[1], r1[2], r1[3]); *(unsigned*)(q8 + 32) = pk_fp8x4(r2[0], r2[1], r2[2], r2[3]); }
            }
        }
    }
};
struct EpiKV {
    static constexpr int MID_T = -1;
    static constexpr bool PERM = true;
    bf16_t* kv; const float* partkv;
    __device__ __forceinline__ void operator()(const f32x4 (&acc)[2][2][4][2], const Unit& u, int wr, int wc, int fr, int fq) const {
        const int row0 = u.pm * BM + wr * 64 + fr;
#pragma unroll
        for (int ai = 0; ai < 2; ++ai)
#pragma unroll
            for (int m = 0; m < 4; ++m) { const int row = row0 + ai * HALF + m * 16; const f32x4* p = (const f32x4*)(partkv + (size_t)row * 8); const f32x4 s = p[0] + p[1];
                const float rs = 1.0f / sqrtf(((s[0] + s[1]) + (s[2] + s[3])) * (1.0f / 256.0f) + RMS_EPS);
#pragma unroll
                for (int bj = 0; bj < 2; ++bj) { const int col = u.aux * BM + bj * HALF + wc * 32 + fq * 8; f32x4 k0 = acc[ai][bj][m][0] * rs, k1 = acc[ai][bj][m][1] * rs; k0 = rmant(k0); k1 = rmant(k1); *(u32x4*)(kv + (size_t)row * KVCOLS + col) = pack8(k0, k1); } }
    }
};
struct EpiResid {
    static constexpr int MID_T = -1;
    static constexpr bool PERM = true;
    const float* xin; float* y; float sc;
    __device__ __forceinline__ void operator()(const f32x4 (&acc)[2][2][4][2], const Unit& u, int wr, int wc, int fr, int fq) const {
        const int row0 = u.pm * BM + wr * 64 + fr;
#pragma unroll
        for (int ai = 0; ai < 2; ++ai)
#pragma unroll
            for (int m = 0; m < 4; ++m) { const size_t ro = (size_t)(row0 + ai * HALF + m * 16) * D;
#pragma unroll
                for (int bj = 0; bj < 2; ++bj) { const size_t o = ro + u.aux * BM + bj * HALF + wc * 32 + fq * 8;
                    const f32x4 a0 = *(const f32x4*)(xin + o), a1 = *(const f32x4*)(xin + o + 4);
                    *(f32x4*)(y + o) = a0 * ALPHA + acc[ai][bj][m][0] * sc; *(f32x4*)(y + o + 4) = a1 * ALPHA + acc[ai][bj][m][1] * sc; }
                asm volatile("" ::: "memory"); }
    }
};
struct EpiResidLN {
    static constexpr int MID_T = -1;
    static constexpr bool PERM = true, PROBE2 = false;
    const float* yin; float* y; float sc; const float* st; const float* g; const float* b;
    __device__ __forceinline__ void operator()(const f32x4 (&acc)[2][2][4][2], const Unit& u, int wr, int wc, int fr, int fq) const {
        const int row0 = u.pm * BM + wr * 64 + fr, col0 = u.aux * BM + wc * 32 + fq * 8;
        f32x4 gg[2][2], bb[2][2];
#pragma unroll
        for (int bj = 0; bj < 2; ++bj)
#pragma unroll
            for (int n = 0; n < 2; ++n) { gg[bj][n] = *(const f32x4*)(g + col0 + bj * HALF + 4 * n); bb[bj][n] = *(const f32x4*)(b + col0 + bj * HALF + 4 * n); }
#pragma unroll
        for (int ai = 0; ai < 2; ++ai)
#pragma unroll
            for (int m = 0; m < 4; ++m) { const int row = row0 + ai * HALF + m * 16; const size_t ro = (size_t)row * D; const float mu = st[2 * row], rs = st[2 * row + 1];
#pragma unroll
                for (int bj = 0; bj < 2; ++bj) { const size_t o = ro + col0 + bj * HALF;
                    const f32x4 a0 = *(const f32x4*)(yin + o), a1 = *(const f32x4*)(yin + o + 4);
                    const f32x4 x0 = (a0 - mu) * rs * gg[bj][0] + bb[bj][0], x1 = (a1 - mu) * rs * gg[bj][1] + bb[bj][1];
                    *(f32x4*)(y + o) = x0 * ALPHA + acc[ai][bj][m][0] * sc; *(f32x4*)(y + o + 4) = x1 * ALPHA + acc[ai][bj][m][1] * sc; }
                asm volatile("" ::: "memory"); }
    }
};
template <bool LNIN> struct EpiOutProj {
    static constexpr bool PERM = true, PROBE2 = false; static constexpr int MID_T = 16;
    const float* xin; float* y; const float* parto; const float* st; const float* g; const float* b;
    __device__ __forceinline__ void sums(int row, float& a, float& c) const { const f32x4* p = (const f32x4*)(parto + (size_t)row * 16); const f32x4 u = p[0] + p[1], v = p[2] + p[3];
        a = ((u[0] + u[1]) + (u[2] + u[3])) * (1.0f / 1024.0f) + RMS_EPS; c = ((v[0] + v[1]) + (v[2] + v[3])) * (1.0f / 1024.0f) + RMS_EPS; }
    __device__ __forceinline__ void mid(f32x4 (&acc)[2][2][4][2], const Unit& u, int wr, int wc, int fr, int fq) const {
        const int row0 = u.pm * BM + wr * 64 + fr;
#pragma unroll
        for (int ai = 0; ai < 2; ++ai)
#pragma unroll
            for (int m = 0; m < 4; ++m) { float a, c; sums(row0 + ai * HALF + m * 16, a, c); const float r = sqrtf(c / a);
#pragma unroll
                for (int bj = 0; bj < 2; ++bj) { acc[ai][bj][m][0] *= r; acc[ai][bj][m][1] *= r; } }
    }
    __device__ __forceinline__ void operator()(const f32x4 (&acc)[2][2][4][2], const Unit& u, int wr, int wc, int fr, int fq) const {
        const int row0 = u.pm * BM + wr * 64 + fr, col0 = u.aux * BM + wc * 32 + fq * 8;
        f32x4 gg[2][2], bb[2][2];
        if (LNIN) {
#pragma unroll
            for (int bj = 0; bj < 2; ++bj)
#pragma unroll
                for (int n = 0; n < 2; ++n) { gg[bj][n] = *(const f32x4*)(g + col0 + bj * HALF + 4 * n); bb[bj][n] = *(const f32x4*)(b + col0 + bj * HALF + 4 * n); }
        }
#pragma unroll
        for (int ai = 0; ai < 2; ++ai)
#pragma unroll
            for (int m = 0; m < 4; ++m) { const int row = row0 + ai * HALF + m * 16; const size_t ro = (size_t)row * D; float a, c; sums(row, a, c); const float rsw = 1.0f / sqrtf(c);
                float mu = 0.f, rs = 1.f; if (LNIN) { mu = st[2 * row]; rs = st[2 * row + 1]; }
#pragma unroll
                for (int bj = 0; bj < 2; ++bj) { const size_t o = ro + col0 + bj * HALF;
                    f32x4 x0 = *(const f32x4*)(xin + o), x1 = *(const f32x4*)(xin + o + 4);
                    if (LNIN) { x0 = (x0 - mu) * rs * gg[bj][0] + bb[bj][0]; x1 = (x1 - mu) * rs * gg[bj][1] + bb[bj][1]; }
                    *(f32x4*)(y + o) = x0 * ALPHA + acc[ai][bj][m][0] * rsw; *(f32x4*)(y + o + 4) = x1 * ALPHA + acc[ai][bj][m][1] * rsw; }
                asm volatile("" ::: "memory"); }
    }
};
struct EpiSwiglu8 {
    static constexpr int MID_T = -1;
    static constexpr bool PERM = true;
    unsigned char* h; int ldh; float sc;
    __device__ __forceinline__ void operator()(const f32x4 (&acc)[2][2][4][2], const Unit& u, int wr, int wc, int fr, int fq) const {
        const int row0 = u.pm * BM + wr * 64 + fr, col = u.aux * HALF + wc * 32 + fq * 8;
#pragma unroll
        for (int ai = 0; ai < 2; ++ai)
#pragma unroll
            for (int m = 0; m < 4; ++m) { f32x4 r0, r1;
#pragma unroll
                for (int k = 0; k < 4; ++k) { const float g0 = acc[ai][0][m][0][k] * sc, g1 = acc[ai][0][m][1][k] * sc;
                    r0[k] = __builtin_amdgcn_fmed3f(g0 * __builtin_amdgcn_rcpf(1.0f + __builtin_amdgcn_exp2f(-1.4426950408889634f * g0)) * (acc[ai][1][m][0][k] * (sc * H8_SCALE)), -448.f, 448.f);
                    r1[k] = __builtin_amdgcn_fmed3f(g1 * __builtin_amdgcn_rcpf(1.0f + __builtin_amdgcn_exp2f(-1.4426950408889634f * g1)) * (acc[ai][1][m][1][k] * (sc * H8_SCALE)), -448.f, 448.f); }
                u32x2 w; w.x = pk_fp8x4(r0[0], r0[1], r0[2], r0[3]); w.y = pk_fp8x4(r1[0], r1[1], r1[2], r1[3]);
                *(u32x2*)(h + (size_t)(row0 + ai * HALF + m * 16) * ldh + col) = w; }
    }
};
struct EpiSwiglu6 {
    static constexpr bool PERM = true, PROBE2 = false; static constexpr int MID_T = -1;
    unsigned char* h; int ldh;
    __device__ __forceinline__ void operator()(const f32x4 (&acc)[2][2][4][2], const Unit& u, int wr, int wc, int fr, int fq) const {
#pragma unroll
        for (int ai = 0; ai < 2; ++ai) {
            float v[4][8];
#pragma unroll
            for (int m = 0; m < 4; ++m)
#pragma unroll
                for (int c = 0; c < 8; ++c) { const float g = acc[ai][0][m][c >> 2][c & 3], uu = acc[ai][1][m][c >> 2][c & 3];
                    v[m][c] = g * __builtin_amdgcn_rcpf(1.0f + __builtin_amdgcn_exp2f(-1.4426950408889634f * g)) * uu; }
            float s1[2][2][8];
#pragma unroll
            for (int mm = 0; mm < 2; ++mm)
#pragma unroll
                for (int c = 0; c < 8; ++c) { auto r = __builtin_amdgcn_permlane32_swap(__float_as_uint(v[mm][c]), __float_as_uint(v[mm + 2][c]), false, false);
                    s1[mm][0][c] = __uint_as_float(r[0]); s1[mm][1][c] = __uint_as_float(r[1]); }
            f32x16 lo, hi;
#pragma unroll
            for (int hh = 0; hh < 2; ++hh)
#pragma unroll
                for (int c = 0; c < 8; ++c) { auto r = __builtin_amdgcn_permlane16_swap(__float_as_uint(s1[0][hh][c]), __float_as_uint(s1[1][hh][c]), false, false);
                    if (hh == 0) { lo[c] = __uint_as_float(r[0]); lo[8 + c] = __uint_as_float(r[1]); } else { hi[c] = __uint_as_float(r[0]); hi[8 + c] = __uint_as_float(r[1]); } }
            unsigned sb; const u32x6 q = mx6_block(lo, hi, sb);
            unsigned char* o = h + (size_t)(u.pm * BM + ai * HALF + wr * 64 + fq * 16 + fr) * ldh + u.aux * 128 + 16 * wc;
            *(u32x4*)o = (u32x4){q[0], q[1], q[2], q[3]}; *(u32x4*)(o + 64) = (u32x4){q[4], q[5], sb, 0u};
        }
    }
};
struct EpiBf16Out {
    static constexpr int MID_T = -1;
    static constexpr bool PERM = true;
    bf16_t* o; int ld; float sc;
    __device__ __forceinline__ void operator()(const f32x4 (&acc)[2][2][4][2], const Unit& u, int wr, int wc, int fr, int fq) const {
        const int row0 = u.pm * BM + wr * 64 + fr;
#pragma unroll
        for (int ai = 0; ai < 2; ++ai)
#pragma unroll
            for (int m = 0; m < 4; ++m)
#pragma unroll
                for (int bj = 0; bj < 2; ++bj) *(u32x4*)(o + (size_t)(row0 + ai * HALF + m * 16) * ld + u.aux * BM + bj * HALF + wc * 32 + fq * 8) = pack8(acc[ai][bj][m][0] * sc, acc[ai][bj][m][1] * sc);
    }
};
struct EpiBf16OutK {
    static constexpr int MID_T = -1;
    static constexpr bool PERM = true;
    bf16_t* o; bf16_t* yp;
    __device__ __forceinline__ void operator()(const f32x4 (&acc)[2][2][4][2], const Unit& u, int wr, int wc, int fr, int fq) const {
        bf16_t* base; int ld;
        if (u.kx) { base = yp + ((size_t)(((u.kx >> 8) & 255) * 128 + (u.kx & 255) - 1) * 256 + wr * 64 + fr) * 256; ld = 256; }
        else { base = o + (size_t)(u.pm * BM + wr * 64 + fr) * D + u.aux * BM; ld = D; }
#pragma unroll
        for (int ai = 0; ai < 2; ++ai)
#pragma unroll
            for (int m = 0; m < 4; ++m)
#pragma unroll
                for (int bj = 0; bj < 2; ++bj) *(u32x4*)(base + (size_t)(ai * HALF + m * 16) * ld + bj * HALF + wc * 32 + fq * 8) = pack8(acc[ai][bj][m][0], acc[ai][bj][m][1]);
    }
};
}

namespace att {
constexpr int NW = 8, QBLK = 32, KVBLK = 64;
constexpr float THR = 8.f;
constexpr int PPITCH = 80;
constexpr int SHM_V = KVBLK * 128 * 2, SHM_K = KVBLK * 272, SHM_P = KVBLK * PPITCH;
constexpr int OFF_V = 0, OFF_K = 3 * SHM_V, OFF_P = OFF_K + 2 * SHM_K,     OFF_WS = OFF_P + 2 * SHM_P, OFF_QP = OFF_WS + NW * 64 * 4, SHM_ATTN = OFF_QP + NW * 4096;
typedef LAS const char* lptr;
typedef short v4i16_t __attribute__((ext_vector_type(4)));
#define SBAR() __builtin_amdgcn_sched_barrier(0)
#define PIN(x) asm volatile("" : "+v"(x))
__device__ __forceinline__ int crow(int r, int hi) { return (r & 3) + 8 * (r >> 2) + 4 * hi; }
__device__ __forceinline__ bf16x8 ldk(lptr p) { return *(const LAS bf16x8*)p; }
__device__ __forceinline__ s16x4 vtr(lptr p) { return __builtin_bit_cast(s16x4, __builtin_amdgcn_ds_read_tr16_b64_v4i16((LAS v4i16_t*)p)); }
__device__ __forceinline__ int v_st(int k, int c) { const int kk = (k & ~0xC) | ((k & 4) << 1) | ((k & 8) >> 1); return ((kk >> 3) * 4 + (c >> 5)) * 512 + ((kk & 7) * 32 + (c & 31)) * 2; }
__device__ __forceinline__ int v_rd_base(int lane) { return ((lane & 3) << 3) | (((lane >> 2) & 3) << 6) | (((lane >> 4) & 1) << 5) | (((lane >> 5) & 1) << 8); }
__device__ __forceinline__ bf16x8 pk4(float a0, float a1, float a2, float a3, float a4, float a5, float a6, float a7) {
  const unsigned x0 = cvt_pk_bf16(a0, a1), x1 = cvt_pk_bf16(a2, a3), y0 = cvt_pk_bf16(a4, a5), y1 = cvt_pk_bf16(a6, a7);
  auto r0 = __builtin_amdgcn_permlane32_swap(x0, y0, false, false); auto r1 = __builtin_amdgcn_permlane32_swap(x1, y1, false, false);
  u32x4 w = {r0[0], r1[0], r0[1], r1[1]}; return __builtin_bit_cast(bf16x8, w);
}
constexpr int PD = 4;
__device__ __forceinline__ bf16x8 kfrag(lptr kb, int n) { const int d0 = n >> 1, h = n & 1; return ldk(kb + h * (32 * 272) + d0 * 32); }
typedef int v8i32_t __attribute__((ext_vector_type(8)));
__device__ __forceinline__ v8i32_t cat8(const bf16x8 a, const bf16x8 b) { return __builtin_bit_cast(v8i32_t, __builtin_shufflevector(__builtin_bit_cast(u32x4, a), __builtin_bit_cast(u32x4, b), 0, 1, 2, 3, 4, 5, 6, 7)); }
template <int NQ, bool DO_QK, bool DO_FIN>
__device__ __forceinline__ void phaseA(f32x16& C0, f32x16& C1, const f32x16& P0, const f32x16& P1, float alphaP, float& l_reg, bf16x8 (&pa)[4],
                                       lptr kb, lptr pb, lptr qp, const bf16x8 (&qr)[8]) {
  constexpr bool R8 = NQ > 8;
  constexpr int NN = 16, NF = NN + (R8 ? 2 : 0);
  float s0 = 0.f, s1 = 0.f, s2 = 0.f, s3 = 0.f;
  bf16x8 f[NN + PD]; bf16x8 ra[2][2], rq[2];
  if (DO_QK) {
#pragma unroll
    for (int n = 0; n < PD; ++n) f[n] = kfrag(kb, n);
  }
#pragma unroll
  for (int n = 0; n < NF; ++n) {
    if (DO_QK) {
      if (n < NN) {
        if (n + PD < NN) f[n + PD] = kfrag(kb, n + PD);
        if (R8) { if (n == 9) { rq[0] = ldk(qp); rq[1] = ldk(qp + 1024); } if (n == 11) { ra[0][0] = ldk(pb); ra[0][1] = ldk(pb + 16); } if (n == 13) { ra[1][0] = ldk(pb + 32 * PPITCH); ra[1][1] = ldk(pb + 32 * PPITCH + 16); } }
        const bf16x8 qf = qr[n >> 1];
        if (n == 0)            C0 = __builtin_amdgcn_mfma_f32_32x32x16_bf16(f[n], qf, f32x16{}, 0, 0, 0);
        else if (n == 1)       C1 = __builtin_amdgcn_mfma_f32_32x32x16_bf16(f[n], qf, f32x16{}, 0, 0, 0);
        else if ((n & 1) == 0) C0 = __builtin_amdgcn_mfma_f32_32x32x16_bf16(f[n], qf, C0, 0, 0, 0);
        else                   C1 = __builtin_amdgcn_mfma_f32_32x32x16_bf16(f[n], qf, C1, 0, 0, 0);
      } else if (R8) {
        const int h = n - NN;
        if (h == 0) C0 = __builtin_amdgcn_mfma_scale_f32_32x32x64_f8f6f4(cat8(ra[0][0], ra[0][1]), cat8(rq[0], rq[1]), C0, 0, 0, 0, 0x7F7F7F7F, 0, 0x7F7F7F7F);
        else        C1 = __builtin_amdgcn_mfma_scale_f32_32x32x64_f8f6f4(cat8(ra[1][0], ra[1][1]), cat8(rq[0], rq[1]), C1, 0, 0, 0, 0x7F7F7F7F, 0, 0x7F7F7F7F);
      }
    }
    if (DO_FIN) {
#pragma unroll
      for (int e = n * 32 / NF; e < (n + 1) * 32 / NF; ++e) { const float v = e < 16 ? P0[e & 15] : P1[e & 15]; if ((e & 3) == 0) s0 += v; else if ((e & 3) == 1) s1 += v; else if ((e & 3) == 2) s2 += v; else s3 += v; }
      PIN(s0); PIN(s1); PIN(s2); PIN(s3);
      if (n == NF / 8)     { pa[0] = pk4(P0[0], P0[1], P0[2], P0[3], P0[4], P0[5], P0[6], P0[7]); PIN(pa[0]); }
      if (n == 3 * NF / 8) { pa[1] = pk4(P0[8], P0[9], P0[10], P0[11], P0[12], P0[13], P0[14], P0[15]); PIN(pa[1]); }
      if (n == 5 * NF / 8) { pa[2] = pk4(P1[0], P1[1], P1[2], P1[3], P1[4], P1[5], P1[6], P1[7]); PIN(pa[2]); }
      if (n == 7 * NF / 8) { pa[3] = pk4(P1[8], P1[9], P1[10], P1[11], P1[12], P1[13], P1[14], P1[15]); PIN(pa[3]); }
    }
    SBAR();
  }
  if (DO_FIN) { float ps = (s0 + s1) + (s2 + s3); auto rr = __builtin_amdgcn_permlane32_swap(__float_as_uint(ps), __float_as_uint(ps), false, false);
    ps = __uint_as_float(rr[0]) + __uint_as_float(rr[1]); l_reg = l_reg * alphaP + ps; }
}
template <bool MASK, bool DO_PV, bool DO_SM>
__device__ __forceinline__ void phaseB(f32x16 (&o)[4], const bf16x8 (&pa)[4], f32x16& C0, f32x16& C1, float& m_reg, float& alpha, lptr vb, float Cs, float thr_raw, int qi, int k0, int hi) {
  s16x4 vl[16 + PD], vh[16 + PD];
  if (DO_PV) {
#pragma unroll
    for (int n = 0; n < PD; ++n) { const int d0 = n & 3, ks = n >> 2; vl[n] = vtr(vb + d0 * 512 + ks * 4096); vh[n] = vtr(vb + d0 * 512 + ks * 4096 + 2048); }
  }
  float mx = -3.0e38f, mnC = 0.f;
#pragma unroll
  for (int n = 0; n < 16; ++n) {
    if (DO_PV) {
      const int d0 = n & 3, ks = n >> 2;
      if (n + PD < 16) { const int d1 = (n + PD) & 3, k1 = (n + PD) >> 2; vl[n + PD] = vtr(vb + d1 * 512 + k1 * 4096); vh[n + PD] = vtr(vb + d1 * 512 + k1 * 4096 + 2048); }
      const bf16x8 vf = (bf16x8){vl[n][0], vl[n][1], vl[n][2], vl[n][3], vh[n][0], vh[n][1], vh[n][2], vh[n][3]};
      o[d0] = __builtin_amdgcn_mfma_f32_32x32x16_bf16(pa[ks], vf, o[d0], 0, 0, 0);
    }
    if (DO_SM) {
      if (n < 4) {
#pragma unroll
        for (int e = n * 8; e < n * 8 + 8; ++e) {
          if (MASK) { const int d = qi - (k0 + (e < 16 ? 0 : 32) + crow(e & 15, hi)); if (d > 128 || d < -128) { if (e < 16) C0[e & 15] = -1e30f; else C1[e & 15] = -1e30f; } }
          mx = fmaxf(mx, e < 16 ? C0[e & 15] : C1[e & 15]); }
        PIN(mx);
      } else if (n == 4) {
        auto rr = __builtin_amdgcn_permlane32_swap(__float_as_uint(mx), __float_as_uint(mx), false, false);
        const float pmax = fmaxf(__uint_as_float(rr[0]), __uint_as_float(rr[1]));
        const bool keep = __all(pmax - m_reg <= thr_raw);
        const float mn = keep ? m_reg : fmaxf(m_reg, pmax);
        alpha = __builtin_amdgcn_exp2f((m_reg - mn) * Cs); m_reg = mn; mnC = -mn * Cs; PIN(alpha); PIN(mnC);
      } else {
#pragma unroll
        for (int e = (n - 5) * 32 / 11; e < (n - 4) * 32 / 11; ++e) {
          if (e < 16) C0[e] = __builtin_amdgcn_exp2f(fmaf(C0[e], Cs, mnC)); else C1[e - 16] = __builtin_amdgcn_exp2f(fmaf(C1[e - 16], Cs, mnC)); }
        if ((n - 5) * 32 / 11 < 16) PIN(C0); if ((n - 4) * 32 / 11 > 16) PIN(C1);
      }
    }
    SBAR();
  }
}

template <int DQK, bool MASK, int LDQ, int LDK, int LDP, int LDV, int LDO>
__device__ __forceinline__ void attn_body(const bf16_t* __restrict__ Qb, const bf16_t* __restrict__ Kb, const bf16_t* __restrict__ Pb, const bf16_t* __restrict__ Vb,
                                          bf16_t* __restrict__ Ob, float* __restrict__ ssq, int q0, int kstart, int NT, float scale, float sink_raw, LAS char* lds) {
  constexpr int NQ = DQK / 16;
  const float Cs = scale * 1.4426950408889634f, thr_raw = THR / scale;
  const int tid = tid_opaque(), wid = tid >> 6, lane = tid & 63, r32 = lane & 31, hi = lane >> 5;
  LAS char* V_lds = lds + OFF_V; LAS char* K_lds = lds + OFF_K; LAS char* P_lds = lds + OFF_P;
  LAS float* ws = (LAS float*)(lds + OFF_WS) + wid * 64; LAS float* li_l = ws; LAS float* al_l = ws + 32;
  float m_reg = MASK ? sink_raw : -1e30f, l_reg = MASK ? 1.f : 0.f; f32x16 o[4] = {}; bf16x8 qr[8];
  const bf16_t* Qw = Qb + (long)(wid * QBLK + r32) * LDQ + hi * 8;
  LAS char* Qp = lds + OFF_QP + wid * 4096 + lane * 16;
#pragma unroll
  for (int d0 = 0; d0 < 8; ++d0) qr[d0] = *reinterpret_cast<const bf16x8*>(Qw + d0 * 16);
  if (NQ > 8) {
    const unsigned char* q8 = (const unsigned char*)(Qb + (long)(wid * QBLK + r32) * LDQ + 128) + hi * 32;
    *(LAS u32x4*)(Qp) = *reinterpret_cast<const u32x4*>(q8); *(LAS u32x4*)(Qp + 1024) = *reinterpret_cast<const u32x4*>(q8 + 16);
  }
  const int sr = tid >> 4, sc = (tid & 15) * 8, vst0 = v_st(sr, sc), vst1 = v_st(32 + sr, sc);
  const int pr = tid >> 3, pc = (tid & 7) * 8;
  const lptr kb0 = (lptr)K_lds + r32 * 272 + hi * 16, pb0 = (lptr)P_lds + r32 * PPITCH + hi * 32, vb0 = (lptr)V_lds + v_rd_base(lane);
  const int qi = q0 + wid * QBLK + r32;
  bf16x8 vs0, vs1, ks0, ks1; u32x2 ps0;
  const unsigned voff0 = sr * LDV + sc, voff1 = (32 + sr) * LDV + sc, koff0 = sr * LDK + sc, koff1 = (32 + sr) * LDK + sc, poff = pr * LDP + pc;
#define SLOAD(k0) do { const bf16_t* Vt = Vb + (long)(k0) * LDV; const bf16_t* Kt = Kb + (long)(k0) * LDK; \
    vs0 = *reinterpret_cast<const bf16x8*>(Vt + voff0); vs1 = *reinterpret_cast<const bf16x8*>(Vt + voff1); \
    ks0 = *reinterpret_cast<const bf16x8*>(Kt + koff0); ks1 = *reinterpret_cast<const bf16x8*>(Kt + koff1); \
    if (NQ > 8) { const unsigned char* Pt = (const unsigned char*)Pb + (long)(k0) * LDP; ps0 = *reinterpret_cast<const u32x2*>(Pt + poff); } } while (0)
#define SWRITE(kb_, vo_) do { *(LAS bf16x8*)(V_lds + (vo_) + vst0) = vs0; *(LAS bf16x8*)(V_lds + (vo_) + vst1) = vs1; \
    *(LAS bf16x8*)(K_lds + (kb_) * SHM_K + sr * 272 + sc * 2) = ks0; *(LAS bf16x8*)(K_lds + (kb_) * SHM_K + (32 + sr) * 272 + sc * 2) = ks1; \
    if (NQ > 8) *(LAS u32x2*)(P_lds + (kb_) * SHM_P + pr * PPITCH + pc) = ps0; } while (0)
#define SWAIT() asm volatile("s_waitcnt vmcnt(0)" ::: "memory")
#define RESC(a) do { if (__any((a) < 1.f)) { if (hi == 0) al_l[r32] = (a); asm volatile("s_waitcnt lgkmcnt(0)" ::: "memory"); \
    _Pragma("unroll") for (int d = 0; d < 4; ++d) _Pragma("unroll") for (int r = 0; r < 16; ++r) o[d][r] *= al_l[crow(r, hi)]; } } while (0)
#define ROTV() do { const int t_ = vprev; vprev = vcur; vcur = vnext; vnext = t_; } while (0)
  f32x16 pA0, pA1, pB0, pB1; float alA = 1.f, alB = 1.f; bf16x8 pa[4];
  int vprev = 0, vcur = SHM_V, vnext = 2 * SHM_V;
  SLOAD(kstart); SWAIT(); SWRITE(0, 0); __syncthreads();
  SLOAD(kstart + KVBLK);
  phaseA<NQ, true, false>(pA0, pA1, pA0, pA1, 1.f, l_reg, pa, kb0, pb0, (lptr)Qp, qr);
  SWAIT(); SWRITE(1, SHM_V);
  phaseB<MASK, false, true>(o, pa, pA0, pA1, m_reg, alA, vb0, Cs, thr_raw, qi, kstart, hi);
  __syncthreads();
  for (int j = 1; j + 1 < NT; j += 2) {
    SBAR(); SLOAD(kstart + (j + 1) * KVBLK); SBAR();
    phaseA<NQ, true, true>(pB0, pB1, pA0, pA1, alA, l_reg, pa, kb0 + SHM_K, pb0 + SHM_P, (lptr)Qp, qr);
    SWAIT(); SWRITE(0, vnext);
    phaseB<MASK, true, true>(o, pa, pB0, pB1, m_reg, alB, vb0 + vprev, Cs, thr_raw, qi, kstart + j * KVBLK, hi);
    RESC(alB); ROTV(); __syncthreads();
    SBAR(); if (j + 2 < NT) SLOAD(kstart + (j + 2) * KVBLK); SBAR();
    phaseA<NQ, true, true>(pA0, pA1, pB0, pB1, alB, l_reg, pa, kb0, pb0, (lptr)Qp, qr);
    if (j + 2 < NT) { SWAIT(); SWRITE(1, vnext); }
    phaseB<MASK, true, true>(o, pa, pA0, pA1, m_reg, alA, vb0 + vprev, Cs, thr_raw, qi, kstart + (j + 1) * KVBLK, hi);
    RESC(alA); ROTV(); __syncthreads();
  }
  SBAR(); phaseA<NQ, true, true>(pB0, pB1, pA0, pA1, alA, l_reg, pa, kb0 + SHM_K, pb0 + SHM_P, (lptr)Qp, qr);
  phaseB<MASK, true, true>(o, pa, pB0, pB1, m_reg, alB, vb0 + vprev, Cs, thr_raw, qi, kstart + (NT - 1) * KVBLK, hi);
  RESC(alB); ROTV();
  phaseA<NQ, false, true>(pA0, pA1, pB0, pB1, alB, l_reg, pa, kb0, pb0, (lptr)Qp, qr);
  phaseB<MASK, true, false>(o, pa, pA0, pA1, m_reg, alA, vb0 + vprev, Cs, thr_raw, qi, 0, hi);
  if (hi == 0) li_l[r32] = l_reg; asm volatile("s_waitcnt lgkmcnt(0)" ::: "memory");
  bf16_t* Ow = Ob + (long)(wid * QBLK) * LDO;
#pragma unroll
  for (int r = 0; r < 16; ++r) { const int orow = crow(r, hi); const float rl = __builtin_amdgcn_rcpf(li_l[orow]); float sq = 0.f;
#pragma unroll
    for (int d0 = 0; d0 < 4; ++d0) { const float v = o[d0][r] * rl; sq += v * v; Ow[(long)orow * LDO + d0 * 32 + r32] = (bf16_t)(cvt_pk_bf16(v, v) & 0xffffu); }
#pragma unroll
    for (int s = 1; s < 32; s <<= 1) sq += __shfl_xor(sq, s);
    if (r32 == 0) ssq[(long)(wid * QBLK + orow) * 16] = sq; }
  __syncthreads();
#undef SLOAD
#undef SWRITE
#undef SWAIT
#undef RESC
#undef ROTV
}
#undef SBAR
#undef PIN
}

constexpr int NWAVES = 8;
#ifndef PROBE_ATT
#define PROBE_ATT 1
#endif
#ifndef PROBE_PRO
#define PROBE_PRO 1
#endif
#ifndef PROBE_MOEUP
#define PROBE_MOEUP 1
#endif
constexpr int RING_BYTES = 133120;
constexpr int MISC_OFF = 139264, LDS_BYTES = 147456;
static_assert(att::SHM_ATTN <= MISC_OFF && RING_BYTES <= MISC_OFF, "LDS map");
constexpr int NPHASE = 21;

__device__ const float INVF[64] = {
 1.000000000e+00f, 8.659643531e-01f, 7.498942018e-01f, 6.493816376e-01f, 5.623413324e-01f, 4.869675338e-01f, 4.216965139e-01f, 3.651741147e-01f, 3.162277639e-01f, 2.738419771e-01f, 2.371373773e-01f, 2.053525001e-01f, 1.778279394e-01f, 1.539926529e-01f, 1.333521456e-01f, 1.154781953e-01f,
 1.000000015e-01f, 8.659642935e-02f, 7.498942316e-02f, 6.493816525e-02f, 5.623413250e-02f, 4.869675264e-02f, 4.216964915e-02f, 3.651741147e-02f, 3.162277490e-02f, 2.738419548e-02f, 2.371373773e-02f, 2.053525113e-02f, 1.778279431e-02f, 1.539926510e-02f, 1.333521400e-02f, 1.154781971e-02f,
 9.999999776e-03f, 8.659643121e-03f, 7.498942316e-03f, 6.493816152e-03f, 5.623413250e-03f, 4.869675264e-03f, 4.216964822e-03f, 3.651741194e-03f, 3.162277630e-03f, 2.738419687e-03f, 2.371373819e-03f, 2.053525066e-03f, 1.778279431e-03f, 1.539926510e-03f, 1.333521446e-03f, 1.154782018e-03f,
 1.000000047e-03f, 8.659643354e-04f, 7.498941850e-04f, 6.493816036e-04f, 5.623413017e-04f, 4.869675322e-04f, 4.216965172e-04f, 3.651741135e-04f, 3.162277571e-04f, 2.738419571e-04f, 2.371373703e-04f, 2.053525095e-04f, 1.778279402e-04f, 1.539926598e-04f, 1.333521504e-04f, 1.154782003e-04f };

struct Args { const float* in[21]; float* out; unsigned char* ws; int ph_lo, ph_hi; };

__device__ __forceinline__ float wave_sum(float v) {
#pragma unroll
    for (int o = 1; o < 64; o <<= 1) v += __shfl_xor(v, o);
    return v;
}
__device__ __forceinline__ void sincos_acc(float ang, float& sn, float& cs) {
    const double a = (double)ang;
    const double n = __builtin_rint(a * 0.63661977236758134308);
    double r = __builtin_fma(-n, 1.57079632679489655800, a); r = __builtin_fma(-n, 6.12323399573676603587e-17, r);
    const double r2 = r * r;
    double sp = 1.0 / 6227020800.0; sp = __builtin_fma(sp, r2, -1.0 / 39916800.0); sp = __builtin_fma(sp, r2, 1.0 / 362880.0); sp = __builtin_fma(sp, r2, -1.0 / 5040.0);
    sp = __builtin_fma(sp, r2, 1.0 / 120.0); sp = __builtin_fma(sp, r2, -1.0 / 6.0); sp = __builtin_fma(sp * r2, r, r);
    double cp = 1.0 / 479001600.0; cp = __builtin_fma(cp, r2, -1.0 / 3628800.0); cp = __builtin_fma(cp, r2, 1.0 / 40320.0); cp = __builtin_fma(cp, r2, -1.0 / 720.0);
    cp = __builtin_fma(cp, r2, 1.0 / 24.0); cp = __builtin_fma(cp, r2, -0.5); cp = __builtin_fma(cp, r2, 1.0);
    const int q = ((int)n) & 3;
    const double s_ = (q & 1) ? cp : sp, c_ = (q & 1) ? sp : cp;
    sn = (float)((q & 2) ? -s_ : s_); cs = (float)(((q + 1) & 2) ? -c_ : c_);
}

__device__ __forceinline__ int src_quad(int kind, int n, int coff) {
    if (kind == 0) return coff + n;
    if (kind == 1) {
        if (n < 768 || (n >= 2112 && n < 2368)) return n;
        if (n >= 2368) return -1;
        int base, half, j;
        if (n < 832) { base = 768; half = 32; j = n - 768; } else if (n < 1856) { j = (n - 832) & 127; base = n - j; half = 64; } else { j = (n - 1856) & 127; base = n - j; half = 64; }
        const int g = j >> 3, e = j & 7; return base + (e < 4 ? 4 * g : half + 4 * g);
    }
    { const int head = n / 192, j = n - head * 192; if (j < 128) return n; const int jj = j - 128, g = jj >> 3, e = jj & 7; return head * 192 + 128 + (e < 4 ? 4 * g : 32 + 4 * g); }
}
__device__ __forceinline__ void tr_item(const float* __restrict__ src, int Nsrc, int K, bf16_t* __restrict__ dst, int k0, int n0, int kind, int coff,
                                        const float* __restrict__ gain, const float* __restrict__ gain2, LAS unsigned* scr, int lane) {
    const int nl = 4 * (lane & 15), ks = lane >> 4;
    const int sq = src_quad(kind, n0 + nl, coff);
#pragma unroll 4
    for (int r = 0; r < 16; ++r) {
        const int k = k0 + 8 * r + 2 * ks;
        f32x4 a = (f32x4){0.f, 0.f, 0.f, 0.f}, b = a;
        if (sq >= 0) { a = *(const f32x4*)(src + (size_t)k * Nsrc + sq); b = *(const f32x4*)(src + (size_t)(k + 1) * Nsrc + sq); }
        if (gain) { const float ga = (gain2 && k >= 1024) ? gain2[k - 1024] : gain[k], gb = (gain2 && k + 1 >= 1024) ? gain2[k + 1 - 1024] : gain[k + 1]; a *= ga; b *= gb; }
#pragma unroll
        for (int j = 0; j < 4; ++j) scr[(nl + j) * 65 + 4 * r + ks] = cvt_pk_bf16(a[j], b[j]);
    }
    asm volatile("s_waitcnt lgkmcnt(0)" ::: "memory");
#pragma unroll 4
    for (int it = 0; it < 16; ++it) {
        const int row = it * 4 + (lane >> 4), ch = lane & 15;
        const LAS unsigned* p = scr + row * 65 + 4 * ch;
        u32x4 w; w.x = p[0]; w.y = p[1]; w.z = p[2]; w.w = p[3];
        *(u32x4*)(dst + (size_t)(n0 + row) * K + k0 + 8 * ch) = w;
    }
    asm volatile("s_waitcnt lgkmcnt(0)" ::: "memory");
}
__device__ __forceinline__ void tr_item8(const float* __restrict__ src, int Nsrc, int K, unsigned char* __restrict__ dst, int k0, int n0, int scol, float scale, LAS unsigned* scr, int lane) {
    const int nl = 4 * (lane & 15), ks = lane >> 4;
#pragma unroll 4
    for (int r = 0; r < 16; ++r) {
        const int k = k0 + 16 * r + 4 * ks; const float* p = src + (size_t)k * Nsrc + scol + nl;
        const f32x4 a = *(const f32x4*)p * scale, b = *(const f32x4*)(p + Nsrc) * scale, c = *(const f32x4*)(p + 2 * (size_t)Nsrc) * scale, d = *(const f32x4*)(p + 3 * (size_t)Nsrc) * scale;
#pragma unroll
        for (int j = 0; j < 4; ++j) scr[(nl + j) * 65 + 4 * r + ks] = pk_fp8x4(a[j], b[j], c[j], d[j]);
    }
    asm volatile("s_waitcnt lgkmcnt(0)" ::: "memory");
#pragma unroll 4
    for (int it = 0; it < 16; ++it) {
        const int row = it * 4 + (lane >> 4), ch = lane & 15;
        const LAS unsigned* p = scr + row * 65 + 4 * ch;
        u32x4 w; w.x = p[0]; w.y = p[1]; w.z = p[2]; w.w = p[3];
        *(u32x4*)(dst + (size_t)(n0 + row) * K + k0 + 16 * ch) = w;
    }
    asm volatile("s_waitcnt lgkmcnt(0)" ::: "memory");
}
__device__ __forceinline__ void tr_item6(const float* __restrict__ src, int Nsrc, unsigned char* __restrict__ dst, int t, int n0, int scol, LAS unsigned* scr, int lane) {
    const int nl = 4 * (lane & 15), ks = lane >> 4;
    f32x4 a[16], b[16];
#pragma unroll
    for (int r = 0; r < 16; ++r) {
        const int kk = 8 * r + 2 * ks, k = 16 * t + 256 * (kk >> 4) + (kk & 15); const float* p = src + (size_t)k * Nsrc + scol + nl;
        a[r] = __builtin_nontemporal_load((const f32x4*)p); b[r] = __builtin_nontemporal_load((const f32x4*)(p + Nsrc));
    }
#pragma unroll
    for (int r = 0; r < 16; ++r) {
#pragma unroll
        for (int j = 0; j < 4; ++j) scr[(nl + j) * 65 + 4 * r + ks] = cvt_pk_bf16(a[r][j], b[r][j]);
    }
    asm volatile("s_waitcnt lgkmcnt(0)" ::: "memory");
#pragma unroll 1
    for (int it = 0; it < 4; ++it) {
        const int pidx = it * 64 + lane, n = pidx >> 2, g = pidx & 3;
        const LAS unsigned* p = scr + n * 65 + 2 * g;
        f32x16 lo, hi;
#pragma unroll
        for (int j = 0; j < 8; ++j) { const unsigned d0 = p[8 * j], d1 = p[8 * j + 1];
            const float x0 = __uint_as_float(d0 << 16), x1 = __uint_as_float(d0 & 0xffff0000u), x2 = __uint_as_float(d1 << 16), x3 = __uint_as_float(d1 & 0xffff0000u);
            if (j < 4) { lo[4 * j] = x0; lo[4 * j + 1] = x1; lo[4 * j + 2] = x2; lo[4 * j + 3] = x3; } else { hi[4 * (j - 4)] = x0; hi[4 * (j - 4) + 1] = x1; hi[4 * (j - 4) + 2] = x2; hi[4 * (j - 4) + 3] = x3; } }
        unsigned sb; const u32x6 q = mx6_block(lo, hi, sb);
        unsigned char* o = dst + (size_t)(n0 + n) * 2048 + t * 128 + 16 * g;
        *(u32x4*)o = (u32x4){q[0], q[1], q[2], q[3]}; *(u32x4*)(o + 64) = (u32x4){q[4], q[5], sb, 0u};
    }
    asm volatile("s_waitcnt lgkmcnt(0)" ::: "memory");
}
__device__ __forceinline__ void tr_item6c(const float* __restrict__ src, int Nsrc, int K, unsigned char* __restrict__ dst, int t, int n0, LAS unsigned* scr, int lane) {
    const int nl = 4 * (lane & 15), ks = lane >> 4;
    f32x4 a[16], b[16];
#pragma unroll
    for (int r = 0; r < 16; ++r) {
        const int k = 128 * t + 8 * r + 2 * ks; const float* p = src + (size_t)k * Nsrc + n0 + nl;
        a[r] = __builtin_nontemporal_load((const f32x4*)p); b[r] = __builtin_nontemporal_load((const f32x4*)(p + Nsrc));
    }
#pragma unroll
    for (int r = 0; r < 16; ++r) {
#pragma unroll
        for (int j = 0; j < 4; ++j) scr[(nl + j) * 65 + 4 * r + ks] = cvt_pk_bf16(a[r][j], b[r][j]);
    }
    asm volatile("s_waitcnt lgkmcnt(0)" ::: "memory");
#pragma unroll 1
    for (int it = 0; it < 4; ++it) {
        const int pidx = it * 64 + lane, n = pidx >> 2, g = pidx & 3;
        const LAS unsigned* p = scr + n * 65 + 16 * g;
        f32x16 lo, hi;
#pragma unroll
        for (int j = 0; j < 8; ++j) { const unsigned d0 = p[j], d1 = p[8 + j];
            lo[2 * j] = __uint_as_float(d0 << 16); lo[2 * j + 1] = __uint_as_float(d0 & 0xffff0000u); hi[2 * j] = __uint_as_float(d1 << 16); hi[2 * j + 1] = __uint_as_float(d1 & 0xffff0000u); }
        unsigned sb; const u32x6 q = mx6_block(lo, hi, sb);
        unsigned char* o = dst + (size_t)(n0 + n) * K + t * 128 + 16 * g;
        *(u32x4*)o = (u32x4){q[0], q[1], q[2], q[3]}; *(u32x4*)(o + 64) = (u32x4){q[4], q[5], sb, 0u};
    }
    asm volatile("s_waitcnt lgkmcnt(0)" ::: "memory");
}
__device__ __forceinline__ void tr_matrix6c(const float* src, int Nsrc, int K, unsigned char* dst, int Ndst, LAS unsigned* scr, int lane, int gw, int NGW, int& cursor) {
    const int nb = Ndst / 64, items = (K / 128) * nb;
    int it = (gw - (cursor % NGW) + NGW) % NGW;
    for (; it < items; it += NGW) tr_item6c(src, Nsrc, K, dst, it / nb, (it % nb) * 64, scr, lane);
    cursor += items;
}
__device__ __forceinline__ void tr_matrix6(const float* src, const float* src2, int Nsrc, unsigned char* dst, int Ndst, LAS unsigned* scr, int lane, int gw, int NGW, int& cursor) {
    const int nb = Ndst / 64, items = 16 * nb;
    int it = (gw - (cursor % NGW) + NGW) % NGW;
    for (; it < items; it += NGW) {
        const int t = it / nb, n0 = (it % nb) * 64, tile = n0 >> 8, j0 = n0 & 255;
        tr_item6(j0 < 128 ? src : src2, Nsrc, dst, t, n0, 128 * tile + (j0 & 127), scr, lane);
    }
    cursor += items;
}
__device__ __forceinline__ void tr_matrix8(const float* src, const float* src2, int Nsrc, int K, unsigned char* dst, int Ndst, int inter, float scale, LAS unsigned* scr, int lane, int gw, int NGW, int& cursor) {
    const int nb = Ndst / 64, items = (K / 256) * nb;
    int it = (gw - (cursor % NGW) + NGW) % NGW;
    for (; it < items; it += NGW) {
        const int kb = it / nb, n0 = (it % nb) * 64;
        if (inter) { const int tile = n0 >> 8, j0 = n0 & 255; tr_item8(j0 < 128 ? src : src2, Nsrc, K, dst, kb * 256, n0, 128 * tile + (j0 & 127), scale, scr, lane); }
        else tr_item8(src, Nsrc, K, dst, kb * 256, n0, n0, scale, scr, lane);
    }
    cursor += items;
}
__device__ __forceinline__ void tr_matrix(const float* src, const float* src2, int Nsrc, int K, bf16_t* dst, int Ndst, int kind, const float* gain, const float* gain2,
                                          LAS unsigned* scr, int lane, int gw, int NGW, int& cursor) {
    const int nb = Ndst / 64, items = (K / 128) * nb;
    int it = (gw - (cursor % NGW) + NGW) % NGW;
    for (; it < items; it += NGW) {
        const int kb = it / nb, n0 = (it % nb) * 64;
        if (kind == 3) { const int tile = n0 >> 8, j0 = n0 & 255; tr_item(j0 < 128 ? src : src2, Nsrc, K, dst, kb * 128, n0, 0, 128 * tile + (j0 & 127) - n0, nullptr, nullptr, scr, lane); }
        else tr_item(src, Nsrc, K, dst, kb * 128, n0, kind, 0, gain, gain2, scr, lane);
    }
    cursor += items;
}

constexpr int MOE_GU_ITEMS = 16 * (2 * FFE / 64), MOE_D_ITEMS = (FFE / 128) * (D / 64), MOE_E_ITEMS = MOE_GU_ITEMS + MOE_D_ITEMS, MOE_ITEMS = NE * MOE_E_ITEMS;
__device__ __forceinline__ void moe_conv_item(const Args& args, int j, LAS unsigned* scr, int lane) {
    const int e = j / MOE_E_ITEMS, r = j - e * MOE_E_ITEMS;
    if (r < MOE_GU_ITEMS) {
        constexpr int nb = 2 * FFE / 64;
        const int t = r / nb, n0 = (r % nb) * 64, tile = n0 >> 8, j0 = n0 & 255;
        tr_item6((j0 < 128 ? args.in[16] : args.in[17]) + (size_t)e * D * FFE, FFE, args.ws + WS_WMGU + (size_t)e * 2 * FFE * D, t, n0, 128 * tile + (j0 & 127), scr, lane);
    } else {
        const int r2 = r - MOE_GU_ITEMS, t = r2 / (D / 64), n0 = (r2 % (D / 64)) * 64;
        tr_item6c(args.in[18] + (size_t)e * FFE * D, D, FFE, args.ws + WS_WMD + (size_t)e * D * FFE, t, n0, scr, lane);
    }
}
__device__ __forceinline__ void moe_conv_burst(const Args& args, LAS unsigned char* lds, int part, int nparts) {
    const int tid = tid_opaque(), lane = tid & 63, wave = tid >> 6, gw = blockIdx.x * NWAVES + wave, NGW = gridDim.x * NWAVES;
    LAS unsigned* scr = (LAS unsigned*)(lds + wave * 16640);
    const int per = (MOE_ITEMS + NGW - 1) / NGW, i0 = per * part / nparts, i1 = per * (part + 1) / nparts;
    __syncthreads();
    for (int i = i0; i < i1; ++i) { const int j = gw + i * NGW; if (j < MOE_ITEMS) moe_conv_item(args, j, scr, lane); }
    __syncthreads();
}

__device__ __forceinline__ void ln_row(f32x4 (&v)[8], const float* __restrict__ g, const float* __restrict__ b, int lane, float& mean_o, float& rstd_o) {
    float s = 0.f;
#pragma unroll
    for (int j = 0; j < 8; ++j) s += (v[j][0] + v[j][1]) + (v[j][2] + v[j][3]);
    const float mean = wave_sum(s) * (1.f / D); float s2 = 0.f;
#pragma unroll
    for (int j = 0; j < 8; ++j) { v[j] = v[j] - mean; s2 += (v[j][0] * v[j][0] + v[j][1] * v[j][1]) + (v[j][2] * v[j][2] + v[j][3] * v[j][3]); }
    const float rstd = 1.f / sqrtf(wave_sum(s2) * (1.f / D) + LN_EPS); mean_o = mean; rstd_o = rstd;
#pragma unroll
    for (int j = 0; j < 8; ++j) { const f32x4 gg = *((const f32x4*)g + lane + 64 * j), bb = *((const f32x4*)b + lane + 64 * j); v[j] = v[j] * rstd * gg + bb; }
}

#define WSP(T, off) ((T*)(args.ws + (off)))
#define IN(k) (lo <= (k) && (k) < hi)
#define SEAM(k) do { if (IN(k) && IN((k) + 1)) { XcdBarrier b_; b_.bar = WSP(unsigned, WS_CTL) + CW_BAR; b_.x = xb_xcc_id(); b_.st = (volatile LAS unsigned*)(lds + MISC_OFF) + 8; xcd_barrier(b_); } } while (0)

__device__ __forceinline__ int moe_unit_table(const int* moemeta, int NT, LAS int* utab) {
    const int tid = tid_opaque();
    pg8::MoeOrder Mo;
#pragma unroll
    for (int e = 0; e <= NE; ++e) Mo.pb[e] = moemeta[e];
    Mo.NT = NT; Mo.G = gridDim.x; Mo.c = blockIdx.x; Mo.nwg = Mo.pb[NE] * NT;
    if (tid < 64) { pg8::Unit u; u.pm = 0; u.pn = 0; u.aux = 0; Mo.next(tid, u); utab[4 * tid] = u.pm; utab[4 * tid + 1] = u.pn; utab[4 * tid + 2] = u.aux; }
    __syncthreads();
    const int left = Mo.nwg - Mo.c; int n = left <= 0 ? 0 : (left + Mo.G - 1) / Mo.G;
    return __builtin_amdgcn_readfirstlane(n < 64 ? n : 64);
}
__device__ __forceinline__ f32x4 tail_sum(const bf16_t* yp, int t, int d, int lane, int SK) {
    f32x4 acc = {0.f, 0.f, 0.f, 0.f};
    for (int q = 0; q < SK; ++q) { const u32x2 a = *((const u32x2*)(yp + ((size_t)(q * 128 + t - 1) * 256 + (d & 255)) * 256) + lane);
        acc += (f32x4){__uint_as_float(a.x << 16), __uint_as_float(a.x & 0xffff0000u), __uint_as_float(a.y << 16), __uint_as_float(a.y & 0xffff0000u)}; }
    return acc;
}
__device__ __forceinline__ int moe_tail_split(int nwg, int G, int& Rf, int& Tn) {
    Rf = nwg / G; Tn = nwg - Rf * G;
    return Tn == 0 ? 1 : (Tn * 7 <= G ? 7 : (Tn * 4 <= G ? 4 : (Tn * 2 <= G ? 2 : 1)));
}
__device__ __forceinline__ int moe_unit_table_k(const int* moemeta, int NT, LAS int* utab, unsigned char* tailmap) {
    const int tid = tid_opaque();
    pg8::MoeOrder Mo;
#pragma unroll
    for (int e = 0; e <= NE; ++e) Mo.pb[e] = moemeta[e];
    Mo.NT = NT; Mo.G = gridDim.x; Mo.c = blockIdx.x; Mo.nwg = Mo.pb[NE] * NT;
    int Rf, Tn; const int SK = moe_tail_split(Mo.nwg, Mo.G, Rf, Tn);
    const int R = Rf < 63 ? Rf : 63;
    const bool piece = SK > 1 ? (Mo.c < Tn * SK) : (Mo.c < Tn);
    if (tid < 64) {
        long Lq = -1; int kx = 0, mark = 0;
        if (tid < R) Lq = (long)tid * Mo.G + Mo.c;
        else if (tid == R && piece) {
            if (SK == 1) Lq = (long)Rf * Mo.G + Mo.c;
            else { const int j = Mo.c / SK, q = Mo.c - j * SK; Lq = (long)Rf * Mo.G + j; kx = (1 + j) | (q << 8) | (SK << 16); mark = (q == 0) ? 1 + j : 0; }
        }
        pg8::Unit u; u.pm = 0; u.pn = 0; u.aux = 0; u.kx = 0;
        if (Lq >= 0) Mo.at(Lq, u);
        if (mark) tailmap[u.pm * 8 + u.aux] = (unsigned char)mark;
        utab[4 * tid] = u.pm; utab[4 * tid + 1] = u.pn; utab[4 * tid + 2] = u.aux; utab[4 * tid + 3] = kx;
    }
    __syncthreads();
    return __builtin_amdgcn_readfirstlane(R + (piece ? 1 : 0));
}
template <int L>
__device__ __forceinline__ void layer_phases(const Args& args, LAS unsigned char* lds, char* lds_gen, int lo, int hi) {
    constexpr int pb = 1 + 10 * L;
    if (IN(pb + 0)) {
        const int G = gridDim.x, bx = blockIdx.x;
        pg8::Gemm g{WSP(const bf16_t, WS_XB), WSP(const bf16_t, WS_WIN + L * SZ_WIN), D}; pg8::StaticOrder So; So.init(S, 2048, G, bx);
        pg8::EpiInProj E{WSP(bf16_t, WS_CQ), WSP(bf16_t, WS_CKV), WSP(bf16_t, WS_KPE), WSP(bf16_t, WS_QS), WSP(bf16_t, WS_KS), WSP(bf16_t, WS_VS), WSP(float, WS_PARTQ), WSP(float, WS_PARTKV),
                         WSP(const float, WS_COSM), WSP(const float, WS_SINM), WSP(const float, WS_COSS), WSP(const float, WS_SINS)};
        pg8::gemm_phase<pg8::EpiInProj, pg8::StaticOrder, true, true>(lds, g, So, E);
    }
    SEAM(pb + 0);
    if (IN(pb + 1)) {
        const int G = gridDim.x, bx = blockIdx.x;
        LAS int* utab = (LAS int*)(lds + MISC_OFF + 1024);
        LAS int* ucnt = (LAS int*)(lds + MISC_OFF + 1024 + 3072);
        if (tid_opaque() == 0) {
            int nl = 0, nq = 0, nk = 0;
            if (G == 256) {
                if (bx < 128) { utab[0] = bx >> 1; utab[1] = 8 + (bx & 1); utab[2] = 8 + (bx & 1); nl = 1; utab[128] = bx >> 3; utab[129] = bx & 7; utab[130] = bx & 7; nk = 1; }
                else { const int c = bx - 128;
                    for (int i = 0; i < 3; ++i) { const int u = 3 * c + i; utab[64 + 4 * i] = u / 6; utab[65 + 4 * i] = u % 6; utab[66 + 4 * i] = u % 6; }
                    nq = 3;
                    for (int i = 0; i < 3; ++i) { const int u = 128 + 3 * c + i; utab[128 + 4 * i] = u >> 3; utab[129 + 4 * i] = u & 7; utab[130 + 4 * i] = u & 7; }
                    nk = 3; }
            } else {
                for (int u = bx; u < 128 && nl < 16; u += G, ++nl) { utab[4 * nl] = u >> 1; utab[4 * nl + 1] = 8 + (u & 1); utab[4 * nl + 2] = 8 + (u & 1); }
                for (int u = bx; u < 384 && nq < 16; u += G, ++nq) { utab[64 + 4 * nq] = u / 6; utab[65 + 4 * nq] = u % 6; utab[66 + 4 * nq] = u % 6; }
                for (int u = bx; u < 512 && nk < 16; u += G, ++nk) { utab[128 + 4 * nk] = u >> 3; utab[129 + 4 * nk] = u & 7; utab[130 + 4 * nk] = u & 7; }
            }
            ucnt[0] = nl; ucnt[1] = nq; ucnt[2] = nk;
        }
        __syncthreads();
        { pg8::TableOrder To{utab, __builtin_amdgcn_readfirstlane(ucnt[0])};
          pg8::Gemm g{WSP(const bf16_t, WS_XB), WSP(const bf16_t, WS_WIN + L * SZ_WIN), D};
          pg8::EpiInProj E{WSP(bf16_t, WS_CQ), WSP(bf16_t, WS_CKV), WSP(bf16_t, WS_KPE), WSP(bf16_t, WS_QS), WSP(bf16_t, WS_KS), WSP(bf16_t, WS_VS), WSP(float, WS_PARTQ), WSP(float, WS_PARTKV),
                           WSP(const float, WS_COSM), WSP(const float, WS_SINM), WSP(const float, WS_COSS), WSP(const float, WS_SINS)};
          pg8::gemm_phase<pg8::EpiInProj, pg8::TableOrder, true, true>(lds, g, To, E); }
        { pg8::TableOrder To{utab + 64, __builtin_amdgcn_readfirstlane(ucnt[1])};
          pg8::Gemm g{WSP(const bf16_t, WS_CQ), WSP(const bf16_t, WS_WQ + L * SZ_WQ), QLORA};
          pg8::EpiQ E{WSP(bf16_t, WS_Q), WSP(const float, WS_PARTQ), WSP(const float, WS_COSM), WSP(const float, WS_SINM)};
          pg8::gemm_phase<pg8::EpiQ, pg8::TableOrder, true, true>(lds, g, To, E); }
        { pg8::TableOrder To{utab + 128, __builtin_amdgcn_readfirstlane(ucnt[2])};
          pg8::Gemm g{WSP(const bf16_t, WS_CKV), WSP(const bf16_t, WS_WKV + L * SZ_WKV), KVLORA};
          pg8::EpiKV E{WSP(bf16_t, WS_KV), WSP(const float, WS_PARTKV)};
          pg8::gemm_phase<pg8::EpiKV, pg8::TableOrder, true, true>(lds, g, To, E); }
    }
    SEAM(pb + 1);
    if (IN(pb + 2)) {
        const int G = gridDim.x, bx = blockIdx.x;
        const int slot = bx % 3; bool pending = true;
        for (int step = 0; ; ++step) {
            const int u = bx + step * G; const bool more = u < 512;
            if (pending && (step == slot || !more)) { moe_conv_burst(args, lds, L, DEPTH); pending = false; }
            if (!more) break;
            const int r = u / 256, c = u % 256, head = 4 * r + ((c & 7) >> 1), qblk = (c >> 3) + 32 * (c & 1);
            att::attn_body<192, false, QCOLS, KVCOLS, 64, KVCOLS, D>(WSP(const bf16_t, WS_Q) + (size_t)qblk * 256 * QCOLS + head * 192, WSP(const bf16_t, WS_KV) + head * 256, WSP(const bf16_t, WS_KPE),
                WSP(const bf16_t, WS_KV) + head * 256 + 128, WSP(bf16_t, WS_OBUF) + (size_t)qblk * 256 * D + head * 128, WSP(float, WS_PARTO) + (size_t)qblk * 256 * 16 + head, qblk * 256, 0, S / 64, SCALE_MLA, 0.f, (LAS char*)lds);
        }
        for (int u = bx; u < 512; u += G) {
            const int head = u >> 6, qblk = u & 63;
            int t0 = 4 * qblk - 2, t1 = 4 * qblk + 5; if (t0 < 0) t0 = 0; if (t1 > S / 64 - 1) t1 = S / 64 - 1;
            const float sk = (args.in[6] + L * 8)[head];
            att::attn_body<128, true, 1024, 256, 64, 256, D>(WSP(const bf16_t, WS_QS) + (size_t)qblk * 256 * 1024 + head * 128, WSP(const bf16_t, WS_KS) + (head >> 2) * 128, nullptr, WSP(const bf16_t, WS_VS) + (head >> 2) * 128,
                WSP(bf16_t, WS_OBUF) + (size_t)qblk * 256 * D + 1024 + head * 128, WSP(float, WS_PARTO) + (size_t)qblk * 256 * 16 + 8 + head, qblk * 256, t0 * 64, t1 - t0 + 1, SCALE_SWA, sk / SCALE_SWA, (LAS char*)lds);
        }
    }
    SEAM(pb + 2);
    if (IN(pb + 4)) {
        const int G = gridDim.x, bx = blockIdx.x;
        pg8::Gemm g{WSP(const bf16_t, WS_OBUF), WSP(const bf16_t, WS_WOUT + L * SZ_WOUT), D}; pg8::StaticOrder So; So.init(S, D, G, bx);
        if constexpr (L == 0) { pg8::EpiOutProj<false> E{args.in[0], WSP(float, WS_XA), WSP(const float, WS_PARTO), nullptr, nullptr, nullptr}; pg8::gemm_phase<pg8::EpiOutProj<false>, pg8::StaticOrder, true, true>(lds, g, So, E); }
        else { pg8::EpiOutProj<true> E{WSP(const float, WS_XA), WSP(float, WS_XA), WSP(const float, WS_PARTO), WSP(const float, WS_ST2), args.in[19] + (L - 1) * D, args.in[20] + (L - 1) * D};
               pg8::gemm_phase<pg8::EpiOutProj<true>, pg8::StaticOrder, true, true>(lds, g, So, E); }
    }
    SEAM(pb + 4);
    if (IN(pb + 5)) {
        const int tid = tid_opaque(), lane = tid & 63, wave = tid >> 6, G = gridDim.x, bx = blockIdx.x;
        const float* lg = args.in[10] + L * D; const float* lb = args.in[11] + L * D;
        float* XA = WSP(float, WS_XA); unsigned* X8 = WSP(unsigned, WS_X8);
        const int RPW = (S + G - 1) / G, r0 = bx * RPW, r1 = (r0 + RPW < S) ? r0 + RPW : S;
        LAS float* wr_l = (LAS float*)lds; LAS int* hist = (LAS int*)(lds + 65536);
        if (L == 1) { const float* wrg = args.in[15]; for (int i = tid; i < D * NE; i += 512) wr_l[i] = wrg[i]; if (tid < NE) hist[tid] = 0; __syncthreads(); }
        for (int row = r0 + wave; row < r1; row += NWAVES) {
            f32x4 v[8]; float* xr = XA + (size_t)row * D;
#pragma unroll
            for (int j = 0; j < 8; ++j) v[j] = *((const f32x4*)xr + lane + 64 * j);
            float mu_, rs_; ln_row(v, lg, lb, lane, mu_, rs_);
            if (lane == 0) { float* st = WSP(float, WS_ST1); st[2 * row] = mu_; st[2 * row + 1] = rs_; }
            { f32x16 lo, hi;
#pragma unroll
              for (int j = 0; j < 4; ++j)
#pragma unroll
                  for (int c = 0; c < 4; ++c) { lo[4 * j + c] = v[j][c]; hi[4 * j + c] = v[4 + j][c]; }
              unsigned sb; const u32x6 q = mx6_block(lo, hi, sb);
              unsigned char* o = (unsigned char*)X8 + (size_t)row * D + (lane >> 2) * 128 + 16 * (lane & 3);
              *(u32x4*)o = (u32x4){q[0], q[1], q[2], q[3]}; *(u32x4*)(o + 64) = (u32x4){q[4], q[5], sb, 0u}; }
            if (L == 1) {
                float q0 = 0.f, q1 = 0.f, q2 = 0.f, q3 = 0.f, q4 = 0.f, q5 = 0.f, q6 = 0.f, q7 = 0.f;
#pragma unroll
                for (int j = 0; j < 8; ++j)
#pragma unroll
                    for (int k = 0; k < 4; ++k) { const LAS f32x4* w = (const LAS f32x4*)(wr_l + (size_t)(4 * (lane + 64 * j) + k) * NE); const f32x4 w0 = w[0], w1 = w[1]; const float xv = v[j][k];
                        q0 += xv * w0[0]; q1 += xv * w0[1]; q2 += xv * w0[2]; q3 += xv * w0[3]; q4 += xv * w1[0]; q5 += xv * w1[1]; q6 += xv * w1[2]; q7 += xv * w1[3]; }
                q0 = wave_sum(q0); q1 = wave_sum(q1); q2 = wave_sum(q2); q3 = wave_sum(q3); q4 = wave_sum(q4); q5 = wave_sum(q5); q6 = wave_sum(q6); q7 = wave_sum(q7);
                int e0 = 0; float l0 = q0;
                if (q1 > l0) { l0 = q1; e0 = 1; } if (q2 > l0) { l0 = q2; e0 = 2; } if (q3 > l0) { l0 = q3; e0 = 3; } if (q4 > l0) { l0 = q4; e0 = 4; } if (q5 > l0) { l0 = q5; e0 = 5; } if (q6 > l0) { l0 = q6; e0 = 6; } if (q7 > l0) { l0 = q7; e0 = 7; }
                int e1 = -1; float l1 = -3.0e38f;
                if (e0 != 0 && q0 > l1) { l1 = q0; e1 = 0; } if (e0 != 1 && q1 > l1) { l1 = q1; e1 = 1; } if (e0 != 2 && q2 > l1) { l1 = q2; e1 = 2; } if (e0 != 3 && q3 > l1) { l1 = q3; e1 = 3; }
                if (e0 != 4 && q4 > l1) { l1 = q4; e1 = 4; } if (e0 != 5 && q5 > l1) { l1 = q5; e1 = 5; } if (e0 != 6 && q6 > l1) { l1 = q6; e1 = 6; } if (e0 != 7 && q7 > l1) { l1 = q7; e1 = 7; }
                const float t = __expf(l1 - l0), g0 = 1.0f / (1.0f + t), g1 = t / (1.0f + t);
                if (lane == 0) { int* sel = WSP(int, WS_SEL); float* gate = WSP(float, WS_GATE); sel[2 * row] = e0; sel[2 * row + 1] = e1; gate[2 * row] = g0; gate[2 * row + 1] = g1;
                    __hip_atomic_fetch_add(hist + e0, 1, __ATOMIC_RELAXED, __HIP_MEMORY_SCOPE_WORKGROUP); __hip_atomic_fetch_add(hist + e1, 1, __ATOMIC_RELAXED, __HIP_MEMORY_SCOPE_WORKGROUP); }
            }
        }
        if (L == 1) { __syncthreads(); if (tid < NE) WSP(int, WS_WGCNT)[bx * NE + tid] = hist[tid]; }
    }
    SEAM(pb + 5);
    if constexpr (L == 0) {
        if (IN(pb + 7)) {
            const int G = gridDim.x, bx = blockIdx.x;
            pg8::Gemm g{WSP(const bf16_t, WS_X8), WSP(const bf16_t, WS_WGU), D}; pg8::StaticOrder So; So.init(S, 2 * FF, G, bx);
            pg8::EpiSwiglu6 E{WSP(unsigned char, WS_H), FF};
            pg8::gemm_phase<pg8::EpiSwiglu6, pg8::StaticOrder, true, true, 2>(lds, g, So, E);
        }
        SEAM(pb + 7);
        if (IN(pb + 8)) {
            const int G = gridDim.x, bx = blockIdx.x;
            pg8::Gemm g{WSP(const bf16_t, WS_H), WSP(const bf16_t, WS_WD), FF}; pg8::StaticOrder So; So.init(S, D, G, bx);
            pg8::EpiResidLN E{WSP(const float, WS_XA), WSP(float, WS_XA), 1.0f, WSP(const float, WS_ST1), args.in[10] + L * D, args.in[11] + L * D};
            pg8::gemm_phase<pg8::EpiResidLN, pg8::StaticOrder, true, true, 2>(lds, g, So, E);
        }
        SEAM(pb + 8);
        if (IN(pb + 9)) {
            const int tid = tid_opaque(), lane = tid & 63, gw = blockIdx.x * NWAVES + (tid >> 6), NGW = gridDim.x * NWAVES;
            const float* lg = args.in[19] + L * D; const float* lb = args.in[20] + L * D; float* XA = WSP(float, WS_XA); bf16_t* XB = WSP(bf16_t, WS_XB);
            for (int row = gw; row < S; row += NGW) {
                f32x4 v[8]; float* xr = XA + (size_t)row * D;
#pragma unroll
                for (int j = 0; j < 8; ++j) v[j] = *((const f32x4*)xr + lane + 64 * j);
                float mu_, rs_; ln_row(v, lg, lb, lane, mu_, rs_);
                if (lane == 0) { float* st = WSP(float, WS_ST2); st[2 * row] = mu_; st[2 * row + 1] = rs_; }
#pragma unroll
                for (int j = 0; j < 8; ++j) *((u32x2*)(XB + (size_t)row * D) + lane + 64 * j) = pg8::pack4(v[j]);
            }
        }
        SEAM(pb + 9);
    } else {
        if (IN(pb + 6)) {
            const int tid = tid_opaque(), lane = tid & 63, wave = tid >> 6, G = gridDim.x, bx = blockIdx.x;
            const int RPW = (S + G - 1) / G, r0 = bx * RPW, r1 = (r0 + RPW < S) ? r0 + RPW : S, na = 2 * (r1 - r0);
            LAS int* tab = (LAS int*)lds;
            LAS int* basee = (LAS int*)(lds + 32768);
            LAS int* asel = (LAS int*)(lds + 33024);
            LAS int* adst = (LAS int*)(lds + 35072);
            const int* wgcnt = WSP(const int, WS_WGCNT); const int* sel = WSP(const int, WS_SEL);
            for (int i = tid; i < G * NE; i += 512) tab[i] = wgcnt[i];
            for (int i = tid; i < na; i += 512) asel[i] = sel[2 * r0 + i];
            __syncthreads();
            if (tid < NE) { int tot = 0, pre = 0; for (int w = 0; w < G; ++w) { const int c = tab[w * NE + tid]; pre += (w < bx) ? c : 0; tot += c; } basee[32 + tid] = tot; basee[40 + tid] = pre; }
            __syncthreads();
            if (tid == 0) { int p = 0; for (int e = 0; e < NE; ++e) { basee[8 + e] = p; basee[e] = 256 * p + basee[40 + e]; p += (basee[32 + e] + 255) >> 8; } basee[16] = p;
                if (bx == 0) { int* moemeta = WSP(int, WS_MOEMETA); for (int e = 0; e <= NE; ++e) moemeta[e] = basee[8 + e]; } }
            __syncthreads();
            if (tid < NE) { int rk = basee[tid]; for (int i = 0; i < na; ++i) if (asel[i] == tid) adst[i] = rk++; }
            __syncthreads();
            int* dest = WSP(int, WS_DEST); const unsigned char* X8 = WSP(const unsigned char, WS_X8); unsigned char* xs = WSP(unsigned char, WS_XS);
            for (int i = tid; i < na; i += 512) dest[2 * r0 + i] = adst[i];
            if (bx < NE) {
                const int rb = 256 * basee[8 + bx] + basee[32 + bx], re = 256 * basee[9 + bx];
                for (int i = rb * 128 + tid; i < re * 128; i += 512) ((u32x4*)xs)[i] = (u32x4){0u, 0u, 0u, 0u};
            }
            for (int a = wave; a < na; a += NWAVES) { const u32x4* s4 = (const u32x4*)(X8 + (size_t)(r0 + (a >> 1)) * D); u32x4* d4 = (u32x4*)(xs + (size_t)adst[a] * D);
#pragma unroll
                for (int j = 0; j < 2; ++j) d4[lane + 64 * j] = s4[lane + 64 * j]; }
        }
        SEAM(pb + 6);
        if (IN(pb + 7)) {
            LAS int* utab = (LAS int*)(lds + MISC_OFF + 1024);
            const int nun = moe_unit_table(WSP(const int, WS_MOEMETA), 2 * FFE / 256, utab);
            pg8::TableOrder To{utab, nun};
            pg8::Gemm g{WSP(const bf16_t, WS_XS), WSP(const bf16_t, WS_WMGU), D};
            pg8::EpiSwiglu6 E{WSP(unsigned char, WS_H), FFE};
            for (int rep = 0; rep < PROBE_MOEUP; ++rep) pg8::gemm_phase<pg8::EpiSwiglu6, pg8::TableOrder, true, true, 2>(lds, g, To, E);
        }
        SEAM(pb + 7);
        if (IN(pb + 8)) {
            LAS int* utab = (LAS int*)(lds + MISC_OFF + 1024);
            const int nun = moe_unit_table_k(WSP(const int, WS_MOEMETA), D / 256, utab, WSP(unsigned char, WS_TAILMAP));
            pg8::TableOrderK To{utab, nun};
            pg8::Gemm g{WSP(const bf16_t, WS_H), WSP(const bf16_t, WS_WMD), FFE};
            pg8::EpiBf16OutK E{WSP(bf16_t, WS_XS), WSP(bf16_t, WS_YP)};
            pg8::gemm_phase<pg8::EpiBf16OutK, pg8::TableOrderK, true, true, 2>(lds, g, To, E);
        }
        SEAM(pb + 8);
        if (IN(pb + 9)) {
            const int tid = tid_opaque(), lane = tid & 63, gw = blockIdx.x * NWAVES + (tid >> 6), NGW = gridDim.x * NWAVES;
            const float* lg = args.in[19] + L * D; const float* lb = args.in[20] + L * D;
            const int* dest = WSP(const int, WS_DEST); const float* gate = WSP(const float, WS_GATE); const float* XA = WSP(const float, WS_XA); const bf16_t* ys = WSP(const bf16_t, WS_XS);
            const float* st1 = WSP(const float, WS_ST1); const float* g1p = args.in[10] + L * D; const float* b1p = args.in[11] + L * D;
            for (int row = gw; row < S; row += NGW) {
                const int d0 = dest[2 * row], d1 = dest[2 * row + 1]; const float g0 = gate[2 * row], g1 = gate[2 * row + 1]; const float mu1 = st1[2 * row], rs1 = st1[2 * row + 1];
                f32x4 v[8]; const float* xr = XA + (size_t)row * D; const u32x2* y0 = (const u32x2*)(ys + (size_t)d0 * D); const u32x2* y1 = (const u32x2*)(ys + (size_t)d1 * D);
                const u32x2 m0 = *(const u32x2*)(WSP(const unsigned char, WS_TAILMAP) + (d0 >> 8) * 8), m1 = *(const u32x2*)(WSP(const unsigned char, WS_TAILMAP) + (d1 >> 8) * 8);
                const bool anyt = (m0.x | m0.y | m1.x | m1.y) != 0u;
#pragma unroll
                for (int j = 0; j < 8; ++j) { const f32x4 yv = *((const f32x4*)xr + lane + 64 * j); const f32x4 x = (yv - mu1) * rs1 * *((const f32x4*)g1p + lane + 64 * j) + *((const f32x4*)b1p + lane + 64 * j); const u32x2 a = y0[lane + 64 * j], b = y1[lane + 64 * j];
                    f32x4 fa = {__uint_as_float(a.x << 16), __uint_as_float(a.x & 0xffff0000u), __uint_as_float(a.y << 16), __uint_as_float(a.y & 0xffff0000u)};
                    f32x4 fb = {__uint_as_float(b.x << 16), __uint_as_float(b.x & 0xffff0000u), __uint_as_float(b.y << 16), __uint_as_float(b.y & 0xffff0000u)};
                    if (anyt) {
                        const int t0 = (int)(((j < 4 ? m0.x : m0.y) >> (8 * (j & 3))) & 255u), t1 = (int)(((j < 4 ? m1.x : m1.y) >> (8 * (j & 3))) & 255u);
                        if (t0 | t1) {
                            const int nwg_ = WSP(const int, WS_MOEMETA)[NE] * (D / 256), G_ = gridDim.x, Tn_ = nwg_ - (nwg_ / G_) * G_, SK = Tn_ * 7 <= G_ ? 7 : (Tn_ * 4 <= G_ ? 4 : 2);
                            if (t0) fa = tail_sum(WSP(const bf16_t, WS_YP), t0, d0, lane, SK);
                            if (t1) fb = tail_sum(WSP(const bf16_t, WS_YP), t1, d1, lane, SK);
                        }
                    }
                    v[j] = x * ALPHA + (fa * g0 + fb * g1); }
                float mu_, rs_; ln_row(v, lg, lb, lane, mu_, rs_);
#pragma unroll
                for (int j = 0; j < 8; ++j) *((f32x4*)(args.out + (size_t)row * D) + lane + 64 * j) = v[j];
            }
        }
    }
}

__global__ void __launch_bounds__(NWAVES * 64, 2) fwd(Args args) {
    extern __shared__ __attribute__((aligned(16))) unsigned char lds_raw[];
    LAS unsigned char* lds = (LAS unsigned char*)lds_raw;
    volatile LAS unsigned* MISC = (volatile LAS unsigned*)(lds + MISC_OFF);
    for (int u = tid_opaque(); u < (LDS_BYTES - MISC_OFF) / 4; u += NWAVES * 64) MISC[u] = 0u;
    __syncthreads();
    (void)xcd_barrier_post(WSP(unsigned, WS_CTL) + CW_BAR, MISC + 8);
    const int lo = args.ph_lo, hi = args.ph_hi;

    if (IN(0)) {
        const int tid = tid_opaque(), lane = tid & 63, wave = tid >> 6, G = gridDim.x, bx = blockIdx.x, gw = bx * NWAVES + wave, NGW = G * NWAVES;
        unsigned char* ws = args.ws;
        LAS unsigned* scr = (LAS unsigned*)(lds + wave * 16640);
        for (int rep = 0; rep < PROBE_PRO; ++rep) {
        int cursor = 0;
        for (int l = 0; l < DEPTH; ++l) {
            tr_matrix(args.in[1] + (size_t)l * D * IN_COLS, nullptr, IN_COLS, D, (bf16_t*)(ws + WS_WIN + l * SZ_WIN), IN_PAD, 1, nullptr, nullptr, scr, lane, gw, NGW, cursor);
            tr_matrix(args.in[3] + (size_t)l * QLORA * QCOLS, nullptr, QCOLS, QLORA, (bf16_t*)(ws + WS_WQ + l * SZ_WQ), QCOLS, 2, args.in[2] + l * QLORA, nullptr, scr, lane, gw, NGW, cursor);
            tr_matrix(args.in[5] + (size_t)l * KVLORA * KVCOLS, nullptr, KVCOLS, KVLORA, (bf16_t*)(ws + WS_WKV + l * SZ_WKV), KVCOLS, 0, args.in[4] + l * KVLORA, nullptr, scr, lane, gw, NGW, cursor);
            tr_matrix(args.in[9] + (size_t)l * D * D, nullptr, D, D, (bf16_t*)(ws + WS_WOUT + l * SZ_WOUT), D, 0, args.in[7] + l * 1024, args.in[8] + l * 1024, scr, lane, gw, NGW, cursor);
        }
        tr_matrix6(args.in[12], args.in[13], FF, ws + WS_WGU, 2 * FF, scr, lane, gw, NGW, cursor);
        tr_matrix6c(args.in[14], D, FF, ws + WS_WD, D, scr, lane, gw, NGW, cursor);
        { const f32x4* x4 = (const f32x4*)args.in[0]; u32x2* o2 = (u32x2*)(ws + WS_XB);
          for (size_t i = (size_t)bx * 512 + tid; i < (size_t)S * D / 4; i += (size_t)G * 512) o2[i] = pg8::pack4(x4[i]); }
        { float* coss = (float*)(ws + WS_COSS); float* sins = (float*)(ws + WS_SINS); float* cosm = (float*)(ws + WS_COSM); float* sinm = (float*)(ws + WS_SINM);
          for (int i = bx * 512 + tid; i < S * 64; i += G * 512) { const int pos = i >> 6, k = i & 63; float sn, cs; sincos_acc((float)pos * INVF[k], sn, cs); coss[i] = cs; sins[i] = sn; }
          for (int i = bx * 512 + tid; i < S * 32; i += G * 512) { const int pos = i >> 5, k = i & 31; float sn, cs; sincos_acc((float)pos * INVF[2 * k], sn, cs); cosm[i] = cs; sinm[i] = sn; } }
        }
    }
    SEAM(0);
    layer_phases<0>(args, lds, (char*)lds_raw, lo, hi);
    layer_phases<1>(args, lds, (char*)lds_raw, lo, hi);
}
#undef IN
#undef SEAM

#ifndef MK_SPLIT
#define MK_SPLIT 0
#endif
extern "C" void kernel_launch(void* const* d_in, const int* in_sizes, int n_in, void* d_out, int out_size, void* d_ws, size_t ws_size, hipStream_t stream) {
    static int grid = 0;
    if (grid == 0) {
        if (n_in != 21 || out_size != S * D || ws_size < WS_END2) { fprintf(stderr, "kernel_launch: unexpected shapes: n_in %d out %d ws %zu (need %zu)\n", n_in, out_size, ws_size, (size_t)WS_END2); grid = -1; return; }
        int dev = 0, cus = 0, per_cu = 0;
        if (hipGetDevice(&dev) != hipSuccess || hipDeviceGetAttribute(&cus, hipDeviceAttributeMultiprocessorCount, dev) != hipSuccess) { grid = -1; return; }
        if (hipFuncSetAttribute((const void*)fwd, hipFuncAttributeMaxDynamicSharedMemorySize, LDS_BYTES) != hipSuccess) { fprintf(stderr, "kernel_launch: hipFuncSetAttribute failed\n"); grid = -1; return; }
        if (hipOccupancyMaxActiveBlocksPerMultiprocessor(&per_cu, (const void*)fwd, NWAVES * 64, LDS_BYTES) != hipSuccess || per_cu < 1) fprintf(stderr, "kernel_launch: occupancy query says %d\n", per_cu);
        (void)hipGetLastError();
        grid = cus;
    }
    if (grid < 0) return;
    (void)hipMemsetAsync((char*)d_ws + WS_CTL, 0, CTL_ZERO_BYTES, stream);
    Args a{};
    for (int i = 0; i < 21; ++i) a.in[i] = (const float*)d_in[i];
    a.out = (float*)d_out; a.ws = (unsigned char*)d_ws;
#if MK_SPLIT
    for (int p = 0; p < NPHASE; ++p) { a.ph_lo = p; a.ph_hi = p + 1; hipLaunchKernelGGL(fwd, dim3(grid), dim3(NWAVES * 64), LDS_BYTES, stream, a); }
#else
    a.ph_lo = 0; a.ph_hi = NPHASE; hipLaunchKernelGGL(fwd, dim3(grid), dim3(NWAVES * 64), LDS_BYTES, stream, a);
#endif
    const hipError_t le = hipPeekAtLastError();
    if (le != hipSuccess) fprintf(stderr, "kernel_launch: launch failed: %s\n", hipGetErrorName(le));
}
```

```cpp
#include <hip/hip_runtime.h>
#include <cstdio>
#include <cstdint>

#define LAS __attribute__((address_space(3)))
#define GAS __attribute__((address_space(1)))
typedef unsigned short bf16_t;
typedef short bf16x8 __attribute__((ext_vector_type(8)));
typedef short s16x4 __attribute__((ext_vector_type(4)));
typedef float f32x4 __attribute__((ext_vector_type(4)));
typedef float f32x16 __attribute__((ext_vector_type(16)));
typedef unsigned u32x4 __attribute__((ext_vector_type(4)));
typedef unsigned u32x2 __attribute__((ext_vector_type(2)));

constexpr int S = 16384, D = 2048, DEPTH = 2;
constexpr int IN_COLS = 2368, IN_PAD = 2560, QCOLS = 1536, KVCOLS = 2048, QLORA = 512, KVLORA = 256;
constexpr int FF = 5632, FFE = 7168, NE = 8;
constexpr int MOE_ROWS = 34816;
constexpr float ALPHA = 1.41421356237309515f, LN_EPS = 1e-5f, RMS_EPS = 1e-6f;
constexpr float SCALE_MLA = 0.07216878364870322f, SCALE_SWA = 0.08838834764831845f;

__device__ __forceinline__ unsigned cvt_pk_bf16(float lo, float hi) { unsigned r; asm volatile("v_cvt_pk_bf16_f32 %0, %1, %2" : "=v"(r) : "v"(lo), "v"(hi)); return r; }

__device__ __forceinline__ unsigned pk_fp8x4(float a, float b, float c, float d) { int w = 0; w = __builtin_amdgcn_cvt_pk_fp8_f32(a, b, w, false); w = __builtin_amdgcn_cvt_pk_fp8_f32(c, d, w, true); return (unsigned)w; }
typedef int v6i32 __attribute__((ext_vector_type(6)));
typedef unsigned u32x6 __attribute__((ext_vector_type(6)));
__device__ __forceinline__ u32x6 mx6_block(const f32x16 lo, const f32x16 hi, unsigned& sb) {
    float am = 0.f;
#pragma unroll
    for (int i = 0; i < 16; ++i) am = fmaxf(am, fmaxf(fabsf(lo[i]), fabsf(hi[i])));
    const unsigned bits = __float_as_uint(am);
    int e = (int)((bits >> 23) & 255u) - 126 - (((bits & 0x7fffffu) <= 0x700000u) ? 3 : 2);
    e = e < -120 ? -120 : e;
    const float scale = __uint_as_float((unsigned)(e + 127) << 23);
    sb = (unsigned)(e + 127) * 0x01010101u;
    u32x6 q;
    asm("v_cvt_scalef32_2xpk16_fp6_f32 %0, %1, %2, %3" : "=&v"(q) : "v"(lo), "v"(hi), "v"(scale));
    return q;
}
constexpr float X8_SCALE = 4.f, W8UP_SCALE = 64.f, W8DN_SCALE = 128.f, H8_SCALE = 16.f;
__device__ __forceinline__ int tid_opaque() { int t = threadIdx.x; asm volatile("" : "+v"(t)); return t; }

constexpr size_t MiB = 1u << 20;
constexpr size_t WS_CTL = 0, CTL_ZERO_BYTES = 1 * MiB;
constexpr size_t WS_COSM = 1 * MiB, WS_SINM = 3 * MiB, WS_COSS = 5 * MiB, WS_SINS = 9 * MiB;
constexpr size_t WS_PARTQ = 13 * MiB, WS_PARTKV = 14 * MiB, WS_PARTO = 15 * MiB;
constexpr size_t WS_SEL = 16 * MiB, WS_GATE = WS_SEL + 128 * 1024, WS_DEST = WS_GATE + 128 * 1024, WS_WGCNT = WS_DEST + 128 * 1024, WS_MOEMETA = WS_WGCNT + 32 * 1024, WS_ST1 = WS_MOEMETA + 4096, WS_ST2 = WS_ST1 + 128 * 1024;
constexpr size_t WS_W = 17 * MiB;
constexpr size_t SZ_WIN = (size_t)IN_PAD * D * 2, SZ_WQ = (size_t)QCOLS * QLORA * 2, SZ_WKV = (size_t)KVCOLS * KVLORA * 2, SZ_WOUT = (size_t)D * D * 2;
constexpr size_t WS_WIN = WS_W, WS_WQ = WS_WIN + 2 * SZ_WIN, WS_WKV = WS_WQ + 2 * SZ_WQ, WS_WOUT = WS_WKV + 2 * SZ_WKV;
constexpr size_t WS_WGU = WS_WOUT + 2 * SZ_WOUT, WS_WD = WS_WGU + (size_t)2 * FF * D, WS_WMGU = WS_WD + (size_t)D * FF;
constexpr size_t WS_WMD = WS_WMGU + (size_t)NE * 2 * FFE * D, WS_XA = WS_WMD + (size_t)NE * D * FFE;
constexpr size_t WS_XB = WS_XA + (size_t)S * D * 4, WS_X8 = WS_XB + (size_t)S * D * 2, WS_SCR = WS_X8 + (size_t)S * D;
constexpr size_t WS_CQ = WS_SCR, WS_CKV = WS_CQ + (size_t)S * 512 * 2, WS_KPE = WS_CKV + (size_t)S * 256 * 2, WS_QS = WS_KPE + (size_t)S * 64 * 2;
constexpr size_t WS_KS = WS_QS + (size_t)S * 1024 * 2, WS_VS = WS_KS + (size_t)S * 256 * 2, WS_Q = WS_VS + (size_t)S * 256 * 2, WS_KV = WS_Q + (size_t)S * QCOLS * 2;
constexpr size_t WS_OBUF = WS_KV + (size_t)S * KVCOLS * 2, WS_ATT_END = WS_OBUF + (size_t)S * D * 2;
constexpr size_t WS_XS = WS_SCR, WS_H = WS_XS + (size_t)MOE_ROWS * D * 2, WS_END0 = WS_H + (size_t)MOE_ROWS * FFE, WS_END = WS_END0 > WS_ATT_END ? WS_END0 : WS_ATT_END;
constexpr size_t WS_YP = (WS_END + 255) / 256 * 256, WS_END2 = WS_YP + (size_t)7 * 128 * 65536 * 2;
constexpr size_t WS_TAILMAP = WS_CTL + 512 * 1024;
static_assert(WS_H + (size_t)S * FF <= WS_END, "scratch union");
static_assert(WS_WIN % 256 == 0 && WS_XA % 256 == 0 && WS_H % 256 == 0 && WS_Q % 256 == 0, "alignment");
constexpr int CW_TMO = 0, CW_BAR = 4096;

#define XB_TMO      128
#define XB_XCNT(j)  (256  + 64 * (j))
#define XB_XSUB(j)  (1280 + 64 * (j))
#define XB_XGEN(j)  (2304 + 64 * (j))
#define XB_TOP      3328
#define XB_TOPGEN   3392
#define XCD_BAR_WORDS 3456
#define XB_SPIN_CAP (1u << 18)
__device__ __forceinline__ unsigned xb_ld(unsigned* p)              { return __hip_atomic_load(p, __ATOMIC_RELAXED, __HIP_MEMORY_SCOPE_AGENT); }
__device__ __forceinline__ unsigned xb_add(unsigned* p, unsigned v) { return __hip_atomic_fetch_add(p, v, __ATOMIC_RELAXED, __HIP_MEMORY_SCOPE_AGENT); }
__device__ __forceinline__ unsigned xb_xcc_id() { return (unsigned)__builtin_amdgcn_s_getreg((3 << 11) | 20) & 0xFu; }
#define XB_SPIN(cond, bar) do { unsigned _sp = 0; while (cond) { __builtin_amdgcn_s_sleep(1); \
    if ((++_sp & 255u) == 0u) { if (xb_ld(&(bar)[XB_TMO])) break; if (_sp > XB_SPIN_CAP) { atomicAdd(&(bar)[XB_TMO], 1u); break; } } } } while (0)
struct XcdBarrier { unsigned* bar; unsigned x; volatile LAS unsigned* st; };
__device__ __forceinline__ XcdBarrier xcd_barrier_post(unsigned* bar, volatile LAS unsigned* st) {
    XcdBarrier b; b.bar = bar; b.x = xb_xcc_id(); b.st = st;
    if (threadIdx.x == 0) (void)xb_add(&bar[XB_XCNT(b.x)], 1u);
    return b;
}
__device__ __forceinline__ void xcd_barrier_complete(unsigned* bar, unsigned x, unsigned& nloc, unsigned& nx) {
    const unsigned G = gridDim.x * gridDim.y * gridDim.z;
    unsigned sum, cnt, mine, sp = 0u;
    for (;;) {
        sum = 0u; cnt = 0u; mine = 0u;
#pragma unroll
        for (unsigned j = 0; j < 16; ++j) { const unsigned c = xb_ld(&bar[XB_XCNT(j)]); sum += c; cnt += (c > 0u) ? 1u : 0u; mine = (j == x) ? c : mine; }
        if (sum == G) break;
        __builtin_amdgcn_s_sleep(1);
        if ((++sp & 255u) == 0u) { if (xb_ld(&bar[XB_TMO])) break; if (sp > XB_SPIN_CAP) { atomicAdd(&bar[XB_TMO], 1u); break; } }
    }
    nloc = mine > 0u ? mine : 1u; nx = cnt > 0u ? cnt : 1u;
}
__device__ __forceinline__ void xcd_barrier(const XcdBarrier& b) {
    asm volatile("s_waitcnt vmcnt(0)" ::: "memory");
    __syncthreads();
    if (threadIdx.x == 0) {
        unsigned* bar = b.bar;
        __builtin_amdgcn_s_waitcnt(0);
        unsigned nloc = b.st[0], nx = b.st[1];
        if (nloc == 0u) { xcd_barrier_complete(bar, b.x, nloc, nx); b.st[0] = nloc; b.st[1] = nx; }
        const unsigned old = xb_add(&bar[XB_XSUB(b.x)], 1u);
        const unsigned gen = old / nloc;
        if (old + 1u == (gen + 1u) * nloc) {
            __builtin_amdgcn_fence(__ATOMIC_RELEASE, "agent");
            asm volatile("s_waitcnt vmcnt(0)" ::: "memory");
            const unsigned og = xb_add(&bar[XB_TOP], 1u);
            const unsigned tg = og / nx;
            if (og + 1u == (tg + 1u) * nx) xb_add(&bar[XB_TOPGEN], 1u);
            else XB_SPIN(xb_ld(&bar[XB_TOPGEN]) == tg, bar);
            __builtin_amdgcn_fence(__ATOMIC_ACQUIRE, "agent");
            xb_add(&bar[XB_XGEN(b.x)], 1u);
            asm volatile("s_waitcnt vmcnt(0)" ::: "memory");
        } else {
            XB_SPIN(xb_ld(&bar[XB_XGEN(b.x)]) == gen, bar);
            __builtin_amdgcn_fence(__ATOMIC_ACQUIRE, "agent");
            asm volatile("s_waitcnt vmcnt(0)" ::: "memory");
        }
    }
    __syncthreads();
}

namespace pg8 {
constexpr int BM = 256, BK = 64, HALF = 128, HTB = HALF * BK * 2, STAGE_BYTES = 8 * HTB, NXCD = 8, WGM = 8;
__host__ __device__ __forceinline__ int lds_byte(int r, int c) { const int st = (r >> 4) * 2 + (c >> 5), rr = r & 15, cc = c & 31, ob = rr * 64 + cc * 2; return st * 1024 + (ob ^ (((ob >> 9) & 1) << 5)); }
__host__ __device__ __forceinline__ void stage_rc(int b, int& R, int& C) { const int st = b / 1024, sb = b % 1024, swz = sb ^ (((sb >> 9) & 1) << 5); R = (st >> 1) * 16 + swz / 64; C = (st & 1) * 32 + (swz % 64) / 2; }
__host__ __device__ __forceinline__ int perm32(int rho) { const int n = rho >> 4, i = rho & 15; return 8 * (i >> 2) + 4 * n + (i & 3); }
struct Unit { int pm, pn, aux, kx; };
struct Gemm { const bf16_t* A; const bf16_t* Bt; int K; };
struct StaticOrder {
    static constexpr bool KSPLIT = false;
    int nM, nN, nwg, G, c;
    __device__ void init(int M, int N, int G_, int c_) { nM = M / BM; nN = N / BM; nwg = nM * nN; G = G_; c = c_; }
    __device__ bool next(int i, Unit& u) const {
        const long L = (long)i * G + c; if (L >= nwg) return false;
        int wgid = (int)L; { const int q = nwg / NXCD, r = nwg % NXCD, xcd = wgid % NXCD, off = wgid / NXCD; wgid = (xcd < r ? xcd * (q + 1) : r * (q + 1) + (xcd - r) * q) + off; }
        const int nig = WGM * nN, gid = wgid / nig, fm = gid * WGM, gsz = (nM - fm) < WGM ? (nM - fm) : WGM;
        u.pm = fm + ((wgid % nig) % gsz); u.pn = (wgid % nig) / gsz; u.aux = u.pn; return true;
    }
};
struct MoeOrder {
    static constexpr bool KSPLIT = false;
    int pb[9], NT, G, c, nwg;
    __device__ __forceinline__ bool next(int i, Unit& u) const { return at((long)i * G + c, u); }
    __device__ __forceinline__ bool at(long L, Unit& u) const {
        if (L >= nwg) return false;
        int wgid = (int)L; { const int q = nwg / NXCD, r = nwg % NXCD, xcd = wgid % NXCD, off = wgid / NXCD; wgid = (xcd < r ? xcd * (q + 1) : r * (q + 1) + (xcd - r) * q) + off; }
        int e = 0;
#pragma unroll
        for (int k = 1; k < 8; ++k) e += (wgid >= pb[k] * NT) ? 1 : 0;
        int pbe = pb[0], pbn = pb[1];
#pragma unroll
        for (int k = 1; k < 8; ++k) { if (e == k) { pbe = pb[k]; pbn = pb[k + 1]; } }
        const int l = wgid - pbe * NT, Pe = pbn - pbe;
        const int nig = WGM * NT, gid = l / nig, fm = gid * WGM, gsz = (Pe - fm) < WGM ? (Pe - fm) : WGM;
        u.pm = pbe + fm + ((l % nig) % gsz); const int pn = (l % nig) / gsz; u.pn = e * NT + pn; u.aux = pn; return true;
    }
};

struct TableOrder {
    static constexpr bool KSPLIT = false;
    const LAS int* tab; int n;
    __device__ __forceinline__ bool next(int i, Unit& u) const {
        if (i >= n) return false;
        u.pm = __builtin_amdgcn_readfirstlane(tab[4 * i]); u.pn = __builtin_amdgcn_readfirstlane(tab[4 * i + 1]); u.aux = __builtin_amdgcn_readfirstlane(tab[4 * i + 2]); return true;
    }
};
struct TableOrderK {
    static constexpr bool KSPLIT = true;
    const LAS int* tab; int n;
    __device__ __forceinline__ bool next(int i, Unit& u) const {
        if (i >= n) return false;
        u.pm = __builtin_amdgcn_readfirstlane(tab[4 * i]); u.pn = __builtin_amdgcn_readfirstlane(tab[4 * i + 1]); u.aux = __builtin_amdgcn_readfirstlane(tab[4 * i + 2]); u.kx = __builtin_amdgcn_readfirstlane(tab[4 * i + 3]); return true;
    }
};
typedef int v8i32 __attribute__((ext_vector_type(8)));
template <class Epi, class Sched, bool ALIGN_EPI, bool SP2, int FMT = 0>
__device__ __forceinline__ void gemm_phase(LAS unsigned char* lds, const Gemm g, const Sched& S, const Epi& E) {
    const int tid = tid_opaque(), wid = __builtin_amdgcn_readfirstlane(tid >> 6), lane = tid & 63, wr = wid >> 2, wc = wid & 3, fr = lane & 15, fq = lane >> 4;
    constexpr bool F8 = (FMT != 0);
    const int K = g.K, RB = F8 ? K : 2 * K, nt = RB / 128;
    unsigned voffA, voffB;
    { int R, C; stage_rc(tid * 16, R, C); const int Rb = Epi::PERM ? ((R & ~31) + perm32(R & 31)) : R; voffA = (unsigned)(R * RB + C * 2); voffB = (unsigned)(Rb * RB + C * 2); }
    const size_t rstep = (size_t)64 * RB;
    const size_t kstep = (size_t)(BK * 2);
    const size_t hstep = (size_t)HALF * RB;
    const size_t tstep = 2 * hstep;
    const unsigned ldsw = (unsigned)wid * 1024u;
    const int aoff = lds_byte(wr * 64 + fr, fq * 8), boff = lds_byte(wc * 32 + fr, fq * 8);
#define PG8_SA(b, h) (((b) * 2 + (h)) * HTB)
#define PG8_SB(b, h) ((4 + (b) * 2 + (h)) * HTB)
#define PG8_STAGE(bufoff, gbase, voff) do { _Pragma("unroll") for (int _i = 0; _i < 2; ++_i) \
        __builtin_amdgcn_global_load_lds((const unsigned*)((const char*)(gbase) + _i * rstep + (voff)), (LAS unsigned*)(lds + (bufoff) + ldsw + _i * 8192), 16, 0, 0); } while (0)
#define PG8_LDA(dst, b, h) do { _Pragma("unroll") for (int m = 0; m < 4; ++m) _Pragma("unroll") for (int k = 0; k < 2; ++k) dst[m][k] = *(const LAS bf16x8*)(lds + PG8_SA(b, h) + aoff + m * 2048 + k * 1024); } while (0)
#define PG8_LDB(dst, b, h) do { _Pragma("unroll") for (int n = 0; n < 2; ++n) _Pragma("unroll") for (int k = 0; k < 2; ++k) dst[n][k] = *(const LAS bf16x8*)(lds + PG8_SB(b, h) + boff + n * 2048 + k * 1024); } while (0)
#define PG8_CAT(x) __builtin_shufflevector(__builtin_bit_cast(u32x4, x[0]), __builtin_bit_cast(u32x4, x[1]), 0, 1, 2, 3, 4, 5, 6, 7)
#define PG8_D6(x) __builtin_bit_cast(v6i32, __builtin_shufflevector(__builtin_bit_cast(u32x4, x[0]), __builtin_bit_cast(u32x4, x[1]), 0, 1, 2, 3, 4, 5))
#define PG8_S6(x) ((int)__builtin_bit_cast(u32x4, x[1])[2])
#define PG8_MMA(ai, bj, At, Bt) do { __builtin_amdgcn_s_setprio(1); if constexpr (FMT == 1) { _Pragma("unroll") for (int m = 0; m < 4; ++m) _Pragma("unroll") for (int n = 0; n < 2; ++n) \
        asm volatile("v_mfma_f32_16x16x128_f8f6f4 %0, %1, %2, %0" : "+v"(acc[ai][bj][m][n]) : "v"(__builtin_bit_cast(v8i32, PG8_CAT(Bt[n]))), "v"(__builtin_bit_cast(v8i32, PG8_CAT(At[m])))); } \
        else if constexpr (FMT == 2) { _Pragma("unroll") for (int m = 0; m < 4; ++m) _Pragma("unroll") for (int n = 0; n < 2; ++n) \
        acc[ai][bj][m][n] = __builtin_amdgcn_mfma_scale_f32_16x16x128_f8f6f4(__builtin_bit_cast(v8i32, PG8_CAT(Bt[n])), __builtin_bit_cast(v8i32, PG8_CAT(At[m])), acc[ai][bj][m][n], 2, 2, 0, PG8_S6(Bt[n]), 0, PG8_S6(At[m])); } \
        else { _Pragma("unroll") for (int m = 0; m < 4; ++m) _Pragma("unroll") for (int n = 0; n < 2; ++n) _Pragma("unroll") for (int k = 0; k < 2; ++k) \
        acc[ai][bj][m][n] = __builtin_amdgcn_mfma_f32_16x16x32_bf16(Bt[n][k], At[m][k], acc[ai][bj][m][n], 0, 0, 0); } __builtin_amdgcn_s_setprio(0); } while (0)
#define PG8_WAIT_V(n) asm volatile("s_waitcnt vmcnt(" #n ")" ::: "memory")
#define PG8_WAIT_L(n) asm volatile("s_waitcnt lgkmcnt(" #n ")" ::: "memory")
#define PG8_BAR __builtin_amdgcn_s_barrier()
#define PG8_SCHED __builtin_amdgcn_sched_barrier(0)
    Unit cur, nxt; int ui = 0;
    if (!S.next(0, cur)) return;
    constexpr bool KS = Sched::KSPLIT;
    auto k_off = [&](const Unit& u) -> size_t { if constexpr (KS) { if (u.kx) return (size_t)((u.kx >> 8) & 255) * (size_t)(nt / (u.kx >> 16)) * 128; } return 0; };
    auto k_cnt = [&](const Unit& u) -> int { if constexpr (KS) { if (u.kx) return nt / (u.kx >> 16); } return nt; };
    int ntc = k_cnt(cur);
    f32x4 acc[2][2][4][2];
#pragma unroll
    for (int a = 0; a < 2; ++a)
#pragma unroll
        for (int b = 0; b < 2; ++b)
#pragma unroll
            for (int m = 0; m < 4; ++m)
#pragma unroll
                for (int n = 0; n < 2; ++n) acc[a][b][m][n] = (f32x4){0.f, 0.f, 0.f, 0.f};
    bf16x8 At[4][2], B0[2][2], B1[2][2];
    const char* cA = (const char*)g.A + (size_t)cur.pm * tstep + k_off(cur); const char* cB = (const char*)g.Bt + (size_t)cur.pn * tstep + k_off(cur);
    if constexpr (SP2) {
        PG8_STAGE(PG8_SB(0, 0), cB, voffB); PG8_STAGE(PG8_SB(0, 1), cB + hstep, voffB); PG8_STAGE(PG8_SA(0, 0), cA, voffA); PG8_STAGE(PG8_SA(0, 1), cA + hstep, voffA);
        if (wr == 1) PG8_BAR;
        PG8_WAIT_V(2); PG8_BAR;
        PG8_STAGE(PG8_SB(1, 0), cB + kstep, voffB); PG8_STAGE(PG8_SA(1, 0), cA + kstep, voffA); PG8_STAGE(PG8_SB(1, 1), cB + hstep + kstep, voffB);
        PG8_WAIT_V(6); PG8_BAR;
    } else {
        PG8_STAGE(PG8_SB(0, 0), cB, voffB); PG8_STAGE(PG8_SA(0, 0), cA, voffA); PG8_STAGE(PG8_SB(0, 1), cB + hstep, voffB); PG8_STAGE(PG8_SA(0, 1), cA + hstep, voffA);
        if (wr == 1) PG8_BAR;
        PG8_WAIT_V(4); PG8_BAR;
        PG8_STAGE(PG8_SB(1, 0), cB + kstep, voffB); PG8_STAGE(PG8_SA(1, 0), cA + kstep, voffA); PG8_STAGE(PG8_SB(1, 1), cB + hstep + kstep, voffB);
        PG8_WAIT_V(6); PG8_BAR;
    }
    for (;;) {
        const bool has_next = S.next(ui + 1, nxt);
        const char* nA = has_next ? (const char*)g.A + (size_t)nxt.pm * tstep + k_off(nxt) : cA; const char* nB = has_next ? (const char*)g.Bt + (size_t)nxt.pn * tstep + k_off(nxt) : cB;
        for (int t = 0; t < ntc; t += 2) {
            if constexpr (Epi::MID_T >= 0) { if (t == Epi::MID_T) { const int l2 = tid_opaque() & 63; E.mid(acc, cur, wr, wc, l2 & 15, l2 >> 4); } }
            const bool last = (t == ntc - 2);
            const char* a1 = cA + (size_t)(t + 1) * kstep;
            const char* a2 = last ? nA : cA + (size_t)(t + 2) * kstep; const char* b2 = last ? nB : cB + (size_t)(t + 2) * kstep;
            const char* a3 = a2 + kstep; const char* b3 = b2 + kstep;
            if constexpr (SP2) {
            PG8_LDB(B0, 0, 0); PG8_LDB(B1, 0, 1); PG8_SCHED; PG8_LDA(At, 0, 0); PG8_STAGE(PG8_SA(1, 1), a1 + hstep, voffA);
            PG8_WAIT_V(8); PG8_WAIT_L(0); PG8_BAR; PG8_MMA(0, 0, At, B0); PG8_MMA(0, 1, At, B1); PG8_BAR; PG8_SCHED;
            PG8_LDA(At, 0, 1); PG8_STAGE(PG8_SB(0, 0), b2, voffB); PG8_STAGE(PG8_SB(0, 1), b2 + hstep, voffB); PG8_STAGE(PG8_SA(0, 0), a2, voffA);
            PG8_WAIT_V(8); PG8_WAIT_L(0); PG8_BAR; PG8_MMA(1, 0, At, B0); PG8_MMA(1, 1, At, B1); PG8_BAR; PG8_SCHED;
            PG8_LDB(B0, 1, 0); PG8_LDB(B1, 1, 1); PG8_SCHED; PG8_LDA(At, 1, 0); PG8_STAGE(PG8_SA(0, 1), a2 + hstep, voffA);
            PG8_WAIT_V(8); PG8_WAIT_L(0); PG8_BAR; PG8_MMA(0, 0, At, B0); PG8_MMA(0, 1, At, B1); PG8_BAR; PG8_SCHED;
            PG8_LDA(At, 1, 1); PG8_STAGE(PG8_SB(1, 0), b3, voffB); PG8_STAGE(PG8_SB(1, 1), b3 + hstep, voffB); PG8_STAGE(PG8_SA(1, 0), a3, voffA);
            PG8_WAIT_V(8); PG8_WAIT_L(0); PG8_BAR; PG8_MMA(1, 0, At, B0); PG8_MMA(1, 1, At, B1); PG8_BAR; PG8_SCHED;
            } else {
            PG8_LDB(B0, 0, 0); PG8_SCHED; PG8_LDA(At, 0, 0); PG8_STAGE(PG8_SA(1, 1), a1 + hstep, voffA);
            PG8_WAIT_L(8); PG8_BAR; PG8_WAIT_L(0); PG8_MMA(0, 0, At, B0); PG8_BAR; PG8_SCHED;
            PG8_LDB(B1, 0, 1); PG8_STAGE(PG8_SB(0, 0), b2, voffB);
            PG8_BAR; PG8_WAIT_L(0); PG8_MMA(0, 1, At, B1); PG8_BAR;
            PG8_LDA(At, 0, 1); PG8_STAGE(PG8_SA(0, 0), a2, voffA);
            PG8_BAR; PG8_WAIT_L(0); PG8_MMA(1, 0, At, B0); PG8_BAR; PG8_SCHED;
            PG8_STAGE(PG8_SB(0, 1), b2 + hstep, voffB);
            PG8_WAIT_V(6); PG8_BAR; PG8_MMA(1, 1, At, B1); PG8_BAR;
            PG8_LDB(B0, 1, 0); PG8_SCHED; PG8_LDA(At, 1, 0); PG8_STAGE(PG8_SA(0, 1), a2 + hstep, voffA);
            PG8_WAIT_L(8); PG8_BAR; PG8_WAIT_L(0); PG8_MMA(0, 0, At, B0); PG8_BAR; PG8_SCHED;
            PG8_LDB(B1, 1, 1); PG8_STAGE(PG8_SB(1, 0), b3, voffB);
            PG8_BAR; PG8_WAIT_L(0); PG8_MMA(0, 1, At, B1); PG8_BAR;
            PG8_LDA(At, 1, 1); PG8_STAGE(PG8_SA(1, 0), a3, voffA);
            PG8_BAR; PG8_WAIT_L(0); PG8_MMA(1, 0, At, B0); PG8_BAR; PG8_SCHED;
            PG8_STAGE(PG8_SB(1, 1), b3 + hstep, voffB);
            PG8_WAIT_V(6); PG8_BAR; PG8_MMA(1, 1, At, B1); PG8_BAR;
            }
        }
        if constexpr (ALIGN_EPI) { if (wr == 0) PG8_BAR; }
        if constexpr (F8) asm volatile("s_nop 15\n\ts_nop 15" ::: "memory");
        { const int l2 = tid_opaque() & 63; E(acc, cur, wr, wc, l2 & 15, l2 >> 4); }
        if (!has_next) break;
#pragma unroll
        for (int a = 0; a < 2; ++a)
#pragma unroll
            for (int b = 0; b < 2; ++b)
#pragma unroll
                for (int m = 0; m < 4; ++m)
#pragma unroll
                    for (int n = 0; n < 2; ++n) acc[a][b][m][n] = (f32x4){0.f, 0.f, 0.f, 0.f};
        cur = nxt; cA = nA; cB = nB; ++ui; ntc = k_cnt(cur);
        if constexpr (ALIGN_EPI) { if (wr == 1) PG8_BAR; }
    }
    PG8_WAIT_V(0);
    if constexpr (!ALIGN_EPI) { if (wr == 0) PG8_BAR; }
    PG8_BAR;
#undef PG8_SA
#undef PG8_SB
#undef PG8_STAGE
#undef PG8_LDA
#undef PG8_LDB
#undef PG8_MMA
#undef PG8_CAT
#undef PG8_D6
#undef PG8_S6
#undef PG8_WAIT_V
#undef PG8_WAIT_L
#undef PG8_BAR
#undef PG8_SCHED
}

__device__ __forceinline__ u32x4 pack8(const f32x4 a, const f32x4 b) { u32x4 w; w.x = cvt_pk_bf16(a[0], a[1]); w.y = cvt_pk_bf16(a[2], a[3]); w.z = cvt_pk_bf16(b[0], b[1]); w.w = cvt_pk_bf16(b[2], b[3]); return w; }
__device__ __forceinline__ u32x2 pack4(const f32x4 a) { u32x2 w; w.x = cvt_pk_bf16(a[0], a[1]); w.y = cvt_pk_bf16(a[2], a[3]); return w; }

constexpr int RM_BITS = 4;
__device__ __forceinline__ f32x4 rmant(const f32x4 v) {
    f32x4 r;
#pragma unroll
    for (int i = 0; i < 4; ++i) r[i] = __uint_as_float((__float_as_uint(v[i]) + (1u << (22 - RM_BITS))) & ~((1u << (23 - RM_BITS)) - 1u));
    return r;
}
struct EpiInProj {
    static constexpr int MID_T = -1;
    static constexpr bool PERM = true;
    bf16_t *cq, *ckv, *kpe, *qs, *ks, *vs; float *partq, *partkv; const float *cosm, *sinm, *coss, *sins;
    __device__ __forceinline__ void operator()(const f32x4 (&acc)[2][2][4][2], const Unit& u, int wr, int wc, int fr, int fq) const {
        const int row0 = u.pm * BM + wr * 64 + fr;
#pragma unroll
        for (int bj = 0; bj < 2; ++bj) {
            const int tc0 = u.aux * BM + bj * HALF + wc * 32 + fq * 8;
            if (tc0 < 768) {
                bf16_t* base; float* part; int ld, col, ps;
                if (tc0 < 512) { base = cq; ld = 512; col = tc0; part = partq; ps = 16; } else { base = ckv; ld = 256; col = tc0 - 512; part = partkv; ps = 8; }
#pragma unroll
                for (int ai = 0; ai < 2; ++ai)
#pragma unroll
                    for (int m = 0; m < 4; ++m) { const int row = row0 + ai * HALF + m * 16; const f32x4 v0 = acc[ai][bj][m][0], v1 = acc[ai][bj][m][1];
                        *(u32x4*)(base + (size_t)row * ld + col) = pack8(v0, v1);
                        float ss = (v0[0] * v0[0] + v0[1] * v0[1]) + (v0[2] * v0[2] + v0[3] * v0[3]) + (v1[0] * v1[0] + v1[1] * v1[1]) + (v1[2] * v1[2] + v1[3] * v1[3]);
                        ss += __shfl_xor(ss, 16); ss += __shfl_xor(ss, 32);
                        if (fq == 0) part[(size_t)row * ps + (col >> 5)] = ss; }
            } else if (tc0 < 2112) {
                bf16_t* base; const float *ct, *st; int ld, col, half, tw, g;
                if (tc0 < 832) { g = (tc0 - 768) >> 3; base = kpe; ld = 64; col = 4 * g; half = 32; ct = cosm; st = sinm; tw = 32; }
                else if (tc0 < 1856) { const int j = tc0 - 832; g = (j & 127) >> 3; base = qs; ld = 1024; col = (j >> 7) * 128 + 4 * g; half = 64; ct = coss; st = sins; tw = 64; }
                else { const int j = tc0 - 1856; g = (j & 127) >> 3; base = ks; ld = 256; col = (j >> 7) * 128 + 4 * g; half = 64; ct = coss; st = sins; tw = 64; }
#pragma unroll
                for (int ai = 0; ai < 2; ++ai)
#pragma unroll
                    for (int m = 0; m < 4; ++m) { const int row = row0 + ai * HALF + m * 16; const f32x4 x1 = acc[ai][bj][m][0], x2 = acc[ai][bj][m][1];
                        const f32x4 c = *(const f32x4*)(ct + (size_t)row * tw + 4 * g), s = *(const f32x4*)(st + (size_t)row * tw + 4 * g);
                        const f32x4 o1 = x1 * c - x2 * s, o2 = x2 * c + x1 * s;
                        if (tc0 < 832) { unsigned char* kp = (unsigned char*)kpe + (size_t)row * 64 + col;
                            *(unsigned*)kp = pk_fp8x4(o1[0], o1[1], o1[2], o1[3]); *(unsigned*)(kp + 32) = pk_fp8x4(o2[0], o2[1], o2[2], o2[3]); }
                        else { *(u32x2*)(base + (size_t)row * ld + col) = pack4(o1); *(u32x2*)(base + (size_t)row * ld + col + half) = pack4(o2); } }
            } else if (tc0 < 2368) {
                const int col = tc0 - 2112;
#pragma unroll
                for (int ai = 0; ai < 2; ++ai)
#pragma unroll
                    for (int m = 0; m < 4; ++m) { const int row = row0 + ai * HALF + m * 16; *(u32x4*)(vs + (size_t)row * 256 + col) = pack8(acc[ai][bj][m][0], acc[ai][bj][m][1]); }
            }
        }
    }
};
struct EpiQ {
    static constexpr int MID_T = -1;
    static constexpr bool PERM = true;
    bf16_t* q; const float *partq, *cosm, *sinm;
    __device__ __forceinline__ void operator()(const f32x4 (&acc)[2][2][4][2], const Unit& u, int wr, int wc, int fr, int fq) const {
        const int row0 = u.pm * BM + wr * 64 + fr;
        float rs[2][4];
#pragma unroll
        for (int ai = 0; ai < 2; ++ai)
#pragma unroll
            for (int m = 0; m < 4; ++m) { const f32x4* p = (const f32x4*)(partq + (size_t)(row0 + ai * HALF + m * 16) * 16); const f32x4 s = (p[0] + p[1]) + (p[2] + p[3]);
                rs[ai][m] = 1.0f / sqrtf(((s[0] + s[1]) + (s[2] + s[3])) * (1.0f / 512.0f) + RMS_EPS); }
#pragma unroll
        for (int bj = 0; bj < 2; ++bj) {
            const int tc0 = u.aux * BM + bj * HALF + wc * 32 + fq * 8, head = tc0 / 192, j = tc0 - head * 192;
            if (j < 128) {
#pragma unroll
                for (int ai = 0; ai < 2; ++ai)
#pragma unroll
                    for (int m = 0; m < 4; ++m) { const int row = row0 + ai * HALF + m * 16; *(u32x4*)(q + (size_t)row * QCOLS + tc0) = pack8(rmant(acc[ai][bj][m][0] * rs[ai][m]), rmant(acc[ai][bj][m][1] * rs[ai][m])); }
            } else {
                const int g = (j - 128) >> 3, col = head * 192 + 128 + 4 * g;
#pragma unroll
                for (int ai = 0; ai < 2; ++ai)
#pragma unroll
                    for (int m = 0; m < 4; ++m) { const int row = row0 + ai * HALF + m * 16; const f32x4 x1 = acc[ai][bj][m][0] * rs[ai][m], x2 = acc[ai][bj][m][1] * rs[ai][m];
                        const f32x4 c = *(const f32x4*)(cosm + (size_t)row * 32 + 4 * g), s = *(const f32x4*)(sinm + (size_t)row * 32 + 4 * g);
                        const f32x4 r1 = x1 * c - x2 * s, r2 = x2 * c + x1 * s; unsigned char* q8 = (unsigned char*)(q + (size_t)row * QCOLS + head * 192 + 128) + 4 * g;
                        *(unsigned*)q8 = pk_fp8x4(r1[0], r1[1], r1[2], r1[3]); *(unsigned*)(q8 + 32) = pk_fp8x4(r2[0], r2[1], r2[2], r2[3]); }
            }
        }
    }
};
struct EpiKV {
    static constexpr int MID_T = -1;
    static constexpr bool PERM = true;
    bf16_t* kv; const float* partkv;
    __device__ __forceinline__ void operator()(const f32x4 (&acc)[2][2][4][2], const Unit& u, int wr, int wc, int fr, int fq) const {
        const int row0 = u.pm * BM + wr * 64 + fr;
#pragma unroll
        for (int ai = 0; ai < 2; ++ai)
#pragma unroll
            for (int m = 0; m < 4; ++m) { const int row = row0 + ai * HALF + m * 16; const f32x4* p = (const f32x4*)(partkv + (size_t)row * 8); const f32x4 s = p[0] + p[1];
                const float rs = 1.0f / sqrtf(((s[0] + s[1]) + (s[2] + s[3])) * (1.0f / 256.0f) + RMS_EPS);
#pragma unroll
                for (int bj = 0; bj < 2; ++bj) { const int col = u.aux * BM + bj * HALF + wc * 32 + fq * 8; f32x4 k0 = acc[ai][bj][m][0] * rs, k1 = acc[ai][bj][m][1] * rs; k0 = rmant(k0); k1 = rmant(k1); *(u32x4*)(kv + (size_t)row * KVCOLS + col) = pack8(k0, k1); } }
    }
};
struct EpiResid {
    static constexpr int MID_T = -1;
    static constexpr bool PERM = true;
    const float* xin; float* y; float sc;
    __device__ __forceinline__ void operator()(const f32x4 (&acc)[2][2][4][2], const Unit& u, int wr, int wc, int fr, int fq) const {
        const int row0 = u.pm * BM + wr * 64 + fr;
#pragma unroll
        for (int ai = 0; ai < 2; ++ai)
#pragma unroll
            for (int m = 0; m < 4; ++m) { const size_t ro = (size_t)(row0 + ai * HALF + m * 16) * D;
#pragma unroll
                for (int bj = 0; bj < 2; ++bj) { const size_t o = ro + u.aux * BM + bj * HALF + wc * 32 + fq * 8;
                    const f32x4 a0 = *(const f32x4*)(xin + o), a1 = *(const f32x4*)(xin + o + 4);
                    *(f32x4*)(y + o) = a0 * ALPHA + acc[ai][bj][m][0] * sc; *(f32x4*)(y + o + 4) = a1 * ALPHA + acc[ai][bj][m][1] * sc; }
                asm volatile("" ::: "memory"); }
    }
};
struct EpiResidLN {
    static constexpr int MID_T = -1;
    static constexpr bool PERM = true, PROBE2 = false;
    const float* yin; float* y; float sc; const float* st; const float* g; const float* b;
    __device__ __forceinline__ void operator()(const f32x4 (&acc)[2][2][4][2], const Unit& u, int wr, int wc, int fr, int fq) const {
        const int row0 = u.pm * BM + wr * 64 + fr, col0 = u.aux * BM + wc * 32 + fq * 8;
        f32x4 gg[2][2], bb[2][2];
#pragma unroll
        for (int bj = 0; bj < 2; ++bj)
#pragma unroll
            for (int n = 0; n < 2; ++n) { gg[bj][n] = *(const f32x4*)(g + col0 + bj * HALF + 4 * n); bb[bj][n] = *(const f32x4*)(b + col0 + bj * HALF + 4 * n); }
#pragma unroll
        for (int ai = 0; ai < 2; ++ai)
#pragma unroll
            for (int m = 0; m < 4; ++m) { const int row = row0 + ai * HALF + m * 16; const size_t ro = (size_t)row * D; const float mu = st[2 * row], rs = st[2 * row + 1];
#pragma unroll
                for (int bj = 0; bj < 2; ++bj) { const size_t o = ro + col0 + bj * HALF;
                    const f32x4 a0 = *(const f32x4*)(yin + o), a1 = *(const f32x4*)(yin + o + 4);
                    const f32x4 x0 = (a0 - mu) * rs * gg[bj][0] + bb[bj][0], x1 = (a1 - mu) * rs * gg[bj][1] + bb[bj][1];
                    *(f32x4*)(y + o) = x0 * ALPHA + acc[ai][bj][m][0] * sc; *(f32x4*)(y + o + 4) = x1 * ALPHA + acc[ai][bj][m][1] * sc; }
                asm volatile("" ::: "memory"); }
    }
};
template <bool LNIN> struct EpiOutProj {
    static constexpr bool PERM = true, PROBE2 = false; static constexpr int MID_T = 16;
    const float* xin; float* y; const float* parto; const float* st; const float* g; const float* b;
    __device__ __forceinline__ void sums(int row, float& a, float& c) const { const f32x4* p = (const f32x4*)(parto + (size_t)row * 16); const f32x4 u = p[0] + p[1], v = p[2] + p[3];
        a = ((u[0] + u[1]) + (u[2] + u[3])) * (1.0f / 1024.0f) + RMS_EPS; c = ((v[0] + v[1]) + (v[2] + v[3])) * (1.0f / 1024.0f) + RMS_EPS; }
    __device__ __forceinline__ void mid(f32x4 (&acc)[2][2][4][2], const Unit& u, int wr, int wc, int fr, int fq) const {
        const int row0 = u.pm * BM + wr * 64 + fr;
#pragma unroll
        for (int ai = 0; ai < 2; ++ai)
#pragma unroll
            for (int m = 0; m < 4; ++m) { float a, c; sums(row0 + ai * HALF + m * 16, a, c); const float r = sqrtf(c / a);
#pragma unroll
                for (int bj = 0; bj < 2; ++bj) { acc[ai][bj][m][0] *= r; acc[ai][bj][m][1] *= r; } }
    }
    __device__ __forceinline__ void operator()(const f32x4 (&acc)[2][2][4][2], const Unit& u, int wr, int wc, int fr, int fq) const {
        const int row0 = u.pm * BM + wr * 64 + fr, col0 = u.aux * BM + wc * 32 + fq * 8;
        f32x4 gg[2][2], bb[2][2];
        if (LNIN) {
#pragma unroll
            for (int bj = 0; bj < 2; ++bj)
#pragma unroll
                for (int n = 0; n < 2; ++n) { gg[bj][n] = *(const f32x4*)(g + col0 + bj * HALF + 4 * n); bb[bj][n] = *(const f32x4*)(b + col0 + bj * HALF + 4 * n); }
        }
#pragma unroll
        for (int ai = 0; ai < 2; ++ai)
#pragma unroll
            for (int m = 0; m < 4; ++m) { const int row = row0 + ai * HALF + m * 16; const size_t ro = (size_t)row * D; float a, c; sums(row, a, c); const float rsw = 1.0f / sqrtf(c);
                float mu = 0.f, rs = 1.f; if (LNIN) { mu = st[2 * row]; rs = st[2 * row + 1]; }
#pragma unroll
                for (int bj = 0; bj < 2; ++bj) { const size_t o = ro + col0 + bj * HALF;
                    f32x4 x0 = *(const f32x4*)(xin + o), x1 = *(const f32x4*)(xin + o + 4);
                    if (LNIN) { x0 = (x0 - mu) * rs * gg[bj][0] + bb[bj][0]; x1 = (x1 - mu) * rs * gg[bj][1] + bb[bj][1]; }
                    *(f32x4*)(y + o) = x0 * ALPHA + acc[ai][bj][m][0] * rsw; *(f32x4*)(y + o + 4) = x1 * ALPHA + acc[ai][bj][m][1] * rsw; }
                asm volatile("" ::: "memory"); }
    }
};
struct EpiSwiglu8 {
    static constexpr int MID_T = -1;
    static constexpr bool PERM = true;
    unsigned char* h; int ldh; float sc;
    __device__ __forceinline__ void operator()(const f32x4 (&acc)[2][2][4][2], const Unit& u, int wr, int wc, int fr, int fq) const {
        const int row0 = u.pm * BM + wr * 64 + fr, col = u.aux * HALF + wc * 32 + fq * 8;
#pragma unroll
        for (int ai = 0; ai < 2; ++ai)
#pragma unroll
            for (int m = 0; m < 4; ++m) { f32x4 r0, r1;
#pragma unroll
                for (int k = 0; k < 4; ++k) { const float g0 = acc[ai][0][m][0][k] * sc, g1 = acc[ai][0][m][1][k] * sc;
                    r0[k] = __builtin_amdgcn_fmed3f(g0 * __builtin_amdgcn_rcpf(1.0f + __builtin_amdgcn_exp2f(-1.4426950408889634f * g0)) * (acc[ai][1][m][0][k] * (sc * H8_SCALE)), -448.f, 448.f);
                    r1[k] = __builtin_amdgcn_fmed3f(g1 * __builtin_amdgcn_rcpf(1.0f + __builtin_amdgcn_exp2f(-1.4426950408889634f * g1)) * (acc[ai][1][m][1][k] * (sc * H8_SCALE)), -448.f, 448.f); }
                u32x2 w; w.x = pk_fp8x4(r0[0], r0[1], r0[2], r0[3]); w.y = pk_fp8x4(r1[0], r1[1], r1[2], r1[3]);
                *(u32x2*)(h + (size_t)(row0 + ai * HALF + m * 16) * ldh + col) = w; }
    }
};
struct EpiSwiglu6 {
    static constexpr bool PERM = true, PROBE2 = false; static constexpr int MID_T = -1;
    unsigned char* h; int ldh;
    __device__ __forceinline__ void operator()(const f32x4 (&acc)[2][2][4][2], const Unit& u, int wr, int wc, int fr, int fq) const {
#pragma unroll
        for (int ai = 0; ai < 2; ++ai) {
            float v[4][8];
#pragma unroll
            for (int m = 0; m < 4; ++m)
#pragma unroll
                for (int c = 0; c < 8; ++c) { const float g = acc[ai][0][m][c >> 2][c & 3], uu = acc[ai][1][m][c >> 2][c & 3];
                    v[m][c] = g * __builtin_amdgcn_rcpf(1.0f + __builtin_amdgcn_exp2f(-1.4426950408889634f * g)) * uu; }
            float s1[2][2][8];
#pragma unroll
            for (int mm = 0; mm < 2; ++mm)
#pragma unroll
                for (int c = 0; c < 8; ++c) { auto r = __builtin_amdgcn_permlane32_swap(__float_as_uint(v[mm][c]), __float_as_uint(v[mm + 2][c]), false, false);
                    s1[mm][0][c] = __uint_as_float(r[0]); s1[mm][1][c] = __uint_as_float(r[1]); }
            f32x16 lo, hi;
#pragma unroll
            for (int hh = 0; hh < 2; ++hh)
#pragma unroll
                for (int c = 0; c < 8; ++c) { auto r = __builtin_amdgcn_permlane16_swap(__float_as_uint(s1[0][hh][c]), __float_as_uint(s1[1][hh][c]), false, false);
                    if (hh == 0) { lo[c] = __uint_as_float(r[0]); lo[8 + c] = __uint_as_float(r[1]); } else { hi[c] = __uint_as_float(r[0]); hi[8 + c] = __uint_as_float(r[1]); } }
            unsigned sb; const u32x6 q = mx6_block(lo, hi, sb);
            unsigned char* o = h + (size_t)(u.pm * BM + ai * HALF + wr * 64 + fq * 16 + fr) * ldh + u.aux * 128 + 16 * wc;
            *(u32x4*)o = (u32x4){q[0], q[1], q[2], q[3]}; *(u32x4*)(o + 64) = (u32x4){q[4], q[5], sb, 0u};
        }
    }
};
struct EpiBf16Out {
    static constexpr int MID_T = -1;
    static constexpr bool PERM = true;
    bf16_t* o; int ld; float sc;
    __device__ __forceinline__ void operator()(const f32x4 (&acc)[2][2][4][2], const Unit& u, int wr, int wc, int fr, int fq) const {
        const int row0 = u.pm * BM + wr * 64 + fr;
#pragma unroll
        for (int ai = 0; ai < 2; ++ai)
#pragma unroll
            for (int m = 0; m < 4; ++m)
#pragma unroll
                for (int bj = 0; bj < 2; ++bj) *(u32x4*)(o + (size_t)(row0 + ai * HALF + m * 16) * ld + u.aux * BM + bj * HALF + wc * 32 + fq * 8) = pack8(acc[ai][bj][m][0] * sc, acc[ai][bj][m][1] * sc);
    }
};
struct EpiBf16OutK {
    static constexpr int MID_T = -1;
    static constexpr bool PERM = true;
    bf16_t* o; bf16_t* yp;
    __device__ __forceinline__ void operator()(const f32x4 (&acc)[2][2][4][2], const Unit& u, int wr, int wc, int fr, int fq) const {
        bf16_t* base; int ld;
        if (u.kx) { base = yp + ((size_t)(((u.kx >> 8) & 255) * 128 + (u.kx & 255) - 1) * 256 + wr * 64 + fr) * 256; ld = 256; }
        else { base = o + (size_t)(u.pm * BM + wr * 64 + fr) * D + u.aux * BM; ld = D; }
#pragma unroll
        for (int ai = 0; ai < 2; ++ai)
#pragma unroll
            for (int m = 0; m < 4; ++m)
#pragma unroll
                for (int bj = 0; bj < 2; ++bj) *(u32x4*)(base + (size_t)(ai * HALF + m * 16) * ld + bj * HALF + wc * 32 + fq * 8) = pack8(acc[ai][bj][m][0], acc[ai][bj][m][1]);
    }
};
}

namespace att {
constexpr int NW = 8, QBLK = 32, KVBLK = 64;
constexpr float THR = 8.f;
constexpr int PPITCH = 80;
constexpr int SHM_V = KVBLK * 128 * 2, SHM_K = KVBLK * 272, SHM_P = KVBLK * PPITCH;
constexpr int OFF_V = 0, OFF_K = 3 * SHM_V, OFF_P = OFF_K + 2 * SHM_K,     OFF_WS = OFF_P + 2 * SHM_P, OFF_QP = OFF_WS + NW * 64 * 4, SHM_ATTN = OFF_QP + NW * 4096;
typedef LAS const char* lptr;
typedef short v4i16_t __attribute__((ext_vector_type(4)));
#define SBAR() __builtin_amdgcn_sched_barrier(0)
#define PIN(x) asm volatile("" : "+v"(x))
__device__ __forceinline__ int crow(int r, int hi) { return (r & 3) + 8 * (r >> 2) + 4 * hi; }
__device__ __forceinline__ bf16x8 ldk(lptr p) { return *(const LAS bf16x8*)p; }
__device__ __forceinline__ s16x4 vtr(lptr p) { return __builtin_bit_cast(s16x4, __builtin_amdgcn_ds_read_tr16_b64_v4i16((LAS v4i16_t*)p)); }
__device__ __forceinline__ int v_st(int k, int c) { const int kk = (k & ~0xC) | ((k & 4) << 1) | ((k & 8) >> 1); return ((kk >> 3) * 4 + (c >> 5)) * 512 + ((kk & 7) * 32 + (c & 31)) * 2; }
__device__ __forceinline__ int v_rd_base(int lane) { return ((lane & 3) << 3) | (((lane >> 2) & 3) << 6) | (((lane >> 4) & 1) << 5) | (((lane >> 5) & 1) << 8); }
__device__ __forceinline__ bf16x8 pk4(float a0, float a1, float a2, float a3, float a4, float a5, float a6, float a7) {
  const unsigned x0 = cvt_pk_bf16(a0, a1), x1 = cvt_pk_bf16(a2, a3), y0 = cvt_pk_bf16(a4, a5), y1 = cvt_pk_bf16(a6, a7);
  auto r0 = __builtin_amdgcn_permlane32_swap(x0, y0, false, false); auto r1 = __builtin_amdgcn_permlane32_swap(x1, y1, false, false);
  u32x4 w = {r0[0], r1[0], r0[1], r1[1]}; return __builtin_bit_cast(bf16x8, w);
}
constexpr int PD = 3;
__device__ __forceinline__ bf16x8 kfrag(lptr kb, int n) { const int d0 = n >> 1, h = n & 1; return ldk(kb + h * (32 * 272) + d0 * 32); }
typedef int v8i32_t __attribute__((ext_vector_type(8)));
__device__ __forceinline__ v8i32_t cat8(const bf16x8 a, const bf16x8 b) { return __builtin_bit_cast(v8i32_t, __builtin_shufflevector(__builtin_bit_cast(u32x4, a), __builtin_bit_cast(u32x4, b), 0, 1, 2, 3, 4, 5, 6, 7)); }
template <int NQ, bool DO_QK, bool DO_FIN>
__device__ __forceinline__ void phaseA(f32x16& C0, f32x16& C1, const f32x16& P0, const f32x16& P1, float alphaP, float& l_reg, bf16x8 (&pa)[4],
                                       lptr kb, lptr pb, const bf16x8 (&rq)[2], const bf16x8 (&qr)[8]) {
  constexpr bool R8 = NQ > 8;
  constexpr int NN = 16, NF = NN + (R8 ? 2 : 0);
  float s0 = 0.f, s1 = 0.f, s2 = 0.f, s3 = 0.f;
  bf16x8 f[NN + PD]; bf16x8 ra[2][2];
  if (DO_QK) {
#pragma unroll
    for (int n = 0; n < PD; ++n) f[n] = kfrag(kb, n);
  }
#pragma unroll
  for (int n = 0; n < NF; ++n) {
    if (DO_QK) {
      if (n < NN) {
        if (n + PD < NN) f[n + PD] = kfrag(kb, n + PD);
        if (R8) { if (n == 11) { ra[0][0] = ldk(pb); ra[0][1] = ldk(pb + 16); } if (n == 13) { ra[1][0] = ldk(pb + 32 * PPITCH); ra[1][1] = ldk(pb + 32 * PPITCH + 16); } }
        const bf16x8 qf = qr[n >> 1];
        if (n == 0)            C0 = __builtin_amdgcn_mfma_f32_32x32x16_bf16(f[n], qf, f32x16{}, 0, 0, 0);
        else if (n == 1)       C1 = __builtin_amdgcn_mfma_f32_32x32x16_bf16(f[n], qf, f32x16{}, 0, 0, 0);
        else if ((n & 1) == 0) C0 = __builtin_amdgcn_mfma_f32_32x32x16_bf16(f[n], qf, C0, 0, 0, 0);
        else                   C1 = __builtin_amdgcn_mfma_f32_32x32x16_bf16(f[n], qf, C1, 0, 0, 0);
      } else if (R8) {
        const int h = n - NN;
        if (h == 0) C0 = __builtin_amdgcn_mfma_scale_f32_32x32x64_f8f6f4(cat8(ra[0][0], ra[0][1]), cat8(rq[0], rq[1]), C0, 0, 0, 0, 0x7F7F7F7F, 0, 0x7F7F7F7F);
        else        C1 = __builtin_amdgcn_mfma_scale_f32_32x32x64_f8f6f4(cat8(ra[1][0], ra[1][1]), cat8(rq[0], rq[1]), C1, 0, 0, 0, 0x7F7F7F7F, 0, 0x7F7F7F7F);
      }
    }
    if (DO_FIN) {
#pragma unroll
      for (int e = n * 32 / NF; e < (n + 1) * 32 / NF; ++e) { const float v = e < 16 ? P0[e & 15] : P1[e & 15]; if ((e & 3) == 0) s0 += v; else if ((e & 3) == 1) s1 += v; else if ((e & 3) == 2) s2 += v; else s3 += v; }
      PIN(s0); PIN(s1); PIN(s2); PIN(s3);
      if (n == NF / 8)     { pa[0] = pk4(P0[0], P0[1], P0[2], P0[3], P0[4], P0[5], P0[6], P0[7]); PIN(pa[0]); }
      if (n == 3 * NF / 8) { pa[1] = pk4(P0[8], P0[9], P0[10], P0[11], P0[12], P0[13], P0[14], P0[15]); PIN(pa[1]); }
      if (n == 5 * NF / 8) { pa[2] = pk4(P1[0], P1[1], P1[2], P1[3], P1[4], P1[5], P1[6], P1[7]); PIN(pa[2]); }
      if (n == 7 * NF / 8) { pa[3] = pk4(P1[8], P1[9], P1[10], P1[11], P1[12], P1[13], P1[14], P1[15]); PIN(pa[3]); }
    }
    SBAR();
  }
  if (DO_FIN) { float ps = (s0 + s1) + (s2 + s3); auto rr = __builtin_amdgcn_permlane32_swap(__float_as_uint(ps), __float_as_uint(ps), false, false);
    ps = __uint_as_float(rr[0]) + __uint_as_float(rr[1]); l_reg = l_reg * alphaP + ps; }
}
template <bool MASK, bool DO_PV, bool DO_SM>
__device__ __forceinline__ void phaseB(f32x16 (&o)[4], const bf16x8 (&pa)[4], f32x16& C0, f32x16& C1, float& m_reg, float& alpha, lptr vb, float Cs, float thr_raw, int qi, int k0, int hi) {
  s16x4 vl[16 + PD], vh[16 + PD];
  if (DO_PV) {
#pragma unroll
    for (int n = 0; n < PD; ++n) { const int d0 = n & 3, ks = n >> 2; vl[n] = vtr(vb + d0 * 512 + ks * 4096); vh[n] = vtr(vb + d0 * 512 + ks * 4096 + 2048); }
  }
  float mx = -3.0e38f, mnC = 0.f;
#pragma unroll
  for (int n = 0; n < 16; ++n) {
    if (DO_PV) {
      const int d0 = n & 3, ks = n >> 2;
      if (n + PD < 16) { const int d1 = (n + PD) & 3, k1 = (n + PD) >> 2; vl[n + PD] = vtr(vb + d1 * 512 + k1 * 4096); vh[n + PD] = vtr(vb + d1 * 512 + k1 * 4096 + 2048); }
      const bf16x8 vf = (bf16x8){vl[n][0], vl[n][1], vl[n][2], vl[n][3], vh[n][0], vh[n][1], vh[n][2], vh[n][3]};
      o[d0] = __builtin_amdgcn_mfma_f32_32x32x16_bf16(pa[ks], vf, o[d0], 0, 0, 0);
    }
    if (DO_SM) {
      if (n < 4) {
#pragma unroll
        for (int e = n * 8; e < n * 8 + 8; ++e) {
          if (MASK) { const int d = qi - (k0 + (e < 16 ? 0 : 32) + crow(e & 15, hi)); if (d > 128 || d < -128) { if (e < 16) C0[e & 15] = -1e30f; else C1[e & 15] = -1e30f; } }
          mx = fmaxf(mx, e < 16 ? C0[e & 15] : C1[e & 15]); }
        PIN(mx);
      } else if (n == 4) {
        auto rr = __builtin_amdgcn_permlane32_swap(__float_as_uint(mx), __float_as_uint(mx), false, false);
        const float pmax = fmaxf(__uint_as_float(rr[0]), __uint_as_float(rr[1]));
        const bool keep = __all(pmax - m_reg <= thr_raw);
        const float mn = keep ? m_reg : fmaxf(m_reg, pmax);
        alpha = __builtin_amdgcn_exp2f((m_reg - mn) * Cs); m_reg = mn; mnC = -mn * Cs; PIN(alpha); PIN(mnC);
      } else {
#pragma unroll
        for (int e = (n - 5) * 32 / 11; e < (n - 4) * 32 / 11; ++e) {
          if (e < 16) C0[e] = __builtin_amdgcn_exp2f(fmaf(C0[e], Cs, mnC)); else C1[e - 16] = __builtin_amdgcn_exp2f(fmaf(C1[e - 16], Cs, mnC)); }
        if ((n - 5) * 32 / 11 < 16) PIN(C0); if ((n - 4) * 32 / 11 > 16) PIN(C1);
      }
    }
    SBAR();
  }
}

template <int DQK, bool MASK, int LDQ, int LDK, int LDP, int LDV, int LDO>
__device__ __forceinline__ void attn_body(const bf16_t* __restrict__ Qb, const bf16_t* __restrict__ Kb, const bf16_t* __restrict__ Pb, const bf16_t* __restrict__ Vb,
                                          bf16_t* __restrict__ Ob, float* __restrict__ ssq, int q0, int kstart, int NT, float scale, float sink_raw, LAS char* lds) {
  constexpr int NQ = DQK / 16;
  const float Cs = scale * 1.4426950408889634f, thr_raw = THR / scale;
  const int tid = tid_opaque(), wid = tid >> 6, lane = tid & 63, r32 = lane & 31, hi = lane >> 5;
  LAS char* V_lds = lds + OFF_V; LAS char* K_lds = lds + OFF_K; LAS char* P_lds = lds + OFF_P;
  LAS float* ws = (LAS float*)(lds + OFF_WS) + wid * 64; LAS float* li_l = ws; LAS float* al_l = ws + 32;
  float m_reg = MASK ? sink_raw : -1e30f, l_reg = MASK ? 1.f : 0.f; f32x16 o[4] = {}; bf16x8 qr[8];
  const bf16_t* Qw = Qb + (long)(wid * QBLK + r32) * LDQ + hi * 8;
  LAS char* Qp = lds + OFF_QP + wid * 4096 + lane * 16;
#pragma unroll
  for (int d0 = 0; d0 < 8; ++d0) qr[d0] = *reinterpret_cast<const bf16x8*>(Qw + d0 * 16);
  bf16x8 rq[2] = {};
  if (NQ > 8) {
    const unsigned char* q8 = (const unsigned char*)(Qb + (long)(wid * QBLK + r32) * LDQ + 128) + hi * 32;
    rq[0] = *reinterpret_cast<const bf16x8*>(q8); rq[1] = *reinterpret_cast<const bf16x8*>(q8 + 16);
  }
  const int sr = tid >> 4, sc = (tid & 15) * 8, vst0 = v_st(sr, sc), vst1 = v_st(32 + sr, sc);
  const int pr = tid >> 3, pc = (tid & 7) * 8;
  const lptr kb0 = (lptr)K_lds + r32 * 272 + hi * 16, pb0 = (lptr)P_lds + r32 * PPITCH + hi * 32, vb0 = (lptr)V_lds + v_rd_base(lane);
  const int qi = q0 + wid * QBLK + r32;
  bf16x8 vs0, vs1, ks0, ks1; u32x2 ps0;
  const unsigned voff0 = sr * LDV + sc, voff1 = (32 + sr) * LDV + sc, koff0 = sr * LDK + sc, koff1 = (32 + sr) * LDK + sc, poff = pr * LDP + pc;
#define SLOAD(k0) do { const bf16_t* Vt = Vb + (long)(k0) * LDV; const bf16_t* Kt = Kb + (long)(k0) * LDK; \
    vs0 = *reinterpret_cast<const bf16x8*>(Vt + voff0); vs1 = *reinterpret_cast<const bf16x8*>(Vt + voff1); \
    ks0 = *reinterpret_cast<const bf16x8*>(Kt + koff0); ks1 = *reinterpret_cast<const bf16x8*>(Kt + koff1); \
    if (NQ > 8) { const unsigned char* Pt = (const unsigned char*)Pb + (long)(k0) * LDP; ps0 = *reinterpret_cast<const u32x2*>(Pt + poff); } } while (0)
#define SWRITE(kb_, vo_) do { *(LAS bf16x8*)(V_lds + (vo_) + vst0) = vs0; *(LAS bf16x8*)(V_lds + (vo_) + vst1) = vs1; \
    *(LAS bf16x8*)(K_lds + (kb_) * SHM_K + sr * 272 + sc * 2) = ks0; *(LAS bf16x8*)(K_lds + (kb_) * SHM_K + (32 + sr) * 272 + sc * 2) = ks1; \
    if (NQ > 8) *(LAS u32x2*)(P_lds + (kb_) * SHM_P + pr * PPITCH + pc) = ps0; } while (0)
#define SWAIT() asm volatile("s_waitcnt vmcnt(0)" ::: "memory")
#define RESC(a) do { if (__any((a) < 1.f)) { if (hi == 0) al_l[r32] = (a); asm volatile("s_waitcnt lgkmcnt(0)" ::: "memory"); \
    _Pragma("unroll") for (int d = 0; d < 4; ++d) _Pragma("unroll") for (int r = 0; r < 16; ++r) o[d][r] *= al_l[crow(r, hi)]; } } while (0)
#define ROTV() do { const int t_ = vprev; vprev = vcur; vcur = vnext; vnext = t_; } while (0)
  f32x16 pA0, pA1, pB0, pB1; float alA = 1.f, alB = 1.f; bf16x8 pa[4];
  int vprev = 0, vcur = SHM_V, vnext = 2 * SHM_V;
  SLOAD(kstart); SWAIT(); SWRITE(0, 0); __syncthreads();
  SLOAD(kstart + KVBLK);
  phaseA<NQ, true, false>(pA0, pA1, pA0, pA1, 1.f, l_reg, pa, kb0, pb0, rq, qr);
  SWAIT(); SWRITE(1, SHM_V);
  phaseB<MASK, false, true>(o, pa, pA0, pA1, m_reg, alA, vb0, Cs, thr_raw, qi, kstart, hi);
  __syncthreads();
  for (int j = 1; j + 1 < NT; j += 2) {
    SBAR(); SLOAD(kstart + (j + 1) * KVBLK); SBAR();
    phaseA<NQ, true, true>(pB0, pB1, pA0, pA1, alA, l_reg, pa, kb0 + SHM_K, pb0 + SHM_P, rq, qr);
    SWAIT(); SWRITE(0, vnext);
    phaseB<MASK, true, true>(o, pa, pB0, pB1, m_reg, alB, vb0 + vprev, Cs, thr_raw, qi, kstart + j * KVBLK, hi);
    RESC(alB); ROTV(); __syncthreads();
    SBAR(); if (j + 2 < NT) SLOAD(kstart + (j + 2) * KVBLK); SBAR();
    phaseA<NQ, true, true>(pA0, pA1, pB0, pB1, alB, l_reg, pa, kb0, pb0, rq, qr);
    if (j + 2 < NT) { SWAIT(); SWRITE(1, vnext); }
    phaseB<MASK, true, true>(o, pa, pA0, pA1, m_reg, alA, vb0 + vprev, Cs, thr_raw, qi, kstart + (j + 1) * KVBLK, hi);
    RESC(alA); ROTV(); __syncthreads();
  }
  SBAR(); phaseA<NQ, true, true>(pB0, pB1, pA0, pA1, alA, l_reg, pa, kb0 + SHM_K, pb0 + SHM_P, rq, qr);
  phaseB<MASK, true, true>(o, pa, pB0, pB1, m_reg, alB, vb0 + vprev, Cs, thr_raw, qi, kstart + (NT - 1) * KVBLK, hi);
  RESC(alB); ROTV();
  phaseA<NQ, false, true>(pA0, pA1, pB0, pB1, alB, l_reg, pa, kb0, pb0, rq, qr);
  phaseB<MASK, true, false>(o, pa, pA0, pA1, m_reg, alA, vb0 + vprev, Cs, thr_raw, qi, 0, hi);
  if (hi == 0) li_l[r32] = l_reg; asm volatile("s_waitcnt lgkmcnt(0)" ::: "memory");
  bf16_t* Ow = Ob + (long)(wid * QBLK) * LDO;
#pragma unroll
  for (int r = 0; r < 16; ++r) { const int orow = crow(r, hi); const float rl = __builtin_amdgcn_rcpf(li_l[orow]); float sq = 0.f;
#pragma unroll
    for (int d0 = 0; d0 < 4; ++d0) { const float v = o[d0][r] * rl; sq += v * v; Ow[(long)orow * LDO + d0 * 32 + r32] = (bf16_t)(cvt_pk_bf16(v, v) & 0xffffu); }
#pragma unroll
    for (int s = 1; s < 32; s <<= 1) sq += __shfl_xor(sq, s);
    if (r32 == 0) ssq[(long)(wid * QBLK + orow) * 16] = sq; }
  __syncthreads();
#undef SLOAD
#undef SWRITE
#undef SWAIT
#undef RESC
#undef ROTV
}
#undef SBAR
#undef PIN
}

constexpr int NWAVES = 8;
#ifndef PROBE_ATT
#define PROBE_ATT 1
#endif
#ifndef PROBE_PRO
#define PROBE_PRO 1
#endif
#ifndef PROBE_MOEUP
#define PROBE_MOEUP 1
#endif
constexpr int RING_BYTES = 133120;
constexpr int MISC_OFF = 139264, LDS_BYTES = 147456;
static_assert(att::SHM_ATTN <= MISC_OFF && RING_BYTES <= MISC_OFF, "LDS map");
constexpr int NPHASE = 21;

__device__ const float INVF[64] = {
 1.000000000e+00f, 8.659643531e-01f, 7.498942018e-01f, 6.493816376e-01f, 5.623413324e-01f, 4.869675338e-01f, 4.216965139e-01f, 3.651741147e-01f, 3.162277639e-01f, 2.738419771e-01f, 2.371373773e-01f, 2.053525001e-01f, 1.778279394e-01f, 1.539926529e-01f, 1.333521456e-01f, 1.154781953e-01f,
 1.000000015e-01f, 8.659642935e-02f, 7.498942316e-02f, 6.493816525e-02f, 5.623413250e-02f, 4.869675264e-02f, 4.216964915e-02f, 3.651741147e-02f, 3.162277490e-02f, 2.738419548e-02f, 2.371373773e-02f, 2.053525113e-02f, 1.778279431e-02f, 1.539926510e-02f, 1.333521400e-02f, 1.154781971e-02f,
 9.999999776e-03f, 8.659643121e-03f, 7.498942316e-03f, 6.493816152e-03f, 5.623413250e-03f, 4.869675264e-03f, 4.216964822e-03f, 3.651741194e-03f, 3.162277630e-03f, 2.738419687e-03f, 2.371373819e-03f, 2.053525066e-03f, 1.778279431e-03f, 1.539926510e-03f, 1.333521446e-03f, 1.154782018e-03f,
 1.000000047e-03f, 8.659643354e-04f, 7.498941850e-04f, 6.493816036e-04f, 5.623413017e-04f, 4.869675322e-04f, 4.216965172e-04f, 3.651741135e-04f, 3.162277571e-04f, 2.738419571e-04f, 2.371373703e-04f, 2.053525095e-04f, 1.778279402e-04f, 1.539926598e-04f, 1.333521504e-04f, 1.154782003e-04f };

struct Args { const float* in[21]; float* out; unsigned char* ws; int ph_lo, ph_hi; };

__device__ __forceinline__ float wave_sum(float v) {
#pragma unroll
    for (int o = 1; o < 64; o <<= 1) v += __shfl_xor(v, o);
    return v;
}
__device__ __forceinline__ void sincos_acc(float ang, float& sn, float& cs) {
    const double a = (double)ang;
    const double n = __builtin_rint(a * 0.63661977236758134308);
    double r = __builtin_fma(-n, 1.57079632679489655800, a); r = __builtin_fma(-n, 6.12323399573676603587e-17, r);
    const double r2 = r * r;
    double sp = 1.0 / 6227020800.0; sp = __builtin_fma(sp, r2, -1.0 / 39916800.0); sp = __builtin_fma(sp, r2, 1.0 / 362880.0); sp = __builtin_fma(sp, r2, -1.0 / 5040.0);
    sp = __builtin_fma(sp, r2, 1.0 / 120.0); sp = __builtin_fma(sp, r2, -1.0 / 6.0); sp = __builtin_fma(sp * r2, r, r);
    double cp = 1.0 / 479001600.0; cp = __builtin_fma(cp, r2, -1.0 / 3628800.0); cp = __builtin_fma(cp, r2, 1.0 / 40320.0); cp = __builtin_fma(cp, r2, -1.0 / 720.0);
    cp = __builtin_fma(cp, r2, 1.0 / 24.0); cp = __builtin_fma(cp, r2, -0.5); cp = __builtin_fma(cp, r2, 1.0);
    const int q = ((int)n) & 3;
    const double s_ = (q & 1) ? cp : sp, c_ = (q & 1) ? sp : cp;
    sn = (float)((q & 2) ? -s_ : s_); cs = (float)(((q + 1) & 2) ? -c_ : c_);
}

__device__ __forceinline__ int src_quad(int kind, int n, int coff) {
    if (kind == 0) return coff + n;
    if (kind == 1) {
        if (n < 768 || (n >= 2112 && n < 2368)) return n;
        if (n >= 2368) return -1;
        int base, half, j;
        if (n < 832) { base = 768; half = 32; j = n - 768; } else if (n < 1856) { j = (n - 832) & 127; base = n - j; half = 64; } else { j = (n - 1856) & 127; base = n - j; half = 64; }
        const int g = j >> 3, e = j & 7; return base + (e < 4 ? 4 * g : half + 4 * g);
    }
    { const int head = n / 192, j = n - head * 192; if (j < 128) return n; const int jj = j - 128, g = jj >> 3, e = jj & 7; return head * 192 + 128 + (e < 4 ? 4 * g : 32 + 4 * g); }
}
__device__ __forceinline__ void tr_item(const float* __restrict__ src, int Nsrc, int K, bf16_t* __restrict__ dst, int k0, int n0, int kind, int coff,
                                        const float* __restrict__ gain, const float* __restrict__ gain2, LAS unsigned* scr, int lane) {
    const int nl = 4 * (lane & 15), ks = lane >> 4;
    const int sq = src_quad(kind, n0 + nl, coff);
#pragma unroll 4
    for (int r = 0; r < 16; ++r) {
        const int k = k0 + 8 * r + 2 * ks;
        f32x4 a = (f32x4){0.f, 0.f, 0.f, 0.f}, b = a;
        if (sq >= 0) { a = *(const f32x4*)(src + (size_t)k * Nsrc + sq); b = *(const f32x4*)(src + (size_t)(k + 1) * Nsrc + sq); }
        if (gain) { const float ga = (gain2 && k >= 1024) ? gain2[k - 1024] : gain[k], gb = (gain2 && k + 1 >= 1024) ? gain2[k + 1 - 1024] : gain[k + 1]; a *= ga; b *= gb; }
#pragma unroll
        for (int j = 0; j < 4; ++j) scr[(nl + j) * 65 + 4 * r + ks] = cvt_pk_bf16(a[j], b[j]);
    }
    asm volatile("s_waitcnt lgkmcnt(0)" ::: "memory");
#pragma unroll 4
    for (int it = 0; it < 16; ++it) {
        const int row = it * 4 + (lane >> 4), ch = lane & 15;
        const LAS unsigned* p = scr + row * 65 + 4 * ch;
        u32x4 w; w.x = p[0]; w.y = p[1]; w.z = p[2]; w.w = p[3];
        *(u32x4*)(dst + (size_t)(n0 + row) * K + k0 + 8 * ch) = w;
    }
    asm volatile("s_waitcnt lgkmcnt(0)" ::: "memory");
}
__device__ __forceinline__ void tr_item8(const float* __restrict__ src, int Nsrc, int K, unsigned char* __restrict__ dst, int k0, int n0, int scol, float scale, LAS unsigned* scr, int lane) {
    const int nl = 4 * (lane & 15), ks = lane >> 4;
#pragma unroll 4
    for (int r = 0; r < 16; ++r) {
        const int k = k0 + 16 * r + 4 * ks; const float* p = src + (size_t)k * Nsrc + scol + nl;
        const f32x4 a = *(const f32x4*)p * scale, b = *(const f32x4*)(p + Nsrc) * scale, c = *(const f32x4*)(p + 2 * (size_t)Nsrc) * scale, d = *(const f32x4*)(p + 3 * (size_t)Nsrc) * scale;
#pragma unroll
        for (int j = 0; j < 4; ++j) scr[(nl + j) * 65 + 4 * r + ks] = pk_fp8x4(a[j], b[j], c[j], d[j]);
    }
    asm volatile("s_waitcnt lgkmcnt(0)" ::: "memory");
#pragma unroll 4
    for (int it = 0; it < 16; ++it) {
        const int row = it * 4 + (lane >> 4), ch = lane & 15;
        const LAS unsigned* p = scr + row * 65 + 4 * ch;
        u32x4 w; w.x = p[0]; w.y = p[1]; w.z = p[2]; w.w = p[3];
        *(u32x4*)(dst + (size_t)(n0 + row) * K + k0 + 16 * ch) = w;
    }
    asm volatile("s_waitcnt lgkmcnt(0)" ::: "memory");
}
__device__ __forceinline__ void tr_item6(const float* __restrict__ src, int Nsrc, unsigned char* __restrict__ dst, int t, int n0, int scol, LAS unsigned* scr, int lane) {
    const int nl = 4 * (lane & 15), ks = lane >> 4;
    f32x4 a[16], b[16];
#pragma unroll
    for (int r = 0; r < 16; ++r) {
        const int kk = 8 * r + 2 * ks, k = 16 * t + 256 * (kk >> 4) + (kk & 15); const float* p = src + (size_t)k * Nsrc + scol + nl;
        a[r] = __builtin_nontemporal_load((const f32x4*)p); b[r] = __builtin_nontemporal_load((const f32x4*)(p + Nsrc));
    }
#pragma unroll
    for (int r = 0; r < 16; ++r) {
#pragma unroll
        for (int j = 0; j < 4; ++j) scr[(nl + j) * 65 + 4 * r + ks] = cvt_pk_bf16(a[r][j], b[r][j]);
    }
    asm volatile("s_waitcnt lgkmcnt(0)" ::: "memory");
#pragma unroll 1
    for (int it = 0; it < 4; ++it) {
        const int pidx = it * 64 + lane, n = pidx >> 2, g = pidx & 3;
        const LAS unsigned* p = scr + n * 65 + 2 * g;
        f32x16 lo, hi;
#pragma unroll
        for (int j = 0; j < 8; ++j) { const unsigned d0 = p[8 * j], d1 = p[8 * j + 1];
            const float x0 = __uint_as_float(d0 << 16), x1 = __uint_as_float(d0 & 0xffff0000u), x2 = __uint_as_float(d1 << 16), x3 = __uint_as_float(d1 & 0xffff0000u);
            if (j < 4) { lo[4 * j] = x0; lo[4 * j + 1] = x1; lo[4 * j + 2] = x2; lo[4 * j + 3] = x3; } else { hi[4 * (j - 4)] = x0; hi[4 * (j - 4) + 1] = x1; hi[4 * (j - 4) + 2] = x2; hi[4 * (j - 4) + 3] = x3; } }
        unsigned sb; const u32x6 q = mx6_block(lo, hi, sb);
        unsigned char* o = dst + (size_t)(n0 + n) * 2048 + t * 128 + 16 * g;
        *(u32x4*)o = (u32x4){q[0], q[1], q[2], q[3]}; *(u32x4*)(o + 64) = (u32x4){q[4], q[5], sb, 0u};
    }
    asm volatile("s_waitcnt lgkmcnt(0)" ::: "memory");
}
__device__ __forceinline__ void tr_item6c(const float* __restrict__ src, int Nsrc, int K, unsigned char* __restrict__ dst, int t, int n0, LAS unsigned* scr, int lane) {
    const int nl = 4 * (lane & 15), ks = lane >> 4;
    f32x4 a[16], b[16];
#pragma unroll
    for (int r = 0; r < 16; ++r) {
        const int k = 128 * t + 8 * r + 2 * ks; const float* p = src + (size_t)k * Nsrc + n0 + nl;
        a[r] = __builtin_nontemporal_load((const f32x4*)p); b[r] = __builtin_nontemporal_load((const f32x4*)(p + Nsrc));
    }
#pragma unroll
    for (int r = 0; r < 16; ++r) {
#pragma unroll
        for (int j = 0; j < 4; ++j) scr[(nl + j) * 65 + 4 * r + ks] = cvt_pk_bf16(a[r][j], b[r][j]);
    }
    asm volatile("s_waitcnt lgkmcnt(0)" ::: "memory");
#pragma unroll 1
    for (int it = 0; it < 4; ++it) {
        const int pidx = it * 64 + lane, n = pidx >> 2, g = pidx & 3;
        const LAS unsigned* p = scr + n * 65 + 16 * g;
        f32x16 lo, hi;
#pragma unroll
        for (int j = 0; j < 8; ++j) { const unsigned d0 = p[j], d1 = p[8 + j];
            lo[2 * j] = __uint_as_float(d0 << 16); lo[2 * j + 1] = __uint_as_float(d0 & 0xffff0000u); hi[2 * j] = __uint_as_float(d1 << 16); hi[2 * j + 1] = __uint_as_float(d1 & 0xffff0000u); }
        unsigned sb; const u32x6 q = mx6_block(lo, hi, sb);
        unsigned char* o = dst + (size_t)(n0 + n) * K + t * 128 + 16 * g;
        *(u32x4*)o = (u32x4){q[0], q[1], q[2], q[3]}; *(u32x4*)(o + 64) = (u32x4){q[4], q[5], sb, 0u};
    }
    asm volatile("s_waitcnt lgkmcnt(0)" ::: "memory");
}
__device__ __forceinline__ void tr_matrix6c(const float* src, int Nsrc, int K, unsigned char* dst, int Ndst, LAS unsigned* scr, int lane, int gw, int NGW, int& cursor) {
    const int nb = Ndst / 64, items = (K / 128) * nb;
    int it = (gw - (cursor % NGW) + NGW) % NGW;
    for (; it < items; it += NGW) tr_item6c(src, Nsrc, K, dst, it / nb, (it % nb) * 64, scr, lane);
    cursor += items;
}
__device__ __forceinline__ void tr_matrix6(const float* src, const float* src2, int Nsrc, unsigned char* dst, int Ndst, LAS unsigned* scr, int lane, int gw, int NGW, int& cursor) {
    const int nb = Ndst / 64, items = 16 * nb;
    int it = (gw - (cursor % NGW) + NGW) % NGW;
    for (; it < items; it += NGW) {
        const int t = it / nb, n0 = (it % nb) * 64, tile = n0 >> 8, j0 = n0 & 255;
        tr_item6(j0 < 128 ? src : src2, Nsrc, dst, t, n0, 128 * tile + (j0 & 127), scr, lane);
    }
    cursor += items;
}
__device__ __forceinline__ void tr_matrix8(const float* src, const float* src2, int Nsrc, int K, unsigned char* dst, int Ndst, int inter, float scale, LAS unsigned* scr, int lane, int gw, int NGW, int& cursor) {
    const int nb = Ndst / 64, items = (K / 256) * nb;
    int it = (gw - (cursor % NGW) + NGW) % NGW;
    for (; it < items; it += NGW) {
        const int kb = it / nb, n0 = (it % nb) * 64;
        if (inter) { const int tile = n0 >> 8, j0 = n0 & 255; tr_item8(j0 < 128 ? src : src2, Nsrc, K, dst, kb * 256, n0, 128 * tile + (j0 & 127), scale, scr, lane); }
        else tr_item8(src, Nsrc, K, dst, kb * 256, n0, n0, scale, scr, lane);
    }
    cursor += items;
}
__device__ __forceinline__ void tr_matrix(const float* src, const float* src2, int Nsrc, int K, bf16_t* dst, int Ndst, int kind, const float* gain, const float* gain2,
                                          LAS unsigned* scr, int lane, int gw, int NGW, int& cursor) {
    const int nb = Ndst / 64, items = (K / 128) * nb;
    int it = (gw - (cursor % NGW) + NGW) % NGW;
    for (; it < items; it += NGW) {
        const int kb = it / nb, n0 = (it % nb) * 64;
        if (kind == 3) { const int tile = n0 >> 8, j0 = n0 & 255; tr_item(j0 < 128 ? src : src2, Nsrc, K, dst, kb * 128, n0, 0, 128 * tile + (j0 & 127) - n0, nullptr, nullptr, scr, lane); }
        else tr_item(src, Nsrc, K, dst, kb * 128, n0, kind, 0, gain, gain2, scr, lane);
    }
    cursor += items;
}

constexpr int MOE_GU_ITEMS = 16 * (2 * FFE / 64), MOE_D_ITEMS = (FFE / 128) * (D / 64), MOE_E_ITEMS = MOE_GU_ITEMS + MOE_D_ITEMS, MOE_ITEMS = NE * MOE_E_ITEMS;
__device__ __forceinline__ void moe_conv_item(const Args& args, int j, LAS unsigned* scr, int lane) {
    const int e = j / MOE_E_ITEMS, r = j - e * MOE_E_ITEMS;
    if (r < MOE_GU_ITEMS) {
        constexpr int nb = 2 * FFE / 64;
        const int t = r / nb, n0 = (r % nb) * 64, tile = n0 >> 8, j0 = n0 & 255;
        tr_item6((j0 < 128 ? args.in[16] : args.in[17]) + (size_t)e * D * FFE, FFE, args.ws + WS_WMGU + (size_t)e * 2 * FFE * D, t, n0, 128 * tile + (j0 & 127), scr, lane);
    } else {
        const int r2 = r - MOE_GU_ITEMS, t = r2 / (D / 64), n0 = (r2 % (D / 64)) * 64;
        tr_item6c(args.in[18] + (size_t)e * FFE * D, D, FFE, args.ws + WS_WMD + (size_t)e * D * FFE, t, n0, scr, lane);
    }
}
__device__ __forceinline__ void moe_conv_burst(const Args& args, LAS unsigned char* lds, int part, int nparts) {
    const int tid = tid_opaque(), lane = tid & 63, wave = tid >> 6, gw = blockIdx.x * NWAVES + wave, NGW = gridDim.x * NWAVES;
    LAS unsigned* scr = (LAS unsigned*)(lds + wave * 16640);
    const int per = (MOE_ITEMS + NGW - 1) / NGW, i0 = per * part / nparts, i1 = per * (part + 1) / nparts;
    __syncthreads();
    for (int i = i0; i < i1; ++i) { const int j = gw + i * NGW; if (j < MOE_ITEMS) moe_conv_item(args, j, scr, lane); }
    __syncthreads();
}

__device__ __forceinline__ void ln_row(f32x4 (&v)[8], const float* __restrict__ g, const float* __restrict__ b, int lane, float& mean_o, float& rstd_o) {
    float s = 0.f;
#pragma unroll
    for (int j = 0; j < 8; ++j) s += (v[j][0] + v[j][1]) + (v[j][2] + v[j][3]);
    const float mean = wave_sum(s) * (1.f / D); float s2 = 0.f;
#pragma unroll
    for (int j = 0; j < 8; ++j) { v[j] = v[j] - mean; s2 += (v[j][0] * v[j][0] + v[j][1] * v[j][1]) + (v[j][2] * v[j][2] + v[j][3] * v[j][3]); }
    const float rstd = 1.f / sqrtf(wave_sum(s2) * (1.f / D) + LN_EPS); mean_o = mean; rstd_o = rstd;
#pragma unroll
    for (int j = 0; j < 8; ++j) { const f32x4 gg = *((const f32x4*)g + lane + 64 * j), bb = *((const f32x4*)b + lane + 64 * j); v[j] = v[j] * rstd * gg + bb; }
}

#define WSP(T, off) ((T*)(args.ws + (off)))
#define IN(k) (lo <= (k) && (k) < hi)
#define SEAM(k) do { if (IN(k) && IN((k) + 1)) { XcdBarrier b_; b_.bar = WSP(unsigned, WS_CTL) + CW_BAR; b_.x = xb_xcc_id(); b_.st = (volatile LAS unsigned*)(lds + MISC_OFF) + 8; xcd_barrier(b_); } } while (0)

__device__ __forceinline__ int moe_unit_table(const int* moemeta, int NT, LAS int* utab) {
    const int tid = tid_opaque();
    pg8::MoeOrder Mo;
#pragma unroll
    for (int e = 0; e <= NE; ++e) Mo.pb[e] = moemeta[e];
    Mo.NT = NT; Mo.G = gridDim.x; Mo.c = blockIdx.x; Mo.nwg = Mo.pb[NE] * NT;
    if (tid < 64) { pg8::Unit u; u.pm = 0; u.pn = 0; u.aux = 0; Mo.next(tid, u); utab[4 * tid] = u.pm; utab[4 * tid + 1] = u.pn; utab[4 * tid + 2] = u.aux; }
    __syncthreads();
    const int left = Mo.nwg - Mo.c; int n = left <= 0 ? 0 : (left + Mo.G - 1) / Mo.G;
    return __builtin_amdgcn_readfirstlane(n < 64 ? n : 64);
}
__device__ __forceinline__ f32x4 tail_sum(const bf16_t* yp, int t, int d, int lane, int SK) {
    f32x4 acc = {0.f, 0.f, 0.f, 0.f};
    for (int q = 0; q < SK; ++q) { const u32x2 a = *((const u32x2*)(yp + ((size_t)(q * 128 + t - 1) * 256 + (d & 255)) * 256) + lane);
        acc += (f32x4){__uint_as_float(a.x << 16), __uint_as_float(a.x & 0xffff0000u), __uint_as_float(a.y << 16), __uint_as_float(a.y & 0xffff0000u)}; }
    return acc;
}
__device__ __forceinline__ int moe_tail_split(int nwg, int G, int& Rf, int& Tn) {
    Rf = nwg / G; Tn = nwg - Rf * G;
    return Tn == 0 ? 1 : (Tn * 7 <= G ? 7 : (Tn * 4 <= G ? 4 : (Tn * 2 <= G ? 2 : 1)));
}
__device__ __forceinline__ int moe_unit_table_k(const int* moemeta, int NT, LAS int* utab, unsigned char* tailmap) {
    const int tid = tid_opaque();
    pg8::MoeOrder Mo;
#pragma unroll
    for (int e = 0; e <= NE; ++e) Mo.pb[e] = moemeta[e];
    Mo.NT = NT; Mo.G = gridDim.x; Mo.c = blockIdx.x; Mo.nwg = Mo.pb[NE] * NT;
    int Rf, Tn; const int SK = moe_tail_split(Mo.nwg, Mo.G, Rf, Tn);
    const int R = Rf < 63 ? Rf : 63;
    const bool piece = SK > 1 ? (Mo.c < Tn * SK) : (Mo.c < Tn);
    if (tid < 64) {
        long Lq = -1; int kx = 0, mark = 0;
        if (tid < R) Lq = (long)tid * Mo.G + Mo.c;
        else if (tid == R && piece) {
            if (SK == 1) Lq = (long)Rf * Mo.G + Mo.c;
            else { const int j = Mo.c / SK, q = Mo.c - j * SK; Lq = (long)Rf * Mo.G + j; kx = (1 + j) | (q << 8) | (SK << 16); mark = (q == 0) ? 1 + j : 0; }
        }
        pg8::Unit u; u.pm = 0; u.pn = 0; u.aux = 0; u.kx = 0;
        if (Lq >= 0) Mo.at(Lq, u);
        if (mark) tailmap[u.pm * 8 + u.aux] = (unsigned char)mark;
        utab[4 * tid] = u.pm; utab[4 * tid + 1] = u.pn; utab[4 * tid + 2] = u.aux; utab[4 * tid + 3] = kx;
    }
    __syncthreads();
    return __builtin_amdgcn_readfirstlane(R + (piece ? 1 : 0));
}
template <int L>
__device__ __forceinline__ void layer_phases(const Args& args, LAS unsigned char* lds, char* lds_gen, int lo, int hi) {
    constexpr int pb = 1 + 10 * L;
    if (IN(pb + 0)) {
        const int G = gridDim.x, bx = blockIdx.x;
        pg8::Gemm g{WSP(const bf16_t, WS_XB), WSP(const bf16_t, WS_WIN + L * SZ_WIN), D}; pg8::StaticOrder So; So.init(S, 2048, G, bx);
        pg8::EpiInProj E{WSP(bf16_t, WS_CQ), WSP(bf16_t, WS_CKV), WSP(bf16_t, WS_KPE), WSP(bf16_t, WS_QS), WSP(bf16_t, WS_KS), WSP(bf16_t, WS_VS), WSP(float, WS_PARTQ), WSP(float, WS_PARTKV),
                         WSP(const float, WS_COSM), WSP(const float, WS_SINM), WSP(const float, WS_COSS), WSP(const float, WS_SINS)};
        pg8::gemm_phase<pg8::EpiInProj, pg8::StaticOrder, true, true>(lds, g, So, E);
    }
    SEAM(pb + 0);
    if (IN(pb + 1)) {
        const int G = gridDim.x, bx = blockIdx.x;
        LAS int* utab = (LAS int*)(lds + MISC_OFF + 1024);
        LAS int* ucnt = (LAS int*)(lds + MISC_OFF + 1024 + 3072);
        if (tid_opaque() == 0) {
            int nl = 0, nq = 0, nk = 0;
            if (G == 256) {
                if (bx < 128) { utab[0] = bx >> 1; utab[1] = 8 + (bx & 1); utab[2] = 8 + (bx & 1); nl = 1; utab[128] = bx >> 3; utab[129] = bx & 7; utab[130] = bx & 7; nk = 1; }
                else { const int c = bx - 128;
                    for (int i = 0; i < 3; ++i) { const int u = 3 * c + i; utab[64 + 4 * i] = u / 6; utab[65 + 4 * i] = u % 6; utab[66 + 4 * i] = u % 6; }
                    nq = 3;
                    for (int i = 0; i < 3; ++i) { const int u = 128 + 3 * c + i; utab[128 + 4 * i] = u >> 3; utab[129 + 4 * i] = u & 7; utab[130 + 4 * i] = u & 7; }
                    nk = 3; }
            } else {
                for (int u = bx; u < 128 && nl < 16; u += G, ++nl) { utab[4 * nl] = u >> 1; utab[4 * nl + 1] = 8 + (u & 1); utab[4 * nl + 2] = 8 + (u & 1); }
                for (int u = bx; u < 384 && nq < 16; u += G, ++nq) { utab[64 + 4 * nq] = u / 6; utab[65 + 4 * nq] = u % 6; utab[66 + 4 * nq] = u % 6; }
                for (int u = bx; u < 512 && nk < 16; u += G, ++nk) { utab[128 + 4 * nk] = u >> 3; utab[129 + 4 * nk] = u & 7; utab[130 + 4 * nk] = u & 7; }
            }
            ucnt[0] = nl; ucnt[1] = nq; ucnt[2] = nk;
        }
        __syncthreads();
        { pg8::TableOrder To{utab, __builtin_amdgcn_readfirstlane(ucnt[0])};
          pg8::Gemm g{WSP(const bf16_t, WS_XB), WSP(const bf16_t, WS_WIN + L * SZ_WIN), D};
          pg8::EpiInProj E{WSP(bf16_t, WS_CQ), WSP(bf16_t, WS_CKV), WSP(bf16_t, WS_KPE), WSP(bf16_t, WS_QS), WSP(bf16_t, WS_KS), WSP(bf16_t, WS_VS), WSP(float, WS_PARTQ), WSP(float, WS_PARTKV),
                           WSP(const float, WS_COSM), WSP(const float, WS_SINM), WSP(const float, WS_COSS), WSP(const float, WS_SINS)};
          pg8::gemm_phase<pg8::EpiInProj, pg8::TableOrder, true, true>(lds, g, To, E); }
        { pg8::TableOrder To{utab + 64, __builtin_amdgcn_readfirstlane(ucnt[1])};
          pg8::Gemm g{WSP(const bf16_t, WS_CQ), WSP(const bf16_t, WS_WQ + L * SZ_WQ), QLORA};
          pg8::EpiQ E{WSP(bf16_t, WS_Q), WSP(const float, WS_PARTQ), WSP(const float, WS_COSM), WSP(const float, WS_SINM)};
          pg8::gemm_phase<pg8::EpiQ, pg8::TableOrder, true, true>(lds, g, To, E); }
        { pg8::TableOrder To{utab + 128, __builtin_amdgcn_readfirstlane(ucnt[2])};
          pg8::Gemm g{WSP(const bf16_t, WS_CKV), WSP(const bf16_t, WS_WKV + L * SZ_WKV), KVLORA};
          pg8::EpiKV E{WSP(bf16_t, WS_KV), WSP(const float, WS_PARTKV)};
          pg8::gemm_phase<pg8::EpiKV, pg8::TableOrder, true, true>(lds, g, To, E); }
    }
    SEAM(pb + 1);
    if (IN(pb + 2)) {
        const int G = gridDim.x, bx = blockIdx.x;
        const int slot = bx % 3; bool pending = true;
        for (int step = 0; ; ++step) {
            const int u = bx + step * G; const bool more = u < 512;
            if (pending && (step == slot || !more)) { moe_conv_burst(args, lds, L, DEPTH); pending = false; }
            if (!more) break;
            const int r = u / 256, c = u % 256, head = 4 * r + ((c & 7) >> 1), qblk = (c >> 3) + 32 * (c & 1);
            att::attn_body<192, false, QCOLS, KVCOLS, 64, KVCOLS, D>(WSP(const bf16_t, WS_Q) + (size_t)qblk * 256 * QCOLS + head * 192, WSP(const bf16_t, WS_KV) + head * 256, WSP(const bf16_t, WS_KPE),
                WSP(const bf16_t, WS_KV) + head * 256 + 128, WSP(bf16_t, WS_OBUF) + (size_t)qblk * 256 * D + head * 128, WSP(float, WS_PARTO) + (size_t)qblk * 256 * 16 + head, qblk * 256, 0, S / 64, SCALE_MLA, 0.f, (LAS char*)lds);
        }
        for (int u = bx; u < 512; u += G) {
            const int head = u >> 6, qblk = u & 63;
            int t0 = 4 * qblk - 2, t1 = 4 * qblk + 5; if (t0 < 0) t0 = 0; if (t1 > S / 64 - 1) t1 = S / 64 - 1;
            const float sk = (args.in[6] + L * 8)[head];
            att::attn_body<128, true, 1024, 256, 64, 256, D>(WSP(const bf16_t, WS_QS) + (size_t)qblk * 256 * 1024 + head * 128, WSP(const bf16_t, WS_KS) + (head >> 2) * 128, nullptr, WSP(const bf16_t, WS_VS) + (head >> 2) * 128,
                WSP(bf16_t, WS_OBUF) + (size_t)qblk * 256 * D + 1024 + head * 128, WSP(float, WS_PARTO) + (size_t)qblk * 256 * 16 + 8 + head, qblk * 256, t0 * 64, t1 - t0 + 1, SCALE_SWA, sk / SCALE_SWA, (LAS char*)lds);
        }
    }
    SEAM(pb + 2);
    if (IN(pb + 4)) {
        const int G = gridDim.x, bx = blockIdx.x;
        pg8::Gemm g{WSP(const bf16_t, WS_OBUF), WSP(const bf16_t, WS_WOUT + L * SZ_WOUT), D}; pg8::StaticOrder So; So.init(S, D, G, bx);
        if constexpr (L == 0) { pg8::EpiOutProj<false> E{args.in[0], WSP(float, WS_XA), WSP(const float, WS_PARTO), nullptr, nullptr, nullptr}; pg8::gemm_phase<pg8::EpiOutProj<false>, pg8::StaticOrder, true, true>(lds, g, So, E); }
        else { pg8::EpiOutProj<true> E{WSP(const float, WS_XA), WSP(float, WS_XA), WSP(const float, WS_PARTO), WSP(const float, WS_ST2), args.in[19] + (L - 1) * D, args.in[20] + (L - 1) * D};
               pg8::gemm_phase<pg8::EpiOutProj<true>, pg8::StaticOrder, true, true>(lds, g, So, E); }
    }
    SEAM(pb + 4);
    if (IN(pb + 5)) {
        const int tid = tid_opaque(), lane = tid & 63, wave = tid >> 6, G = gridDim.x, bx = blockIdx.x;
        const float* lg = args.in[10] + L * D; const float* lb = args.in[11] + L * D;
        float* XA = WSP(float, WS_XA); unsigned* X8 = WSP(unsigned, WS_X8);
        const int RPW = (S + G - 1) / G, r0 = bx * RPW, r1 = (r0 + RPW < S) ? r0 + RPW : S;
        LAS float* wr_l = (LAS float*)lds; LAS int* hist = (LAS int*)(lds + 65536);
        if (L == 1) { const float* wrg = args.in[15]; for (int i = tid; i < D * NE; i += 512) wr_l[i] = wrg[i]; if (tid < NE) hist[tid] = 0; __syncthreads(); }
        for (int row = r0 + wave; row < r1; row += NWAVES) {
            f32x4 v[8]; float* xr = XA + (size_t)row * D;
#pragma unroll
            for (int j = 0; j < 8; ++j) v[j] = *((const f32x4*)xr + lane + 64 * j);
            float mu_, rs_; ln_row(v, lg, lb, lane, mu_, rs_);
            if (lane == 0) { float* st = WSP(float, WS_ST1); st[2 * row] = mu_; st[2 * row + 1] = rs_; }
            { f32x16 lo, hi;
#pragma unroll
              for (int j = 0; j < 4; ++j)
#pragma unroll
                  for (int c = 0; c < 4; ++c) { lo[4 * j + c] = v[j][c]; hi[4 * j + c] = v[4 + j][c]; }
              unsigned sb; const u32x6 q = mx6_block(lo, hi, sb);
              unsigned char* o = (unsigned char*)X8 + (size_t)row * D + (lane >> 2) * 128 + 16 * (lane & 3);
              *(u32x4*)o = (u32x4){q[0], q[1], q[2], q[3]}; *(u32x4*)(o + 64) = (u32x4){q[4], q[5], sb, 0u}; }
            if (L == 1) {
                float q0 = 0.f, q1 = 0.f, q2 = 0.f, q3 = 0.f, q4 = 0.f, q5 = 0.f, q6 = 0.f, q7 = 0.f;
#pragma unroll
                for (int j = 0; j < 8; ++j)
#pragma unroll
                    for (int k = 0; k < 4; ++k) { const LAS f32x4* w = (const LAS f32x4*)(wr_l + (size_t)(4 * (lane + 64 * j) + k) * NE); const f32x4 w0 = w[0], w1 = w[1]; const float xv = v[j][k];
                        q0 += xv * w0[0]; q1 += xv * w0[1]; q2 += xv * w0[2]; q3 += xv * w0[3]; q4 += xv * w1[0]; q5 += xv * w1[1]; q6 += xv * w1[2]; q7 += xv * w1[3]; }
                q0 = wave_sum(q0); q1 = wave_sum(q1); q2 = wave_sum(q2); q3 = wave_sum(q3); q4 = wave_sum(q4); q5 = wave_sum(q5); q6 = wave_sum(q6); q7 = wave_sum(q7);
                int e0 = 0; float l0 = q0;
                if (q1 > l0) { l0 = q1; e0 = 1; } if (q2 > l0) { l0 = q2; e0 = 2; } if (q3 > l0) { l0 = q3; e0 = 3; } if (q4 > l0) { l0 = q4; e0 = 4; } if (q5 > l0) { l0 = q5; e0 = 5; } if (q6 > l0) { l0 = q6; e0 = 6; } if (q7 > l0) { l0 = q7; e0 = 7; }
                int e1 = -1; float l1 = -3.0e38f;
                if (e0 != 0 && q0 > l1) { l1 = q0; e1 = 0; } if (e0 != 1 && q1 > l1) { l1 = q1; e1 = 1; } if (e0 != 2 && q2 > l1) { l1 = q2; e1 = 2; } if (e0 != 3 && q3 > l1) { l1 = q3; e1 = 3; }
                if (e0 != 4 && q4 > l1) { l1 = q4; e1 = 4; } if (e0 != 5 && q5 > l1) { l1 = q5; e1 = 5; } if (e0 != 6 && q6 > l1) { l1 = q6; e1 = 6; } if (e0 != 7 && q7 > l1) { l1 = q7; e1 = 7; }
                const float t = __expf(l1 - l0), g0 = 1.0f / (1.0f + t), g1 = t / (1.0f + t);
                if (lane == 0) { int* sel = WSP(int, WS_SEL); float* gate = WSP(float, WS_GATE); sel[2 * row] = e0; sel[2 * row + 1] = e1; gate[2 * row] = g0; gate[2 * row + 1] = g1;
                    __hip_atomic_fetch_add(hist + e0, 1, __ATOMIC_RELAXED, __HIP_MEMORY_SCOPE_WORKGROUP); __hip_atomic_fetch_add(hist + e1, 1, __ATOMIC_RELAXED, __HIP_MEMORY_SCOPE_WORKGROUP); }
            }
        }
        if (L == 1) { __syncthreads(); if (tid < NE) WSP(int, WS_WGCNT)[bx * NE + tid] = hist[tid]; }
    }
    SEAM(pb + 5);
    if constexpr (L == 0) {
        if (IN(pb + 7)) {
            const int G = gridDim.x, bx = blockIdx.x;
            pg8::Gemm g{WSP(const bf16_t, WS_X8), WSP(const bf16_t, WS_WGU), D}; pg8::StaticOrder So; So.init(S, 2 * FF, G, bx);
            pg8::EpiSwiglu6 E{WSP(unsigned char, WS_H), FF};
            pg8::gemm_phase<pg8::EpiSwiglu6, pg8::StaticOrder, true, true, 2>(lds, g, So, E);
        }
        SEAM(pb + 7);
        if (IN(pb + 8)) {
            const int G = gridDim.x, bx = blockIdx.x;
            pg8::Gemm g{WSP(const bf16_t, WS_H), WSP(const bf16_t, WS_WD), FF}; pg8::StaticOrder So; So.init(S, D, G, bx);
            pg8::EpiResidLN E{WSP(const float, WS_XA), WSP(float, WS_XA), 1.0f, WSP(const float, WS_ST1), args.in[10] + L * D, args.in[11] + L * D};
            pg8::gemm_phase<pg8::EpiResidLN, pg8::StaticOrder, true, true, 2>(lds, g, So, E);
        }
        SEAM(pb + 8);
        if (IN(pb + 9)) {
            const int tid = tid_opaque(), lane = tid & 63, gw = blockIdx.x * NWAVES + (tid >> 6), NGW = gridDim.x * NWAVES;
            const float* lg = args.in[19] + L * D; const float* lb = args.in[20] + L * D; float* XA = WSP(float, WS_XA); bf16_t* XB = WSP(bf16_t, WS_XB);
            for (int row = gw; row < S; row += NGW) {
                f32x4 v[8]; float* xr = XA + (size_t)row * D;
#pragma unroll
                for (int j = 0; j < 8; ++j) v[j] = *((const f32x4*)xr + lane + 64 * j);
                float mu_, rs_; ln_row(v, lg, lb, lane, mu_, rs_);
                if (lane == 0) { float* st = WSP(float, WS_ST2); st[2 * row] = mu_; st[2 * row + 1] = rs_; }
#pragma unroll
                for (int j = 0; j < 8; ++j) *((u32x2*)(XB + (size_t)row * D) + lane + 64 * j) = pg8::pack4(v[j]);
            }
        }
        SEAM(pb + 9);
    } else {
        if (IN(pb + 6)) {
            const int tid = tid_opaque(), lane = tid & 63, wave = tid >> 6, G = gridDim.x, bx = blockIdx.x;
            const int RPW = (S + G - 1) / G, r0 = bx * RPW, r1 = (r0 + RPW < S) ? r0 + RPW : S, na = 2 * (r1 - r0);
            LAS int* tab = (LAS int*)lds;
            LAS int* basee = (LAS int*)(lds + 32768);
            LAS int* asel = (LAS int*)(lds + 33024);
            LAS int* adst = (LAS int*)(lds + 35072);
            const int* wgcnt = WSP(const int, WS_WGCNT); const int* sel = WSP(const int, WS_SEL);
            for (int i = tid; i < G * NE; i += 512) tab[i] = wgcnt[i];
            for (int i = tid; i < na; i += 512) asel[i] = sel[2 * r0 + i];
            __syncthreads();
            if (tid < NE) { int tot = 0, pre = 0; for (int w = 0; w < G; ++w) { const int c = tab[w * NE + tid]; pre += (w < bx) ? c : 0; tot += c; } basee[32 + tid] = tot; basee[40 + tid] = pre; }
            __syncthreads();
            if (tid == 0) { int p = 0; for (int e = 0; e < NE; ++e) { basee[8 + e] = p; basee[e] = 256 * p + basee[40 + e]; p += (basee[32 + e] + 255) >> 8; } basee[16] = p;
                if (bx == 0) { int* moemeta = WSP(int, WS_MOEMETA); for (int e = 0; e <= NE; ++e) moemeta[e] = basee[8 + e]; } }
            __syncthreads();
            if (tid < NE) { int rk = basee[tid]; for (int i = 0; i < na; ++i) if (asel[i] == tid) adst[i] = rk++; }
            __syncthreads();
            int* dest = WSP(int, WS_DEST); const unsigned char* X8 = WSP(const unsigned char, WS_X8); unsigned char* xs = WSP(unsigned char, WS_XS);
            for (int i = tid; i < na; i += 512) dest[2 * r0 + i] = adst[i];
            if (bx < NE) {
                const int rb = 256 * basee[8 + bx] + basee[32 + bx], re = 256 * basee[9 + bx];
                for (int i = rb * 128 + tid; i < re * 128; i += 512) ((u32x4*)xs)[i] = (u32x4){0u, 0u, 0u, 0u};
            }
            for (int a = wave; a < na; a += NWAVES) { const u32x4* s4 = (const u32x4*)(X8 + (size_t)(r0 + (a >> 1)) * D); u32x4* d4 = (u32x4*)(xs + (size_t)adst[a] * D);
#pragma unroll
                for (int j = 0; j < 2; ++j) d4[lane + 64 * j] = s4[lane + 64 * j]; }
        }
        SEAM(pb + 6);
        if (IN(pb + 7)) {
            LAS int* utab = (LAS int*)(lds + MISC_OFF + 1024);
            const int nun = moe_unit_table(WSP(const int, WS_MOEMETA), 2 * FFE / 256, utab);
            pg8::TableOrder To{utab, nun};
            pg8::Gemm g{WSP(const bf16_t, WS_XS), WSP(const bf16_t, WS_WMGU), D};
            pg8::EpiSwiglu6 E{WSP(unsigned char, WS_H), FFE};
            for (int rep = 0; rep < PROBE_MOEUP; ++rep) pg8::gemm_phase<pg8::EpiSwiglu6, pg8::TableOrder, true, true, 2>(lds, g, To, E);
        }
        SEAM(pb + 7);
        if (IN(pb + 8)) {
            LAS int* utab = (LAS int*)(lds + MISC_OFF + 1024);
            const int nun = moe_unit_table_k(WSP(const int, WS_MOEMETA), D / 256, utab, WSP(unsigned char, WS_TAILMAP));
            pg8::TableOrderK To{utab, nun};
            pg8::Gemm g{WSP(const bf16_t, WS_H), WSP(const bf16_t, WS_WMD), FFE};
            pg8::EpiBf16OutK E{WSP(bf16_t, WS_XS), WSP(bf16_t, WS_YP)};
            pg8::gemm_phase<pg8::EpiBf16OutK, pg8::TableOrderK, true, true, 2>(lds, g, To, E);
        }
        SEAM(pb + 8);
        if (IN(pb + 9)) {
            const int tid = tid_opaque(), lane = tid & 63, gw = blockIdx.x * NWAVES + (tid >> 6), NGW = gridDim.x * NWAVES;
            const float* lg = args.in[19] + L * D; const float* lb = args.in[20] + L * D;
            const int* dest = WSP(const int, WS_DEST); const float* gate = WSP(const float, WS_GATE); const float* XA = WSP(const float, WS_XA); const bf16_t* ys = WSP(const bf16_t, WS_XS);
            const float* st1 = WSP(const float, WS_ST1); const float* g1p = args.in[10] + L * D; const float* b1p = args.in[11] + L * D;
            for (int row = gw; row < S; row += NGW) {
                const int d0 = dest[2 * row], d1 = dest[2 * row + 1]; const float g0 = gate[2 * row], g1 = gate[2 * row + 1]; const float mu1 = st1[2 * row], rs1 = st1[2 * row + 1];
                f32x4 v[8]; const float* xr = XA + (size_t)row * D; const u32x2* y0 = (const u32x2*)(ys + (size_t)d0 * D); const u32x2* y1 = (const u32x2*)(ys + (size_t)d1 * D);
                const u32x2 m0 = *(const u32x2*)(WSP(const unsigned char, WS_TAILMAP) + (d0 >> 8) * 8), m1 = *(const u32x2*)(WSP(const unsigned char, WS_TAILMAP) + (d1 >> 8) * 8);
                const bool anyt = (m0.x | m0.y | m1.x | m1.y) != 0u;
#pragma unroll
                for (int j = 0; j < 8; ++j) { const f32x4 yv = *((const f32x4*)xr + lane + 64 * j); const f32x4 x = (yv - mu1) * rs1 * *((const f32x4*)g1p + lane + 64 * j) + *((const f32x4*)b1p + lane + 64 * j); const u32x2 a = y0[lane + 64 * j], b = y1[lane + 64 * j];
                    f32x4 fa = {__uint_as_float(a.x << 16), __uint_as_float(a.x & 0xffff0000u), __uint_as_float(a.y << 16), __uint_as_float(a.y & 0xffff0000u)};
                    f32x4 fb = {__uint_as_float(b.x << 16), __uint_as_float(b.x & 0xffff0000u), __uint_as_float(b.y << 16), __uint_as_float(b.y & 0xffff0000u)};
                    if (anyt) {
                        const int t0 = (int)(((j < 4 ? m0.x : m0.y) >> (8 * (j & 3))) & 255u), t1 = (int)(((j < 4 ? m1.x : m1.y) >> (8 * (j & 3))) & 255u);
                        if (t0 | t1) {
                            const int nwg_ = WSP(const int, WS_MOEMETA)[NE] * (D / 256), G_ = gridDim.x, Tn_ = nwg_ - (nwg_ / G_) * G_, SK = Tn_ * 7 <= G_ ? 7 : (Tn_ * 4 <= G_ ? 4 : 2);
                            if (t0) fa = tail_sum(WSP(const bf16_t, WS_YP), t0, d0, lane, SK);
                            if (t1) fb = tail_sum(WSP(const bf16_t, WS_YP), t1, d1, lane, SK);
                        }
                    }
                    v[j] = x * ALPHA + (fa * g0 + fb * g1); }
                float mu_, rs_; ln_row(v, lg, lb, lane, mu_, rs_);
#pragma unroll
                for (int j = 0; j < 8; ++j) *((f32x4*)(args.out + (size_t)row * D) + lane + 64 * j) = v[j];
            }
        }
    }
}

__global__ void __launch_bounds__(NWAVES * 64, 2) fwd(Args args) {
    extern __shared__ __attribute__((aligned(16))) unsigned char lds_raw[];
    LAS unsigned char* lds = (LAS unsigned char*)lds_raw;
    volatile LAS unsigned* MISC = (volatile LAS unsigned*)(lds + MISC_OFF);
    for (int u = tid_opaque(); u < (LDS_BYTES - MISC_OFF) / 4; u += NWAVES * 64) MISC[u] = 0u;
    __syncthreads();
    (void)xcd_barrier_post(WSP(unsigned, WS_CTL) + CW_BAR, MISC + 8);
    const int lo = args.ph_lo, hi = args.ph_hi;

    if (IN(0)) {
        const int tid = tid_opaque(), lane = tid & 63, wave = tid >> 6, G = gridDim.x, bx = blockIdx.x, gw = bx * NWAVES + wave, NGW = G * NWAVES;
        unsigned char* ws = args.ws;
        LAS unsigned* scr = (LAS unsigned*)(lds + wave * 16640);
        for (int rep = 0; rep < PROBE_PRO; ++rep) {
        int cursor = 0;
        for (int l = 0; l < DEPTH; ++l) {
            tr_matrix(args.in[1] + (size_t)l * D * IN_COLS, nullptr, IN_COLS, D, (bf16_t*)(ws + WS_WIN + l * SZ_WIN), IN_PAD, 1, nullptr, nullptr, scr, lane, gw, NGW, cursor);
            tr_matrix(args.in[3] + (size_t)l * QLORA * QCOLS, nullptr, QCOLS, QLORA, (bf16_t*)(ws + WS_WQ + l * SZ_WQ), QCOLS, 2, args.in[2] + l * QLORA, nullptr, scr, lane, gw, NGW, cursor);
            tr_matrix(args.in[5] + (size_t)l * KVLORA * KVCOLS, nullptr, KVCOLS, KVLORA, (bf16_t*)(ws + WS_WKV + l * SZ_WKV), KVCOLS, 0, args.in[4] + l * KVLORA, nullptr, scr, lane, gw, NGW, cursor);
            tr_matrix(args.in[9] + (size_t)l * D * D, nullptr, D, D, (bf16_t*)(ws + WS_WOUT + l * SZ_WOUT), D, 0, args.in[7] + l * 1024, args.in[8] + l * 1024, scr, lane, gw, NGW, cursor);
        }
        tr_matrix6(args.in[12], args.in[13], FF, ws + WS_WGU, 2 * FF, scr, lane, gw, NGW, cursor);
        tr_matrix6c(args.in[14], D, FF, ws + WS_WD, D, scr, lane, gw, NGW, cursor);
        { const f32x4* x4 = (const f32x4*)args.in[0]; u32x2* o2 = (u32x2*)(ws + WS_XB);
          for (size_t i = (size_t)bx * 512 + tid; i < (size_t)S * D / 4; i += (size_t)G * 512) o2[i] = pg8::pack4(x4[i]); }
        { float* coss = (float*)(ws + WS_COSS); float* sins = (float*)(ws + WS_SINS); float* cosm = (float*)(ws + WS_COSM); float* sinm = (float*)(ws + WS_SINM);
          for (int i = bx * 512 + tid; i < S * 64; i += G * 512) { const int pos = i >> 6, k = i & 63; float sn, cs; sincos_acc((float)pos * INVF[k], sn, cs); coss[i] = cs; sins[i] = sn; }
          for (int i = bx * 512 + tid; i < S * 32; i += G * 512) { const int pos = i >> 5, k = i & 31; float sn, cs; sincos_acc((float)pos * INVF[2 * k], sn, cs); cosm[i] = cs; sinm[i] = sn; } }
        }
    }
    SEAM(0);
    layer_phases<0>(args, lds, (char*)lds_raw, lo, hi);
    layer_phases<1>(args, lds, (char*)lds_raw, lo, hi);
}
#undef IN
#undef SEAM

#ifndef MK_SPLIT
#define MK_SPLIT 0
#endif
extern "C" void kernel_launch(void* const* d_in, const int* in_sizes, int n_in, void* d_out, int out_size, void* d_ws, size_t ws_size, hipStream_t stream) {
    static int grid = 0;
    if (grid == 0) {
        if (n_in != 21 || out_size != S * D || ws_size < WS_END2) { fprintf(stderr, "kernel_launch: unexpected shapes: n_in %d out %d ws %zu (need %zu)\n", n_in, out_size, ws_size, (size_t)WS_END2); grid = -1; return; }
        int dev = 0, cus = 0, per_cu = 0;
        if (hipGetDevice(&dev) != hipSuccess || hipDeviceGetAttribute(&cus, hipDeviceAttributeMultiprocessorCount, dev) != hipSuccess) { grid = -1; return; }
        if (hipFuncSetAttribute((const void*)fwd, hipFuncAttributeMaxDynamicSharedMemorySize, LDS_BYTES) != hipSuccess) { fprintf(stderr, "kernel_launch: hipFuncSetAttribute failed\n"); grid = -1; return; }
        if (hipOccupancyMaxActiveBlocksPerMultiprocessor(&per_cu, (const void*)fwd, NWAVES * 64, LDS_BYTES) != hipSuccess || per_cu < 1) fprintf(stderr, "kernel_launch: occupancy query says %d\n", per_cu);
        (void)hipGetLastError();
        grid = cus;
    }
    if (grid < 0) return;
    (void)hipMemsetAsync((char*)d_ws + WS_CTL, 0, CTL_ZERO_BYTES, stream);
    Args a{};
    for (int i = 0; i < 21; ++i) a.in[i] = (const float*)d_in[i];
    a.out = (float*)d_out; a.ws = (unsigned char*)d_ws;
#if MK_SPLIT
    for (int p = 0; p < NPHASE; ++p) { a.ph_lo = p; a.ph_hi = p + 1; hipLaunchKernelGGL(fwd, dim3(grid), dim3(NWAVES * 64), LDS_BYTES, stream, a); }
#else
    a.ph_lo = 0; a.ph_hi = NPHASE; hipLaunchKernelGGL(fwd, dim3(grid), dim3(NWAVES * 64), LDS_BYTES, stream, a);
#endif
    const hipError_t le = hipPeekAtLastError();
    if (le != hipSuccess) fprintf(stderr, "kernel_launch: launch failed: %s\n", hipGetErrorName(le));
}
```

```cpp
#include <hip/hip_runtime.h>
#include <cstdio>
#include <cstdint>

#define LAS __attribute__((address_space(3)))
#define GAS __attribute__((address_space(1)))
typedef unsigned short bf16_t;
typedef short bf16x8 __attribute__((ext_vector_type(8)));
typedef short s16x4 __attribute__((ext_vector_type(4)));
typedef float f32x4 __attribute__((ext_vector_type(4)));
typedef float f32x16 __attribute__((ext_vector_type(16)));
typedef unsigned u32x4 __attribute__((ext_vector_type(4)));
typedef unsigned u32x2 __attribute__((ext_vector_type(2)));

constexpr int S = 16384, D = 2048, DEPTH = 2;
constexpr int IN_COLS = 2368, IN_PAD = 2560, QCOLS = 1536, KVCOLS = 2048, QLORA = 512, KVLORA = 256;
constexpr int FF = 5632, FFE = 7168, NE = 8;
constexpr int MOE_ROWS = 34816;
constexpr float ALPHA = 1.41421356237309515f, LN_EPS = 1e-5f, RMS_EPS = 1e-6f;
constexpr float SCALE_MLA = 0.07216878364870322f, SCALE_SWA = 0.08838834764831845f;

__device__ __forceinline__ unsigned cvt_pk_bf16(float lo, float hi) { unsigned r; asm volatile("v_cvt_pk_bf16_f32 %0, %1, %2" : "=v"(r) : "v"(lo), "v"(hi)); return r; }

__device__ __forceinline__ unsigned pk_fp8x4(float a, float b, float c, float d) { int w = 0; w = __builtin_amdgcn_cvt_pk_fp8_f32(a, b, w, false); w = __builtin_amdgcn_cvt_pk_fp8_f32(c, d, w, true); return (unsigned)w; }
typedef int v6i32 __attribute__((ext_vector_type(6)));
typedef unsigned u32x6 __attribute__((ext_vector_type(6)));
__device__ __forceinline__ u32x6 mx6_block(const f32x16 lo, const f32x16 hi, unsigned& sb) {
    float am = 0.f;
#pragma unroll
    for (int i = 0; i < 16; ++i) am = fmaxf(am, fmaxf(fabsf(lo[i]), fabsf(hi[i])));
    const unsigned bits = __float_as_uint(am);
    int e = (int)((bits >> 23) & 255u) - 126 - (((bits & 0x7fffffu) <= 0x700000u) ? 3 : 2);
    e = e < -120 ? -120 : e;
    const float scale = __uint_as_float((unsigned)(e + 127) << 23);
    sb = (unsigned)(e + 127) * 0x01010101u;
    u32x6 q;
    asm("v_cvt_scalef32_2xpk16_fp6_f32 %0, %1, %2, %3" : "=&v"(q) : "v"(lo), "v"(hi), "v"(scale));
    return q;
}
constexpr float X8_SCALE = 4.f, W8UP_SCALE = 64.f, W8DN_SCALE = 128.f, H8_SCALE = 16.f;
__device__ __forceinline__ int tid_opaque() { int t = threadIdx.x; asm volatile("" : "+v"(t)); return t; }

constexpr size_t MiB = 1u << 20;
constexpr size_t WS_CTL = 0, CTL_ZERO_BYTES = 1 * MiB;
constexpr size_t WS_COSM = 1 * MiB, WS_SINM = 3 * MiB, WS_COSS = 5 * MiB, WS_SINS = 9 * MiB;
constexpr size_t WS_PARTQ = 13 * MiB, WS_PARTKV = 14 * MiB, WS_PARTO = 15 * MiB;
constexpr size_t WS_SEL = 16 * MiB, WS_GATE = WS_SEL + 128 * 1024, WS_DEST = WS_GATE + 128 * 1024, WS_WGCNT = WS_DEST + 128 * 1024, WS_MOEMETA = WS_WGCNT + 32 * 1024, WS_ST1 = WS_MOEMETA + 4096, WS_ST2 = WS_ST1 + 128 * 1024;
constexpr size_t WS_W = 17 * MiB;
constexpr size_t SZ_WIN = (size_t)IN_PAD * D * 2, SZ_WQ = (size_t)QCOLS * QLORA * 2, SZ_WKV = (size_t)KVCOLS * KVLORA * 2, SZ_WOUT = (size_t)D * D * 2;
constexpr size_t WS_WIN = WS_W, WS_WQ = WS_WIN + 2 * SZ_WIN, WS_WKV = WS_WQ + 2 * SZ_WQ, WS_WOUT = WS_WKV + 2 * SZ_WKV;
constexpr size_t WS_WGU = WS_WOUT + 2 * SZ_WOUT, WS_WD = WS_WGU + (size_t)2 * FF * D, WS_WMGU = WS_WD + (size_t)D * FF;
constexpr size_t WS_WMD = WS_WMGU + (size_t)NE * 2 * FFE * D, WS_XA = WS_WMD + (size_t)NE * D * FFE;
constexpr size_t WS_XB = WS_XA + (size_t)S * D * 4, WS_X8 = WS_XB + (size_t)S * D * 2, WS_SCR = WS_X8 + (size_t)S * D;
constexpr size_t WS_CQ = WS_SCR, WS_CKV = WS_CQ + (size_t)S * 512 * 2, WS_KPE = WS_CKV + (size_t)S * 256 * 2, WS_QS = WS_KPE + (size_t)S * 64 * 2;
constexpr size_t WS_KS = WS_QS + (size_t)S * 1024 * 2, WS_VS = WS_KS + (size_t)S * 256 * 2, WS_Q = WS_VS + (size_t)S * 256 * 2, WS_KV = WS_Q + (size_t)S * QCOLS * 2;
constexpr size_t WS_OBUF = WS_KV + (size_t)S * KVCOLS * 2, WS_ATT_END = WS_OBUF + (size_t)S * D * 2;
constexpr size_t WS_XS = WS_SCR, WS_H = WS_XS + (size_t)MOE_ROWS * D * 2, WS_END0 = WS_H + (size_t)MOE_ROWS * FFE, WS_END = WS_END0 > WS_ATT_END ? WS_END0 : WS_ATT_END;
constexpr size_t WS_YP = (WS_END + 255) / 256 * 256, WS_END2 = WS_YP + (size_t)7 * 128 * 65536 * 2;
constexpr size_t WS_TAILMAP = WS_CTL + 512 * 1024;
static_assert(WS_H + (size_t)S * FF <= WS_END, "scratch union");
static_assert(WS_WIN % 256 == 0 && WS_XA % 256 == 0 && WS_H % 256 == 0 && WS_Q % 256 == 0, "alignment");
constexpr int CW_TMO = 0, CW_BAR = 4096;

#define XB_TMO      128
#define XB_XCNT(j)  (256  + 64 * (j))
#define XB_XSUB(j)  (1280 + 64 * (j))
#define XB_XGEN(j)  (2304 + 64 * (j))
#define XB_TOP      3328
#define XB_TOPGEN   3392
#define XCD_BAR_WORDS 3456
#define XB_SPIN_CAP (1u << 18)
__device__ __forceinline__ unsigned xb_ld(unsigned* p)              { return __hip_atomic_load(p, __ATOMIC_RELAXED, __HIP_MEMORY_SCOPE_AGENT); }
__device__ __forceinline__ unsigned xb_add(unsigned* p, unsigned v) { return __hip_atomic_fetch_add(p, v, __ATOMIC_RELAXED, __HIP_MEMORY_SCOPE_AGENT); }
__device__ __forceinline__ unsigned xb_xcc_id() { return (unsigned)__builtin_amdgcn_s_getreg((3 << 11) | 20) & 0xFu; }
#define XB_SPIN(cond, bar) do { unsigned _sp = 0; while (cond) { __builtin_amdgcn_s_sleep(1); \
    if ((++_sp & 255u) == 0u) { if (xb_ld(&(bar)[XB_TMO])) break; if (_sp > XB_SPIN_CAP) { atomicAdd(&(bar)[XB_TMO], 1u); break; } } } } while (0)
struct XcdBarrier { unsigned* bar; unsigned x; volatile LAS unsigned* st; };
__device__ __forceinline__ XcdBarrier xcd_barrier_post(unsigned* bar, volatile LAS unsigned* st) {
    XcdBarrier b; b.bar = bar; b.x = xb_xcc_id(); b.st = st;
    if (threadIdx.x == 0) (void)xb_add(&bar[XB_XCNT(b.x)], 1u);
    return b;
}
__device__ __forceinline__ void xcd_barrier_complete(unsigned* bar, unsigned x, unsigned& nloc, unsigned& nx) {
    const unsigned G = gridDim.x * gridDim.y * gridDim.z;
    unsigned sum, cnt, mine, sp = 0u;
    for (;;) {
        sum = 0u; cnt = 0u; mine = 0u;
#pragma unroll
        for (unsigned j = 0; j < 16; ++j) { const unsigned c = xb_ld(&bar[XB_XCNT(j)]); sum += c; cnt += (c > 0u) ? 1u : 0u; mine = (j == x) ? c : mine; }
        if (sum == G) break;
        __builtin_amdgcn_s_sleep(1);
        if ((++sp & 255u) == 0u) { if (xb_ld(&bar[XB_TMO])) break; if (sp > XB_SPIN_CAP) { atomicAdd(&bar[XB_TMO], 1u); break; } }
    }
    nloc = mine > 0u ? mine : 1u; nx = cnt > 0u ? cnt : 1u;
}
__device__ __forceinline__ void xcd_barrier(const XcdBarrier& b) {
    asm volatile("s_waitcnt vmcnt(0)" ::: "memory");
    __syncthreads();
    if (threadIdx.x == 0) {
        unsigned* bar = b.bar;
        __builtin_amdgcn_s_waitcnt(0);
        unsigned nloc = b.st[0], nx = b.st[1];
        if (nloc == 0u) { xcd_barrier_complete(bar, b.x, nloc, nx); b.st[0] = nloc; b.st[1] = nx; }
        const unsigned old = xb_add(&bar[XB_XSUB(b.x)], 1u);
        const unsigned gen = old / nloc;
        if (old + 1u == (gen + 1u) * nloc) {
            __builtin_amdgcn_fence(__ATOMIC_RELEASE, "agent");
            asm volatile("s_waitcnt vmcnt(0)" ::: "memory");
            const unsigned og = xb_add(&bar[XB_TOP], 1u);
            const unsigned tg = og / nx;
            if (og + 1u == (tg + 1u) * nx) xb_add(&bar[XB_TOPGEN], 1u);
            else XB_SPIN(xb_ld(&bar[XB_TOPGEN]) == tg, bar);
            __builtin_amdgcn_fence(__ATOMIC_ACQUIRE, "agent");
            xb_add(&bar[XB_XGEN(b.x)], 1u);
            asm volatile("s_waitcnt vmcnt(0)" ::: "memory");
        } else {
            XB_SPIN(xb_ld(&bar[XB_XGEN(b.x)]) == gen, bar);
            __builtin_amdgcn_fence(__ATOMIC_ACQUIRE, "agent");
            asm volatile("s_waitcnt vmcnt(0)" ::: "memory");
        }
    }
    __syncthreads();
}

namespace pg8 {
constexpr int BM = 256, BK = 64, HALF = 128, HTB = HALF * BK * 2, STAGE_BYTES = 8 * HTB, NXCD = 8, WGM = 8;
__host__ __device__ __forceinline__ int lds_byte(int r, int c) { const int st = (r >> 4) * 2 + (c >> 5), rr = r & 15, cc = c & 31, ob = rr * 64 + cc * 2; return st * 1024 + (ob ^ (((ob >> 9) & 1) << 5)); }
__host__ __device__ __forceinline__ void stage_rc(int b, int& R, int& C) { const int st = b / 1024, sb = b % 1024, swz = sb ^ (((sb >> 9) & 1) << 5); R = (st >> 1) * 16 + swz / 64; C = (st & 1) * 32 + (swz % 64) / 2; }
__host__ __device__ __forceinline__ int perm32(int rho) { const int n = rho >> 4, i = rho & 15; return 8 * (i >> 2) + 4 * n + (i & 3); }
struct Unit { int pm, pn, aux, kx; };
struct Gemm { const bf16_t* A; const bf16_t* Bt; int K; };
struct StaticOrder {
    static constexpr bool KSPLIT = false;
    int nM, nN, nwg, G, c;
    __device__ void init(int M, int N, int G_, int c_) { nM = M / BM; nN = N / BM; nwg = nM * nN; G = G_; c = c_; }
    __device__ bool next(int i, Unit& u) const {
        const long L = (long)i * G + c; if (L >= nwg) return false;
        int wgid = (int)L; { const int q = nwg / NXCD, r = nwg % NXCD, xcd = wgid % NXCD, off = wgid / NXCD; wgid = (xcd < r ? xcd * (q + 1) : r * (q + 1) + (xcd - r) * q) + off; }
        const int nig = WGM * nN, gid = wgid / nig, fm = gid * WGM, gsz = (nM - fm) < WGM ? (nM - fm) : WGM;
        u.pm = fm + ((wgid % nig) % gsz); u.pn = (wgid % nig) / gsz; u.aux = u.pn; return true;
    }
};
struct MoeOrder {
    static constexpr bool KSPLIT = false;
    int pb[9], NT, G, c, nwg;
    __device__ __forceinline__ bool next(int i, Unit& u) const { return at((long)i * G + c, u); }
    __device__ __forceinline__ bool at(long L, Unit& u) const {
        if (L >= nwg) return false;
        int wgid = (int)L; { const int q = nwg / NXCD, r = nwg % NXCD, xcd = wgid % NXCD, off = wgid / NXCD; wgid = (xcd < r ? xcd * (q + 1) : r * (q + 1) + (xcd - r) * q) + off; }
        int e = 0;
#pragma unroll
        for (int k = 1; k < 8; ++k) e += (wgid >= pb[k] * NT) ? 1 : 0;
        int pbe = pb[0], pbn = pb[1];
#pragma unroll
        for (int k = 1; k < 8; ++k) { if (e == k) { pbe = pb[k]; pbn = pb[k + 1]; } }
        const int l = wgid - pbe * NT, Pe = pbn - pbe;
        const int nig = WGM * NT, gid = l / nig, fm = gid * WGM, gsz = (Pe - fm) < WGM ? (Pe - fm) : WGM;
        u.pm = pbe + fm + ((l % nig) % gsz); const int pn = (l % nig) / gsz; u.pn = e * NT + pn; u.aux = pn; return true;
    }
};

struct TableOrder {
    static constexpr bool KSPLIT = false;
    const LAS int* tab; int n;
    __device__ __forceinline__ bool next(int i, Unit& u) const {
        if (i >= n) return false;
        u.pm = __builtin_amdgcn_readfirstlane(tab[4 * i]); u.pn = __builtin_amdgcn_readfirstlane(tab[4 * i + 1]); u.aux = __builtin_amdgcn_readfirstlane(tab[4 * i + 2]); return true;
    }
};
struct TableOrderK {
    static constexpr bool KSPLIT = true;
    const LAS int* tab; int n;
    __device__ __forceinline__ bool next(int i, Unit& u) const {
        if (i >= n) return false;
        u.pm = __builtin_amdgcn_readfirstlane(tab[4 * i]); u.pn = __builtin_amdgcn_readfirstlane(tab[4 * i + 1]); u.aux = __builtin_amdgcn_readfirstlane(tab[4 * i + 2]); u.kx = __builtin_amdgcn_readfirstlane(tab[4 * i + 3]); return true;
    }
};
typedef int v8i32 __attribute__((ext_vector_type(8)));
template <class Epi, class Sched, bool ALIGN_EPI, bool SP2, int FMT = 0>
__device__ __forceinline__ void gemm_phase(LAS unsigned char* lds, const Gemm g, const Sched& S, const Epi& E) {
    const int tid = tid_opaque(), wid = __builtin_amdgcn_readfirstlane(tid >> 6), lane = tid & 63, wr = wid >> 2, wc = wid & 3, fr = lane & 15, fq = lane >> 4;
    constexpr bool F8 = (FMT != 0);
    const int K = g.K, RB = F8 ? K : 2 * K, nt = RB / 128;
    unsigned voffA, voffB;
    { int R, C; stage_rc(tid * 16, R, C); const int Rb = Epi::PERM ? ((R & ~31) + perm32(R & 31)) : R; voffA = (unsigned)(R * RB + C * 2); voffB = (unsigned)(Rb * RB + C * 2); }
    const size_t rstep = (size_t)64 * RB;
    const size_t kstep = (size_t)(BK * 2);
    const size_t hstep = (size_t)HALF * RB;
    const size_t tstep = 2 * hstep;
    const unsigned ldsw = (unsigned)wid * 1024u;
    const int aoff = lds_byte(wr * 64 + fr, fq * 8), boff = lds_byte(wc * 32 + fr, fq * 8);
#define PG8_SA(b, h) (((b) * 2 + (h)) * HTB)
#define PG8_SB(b, h) ((4 + (b) * 2 + (h)) * HTB)
#define PG8_STAGE(bufoff, gbase, voff) do { _Pragma("unroll") for (int _i = 0; _i < 2; ++_i) \
        __builtin_amdgcn_global_load_lds((const unsigned*)((const char*)(gbase) + _i * rstep + (voff)), (LAS unsigned*)(lds + (bufoff) + ldsw + _i * 8192), 16, 0, 0); } while (0)
#define PG8_LDA(dst, b, h) do { _Pragma("unroll") for (int m = 0; m < 4; ++m) _Pragma("unroll") for (int k = 0; k < 2; ++k) dst[m][k] = *(const LAS bf16x8*)(lds + PG8_SA(b, h) + aoff + m * 2048 + k * 1024); } while (0)
#define PG8_LDB(dst, b, h) do { _Pragma("unroll") for (int n = 0; n < 2; ++n) _Pragma("unroll") for (int k = 0; k < 2; ++k) dst[n][k] = *(const LAS bf16x8*)(lds + PG8_SB(b, h) + boff + n * 2048 + k * 1024); } while (0)
#define PG8_CAT(x) __builtin_shufflevector(__builtin_bit_cast(u32x4, x[0]), __builtin_bit_cast(u32x4, x[1]), 0, 1, 2, 3, 4, 5, 6, 7)
#define PG8_D6(x) __builtin_bit_cast(v6i32, __builtin_shufflevector(__builtin_bit_cast(u32x4, x[0]), __builtin_bit_cast(u32x4, x[1]), 0, 1, 2, 3, 4, 5))
#define PG8_S6(x) ((int)__builtin_bit_cast(u32x4, x[1])[2])
#define PG8_MMA(ai, bj, At, Bt) do { __builtin_amdgcn_s_setprio(1); if constexpr (FMT == 1) { _Pragma("unroll") for (int m = 0; m < 4; ++m) _Pragma("unroll") for (int n = 0; n < 2; ++n) \
        asm volatile("v_mfma_f32_16x16x128_f8f6f4 %0, %1, %2, %0" : "+v"(acc[ai][bj][m][n]) : "v"(__builtin_bit_cast(v8i32, PG8_CAT(Bt[n]))), "v"(__builtin_bit_cast(v8i32, PG8_CAT(At[m])))); } \
        else if constexpr (FMT == 2) { _Pragma("unroll") for (int m = 0; m < 4; ++m) _Pragma("unroll") for (int n = 0; n < 2; ++n) \
        acc[ai][bj][m][n] = __builtin_amdgcn_mfma_scale_f32_16x16x128_f8f6f4(__builtin_bit_cast(v8i32, PG8_CAT(Bt[n])), __builtin_bit_cast(v8i32, PG8_CAT(At[m])), acc[ai][bj][m][n], 2, 2, 0, PG8_S6(Bt[n]), 0, PG8_S6(At[m])); } \
        else { _Pragma("unroll") for (int m = 0; m < 4; ++m) _Pragma("unroll") for (int n = 0; n < 2; ++n) _Pragma("unroll") for (int k = 0; k < 2; ++k) \
        acc[ai][bj][m][n] = __builtin_amdgcn_mfma_f32_16x16x32_bf16(Bt[n][k], At[m][k], acc[ai][bj][m][n], 0, 0, 0); } __builtin_amdgcn_s_setprio(0); } while (0)
#define PG8_WAIT_V(n) asm volatile("s_waitcnt vmcnt(" #n ")" ::: "memory")
#define PG8_WAIT_L(n) asm volatile("s_waitcnt lgkmcnt(" #n ")" ::: "memory")
#define PG8_BAR __builtin_amdgcn_s_barrier()
#define PG8_SCHED __builtin_amdgcn_sched_barrier(0)
    Unit cur, nxt; int ui = 0;
    if (!S.next(0, cur)) return;
    constexpr bool KS = Sched::KSPLIT;
    auto k_off = [&](const Unit& u) -> size_t { if constexpr (KS) { if (u.kx) return (size_t)((u.kx >> 8) & 255) * (size_t)(nt / (u.kx >> 16)) * 128; } return 0; };
    auto k_cnt = [&](const Unit& u) -> int { if constexpr (KS) { if (u.kx) return nt / (u.kx >> 16); } return nt; };
    int ntc = k_cnt(cur);
    f32x4 acc[2][2][4][2];
#pragma unroll
    for (int a = 0; a < 2; ++a)
#pragma unroll
        for (int b = 0; b < 2; ++b)
#pragma unroll
            for (int m = 0; m < 4; ++m)
#pragma unroll
                for (int n = 0; n < 2; ++n) acc[a][b][m][n] = (f32x4){0.f, 0.f, 0.f, 0.f};
    bf16x8 At[4][2], B0[2][2], B1[2][2];
    const char* cA = (const char*)g.A + (size_t)cur.pm * tstep + k_off(cur); const char* cB = (const char*)g.Bt + (size_t)cur.pn * tstep + k_off(cur);
    if constexpr (SP2) {
        PG8_STAGE(PG8_SB(0, 0), cB, voffB); PG8_STAGE(PG8_SB(0, 1), cB + hstep, voffB); PG8_STAGE(PG8_SA(0, 0), cA, voffA); PG8_STAGE(PG8_SA(0, 1), cA + hstep, voffA);
        if (wr == 1) PG8_BAR;
        PG8_WAIT_V(2); PG8_BAR;
        PG8_STAGE(PG8_SB(1, 0), cB + kstep, voffB); PG8_STAGE(PG8_SA(1, 0), cA + kstep, voffA); PG8_STAGE(PG8_SB(1, 1), cB + hstep + kstep, voffB);
        PG8_WAIT_V(6); PG8_BAR;
    } else {
        PG8_STAGE(PG8_SB(0, 0), cB, voffB); PG8_STAGE(PG8_SA(0, 0), cA, voffA); PG8_STAGE(PG8_SB(0, 1), cB + hstep, voffB); PG8_STAGE(PG8_SA(0, 1), cA + hstep, voffA);
        if (wr == 1) PG8_BAR;
        PG8_WAIT_V(4); PG8_BAR;
        PG8_STAGE(PG8_SB(1, 0), cB + kstep, voffB); PG8_STAGE(PG8_SA(1, 0), cA + kstep, voffA); PG8_STAGE(PG8_SB(1, 1), cB + hstep + kstep, voffB);
        PG8_WAIT_V(6); PG8_BAR;
    }
    for (;;) {
        const bool has_next = S.next(ui + 1, nxt);
        const char* nA = has_next ? (const char*)g.A + (size_t)nxt.pm * tstep + k_off(nxt) : cA; const char* nB = has_next ? (const char*)g.Bt + (size_t)nxt.pn * tstep + k_off(nxt) : cB;
        for (int t = 0; t < ntc; t += 2) {
            if constexpr (Epi::MID_T >= 0) { if (t == Epi::MID_T) { const int l2 = tid_opaque() & 63; E.mid(acc, cur, wr, wc, l2 & 15, l2 >> 4); } }
            const bool last = (t == ntc - 2);
            const char* a1 = cA + (size_t)(t + 1) * kstep;
            const char* a2 = last ? nA : cA + (size_t)(t + 2) * kstep; const char* b2 = last ? nB : cB + (size_t)(t + 2) * kstep;
            const char* a3 = a2 + kstep; const char* b3 = b2 + kstep;
            if constexpr (SP2) {
            PG8_LDB(B0, 0, 0); PG8_LDB(B1, 0, 1); PG8_SCHED; PG8_LDA(At, 0, 0); PG8_STAGE(PG8_SA(1, 1), a1 + hstep, voffA);
            PG8_WAIT_V(8); PG8_WAIT_L(0); PG8_BAR; PG8_MMA(0, 0, At, B0); PG8_MMA(0, 1, At, B1); PG8_BAR; PG8_SCHED;
            PG8_LDA(At, 0, 1); PG8_STAGE(PG8_SB(0, 0), b2, voffB); PG8_STAGE(PG8_SB(0, 1), b2 + hstep, voffB); PG8_STAGE(PG8_SA(0, 0), a2, voffA);
            PG8_WAIT_V(8); PG8_WAIT_L(0); PG8_BAR; PG8_MMA(1, 0, At, B0); PG8_MMA(1, 1, At, B1); PG8_BAR; PG8_SCHED;
            PG8_LDB(B0, 1, 0); PG8_LDB(B1, 1, 1); PG8_SCHED; PG8_LDA(At, 1, 0); PG8_STAGE(PG8_SA(0, 1), a2 + hstep, voffA);
            PG8_WAIT_V(8); PG8_WAIT_L(0); PG8_BAR; PG8_MMA(0, 0, At, B0); PG8_MMA(0, 1, At, B1); PG8_BAR; PG8_SCHED;
            PG8_LDA(At, 1, 1); PG8_STAGE(PG8_SB(1, 0), b3, voffB); PG8_STAGE(PG8_SB(1, 1), b3 + hstep, voffB); PG8_STAGE(PG8_SA(1, 0), a3, voffA);
            PG8_WAIT_V(8); PG8_WAIT_L(0); PG8_BAR; PG8_MMA(1, 0, At, B0); PG8_MMA(1, 1, At, B1); PG8_BAR; PG8_SCHED;
            } else {
            PG8_LDB(B0, 0, 0); PG8_SCHED; PG8_LDA(At, 0, 0); PG8_STAGE(PG8_SA(1, 1), a1 + hstep, voffA);
            PG8_WAIT_L(8); PG8_BAR; PG8_WAIT_L(0); PG8_MMA(0, 0, At, B0); PG8_BAR; PG8_SCHED;
            PG8_LDB(B1, 0, 1); PG8_STAGE(PG8_SB(0, 0), b2, voffB);
            PG8_BAR; PG8_WAIT_L(0); PG8_MMA(0, 1, At, B1); PG8_BAR;
            PG8_LDA(At, 0, 1); PG8_STAGE(PG8_SA(0, 0), a2, voffA);
            PG8_BAR; PG8_WAIT_L(0); PG8_MMA(1, 0, At, B0); PG8_BAR; PG8_SCHED;
            PG8_STAGE(PG8_SB(0, 1), b2 + hstep, voffB);
            PG8_WAIT_V(6); PG8_BAR; PG8_MMA(1, 1, At, B1); PG8_BAR;
            PG8_LDB(B0, 1, 0); PG8_SCHED; PG8_LDA(At, 1, 0); PG8_STAGE(PG8_SA(0, 1), a2 + hstep, voffA);
            PG8_WAIT_L(8); PG8_BAR; PG8_WAIT_L(0); PG8_MMA(0, 0, At, B0); PG8_BAR; PG8_SCHED;
            PG8_LDB(B1, 1, 1); PG8_STAGE(PG8_SB(1, 0), b3, voffB);
            PG8_BAR; PG8_WAIT_L(0); PG8_MMA(0, 1, At, B1); PG8_BAR;
            PG8_LDA(At, 1, 1); PG8_STAGE(PG8_SA(1, 0), a3, voffA);
            PG8_BAR; PG8_WAIT_L(0); PG8_MMA(1, 0, At, B0); PG8_BAR; PG8_SCHED;
            PG8_STAGE(PG8_SB(1, 1), b3 + hstep, voffB);
            PG8_WAIT_V(6); PG8_BAR; PG8_MMA(1, 1, At, B1); PG8_BAR;
            }
        }
        if constexpr (ALIGN_EPI) { if (wr == 0) PG8_BAR; }
        if constexpr (F8) asm volatile("s_nop 15\n\ts_nop 15" ::: "memory");
        { const int l2 = tid_opaque() & 63; E(acc, cur, wr, wc, l2 & 15, l2 >> 4); }
        if (!has_next) break;
#pragma unroll
        for (int a = 0; a < 2; ++a)
#pragma unroll
            for (int b = 0; b < 2; ++b)
#pragma unroll
                for (int m = 0; m < 4; ++m)
#pragma unroll
                    for (int n = 0; n < 2; ++n) acc[a][b][m][n] = (f32x4){0.f, 0.f, 0.f, 0.f};
        cur = nxt; cA = nA; cB = nB; ++ui; ntc = k_cnt(cur);
        if constexpr (ALIGN_EPI) { if (wr == 1) PG8_BAR; }
    }
    PG8_WAIT_V(0);
    if constexpr (!ALIGN_EPI) { if (wr == 0) PG8_BAR; }
    PG8_BAR;
#undef PG8_SA
#undef PG8_SB
#undef PG8_STAGE
#undef PG8_LDA
#undef PG8_LDB
#undef PG8_MMA
#undef PG8_CAT
#undef PG8_D6
#undef PG8_S6
#undef PG8_WAIT_V
#undef PG8_WAIT_L
#undef PG8_BAR
#undef PG8_SCHED
}

__device__ __forceinline__ u32x4 pack8(const f32x4 a, const f32x4 b) { u32x4 w; w.x = cvt_pk_bf16(a[0], a[1]); w.y = cvt_pk_bf16(a[2], a[3]); w.z = cvt_pk_bf16(b[0], b[1]); w.w = cvt_pk_bf16(b[2], b[3]); return w; }
__device__ __forceinline__ u32x2 pack4(const f32x4 a) { u32x2 w; w.x = cvt_pk_bf16(a[0], a[1]); w.y = cvt_pk_bf16(a[2], a[3]); return w; }

constexpr int RM_BITS = 4;
template <int B = RM_BITS>
__device__ __forceinline__ f32x4 rmant(const f32x4 v) {
    f32x4 r;
#pragma unroll
    for (int i = 0; i < 4; ++i) r[i] = __uint_as_float((__float_as_uint(v[i]) + (1u << (22 - B))) & ~((1u << (23 - B)) - 1u));
    return r;
}
constexpr int RM_BITS_V = 3;
struct EpiInProj {
    static constexpr int MID_T = -1;
    static constexpr bool PERM = true;
    bf16_t *cq, *ckv, *kpe, *qs, *ks, *vs; float *partq, *partkv; const float *cosm, *sinm, *coss, *sins;
    __device__ __forceinline__ void operator()(const f32x4 (&acc)[2][2][4][2], const Unit& u, int wr, int wc, int fr, int fq) const {
        const int row0 = u.pm * BM + wr * 64 + fr;
#pragma unroll
        for (int bj = 0; bj < 2; ++bj) {
            const int tc0 = u.aux * BM + bj * HALF + wc * 32 + fq * 8;
            if (tc0 < 768) {
                bf16_t* base; float* part; int ld, col, ps;
                if (tc0 < 512) { base = cq; ld = 512; col = tc0; part = partq; ps = 16; } else { base = ckv; ld = 256; col = tc0 - 512; part = partkv; ps = 8; }
#pragma unroll
                for (int ai = 0; ai < 2; ++ai)
#pragma unroll
                    for (int m = 0; m < 4; ++m) { const int row = row0 + ai * HALF + m * 16; const f32x4 v0 = acc[ai][bj][m][0], v1 = acc[ai][bj][m][1];
                        *(u32x4*)(base + (size_t)row * ld + col) = pack8(v0, v1);
                        float ss = (v0[0] * v0[0] + v0[1] * v0[1]) + (v0[2] * v0[2] + v0[3] * v0[3]) + (v1[0] * v1[0] + v1[1] * v1[1]) + (v1[2] * v1[2] + v1[3] * v1[3]);
                        ss += __shfl_xor(ss, 16); ss += __shfl_xor(ss, 32);
                        if (fq == 0) part[(size_t)row * ps + (col >> 5)] = ss; }
            } else if (tc0 < 2112) {
                bf16_t* base; const float *ct, *st; int ld, col, half, tw, g;
                if (tc0 < 832) { g = (tc0 - 768) >> 3; base = kpe; ld = 64; col = 4 * g; half = 32; ct = cosm; st = sinm; tw = 32; }
                else if (tc0 < 1856) { const int j = tc0 - 832; g = (j & 127) >> 3; base = qs; ld = 1024; col = (j >> 7) * 128 + 4 * g; half = 64; ct = coss; st = sins; tw = 64; }
                else { const int j = tc0 - 1856; g = (j & 127) >> 3; base = ks; ld = 256; col = (j >> 7) * 128 + 4 * g; half = 64; ct = coss; st = sins; tw = 64; }
#pragma unroll
                for (int ai = 0; ai < 2; ++ai)
#pragma unroll
                    for (int m = 0; m < 4; ++m) { const int row = row0 + ai * HALF + m * 16; const f32x4 x1 = acc[ai][bj][m][0], x2 = acc[ai][bj][m][1];
                        const f32x4 c = *(const f32x4*)(ct + (size_t)row * tw + 4 * g), s = *(const f32x4*)(st + (size_t)row * tw + 4 * g);
                        const f32x4 o1 = x1 * c - x2 * s, o2 = x2 * c + x1 * s;
                        if (tc0 < 832) { unsigned char* kp = (unsigned char*)kpe + (size_t)row * 64 + col;
                            *(unsigned*)kp = pk_fp8x4(o1[0], o1[1], o1[2], o1[3]); *(unsigned*)(kp + 32) = pk_fp8x4(o2[0], o2[1], o2[2], o2[3]); }
                        else { *(u32x2*)(base + (size_t)row * ld + col) = pack4(o1); *(u32x2*)(base + (size_t)row * ld + col + half) = pack4(o2); } }
            } else if (tc0 < 2368) {
                const int col = tc0 - 2112;
#pragma unroll
                for (int ai = 0; ai < 2; ++ai)
#pragma unroll
                    for (int m = 0; m < 4; ++m) { const int row = row0 + ai * HALF + m * 16; *(u32x4*)(vs + (size_t)row * 256 + col) = pack8(acc[ai][bj][m][0], acc[ai][bj][m][1]); }
            }
        }
    }
};
struct EpiQ {
    static constexpr int MID_T = -1;
    static constexpr bool PERM = true;
    bf16_t* q; const float *partq, *cosm, *sinm;
    __device__ __forceinline__ void operator()(const f32x4 (&acc)[2][2][4][2], const Unit& u, int wr, int wc, int fr, int fq) const {
        const int row0 = u.pm * BM + wr * 64 + fr;
        float rs[2][4];
#pragma unroll
        for (int ai = 0; ai < 2; ++ai)
#pragma unroll
            for (int m = 0; m < 4; ++m) { const f32x4* p = (const f32x4*)(partq + (size_t)(row0 + ai * HALF + m * 16) * 16); const f32x4 s = (p[0] + p[1]) + (p[2] + p[3]);
                rs[ai][m] = 1.0f / sqrtf(((s[0] + s[1]) + (s[2] + s[3])) * (1.0f / 512.0f) + RMS_EPS); }
#pragma unroll
        for (int bj = 0; bj < 2; ++bj) {
            const int tc0 = u.aux * BM + bj * HALF + wc * 32 + fq * 8, head = tc0 / 192, j = tc0 - head * 192;
            if (j < 128) {
#pragma unroll
                for (int ai = 0; ai < 2; ++ai)
#pragma unroll
                    for (int m = 0; m < 4; ++m) { const int row = row0 + ai * HALF + m * 16; *(u32x4*)(q + (size_t)row * QCOLS + tc0) = pack8(rmant(acc[ai][bj][m][0] * rs[ai][m]), rmant(acc[ai][bj][m][1] * rs[ai][m])); }
            } else {
                const int g = (j - 128) >> 3, col = head * 192 + 128 + 4 * g;
#pragma unroll
                for (int ai = 0; ai < 2; ++ai)
#pragma unroll
                    for (int m = 0; m < 4; ++m) { const int row = row0 + ai * HALF + m * 16; const f32x4 x1 = acc[ai][bj][m][0] * rs[ai][m], x2 = acc[ai][bj][m][1] * rs[ai][m];
                        const f32x4 c = *(const f32x4*)(cosm + (size_t)row * 32 + 4 * g), s = *(const f32x4*)(sinm + (size_t)row * 32 + 4 * g);
                        const f32x4 r1 = x1 * c - x2 * s, r2 = x2 * c + x1 * s; unsigned char* q8 = (unsigned char*)(q + (size_t)row * QCOLS + head * 192 + 128) + 4 * g;
                        *(unsigned*)q8 = pk_fp8x4(r1[0], r1[1], r1[2], r1[3]); *(unsigned*)(q8 + 32) = pk_fp8x4(r2[0], r2[1], r2[2], r2[3]); }
            }
        }
    }
};
struct EpiKV {
    static constexpr int MID_T = -1;
    static constexpr bool PERM = true;
    bf16_t* kv; const float* partkv;
    __device__ __forceinline__ void operator()(const f32x4 (&acc)[2][2][4][2], const Unit& u, int wr, int wc, int fr, int fq) const {
        const int row0 = u.pm * BM + wr * 64 + fr;
#pragma unroll
        for (int ai = 0; ai < 2; ++ai)
#pragma unroll
            for (int m = 0; m < 4; ++m) { const int row = row0 + ai * HALF + m * 16; const f32x4* p = (const f32x4*)(partkv + (size_t)row * 8); const f32x4 s = p[0] + p[1];
                const float rs = 1.0f / sqrtf(((s[0] + s[1]) + (s[2] + s[3])) * (1.0f / 256.0f) + RMS_EPS);
#pragma unroll
                for (int bj = 0; bj < 2; ++bj) { const int col = u.aux * BM + bj * HALF + wc * 32 + fq * 8; f32x4 k0 = acc[ai][bj][m][0] * rs, k1 = acc[ai][bj][m][1] * rs; if (bj == 0) { k0 = rmant(k0); k1 = rmant(k1); } else { k0 = rmant<RM_BITS_V>(k0); k1 = rmant<RM_BITS_V>(k1); } *(u32x4*)(kv + (size_t)row * KVCOLS + col) = pack8(k0, k1); } }
    }
};
struct EpiResid {
    static constexpr int MID_T = -1;
    static constexpr bool PERM = true;
    const float* xin; float* y; float sc;
    __device__ __forceinline__ void operator()(const f32x4 (&acc)[2][2][4][2], const Unit& u, int wr, int wc, int fr, int fq) const {
        const int row0 = u.pm * BM + wr * 64 + fr;
#pragma unroll
        for (int ai = 0; ai < 2; ++ai)
#pragma unroll
            for (int m = 0; m < 4; ++m) { const size_t ro = (size_t)(row0 + ai * HALF + m * 16) * D;
#pragma unroll
                for (int bj = 0; bj < 2; ++bj) { const size_t o = ro + u.aux * BM + bj * HALF + wc * 32 + fq * 8;
                    const f32x4 a0 = *(const f32x4*)(xin + o), a1 = *(const f32x4*)(xin + o + 4);
                    *(f32x4*)(y + o) = a0 * ALPHA + acc[ai][bj][m][0] * sc; *(f32x4*)(y + o + 4) = a1 * ALPHA + acc[ai][bj][m][1] * sc; }
                asm volatile("" ::: "memory"); }
    }
};
struct EpiResidLN {
    static constexpr int MID_T = -1;
    static constexpr bool PERM = true, PROBE2 = false;
    const float* yin; float* y; float sc; const float* st; const float* g; const float* b;
    __device__ __forceinline__ void operator()(const f32x4 (&acc)[2][2][4][2], const Unit& u, int wr, int wc, int fr, int fq) const {
        const int row0 = u.pm * BM + wr * 64 + fr, col0 = u.aux * BM + wc * 32 + fq * 8;
        f32x4 gg[2][2], bb[2][2];
#pragma unroll
        for (int bj = 0; bj < 2; ++bj)
#pragma unroll
            for (int n = 0; n < 2; ++n) { gg[bj][n] = *(const f32x4*)(g + col0 + bj * HALF + 4 * n); bb[bj][n] = *(const f32x4*)(b + col0 + bj * HALF + 4 * n); }
#pragma unroll
        for (int ai = 0; ai < 2; ++ai)
#pragma unroll
            for (int m = 0; m < 4; ++m) { const int row = row0 + ai * HALF + m * 16; const size_t ro = (size_t)row * D; const float mu = st[2 * row], rs = st[2 * row + 1];
#pragma unroll
                for (int bj = 0; bj < 2; ++bj) { const size_t o = ro + col0 + bj * HALF;
                    const f32x4 a0 = *(const f32x4*)(yin + o), a1 = *(const f32x4*)(yin + o + 4);
                    const f32x4 x0 = (a0 - mu) * rs * gg[bj][0] + bb[bj][0], x1 = (a1 - mu) * rs * gg[bj][1] + bb[bj][1];
                    *(f32x4*)(y + o) = x0 * ALPHA + acc[ai][bj][m][0] * sc; *(f32x4*)(y + o + 4) = x1 * ALPHA + acc[ai][bj][m][1] * sc; }
                asm volatile("" ::: "memory"); }
    }
};
template <bool LNIN> struct EpiOutProj {
    static constexpr bool PERM = true, PROBE2 = false; static constexpr int MID_T = 16;
    const float* xin; float* y; const float* parto; const float* st; const float* g; const float* b;
    __device__ __forceinline__ void sums(int row, float& a, float& c) const { const f32x4* p = (const f32x4*)(parto + (size_t)row * 16); const f32x4 u = p[0] + p[1], v = p[2] + p[3];
        a = ((u[0] + u[1]) + (u[2] + u[3])) * (1.0f / 1024.0f) + RMS_EPS; c = ((v[0] + v[1]) + (v[2] + v[3])) * (1.0f / 1024.0f) + RMS_EPS; }
    __device__ __forceinline__ void mid(f32x4 (&acc)[2][2][4][2], const Unit& u, int wr, int wc, int fr, int fq) const {
        const int row0 = u.pm * BM + wr * 64 + fr;
#pragma unroll
        for (int ai = 0; ai < 2; ++ai)
#pragma unroll
            for (int m = 0; m < 4; ++m) { float a, c; sums(row0 + ai * HALF + m * 16, a, c); const float r = sqrtf(c / a);
#pragma unroll
                for (int bj = 0; bj < 2; ++bj) { acc[ai][bj][m][0] *= r; acc[ai][bj][m][1] *= r; } }
    }
    __device__ __forceinline__ void operator()(const f32x4 (&acc)[2][2][4][2], const Unit& u, int wr, int wc, int fr, int fq) const {
        const int row0 = u.pm * BM + wr * 64 + fr, col0 = u.aux * BM + wc * 32 + fq * 8;
        f32x4 gg[2][2], bb[2][2];
        if (LNIN) {
#pragma unroll
            for (int bj = 0; bj < 2; ++bj)
#pragma unroll
                for (int n = 0; n < 2; ++n) { gg[bj][n] = *(const f32x4*)(g + col0 + bj * HALF + 4 * n); bb[bj][n] = *(const f32x4*)(b + col0 + bj * HALF + 4 * n); }
        }
#pragma unroll
        for (int ai = 0; ai < 2; ++ai)
#pragma unroll
            for (int m = 0; m < 4; ++m) { const int row = row0 + ai * HALF + m * 16; const size_t ro = (size_t)row * D; float a, c; sums(row, a, c); const float rsw = 1.0f / sqrtf(c);
                float mu = 0.f, rs = 1.f; if (LNIN) { mu = st[2 * row]; rs = st[2 * row + 1]; }
#pragma unroll
                for (int bj = 0; bj < 2; ++bj) { const size_t o = ro + col0 + bj * HALF;
                    f32x4 x0 = *(const f32x4*)(xin + o), x1 = *(const f32x4*)(xin + o + 4);
                    if (LNIN) { x0 = (x0 - mu) * rs * gg[bj][0] + bb[bj][0]; x1 = (x1 - mu) * rs * gg[bj][1] + bb[bj][1]; }
                    *(f32x4*)(y + o) = x0 * ALPHA + acc[ai][bj][m][0] * rsw; *(f32x4*)(y + o + 4) = x1 * ALPHA + acc[ai][bj][m][1] * rsw; }
                asm volatile("" ::: "memory"); }
    }
};
struct EpiSwiglu8 {
    static constexpr int MID_T = -1;
    static constexpr bool PERM = true;
    unsigned char* h; int ldh; float sc;
    __device__ __forceinline__ void operator()(const f32x4 (&acc)[2][2][4][2], const Unit& u, int wr, int wc, int fr, int fq) const {
        const int row0 = u.pm * BM + wr * 64 + fr, col = u.aux * HALF + wc * 32 + fq * 8;
#pragma unroll
        for (int ai = 0; ai < 2; ++ai)
#pragma unroll
            for (int m = 0; m < 4; ++m) { f32x4 r0, r1;
#pragma unroll
                for (int k = 0; k < 4; ++k) { const float g0 = acc[ai][0][m][0][k] * sc, g1 = acc[ai][0][m][1][k] * sc;
                    r0[k] = __builtin_amdgcn_fmed3f(g0 * __builtin_amdgcn_rcpf(1.0f + __builtin_amdgcn_exp2f(-1.4426950408889634f * g0)) * (acc[ai][1][m][0][k] * (sc * H8_SCALE)), -448.f, 448.f);
                    r1[k] = __builtin_amdgcn_fmed3f(g1 * __builtin_amdgcn_rcpf(1.0f + __builtin_amdgcn_exp2f(-1.4426950408889634f * g1)) * (acc[ai][1][m][1][k] * (sc * H8_SCALE)), -448.f, 448.f); }
                u32x2 w; w.x = pk_fp8x4(r0[0], r0[1], r0[2], r0[3]); w.y = pk_fp8x4(r1[0], r1[1], r1[2], r1[3]);
                *(u32x2*)(h + (size_t)(row0 + ai * HALF + m * 16) * ldh + col) = w; }
    }
};
struct EpiSwiglu6 {
    static constexpr bool PERM = true, PROBE2 = false; static constexpr int MID_T = -1;
    unsigned char* h; int ldh;
    __device__ __forceinline__ void operator()(const f32x4 (&acc)[2][2][4][2], const Unit& u, int wr, int wc, int fr, int fq) const {
#pragma unroll
        for (int ai = 0; ai < 2; ++ai) {
            float v[4][8];
#pragma unroll
            for (int m = 0; m < 4; ++m)
#pragma unroll
                for (int c = 0; c < 8; ++c) { const float g = acc[ai][0][m][c >> 2][c & 3], uu = acc[ai][1][m][c >> 2][c & 3];
                    v[m][c] = g * __builtin_amdgcn_rcpf(1.0f + __builtin_amdgcn_exp2f(-1.4426950408889634f * g)) * uu; }
            float s1[2][2][8];
#pragma unroll
            for (int mm = 0; mm < 2; ++mm)
#pragma unroll
                for (int c = 0; c < 8; ++c) { auto r = __builtin_amdgcn_permlane32_swap(__float_as_uint(v[mm][c]), __float_as_uint(v[mm + 2][c]), false, false);
                    s1[mm][0][c] = __uint_as_float(r[0]); s1[mm][1][c] = __uint_as_float(r[1]); }
            f32x16 lo, hi;
#pragma unroll
            for (int hh = 0; hh < 2; ++hh)
#pragma unroll
                for (int c = 0; c < 8; ++c) { auto r = __builtin_amdgcn_permlane16_swap(__float_as_uint(s1[0][hh][c]), __float_as_uint(s1[1][hh][c]), false, false);
                    if (hh == 0) { lo[c] = __uint_as_float(r[0]); lo[8 + c] = __uint_as_float(r[1]); } else { hi[c] = __uint_as_float(r[0]); hi[8 + c] = __uint_as_float(r[1]); } }
            unsigned sb; const u32x6 q = mx6_block(lo, hi, sb);
            unsigned char* o = h + (size_t)(u.pm * BM + ai * HALF + wr * 64 + fq * 16 + fr) * ldh + u.aux * 128 + 16 * wc;
            *(u32x4*)o = (u32x4){q[0], q[1], q[2], q[3]}; *(u32x4*)(o + 64) = (u32x4){q[4], q[5], sb, 0u};
        }
    }
};
struct EpiBf16Out {
    static constexpr int MID_T = -1;
    static constexpr bool PERM = true;
    bf16_t* o; int ld; float sc;
    __device__ __forceinline__ void operator()(const f32x4 (&acc)[2][2][4][2], const Unit& u, int wr, int wc, int fr, int fq) const {
        const int row0 = u.pm * BM + wr * 64 + fr;
#pragma unroll
        for (int ai = 0; ai < 2; ++ai)
#pragma unroll
            for (int m = 0; m < 4; ++m)
#pragma unroll
                for (int bj = 0; bj < 2; ++bj) *(u32x4*)(o + (size_t)(row0 + ai * HALF + m * 16) * ld + u.aux * BM + bj * HALF + wc * 32 + fq * 8) = pack8(acc[ai][bj][m][0] * sc, acc[ai][bj][m][1] * sc);
    }
};
struct EpiBf16OutK {
    static constexpr int MID_T = -1;
    static constexpr bool PERM = true;
    bf16_t* o; bf16_t* yp;
    __device__ __forceinline__ void operator()(const f32x4 (&acc)[2][2][4][2], const Unit& u, int wr, int wc, int fr, int fq) const {
        bf16_t* base; int ld;
        if (u.kx) { base = yp + ((size_t)(((u.kx >> 8) & 255) * 128 + (u.kx & 255) - 1) * 256 + wr * 64 + fr) * 256; ld = 256; }
        else { base = o + (size_t)(u.pm * BM + wr * 64 + fr) * D + u.aux * BM; ld = D; }
#pragma unroll
        for (int ai = 0; ai < 2; ++ai)
#pragma unroll
            for (int m = 0; m < 4; ++m)
#pragma unroll
                for (int bj = 0; bj < 2; ++bj) *(u32x4*)(base + (size_t)(ai * HALF + m * 16) * ld + bj * HALF + wc * 32 + fq * 8) = pack8(acc[ai][bj][m][0], acc[ai][bj][m][1]);
    }
};
}

namespace att {
constexpr int NW = 8, QBLK = 32, KVBLK = 64;
constexpr float THR = 8.f;
constexpr int PPITCH = 80;
constexpr int SHM_V = KVBLK * 128 * 2, SHM_K = KVBLK * 272, SHM_P = KVBLK * PPITCH;
constexpr int OFF_V = 0, OFF_K = 3 * SHM_V, OFF_P = OFF_K + 2 * SHM_K,     OFF_WS = OFF_P + 2 * SHM_P, OFF_QP = OFF_WS + NW * 64 * 4, SHM_ATTN = OFF_QP + NW * 4096;
typedef LAS const char* lptr;
typedef short v4i16_t __attribute__((ext_vector_type(4)));
#define SBAR() __builtin_amdgcn_sched_barrier(0)
#define PIN(x) asm volatile("" : "+v"(x))
__device__ __forceinline__ int crow(int r, int hi) { return (r & 3) + 8 * (r >> 2) + 4 * hi; }
__device__ __forceinline__ bf16x8 ldk(lptr p) { return *(const LAS bf16x8*)p; }
__device__ __forceinline__ s16x4 vtr(lptr p) { return __builtin_bit_cast(s16x4, __builtin_amdgcn_ds_read_tr16_b64_v4i16((LAS v4i16_t*)p)); }
__device__ __forceinline__ int v_st(int k, int c) { const int kk = (k & ~0xC) | ((k & 4) << 1) | ((k & 8) >> 1); return ((kk >> 3) * 4 + (c >> 5)) * 512 + ((kk & 7) * 32 + (c & 31)) * 2; }
__device__ __forceinline__ int v_rd_base(int lane) { return ((lane & 3) << 3) | (((lane >> 2) & 3) << 6) | (((lane >> 4) & 1) << 5) | (((lane >> 5) & 1) << 8); }
__device__ __forceinline__ bf16x8 pk4(float a0, float a1, float a2, float a3, float a4, float a5, float a6, float a7) {
  const unsigned x0 = cvt_pk_bf16(a0, a1), x1 = cvt_pk_bf16(a2, a3), y0 = cvt_pk_bf16(a4, a5), y1 = cvt_pk_bf16(a6, a7);
  auto r0 = __builtin_amdgcn_permlane32_swap(x0, y0, false, false); auto r1 = __builtin_amdgcn_permlane32_swap(x1, y1, false, false);
  u32x4 w = {r0[0], r1[0], r0[1], r1[1]}; return __builtin_bit_cast(bf16x8, w);
}
constexpr int PD = 3;
__device__ __forceinline__ bf16x8 kfrag(lptr kb, int n) { const int d0 = n >> 1, h = n & 1; return ldk(kb + h * (32 * 272) + d0 * 32); }
typedef int v8i32_t __attribute__((ext_vector_type(8)));
__device__ __forceinline__ v8i32_t cat8(const bf16x8 a, const bf16x8 b) { return __builtin_bit_cast(v8i32_t, __builtin_shufflevector(__builtin_bit_cast(u32x4, a), __builtin_bit_cast(u32x4, b), 0, 1, 2, 3, 4, 5, 6, 7)); }
template <int NQ, bool DO_QK, bool DO_FIN>
__device__ __forceinline__ void phaseA(f32x16& C0, f32x16& C1, const f32x16& P0, const f32x16& P1, float alphaP, float& l_reg, bf16x8 (&pa)[4],
                                       lptr kb, lptr pb, const bf16x8 (&rq)[2], const bf16x8 (&qr)[8]) {
  constexpr bool R8 = NQ > 8;
  constexpr int NN = 16, NF = NN + (R8 ? 2 : 0);
  float s0 = 0.f, s1 = 0.f, s2 = 0.f, s3 = 0.f;
  bf16x8 f[NN + PD]; bf16x8 ra[2][2];
  if (DO_QK) {
#pragma unroll
    for (int n = 0; n < PD; ++n) f[n] = kfrag(kb, n);
  }
#pragma unroll
  for (int n = 0; n < NF; ++n) {
    if (DO_QK) {
      if (n < NN) {
        if (n + PD < NN) f[n + PD] = kfrag(kb, n + PD);
        if (R8) { if (n == 11) { ra[0][0] = ldk(pb); ra[0][1] = ldk(pb + 16); } if (n == 13) { ra[1][0] = ldk(pb + 32 * PPITCH); ra[1][1] = ldk(pb + 32 * PPITCH + 16); } }
        const bf16x8 qf = qr[n >> 1];
        if (n == 0)            C0 = __builtin_amdgcn_mfma_f32_32x32x16_bf16(f[n], qf, f32x16{}, 0, 0, 0);
        else if (n == 1)       C1 = __builtin_amdgcn_mfma_f32_32x32x16_bf16(f[n], qf, f32x16{}, 0, 0, 0);
        else if ((n & 1) == 0) C0 = __builtin_amdgcn_mfma_f32_32x32x16_bf16(f[n], qf, C0, 0, 0, 0);
        else                   C1 = __builtin_amdgcn_mfma_f32_32x32x16_bf16(f[n], qf, C1, 0, 0, 0);
      } else if (R8) {
        const int h = n - NN;
        if (h == 0) C0 = __builtin_amdgcn_mfma_scale_f32_32x32x64_f8f6f4(cat8(ra[0][0], ra[0][1]), cat8(rq[0], rq[1]), C0, 0, 0, 0, 0x7F7F7F7F, 0, 0x7F7F7F7F);
        else        C1 = __builtin_amdgcn_mfma_scale_f32_32x32x64_f8f6f4(cat8(ra[1][0], ra[1][1]), cat8(rq[0], rq[1]), C1, 0, 0, 0, 0x7F7F7F7F, 0, 0x7F7F7F7F);
      }
    }
    if (DO_FIN) {
#pragma unroll
      for (int e = n * 32 / NF; e < (n + 1) * 32 / NF; ++e) { const float v = e < 16 ? P0[e & 15] : P1[e & 15]; if ((e & 3) == 0) s0 += v; else if ((e & 3) == 1) s1 += v; else if ((e & 3) == 2) s2 += v; else s3 += v; }
      PIN(s0); PIN(s1); PIN(s2); PIN(s3);
      if (n == NF / 8)     { pa[0] = pk4(P0[0], P0[1], P0[2], P0[3], P0[4], P0[5], P0[6], P0[7]); PIN(pa[0]); }
      if (n == 3 * NF / 8) { pa[1] = pk4(P0[8], P0[9], P0[10], P0[11], P0[12], P0[13], P0[14], P0[15]); PIN(pa[1]); }
      if (n == 5 * NF / 8) { pa[2] = pk4(P1[0], P1[1], P1[2], P1[3], P1[4], P1[5], P1[6], P1[7]); PIN(pa[2]); }
      if (n == 7 * NF / 8) { pa[3] = pk4(P1[8], P1[9], P1[10], P1[11], P1[12], P1[13], P1[14], P1[15]); PIN(pa[3]); }
    }
    SBAR();
  }
  if (DO_FIN) { float ps = (s0 + s1) + (s2 + s3); auto rr = __builtin_amdgcn_permlane32_swap(__float_as_uint(ps), __float_as_uint(ps), false, false);
    ps = __uint_as_float(rr[0]) + __uint_as_float(rr[1]); l_reg = l_reg * alphaP + ps; }
}
template <bool MASK, bool DO_PV, bool DO_SM>
__device__ __forceinline__ void phaseB(f32x16 (&o)[4], const bf16x8 (&pa)[4], f32x16& C0, f32x16& C1, float& m_reg, float& alpha, lptr vb, float Cs, float thr_raw, int qi, int k0, int hi) {
  s16x4 vl[16 + PD], vh[16 + PD];
  if (DO_PV) {
#pragma unroll
    for (int n = 0; n < PD; ++n) { const int d0 = n & 3, ks = n >> 2; vl[n] = vtr(vb + d0 * 512 + ks * 4096); vh[n] = vtr(vb + d0 * 512 + ks * 4096 + 2048); }
  }
  float mx = -3.0e38f, mnC = 0.f;
#pragma unroll
  for (int n = 0; n < 16; ++n) {
    if (DO_PV) {
      const int d0 = n & 3, ks = n >> 2;
      if (n + PD < 16) { const int d1 = (n + PD) & 3, k1 = (n + PD) >> 2; vl[n + PD] = vtr(vb + d1 * 512 + k1 * 4096); vh[n + PD] = vtr(vb + d1 * 512 + k1 * 4096 + 2048); }
      const bf16x8 vf = (bf16x8){vl[n][0], vl[n][1], vl[n][2], vl[n][3], vh[n][0], vh[n][1], vh[n][2], vh[n][3]};
      o[d0] = __builtin_amdgcn_mfma_f32_32x32x16_bf16(pa[ks], vf, o[d0], 0, 0, 0);
    }
    if (DO_SM) {
      if (n < 4) {
#pragma unroll
        for (int e = n * 8; e < n * 8 + 8; ++e) {
          if (MASK) { const int d = qi - (k0 + (e < 16 ? 0 : 32) + crow(e & 15, hi)); if (d > 128 || d < -128) { if (e < 16) C0[e & 15] = -1e30f; else C1[e & 15] = -1e30f; } }
          mx = fmaxf(mx, e < 16 ? C0[e & 15] : C1[e & 15]); }
        PIN(mx);
      } else if (n == 4) {
        auto rr = __builtin_amdgcn_permlane32_swap(__float_as_uint(mx), __float_as_uint(mx), false, false);
        const float pmax = fmaxf(__uint_as_float(rr[0]), __uint_as_float(rr[1]));
        const bool keep = __all(pmax - m_reg <= thr_raw);
        const float mn = keep ? m_reg : fmaxf(m_reg, pmax);
        alpha = __builtin_amdgcn_exp2f((m_reg - mn) * Cs); m_reg = mn; mnC = -mn * Cs; PIN(alpha); PIN(mnC);
      } else {
#pragma unroll
        for (int e = (n - 5) * 32 / 11; e < (n - 4) * 32 / 11; ++e) {
          if (e < 16) C0[e] = __builtin_amdgcn_exp2f(fmaf(C0[e], Cs, mnC)); else C1[e - 16] = __builtin_amdgcn_exp2f(fmaf(C1[e - 16], Cs, mnC)); }
        if ((n - 5) * 32 / 11 < 16) PIN(C0); if ((n - 4) * 32 / 11 > 16) PIN(C1);
      }
    }
    SBAR();
  }
}

template <int DQK, bool MASK, int LDQ, int LDK, int LDP, int LDV, int LDO>
__device__ __forceinline__ void attn_body(const bf16_t* __restrict__ Qb, const bf16_t* __restrict__ Kb, const bf16_t* __restrict__ Pb, const bf16_t* __restrict__ Vb,
                                          bf16_t* __restrict__ Ob, float* __restrict__ ssq, int q0, int kstart, int NT, float scale, float sink_raw, LAS char* lds) {
  constexpr int NQ = DQK / 16;
  const float Cs = scale * 1.4426950408889634f, thr_raw = THR / scale;
  const int tid = tid_opaque(), wid = tid >> 6, lane = tid & 63, r32 = lane & 31, hi = lane >> 5;
  LAS char* V_lds = lds + OFF_V; LAS char* K_lds = lds + OFF_K; LAS char* P_lds = lds + OFF_P;
  LAS float* ws = (LAS float*)(lds + OFF_WS) + wid * 64; LAS float* li_l = ws; LAS float* al_l = ws + 32;
  float m_reg = MASK ? sink_raw : -1e30f, l_reg = MASK ? 1.f : 0.f; f32x16 o[4] = {}; bf16x8 qr[8];
  const bf16_t* Qw = Qb + (long)(wid * QBLK + r32) * LDQ + hi * 8;
  LAS char* Qp = lds + OFF_QP + wid * 4096 + lane * 16;
#pragma unroll
  for (int d0 = 0; d0 < 8; ++d0) qr[d0] = *reinterpret_cast<const bf16x8*>(Qw + d0 * 16);
  bf16x8 rq[2] = {};
  if (NQ > 8) {
    const unsigned char* q8 = (const unsigned char*)(Qb + (long)(wid * QBLK + r32) * LDQ + 128) + hi * 32;
    rq[0] = *reinterpret_cast<const bf16x8*>(q8); rq[1] = *reinterpret_cast<const bf16x8*>(q8 + 16);
  }
  const int sr = tid >> 4, sc = (tid & 15) * 8, vst0 = v_st(sr, sc), vst1 = v_st(32 + sr, sc);
  const int pr = tid >> 3, pc = (tid & 7) * 8;
  const lptr kb0 = (lptr)K_lds + r32 * 272 + hi * 16, pb0 = (lptr)P_lds + r32 * PPITCH + hi * 32, vb0 = (lptr)V_lds + v_rd_base(lane);
  const int qi = q0 + wid * QBLK + r32;
  bf16x8 vs0, vs1, ks0, ks1; u32x2 ps0;
  const unsigned voff0 = sr * LDV + sc, voff1 = (32 + sr) * LDV + sc, koff0 = sr * LDK + sc, koff1 = (32 + sr) * LDK + sc, poff = pr * LDP + pc;
#define SLOAD(k0) do { const bf16_t* Vt = Vb + (long)(k0) * LDV; const bf16_t* Kt = Kb + (long)(k0) * LDK; \
    vs0 = *reinterpret_cast<const bf16x8*>(Vt + voff0); vs1 = *reinterpret_cast<const bf16x8*>(Vt + voff1); \
    ks0 = *reinterpret_cast<const bf16x8*>(Kt + koff0); ks1 = *reinterpret_cast<const bf16x8*>(Kt + koff1); \
    if (NQ > 8) { const unsigned char* Pt = (const unsigned char*)Pb + (long)(k0) * LDP; ps0 = *reinterpret_cast<const u32x2*>(Pt + poff); } } while (0)
#define SWRITE(kb_, vo_) do { *(LAS bf16x8*)(V_lds + (vo_) + vst0) = vs0; *(LAS bf16x8*)(V_lds + (vo_) + vst1) = vs1; \
    *(LAS bf16x8*)(K_lds + (kb_) * SHM_K + sr * 272 + sc * 2) = ks0; *(LAS bf16x8*)(K_lds + (kb_) * SHM_K + (32 + sr) * 272 + sc * 2) = ks1; \
    if (NQ > 8) *(LAS u32x2*)(P_lds + (kb_) * SHM_P + pr * PPITCH + pc) = ps0; } while (0)
#define SWAIT() asm volatile("s_waitcnt vmcnt(0)" ::: "memory")
#define RESC(a) do { if (__any((a) < 1.f)) { if (hi == 0) al_l[r32] = (a); asm volatile("s_waitcnt lgkmcnt(0)" ::: "memory"); \
    _Pragma("unroll") for (int d = 0; d < 4; ++d) _Pragma("unroll") for (int r = 0; r < 16; ++r) o[d][r] *= al_l[crow(r, hi)]; } } while (0)
#define ROTV() do { const int t_ = vprev; vprev = vcur; vcur = vnext; vnext = t_; } while (0)
  f32x16 pA0, pA1, pB0, pB1; float alA = 1.f, alB = 1.f; bf16x8 pa[4];
  int vprev = 0, vcur = SHM_V, vnext = 2 * SHM_V;
  SLOAD(kstart); SWAIT(); SWRITE(0, 0); __syncthreads();
  SLOAD(kstart + KVBLK);
  phaseA<NQ, true, false>(pA0, pA1, pA0, pA1, 1.f, l_reg, pa, kb0, pb0, rq, qr);
  SWAIT(); SWRITE(1, SHM_V);
  phaseB<MASK, false, true>(o, pa, pA0, pA1, m_reg, alA, vb0, Cs, thr_raw, qi, kstart, hi);
  __syncthreads();
  for (int j = 1; j + 1 < NT; j += 2) {
    SBAR(); SLOAD(kstart + (j + 1) * KVBLK); SBAR();
    phaseA<NQ, true, true>(pB0, pB1, pA0, pA1, alA, l_reg, pa, kb0 + SHM_K, pb0 + SHM_P, rq, qr);
    SWAIT(); SWRITE(0, vnext);
    phaseB<MASK, true, true>(o, pa, pB0, pB1, m_reg, alB, vb0 + vprev, Cs, thr_raw, qi, kstart + j * KVBLK, hi);
    RESC(alB); ROTV(); __syncthreads();
    SBAR(); if (j + 2 < NT) SLOAD(kstart + (j + 2) * KVBLK); SBAR();
    phaseA<NQ, true, true>(pA0, pA1, pB0, pB1, alB, l_reg, pa, kb0, pb0, rq, qr);
    if (j + 2 < NT) { SWAIT(); SWRITE(1, vnext); }
    phaseB<MASK, true, true>(o, pa, pA0, pA1, m_reg, alA, vb0 + vprev, Cs, thr_raw, qi, kstart + (j + 1) * KVBLK, hi);
    RESC(alA); ROTV(); __syncthreads();
  }
  SBAR(); phaseA<NQ, true, true>(pB0, pB1, pA0, pA1, alA, l_reg, pa, kb0 + SHM_K, pb0 + SHM_P, rq, qr);
  phaseB<MASK, true, true>(o, pa, pB0, pB1, m_reg, alB, vb0 + vprev, Cs, thr_raw, qi, kstart + (NT - 1) * KVBLK, hi);
  RESC(alB); ROTV();
  phaseA<NQ, false, true>(pA0, pA1, pB0, pB1, alB, l_reg, pa, kb0, pb0, rq, qr);
  phaseB<MASK, true, false>(o, pa, pA0, pA1, m_reg, alA, vb0 + vprev, Cs, thr_raw, qi, 0, hi);
  if (hi == 0) li_l[r32] = l_reg; asm volatile("s_waitcnt lgkmcnt(0)" ::: "memory");
  bf16_t* Ow = Ob + (long)(wid * QBLK) * LDO;
#pragma unroll
  for (int r = 0; r < 16; ++r) { const int orow = crow(r, hi); const float rl = __builtin_amdgcn_rcpf(li_l[orow]); float sq = 0.f;
#pragma unroll
    for (int d0 = 0; d0 < 4; ++d0) { const float v = o[d0][r] * rl; sq += v * v; Ow[(long)orow * LDO + d0 * 32 + r32] = (bf16_t)(cvt_pk_bf16(v, v) & 0xffffu); }
#pragma unroll
    for (int s = 1; s < 32; s <<= 1) sq += __shfl_xor(sq, s);
    if (r32 == 0) ssq[(long)(wid * QBLK + orow) * 16] = sq; }
  __syncthreads();
#undef SLOAD
#undef SWRITE
#undef SWAIT
#undef RESC
#undef ROTV
}
#undef SBAR
#undef PIN
}

constexpr int NWAVES = 8;
#ifndef PROBE_ATT
#define PROBE_ATT 1
#endif
#ifndef PROBE_PRO
#define PROBE_PRO 1
#endif
#ifndef PROBE_MOEUP
#define PROBE_MOEUP 1
#endif
constexpr int RING_BYTES = 133120;
constexpr int MISC_OFF = 139264, LDS_BYTES = 147456;
static_assert(att::SHM_ATTN <= MISC_OFF && RING_BYTES <= MISC_OFF, "LDS map");
constexpr int NPHASE = 21;

__device__ const float INVF[64] = {
 1.000000000e+00f, 8.659643531e-01f, 7.498942018e-01f, 6.493816376e-01f, 5.623413324e-01f, 4.869675338e-01f, 4.216965139e-01f, 3.651741147e-01f, 3.162277639e-01f, 2.738419771e-01f, 2.371373773e-01f, 2.053525001e-01f, 1.778279394e-01f, 1.539926529e-01f, 1.333521456e-01f, 1.154781953e-01f,
 1.000000015e-01f, 8.659642935e-02f, 7.498942316e-02f, 6.493816525e-02f, 5.623413250e-02f, 4.869675264e-02f, 4.216964915e-02f, 3.651741147e-02f, 3.162277490e-02f, 2.738419548e-02f, 2.371373773e-02f, 2.053525113e-02f, 1.778279431e-02f, 1.539926510e-02f, 1.333521400e-02f, 1.154781971e-02f,
 9.999999776e-03f, 8.659643121e-03f, 7.498942316e-03f, 6.493816152e-03f, 5.623413250e-03f, 4.869675264e-03f, 4.216964822e-03f, 3.651741194e-03f, 3.162277630e-03f, 2.738419687e-03f, 2.371373819e-03f, 2.053525066e-03f, 1.778279431e-03f, 1.539926510e-03f, 1.333521446e-03f, 1.154782018e-03f,
 1.000000047e-03f, 8.659643354e-04f, 7.498941850e-04f, 6.493816036e-04f, 5.623413017e-04f, 4.869675322e-04f, 4.216965172e-04f, 3.651741135e-04f, 3.162277571e-04f, 2.738419571e-04f, 2.371373703e-04f, 2.053525095e-04f, 1.778279402e-04f, 1.539926598e-04f, 1.333521504e-04f, 1.154782003e-04f };

struct Args { const float* in[21]; float* out; unsigned char* ws; int ph_lo, ph_hi; };

__device__ __forceinline__ float wave_sum(float v) {
#pragma unroll
    for (int o = 1; o < 64; o <<= 1) v += __shfl_xor(v, o);
    return v;
}
__device__ __forceinline__ void sincos_acc(float ang, float& sn, float& cs) {
    const double a = (double)ang;
    const double n = __builtin_rint(a * 0.63661977236758134308);
    double r = __builtin_fma(-n, 1.57079632679489655800, a); r = __builtin_fma(-n, 6.12323399573676603587e-17, r);
    const double r2 = r * r;
    double sp = 1.0 / 6227020800.0; sp = __builtin_fma(sp, r2, -1.0 / 39916800.0); sp = __builtin_fma(sp, r2, 1.0 / 362880.0); sp = __builtin_fma(sp, r2, -1.0 / 5040.0);
    sp = __builtin_fma(sp, r2, 1.0 / 120.0); sp = __builtin_fma(sp, r2, -1.0 / 6.0); sp = __builtin_fma(sp * r2, r, r);
    double cp = 1.0 / 479001600.0; cp = __builtin_fma(cp, r2, -1.0 / 3628800.0); cp = __builtin_fma(cp, r2, 1.0 / 40320.0); cp = __builtin_fma(cp, r2, -1.0 / 720.0);
    cp = __builtin_fma(cp, r2, 1.0 / 24.0); cp = __builtin_fma(cp, r2, -0.5); cp = __builtin_fma(cp, r2, 1.0);
    const int q = ((int)n) & 3;
    const double s_ = (q & 1) ? cp : sp, c_ = (q & 1) ? sp : cp;
    sn = (float)((q & 2) ? -s_ : s_); cs = (float)(((q + 1) & 2) ? -c_ : c_);
}

__device__ __forceinline__ int src_quad(int kind, int n, int coff) {
    if (kind == 0) return coff + n;
    if (kind == 1) {
        if (n < 768 || (n >= 2112 && n < 2368)) return n;
        if (n >= 2368) return -1;
        int base, half, j;
        if (n < 832) { base = 768; half = 32; j = n - 768; } else if (n < 1856) { j = (n - 832) & 127; base = n - j; half = 64; } else { j = (n - 1856) & 127; base = n - j; half = 64; }
        const int g = j >> 3, e = j & 7; return base + (e < 4 ? 4 * g : half + 4 * g);
    }
    { const int head = n / 192, j = n - head * 192; if (j < 128) return n; const int jj = j - 128, g = jj >> 3, e = jj & 7; return head * 192 + 128 + (e < 4 ? 4 * g : 32 + 4 * g); }
}
__device__ __forceinline__ void tr_item(const float* __restrict__ src, int Nsrc, int K, bf16_t* __restrict__ dst, int k0, int n0, int kind, int coff,
                                        const float* __restrict__ gain, const float* __restrict__ gain2, LAS unsigned* scr, int lane) {
    const int nl = 4 * (lane & 15), ks = lane >> 4;
    const int sq = src_quad(kind, n0 + nl, coff);
#pragma unroll 4
    for (int r = 0; r < 16; ++r) {
        const int k = k0 + 8 * r + 2 * ks;
        f32x4 a = (f32x4){0.f, 0.f, 0.f, 0.f}, b = a;
        if (sq >= 0) { a = *(const f32x4*)(src + (size_t)k * Nsrc + sq); b = *(const f32x4*)(src + (size_t)(k + 1) * Nsrc + sq); }
        if (gain) { const float ga = (gain2 && k >= 1024) ? gain2[k - 1024] : gain[k], gb = (gain2 && k + 1 >= 1024) ? gain2[k + 1 - 1024] : gain[k + 1]; a *= ga; b *= gb; }
#pragma unroll
        for (int j = 0; j < 4; ++j) scr[(nl + j) * 65 + 4 * r + ks] = cvt_pk_bf16(a[j], b[j]);
    }
    asm volatile("s_waitcnt lgkmcnt(0)" ::: "memory");
#pragma unroll 4
    for (int it = 0; it < 16; ++it) {
        const int row = it * 4 + (lane >> 4), ch = lane & 15;
        const LAS unsigned* p = scr + row * 65 + 4 * ch;
        u32x4 w; w.x = p[0]; w.y = p[1]; w.z = p[2]; w.w = p[3];
        *(u32x4*)(dst + (size_t)(n0 + row) * K + k0 + 8 * ch) = w;
    }
    asm volatile("s_waitcnt lgkmcnt(0)" ::: "memory");
}
__device__ __forceinline__ void tr_item8(const float* __restrict__ src, int Nsrc, int K, unsigned char* __restrict__ dst, int k0, int n0, int scol, float scale, LAS unsigned* scr, int lane) {
    const int nl = 4 * (lane & 15), ks = lane >> 4;
#pragma unroll 4
    for (int r = 0; r < 16; ++r) {
        const int k = k0 + 16 * r + 4 * ks; const float* p = src + (size_t)k * Nsrc + scol + nl;
        const f32x4 a = *(const f32x4*)p * scale, b = *(const f32x4*)(p + Nsrc) * scale, c = *(const f32x4*)(p + 2 * (size_t)Nsrc) * scale, d = *(const f32x4*)(p + 3 * (size_t)Nsrc) * scale;
#pragma unroll
        for (int j = 0; j < 4; ++j) scr[(nl + j) * 65 + 4 * r + ks] = pk_fp8x4(a[j], b[j], c[j], d[j]);
    }
    asm volatile("s_waitcnt lgkmcnt(0)" ::: "memory");
#pragma unroll 4
    for (int it = 0; it < 16; ++it) {
        const int row = it * 4 + (lane >> 4), ch = lane & 15;
        const LAS unsigned* p = scr + row * 65 + 4 * ch;
        u32x4 w; w.x = p[0]; w.y = p[1]; w.z = p[2]; w.w = p[3];
        *(u32x4*)(dst + (size_t)(n0 + row) * K + k0 + 16 * ch) = w;
    }
    asm volatile("s_waitcnt lgkmcnt(0)" ::: "memory");
}
__device__ __forceinline__ void tr_item6(const float* __restrict__ src, int Nsrc, unsigned char* __restrict__ dst, int t, int n0, int scol, LAS unsigned* scr, int lane) {
    const int nl = 4 * (lane & 15), ks = lane >> 4;
    f32x4 a[16], b[16];
#pragma unroll
    for (int r = 0; r < 16; ++r) {
        const int kk = 8 * r + 2 * ks, k = 16 * t + 256 * (kk >> 4) + (kk & 15); const float* p = src + (size_t)k * Nsrc + scol + nl;
        a[r] = __builtin_nontemporal_load((const f32x4*)p); b[r] = __builtin_nontemporal_load((const f32x4*)(p + Nsrc));
    }
#pragma unroll
    for (int r = 0; r < 16; ++r) {
#pragma unroll
        for (int j = 0; j < 4; ++j) scr[(nl + j) * 65 + 4 * r + ks] = cvt_pk_bf16(a[r][j], b[r][j]);
    }
    asm volatile("s_waitcnt lgkmcnt(0)" ::: "memory");
#pragma unroll 1
    for (int it = 0; it < 4; ++it) {
        const int pidx = it * 64 + lane, n = pidx >> 2, g = pidx & 3;
        const LAS unsigned* p = scr + n * 65 + 2 * g;
        f32x16 lo, hi;
#pragma unroll
        for (int j = 0; j < 8; ++j) { const unsigned d0 = p[8 * j], d1 = p[8 * j + 1];
            const float x0 = __uint_as_float(d0 << 16), x1 = __uint_as_float(d0 & 0xffff0000u), x2 = __uint_as_float(d1 << 16), x3 = __uint_as_float(d1 & 0xffff0000u);
            if (j < 4) { lo[4 * j] = x0; lo[4 * j + 1] = x1; lo[4 * j + 2] = x2; lo[4 * j + 3] = x3; } else { hi[4 * (j - 4)] = x0; hi[4 * (j - 4) + 1] = x1; hi[4 * (j - 4) + 2] = x2; hi[4 * (j - 4) + 3] = x3; } }
        unsigned sb; const u32x6 q = mx6_block(lo, hi, sb);
        unsigned char* o = dst + (size_t)(n0 + n) * 2048 + t * 128 + 16 * g;
        *(u32x4*)o = (u32x4){q[0], q[1], q[2], q[3]}; *(u32x4*)(o + 64) = (u32x4){q[4], q[5], sb, 0u};
    }
    asm volatile("s_waitcnt lgkmcnt(0)" ::: "memory");
}
__device__ __forceinline__ void tr_item6c(const float* __restrict__ src, int Nsrc, int K, unsigned char* __restrict__ dst, int t, int n0, LAS unsigned* scr, int lane) {
    const int nl = 4 * (lane & 15), ks = lane >> 4;
    f32x4 a[16], b[16];
#pragma unroll
    for (int r = 0; r < 16; ++r) {
        const int k = 128 * t + 8 * r + 2 * ks; const float* p = src + (size_t)k * Nsrc + n0 + nl;
        a[r] = __builtin_nontemporal_load((const f32x4*)p); b[r] = __builtin_nontemporal_load((const f32x4*)(p + Nsrc));
    }
#pragma unroll
    for (int r = 0; r < 16; ++r) {
#pragma unroll
        for (int j = 0; j < 4; ++j) scr[(nl + j) * 65 + 4 * r + ks] = cvt_pk_bf16(a[r][j], b[r][j]);
    }
    asm volatile("s_waitcnt lgkmcnt(0)" ::: "memory");
#pragma unroll 1
    for (int it = 0; it < 4; ++it) {
        const int pidx = it * 64 + lane, n = pidx >> 2, g = pidx & 3;
        const LAS unsigned* p = scr + n * 65 + 16 * g;
        f32x16 lo, hi;
#pragma unroll
        for (int j = 0; j < 8; ++j) { const unsigned d0 = p[j], d1 = p[8 + j];
            lo[2 * j] = __uint_as_float(d0 << 16); lo[2 * j + 1] = __uint_as_float(d0 & 0xffff0000u); hi[2 * j] = __uint_as_float(d1 << 16); hi[2 * j + 1] = __uint_as_float(d1 & 0xffff0000u); }
        unsigned sb; const u32x6 q = mx6_block(lo, hi, sb);
        unsigned char* o = dst + (size_t)(n0 + n) * K + t * 128 + 16 * g;
        *(u32x4*)o = (u32x4){q[0], q[1], q[2], q[3]}; *(u32x4*)(o + 64) = (u32x4){q[4], q[5], sb, 0u};
    }
    asm volatile("s_waitcnt lgkmcnt(0)" ::: "memory");
}
__device__ __forceinline__ void tr_matrix6c(const float* src, int Nsrc, int K, unsigned char* dst, int Ndst, LAS unsigned* scr, int lane, int gw, int NGW, int& cursor) {
    const int nb = Ndst / 64, items = (K / 128) * nb;
    int it = (gw - (cursor % NGW) + NGW) % NGW;
    for (; it < items; it += NGW) tr_item6c(src, Nsrc, K, dst, it / nb, (it % nb) * 64, scr, lane);
    cursor += items;
}
__device__ __forceinline__ void tr_matrix6(const float* src, const float* src2, int Nsrc, unsigned char* dst, int Ndst, LAS unsigned* scr, int lane, int gw, int NGW, int& cursor) {
    const int nb = Ndst / 64, items = 16 * nb;
    int it = (gw - (cursor % NGW) + NGW) % NGW;
    for (; it < items; it += NGW) {
        const int t = it / nb, n0 = (it % nb) * 64, tile = n0 >> 8, j0 = n0 & 255;
        tr_item6(j0 < 128 ? src : src2, Nsrc, dst, t, n0, 128 * tile + (j0 & 127), scr, lane);
    }
    cursor += items;
}
__device__ __forceinline__ void tr_matrix8(const float* src, const float* src2, int Nsrc, int K, unsigned char* dst, int Ndst, int inter, float scale, LAS unsigned* scr, int lane, int gw, int NGW, int& cursor) {
    const int nb = Ndst / 64, items = (K / 256) * nb;
    int it = (gw - (cursor % NGW) + NGW) % NGW;
    for (; it < items; it += NGW) {
        const int kb = it / nb, n0 = (it % nb) * 64;
        if (inter) { const int tile = n0 >> 8, j0 = n0 & 255; tr_item8(j0 < 128 ? src : src2, Nsrc, K, dst, kb * 256, n0, 128 * tile + (j0 & 127), scale, scr, lane); }
        else tr_item8(src, Nsrc, K, dst, kb * 256, n0, n0, scale, scr, lane);
    }
    cursor += items;
}
__device__ __forceinline__ void tr_matrix(const float* src, const float* src2, int Nsrc, int K, bf16_t* dst, int Ndst, int kind, const float* gain, const float* gain2,
                                          LAS unsigned* scr, int lane, int gw, int NGW, int& cursor) {
    const int nb = Ndst / 64, items = (K / 128) * nb;
    int it = (gw - (cursor % NGW) + NGW) % NGW;
    for (; it < items; it += NGW) {
        const int kb = it / nb, n0 = (it % nb) * 64;
        if (kind == 3) { const int tile = n0 >> 8, j0 = n0 & 255; tr_item(j0 < 128 ? src : src2, Nsrc, K, dst, kb * 128, n0, 0, 128 * tile + (j0 & 127) - n0, nullptr, nullptr, scr, lane); }
        else tr_item(src, Nsrc, K, dst, kb * 128, n0, kind, 0, gain, gain2, scr, lane);
    }
    cursor += items;
}

constexpr int MOE_GU_ITEMS = 16 * (2 * FFE / 64), MOE_D_ITEMS = (FFE / 128) * (D / 64), MOE_E_ITEMS = MOE_GU_ITEMS + MOE_D_ITEMS, MOE_ITEMS = NE * MOE_E_ITEMS;
__device__ __forceinline__ void moe_conv_item(const Args& args, int j, LAS unsigned* scr, int lane) {
    const int e = j / MOE_E_ITEMS, r = j - e * MOE_E_ITEMS;
    if (r < MOE_GU_ITEMS) {
        constexpr int nb = 2 * FFE / 64;
        const int t = r / nb, n0 = (r % nb) * 64, tile = n0 >> 8, j0 = n0 & 255;
        tr_item6((j0 < 128 ? args.in[16] : args.in[17]) + (size_t)e * D * FFE, FFE, args.ws + WS_WMGU + (size_t)e * 2 * FFE * D, t, n0, 128 * tile + (j0 & 127), scr, lane);
    } else {
        const int r2 = r - MOE_GU_ITEMS, t = r2 / (D / 64), n0 = (r2 % (D / 64)) * 64;
        tr_item6c(args.in[18] + (size_t)e * FFE * D, D, FFE, args.ws + WS_WMD + (size_t)e * D * FFE, t, n0, scr, lane);
    }
}
__device__ __forceinline__ void moe_conv_burst(const Args& args, LAS unsigned char* lds, int part, int nparts) {
    const int tid = tid_opaque(), lane = tid & 63, wave = tid >> 6, gw = blockIdx.x * NWAVES + wave, NGW = gridDim.x * NWAVES;
    LAS unsigned* scr = (LAS unsigned*)(lds + wave * 16640);
    const int per = (MOE_ITEMS + NGW - 1) / NGW, i0 = per * part / nparts, i1 = per * (part + 1) / nparts;
    __syncthreads();
    for (int i = i0; i < i1; ++i) { const int j = gw + i * NGW; if (j < MOE_ITEMS) moe_conv_item(args, j, scr, lane); }
    __syncthreads();
}

__device__ __forceinline__ void ln_row(f32x4 (&v)[8], const float* __restrict__ g, const float* __restrict__ b, int lane, float& mean_o, float& rstd_o) {
    float s = 0.f;
#pragma unroll
    for (int j = 0; j < 8; ++j) s += (v[j][0] + v[j][1]) + (v[j][2] + v[j][3]);
    const float mean = wave_sum(s) * (1.f / D); float s2 = 0.f;
#pragma unroll
    for (int j = 0; j < 8; ++j) { v[j] = v[j] - mean; s2 += (v[j][0] * v[j][0] + v[j][1] * v[j][1]) + (v[j][2] * v[j][2] + v[j][3] * v[j][3]); }
    const float rstd = 1.f / sqrtf(wave_sum(s2) * (1.f / D) + LN_EPS); mean_o = mean; rstd_o = rstd;
#pragma unroll
    for (int j = 0; j < 8; ++j) { const f32x4 gg = *((const f32x4*)g + lane + 64 * j), bb = *((const f32x4*)b + lane + 64 * j); v[j] = v[j] * rstd * gg + bb; }
}

#define WSP(T, off) ((T*)(args.ws + (off)))
#define IN(k) (lo <= (k) && (k) < hi)
#define SEAM(k) do { if (IN(k) && IN((k) + 1)) { XcdBarrier b_; b_.bar = WSP(unsigned, WS_CTL) + CW_BAR; b_.x = xb_xcc_id(); b_.st = (volatile LAS unsigned*)(lds + MISC_OFF) + 8; xcd_barrier(b_); } } while (0)

__device__ __forceinline__ int moe_unit_table(const int* moemeta, int NT, LAS int* utab) {
    const int tid = tid_opaque();
    pg8::MoeOrder Mo;
#pragma unroll
    for (int e = 0; e <= NE; ++e) Mo.pb[e] = moemeta[e];
    Mo.NT = NT; Mo.G = gridDim.x; Mo.c = blockIdx.x; Mo.nwg = Mo.pb[NE] * NT;
    if (tid < 64) { pg8::Unit u; u.pm = 0; u.pn = 0; u.aux = 0; Mo.next(tid, u); utab[4 * tid] = u.pm; utab[4 * tid + 1] = u.pn; utab[4 * tid + 2] = u.aux; }
    __syncthreads();
    const int left = Mo.nwg - Mo.c; int n = left <= 0 ? 0 : (left + Mo.G - 1) / Mo.G;
    return __builtin_amdgcn_readfirstlane(n < 64 ? n : 64);
}
__device__ __forceinline__ f32x4 tail_sum(const bf16_t* yp, int t, int d, int lane, int SK) {
    f32x4 acc = {0.f, 0.f, 0.f, 0.f};
    for (int q = 0; q < SK; ++q) { const u32x2 a = *((const u32x2*)(yp + ((size_t)(q * 128 + t - 1) * 256 + (d & 255)) * 256) + lane);
        acc += (f32x4){__uint_as_float(a.x << 16), __uint_as_float(a.x & 0xffff0000u), __uint_as_float(a.y << 16), __uint_as_float(a.y & 0xffff0000u)}; }
    return acc;
}
__device__ __forceinline__ int moe_tail_split(int nwg, int G, int& Rf, int& Tn) {
    Rf = nwg / G; Tn = nwg - Rf * G;
    return Tn == 0 ? 1 : (Tn * 7 <= G ? 7 : (Tn * 4 <= G ? 4 : (Tn * 2 <= G ? 2 : 1)));
}
__device__ __forceinline__ int moe_unit_table_k(const int* moemeta, int NT, LAS int* utab, unsigned char* tailmap) {
    const int tid = tid_opaque();
    pg8::MoeOrder Mo;
#pragma unroll
    for (int e = 0; e <= NE; ++e) Mo.pb[e] = moemeta[e];
    Mo.NT = NT; Mo.G = gridDim.x; Mo.c = blockIdx.x; Mo.nwg = Mo.pb[NE] * NT;
    int Rf, Tn; const int SK = moe_tail_split(Mo.nwg, Mo.G, Rf, Tn);
    const int R = Rf < 63 ? Rf : 63;
    const bool piece = SK > 1 ? (Mo.c < Tn * SK) : (Mo.c < Tn);
    if (tid < 64) {
        long Lq = -1; int kx = 0, mark = 0;
        if (tid < R) Lq = (long)tid * Mo.G + Mo.c;
        else if (tid == R && piece) {
            if (SK == 1) Lq = (long)Rf * Mo.G + Mo.c;
            else { const int j = Mo.c / SK, q = Mo.c - j * SK; Lq = (long)Rf * Mo.G + j; kx = (1 + j) | (q << 8) | (SK << 16); mark = (q == 0) ? 1 + j : 0; }
        }
        pg8::Unit u; u.pm = 0; u.pn = 0; u.aux = 0; u.kx = 0;
        if (Lq >= 0) Mo.at(Lq, u);
        if (mark) tailmap[u.pm * 8 + u.aux] = (unsigned char)mark;
        utab[4 * tid] = u.pm; utab[4 * tid + 1] = u.pn; utab[4 * tid + 2] = u.aux; utab[4 * tid + 3] = kx;
    }
    __syncthreads();
    return __builtin_amdgcn_readfirstlane(R + (piece ? 1 : 0));
}
template <int L>
__device__ __forceinline__ void layer_phases(const Args& args, LAS unsigned char* lds, char* lds_gen, int lo, int hi) {
    constexpr int pb = 1 + 10 * L;
    if (IN(pb + 0)) {
        const int G = gridDim.x, bx = blockIdx.x;
        pg8::Gemm g{WSP(const bf16_t, WS_XB), WSP(const bf16_t, WS_WIN + L * SZ_WIN), D}; pg8::StaticOrder So; So.init(S, 2048, G, bx);
        pg8::EpiInProj E{WSP(bf16_t, WS_CQ), WSP(bf16_t, WS_CKV), WSP(bf16_t, WS_KPE), WSP(bf16_t, WS_QS), WSP(bf16_t, WS_KS), WSP(bf16_t, WS_VS), WSP(float, WS_PARTQ), WSP(float, WS_PARTKV),
                         WSP(const float, WS_COSM), WSP(const float, WS_SINM), WSP(const float, WS_COSS), WSP(const float, WS_SINS)};
        pg8::gemm_phase<pg8::EpiInProj, pg8::StaticOrder, true, true>(lds, g, So, E);
    }
    SEAM(pb + 0);
    if (IN(pb + 1)) {
        const int G = gridDim.x, bx = blockIdx.x;
        LAS int* utab = (LAS int*)(lds + MISC_OFF + 1024);
        LAS int* ucnt = (LAS int*)(lds + MISC_OFF + 1024 + 3072);
        if (tid_opaque() == 0) {
            int nl = 0, nq = 0, nk = 0;
            if (G == 256) {
                if (bx < 128) { utab[0] = bx >> 1; utab[1] = 8 + (bx & 1); utab[2] = 8 + (bx & 1); nl = 1; utab[128] = bx >> 3; utab[129] = bx & 7; utab[130] = bx & 7; nk = 1; }
                else { const int c = bx - 128;
                    for (int i = 0; i < 3; ++i) { const int u = 3 * c + i; utab[64 + 4 * i] = u / 6; utab[65 + 4 * i] = u % 6; utab[66 + 4 * i] = u % 6; }
                    nq = 3;
                    for (int i = 0; i < 3; ++i) { const int u = 128 + 3 * c + i; utab[128 + 4 * i] = u >> 3; utab[129 + 4 * i] = u & 7; utab[130 + 4 * i] = u & 7; }
                    nk = 3; }
            } else {
                for (int u = bx; u < 128 && nl < 16; u += G, ++nl) { utab[4 * nl] = u >> 1; utab[4 * nl + 1] = 8 + (u & 1); utab[4 * nl + 2] = 8 + (u & 1); }
                for (int u = bx; u < 384 && nq < 16; u += G, ++nq) { utab[64 + 4 * nq] = u / 6; utab[65 + 4 * nq] = u % 6; utab[66 + 4 * nq] = u % 6; }
                for (int u = bx; u < 512 && nk < 16; u += G, ++nk) { utab[128 + 4 * nk] = u >> 3; utab[129 + 4 * nk] = u & 7; utab[130 + 4 * nk] = u & 7; }
            }
            ucnt[0] = nl; ucnt[1] = nq; ucnt[2] = nk;
        }
        __syncthreads();
        { pg8::TableOrder To{utab, __builtin_amdgcn_readfirstlane(ucnt[0])};
          pg8::Gemm g{WSP(const bf16_t, WS_XB), WSP(const bf16_t, WS_WIN + L * SZ_WIN), D};
          pg8::EpiInProj E{WSP(bf16_t, WS_CQ), WSP(bf16_t, WS_CKV), WSP(bf16_t, WS_KPE), WSP(bf16_t, WS_QS), WSP(bf16_t, WS_KS), WSP(bf16_t, WS_VS), WSP(float, WS_PARTQ), WSP(float, WS_PARTKV),
                           WSP(const float, WS_COSM), WSP(const float, WS_SINM), WSP(const float, WS_COSS), WSP(const float, WS_SINS)};
          pg8::gemm_phase<pg8::EpiInProj, pg8::TableOrder, true, true>(lds, g, To, E); }
        { pg8::TableOrder To{utab + 64, __builtin_amdgcn_readfirstlane(ucnt[1])};
          pg8::Gemm g{WSP(const bf16_t, WS_CQ), WSP(const bf16_t, WS_WQ + L * SZ_WQ), QLORA};
          pg8::EpiQ E{WSP(bf16_t, WS_Q), WSP(const float, WS_PARTQ), WSP(const float, WS_COSM), WSP(const float, WS_SINM)};
          pg8::gemm_phase<pg8::EpiQ, pg8::TableOrder, true, true>(lds, g, To, E); }
        { pg8::TableOrder To{utab + 128, __builtin_amdgcn_readfirstlane(ucnt[2])};
          pg8::Gemm g{WSP(const bf16_t, WS_CKV), WSP(const bf16_t, WS_WKV + L * SZ_WKV), KVLORA};
          pg8::EpiKV E{WSP(bf16_t, WS_KV), WSP(const float, WS_PARTKV)};
          pg8::gemm_phase<pg8::EpiKV, pg8::TableOrder, true, true>(lds, g, To, E); }
    }
    SEAM(pb + 1);
    if (IN(pb + 2)) {
        const int G = gridDim.x, bx = blockIdx.x;
        const int slot = bx % 3; bool pending = true;
        for (int step = 0; ; ++step) {
            const int u = bx + step * G; const bool more = u < 512;
            if (pending && (step == slot || !more)) { moe_conv_burst(args, lds, L, DEPTH); pending = false; }
            if (!more) break;
            const int r = u / 256, c = u % 256, head = 4 * r + ((c & 7) >> 1), qblk = (c >> 3) + 32 * (c & 1);
            att::attn_body<192, false, QCOLS, KVCOLS, 64, KVCOLS, D>(WSP(const bf16_t, WS_Q) + (size_t)qblk * 256 * QCOLS + head * 192, WSP(const bf16_t, WS_KV) + head * 256, WSP(const bf16_t, WS_KPE),
                WSP(const bf16_t, WS_KV) + head * 256 + 128, WSP(bf16_t, WS_OBUF) + (size_t)qblk * 256 * D + head * 128, WSP(float, WS_PARTO) + (size_t)qblk * 256 * 16 + head, qblk * 256, 0, S / 64, SCALE_MLA, 0.f, (LAS char*)lds);
        }
        for (int u = bx; u < 512; u += G) {
            const int head = u >> 6, qblk = u & 63;
            int t0 = 4 * qblk - 2, t1 = 4 * qblk + 5; if (t0 < 0) t0 = 0; if (t1 > S / 64 - 1) t1 = S / 64 - 1;
            const float sk = (args.in[6] + L * 8)[head];
            att::attn_body<128, true, 1024, 256, 64, 256, D>(WSP(const bf16_t, WS_QS) + (size_t)qblk * 256 * 1024 + head * 128, WSP(const bf16_t, WS_KS) + (head >> 2) * 128, nullptr, WSP(const bf16_t, WS_VS) + (head >> 2) * 128,
                WSP(bf16_t, WS_OBUF) + (size_t)qblk * 256 * D + 1024 + head * 128, WSP(float, WS_PARTO) + (size_t)qblk * 256 * 16 + 8 + head, qblk * 256, t0 * 64, t1 - t0 + 1, SCALE_SWA, sk / SCALE_SWA, (LAS char*)lds);
        }
    }
    SEAM(pb + 2);
    if (IN(pb + 4)) {
        const int G = gridDim.x, bx = blockIdx.x;
        pg8::Gemm g{WSP(const bf16_t, WS_OBUF), WSP(const bf16_t, WS_WOUT + L * SZ_WOUT), D}; pg8::StaticOrder So; So.init(S, D, G, bx);
        if constexpr (L == 0) { pg8::EpiOutProj<false> E{args.in[0], WSP(float, WS_XA), WSP(const float, WS_PARTO), nullptr, nullptr, nullptr}; pg8::gemm_phase<pg8::EpiOutProj<false>, pg8::StaticOrder, true, true>(lds, g, So, E); }
        else { pg8::EpiOutProj<true> E{WSP(const float, WS_XA), WSP(float, WS_XA), WSP(const float, WS_PARTO), WSP(const float, WS_ST2), args.in[19] + (L - 1) * D, args.in[20] + (L - 1) * D};
               pg8::gemm_phase<pg8::EpiOutProj<true>, pg8::StaticOrder, true, true>(lds, g, So, E); }
    }
    SEAM(pb + 4);
    if (IN(pb + 5)) {
        const int tid = tid_opaque(), lane = tid & 63, wave = tid >> 6, G = gridDim.x, bx = blockIdx.x;
        const float* lg = args.in[10] + L * D; const float* lb = args.in[11] + L * D;
        float* XA = WSP(float, WS_XA); unsigned* X8 = WSP(unsigned, WS_X8);
        const int RPW = (S + G - 1) / G, r0 = bx * RPW, r1 = (r0 + RPW < S) ? r0 + RPW : S;
        LAS float* wr_l = (LAS float*)lds; LAS int* hist = (LAS int*)(lds + 65536);
        if (L == 1) { const float* wrg = args.in[15]; for (int i = tid; i < D * NE; i += 512) wr_l[i] = wrg[i]; if (tid < NE) hist[tid] = 0; __syncthreads(); }
        for (int row = r0 + wave; row < r1; row += NWAVES) {
            f32x4 v[8]; float* xr = XA + (size_t)row * D;
#pragma unroll
            for (int j = 0; j < 8; ++j) v[j] = *((const f32x4*)xr + lane + 64 * j);
            float mu_, rs_; ln_row(v, lg, lb, lane, mu_, rs_);
            if (lane == 0) { float* st = WSP(float, WS_ST1); st[2 * row] = mu_; st[2 * row + 1] = rs_; }
            { f32x16 lo, hi;
#pragma unroll
              for (int j = 0; j < 4; ++j)
#pragma unroll
                  for (int c = 0; c < 4; ++c) { lo[4 * j + c] = v[j][c]; hi[4 * j + c] = v[4 + j][c]; }
              unsigned sb; const u32x6 q = mx6_block(lo, hi, sb);
              unsigned char* o = (unsigned char*)X8 + (size_t)row * D + (lane >> 2) * 128 + 16 * (lane & 3);
              *(u32x4*)o = (u32x4){q[0], q[1], q[2], q[3]}; *(u32x4*)(o + 64) = (u32x4){q[4], q[5], sb, 0u}; }
            if (L == 1) {
                float q0 = 0.f, q1 = 0.f, q2 = 0.f, q3 = 0.f, q4 = 0.f, q5 = 0.f, q6 = 0.f, q7 = 0.f;
#pragma unroll
                for (int j = 0; j < 8; ++j)
#pragma unroll
                    for (int k = 0; k < 4; ++k) { const LAS f32x4* w = (const LAS f32x4*)(wr_l + (size_t)(4 * (lane + 64 * j) + k) * NE); const f32x4 w0 = w[0], w1 = w[1]; const float xv = v[j][k];
                        q0 += xv * w0[0]; q1 += xv * w0[1]; q2 += xv * w0[2]; q3 += xv * w0[3]; q4 += xv * w1[0]; q5 += xv * w1[1]; q6 += xv * w1[2]; q7 += xv * w1[3]; }
                q0 = wave_sum(q0); q1 = wave_sum(q1); q2 = wave_sum(q2); q3 = wave_sum(q3); q4 = wave_sum(q4); q5 = wave_sum(q5); q6 = wave_sum(q6); q7 = wave_sum(q7);
                int e0 = 0; float l0 = q0;
                if (q1 > l0) { l0 = q1; e0 = 1; } if (q2 > l0) { l0 = q2; e0 = 2; } if (q3 > l0) { l0 = q3; e0 = 3; } if (q4 > l0) { l0 = q4; e0 = 4; } if (q5 > l0) { l0 = q5; e0 = 5; } if (q6 > l0) { l0 = q6; e0 = 6; } if (q7 > l0) { l0 = q7; e0 = 7; }
                int e1 = -1; float l1 = -3.0e38f;
                if (e0 != 0 && q0 > l1) { l1 = q0; e1 = 0; } if (e0 != 1 && q1 > l1) { l1 = q1; e1 = 1; } if (e0 != 2 && q2 > l1) { l1 = q2; e1 = 2; } if (e0 != 3 && q3 > l1) { l1 = q3; e1 = 3; }
                if (e0 != 4 && q4 > l1) { l1 = q4; e1 = 4; } if (e0 != 5 && q5 > l1) { l1 = q5; e1 = 5; } if (e0 != 6 && q6 > l1) { l1 = q6; e1 = 6; } if (e0 != 7 && q7 > l1) { l1 = q7; e1 = 7; }
                const float t = __expf(l1 - l0), g0 = 1.0f / (1.0f + t), g1 = t / (1.0f + t);
                if (lane == 0) { int* sel = WSP(int, WS_SEL); float* gate = WSP(float, WS_GATE); sel[2 * row] = e0; sel[2 * row + 1] = e1; gate[2 * row] = g0; gate[2 * row + 1] = g1;
                    __hip_atomic_fetch_add(hist + e0, 1, __ATOMIC_RELAXED, __HIP_MEMORY_SCOPE_WORKGROUP); __hip_atomic_fetch_add(hist + e1, 1, __ATOMIC_RELAXED, __HIP_MEMORY_SCOPE_WORKGROUP); }
            }
        }
        if (L == 1) { __syncthreads(); if (tid < NE) WSP(int, WS_WGCNT)[bx * NE + tid] = hist[tid]; }
    }
    SEAM(pb + 5);
    if constexpr (L == 0) {
        if (IN(pb + 7)) {
            const int G = gridDim.x, bx = blockIdx.x;
            pg8::Gemm g{WSP(const bf16_t, WS_X8), WSP(const bf16_t, WS_WGU), D}; pg8::StaticOrder So; So.init(S, 2 * FF, G, bx);
            pg8::EpiSwiglu6 E{WSP(unsigned char, WS_H), FF};
            pg8::gemm_phase<pg8::EpiSwiglu6, pg8::StaticOrder, true, true, 2>(lds, g, So, E);
        }
        SEAM(pb + 7);
        if (IN(pb + 8)) {
            const int G = gridDim.x, bx = blockIdx.x;
            pg8::Gemm g{WSP(const bf16_t, WS_H), WSP(const bf16_t, WS_WD), FF}; pg8::StaticOrder So; So.init(S, D, G, bx);
            pg8::EpiResidLN E{WSP(const float, WS_XA), WSP(float, WS_XA), 1.0f, WSP(const float, WS_ST1), args.in[10] + L * D, args.in[11] + L * D};
            pg8::gemm_phase<pg8::EpiResidLN, pg8::StaticOrder, true, true, 2>(lds, g, So, E);
        }
        SEAM(pb + 8);
        if (IN(pb + 9)) {
            const int tid = tid_opaque(), lane = tid & 63, gw = blockIdx.x * NWAVES + (tid >> 6), NGW = gridDim.x * NWAVES;
            const float* lg = args.in[19] + L * D; const float* lb = args.in[20] + L * D; float* XA = WSP(float, WS_XA); bf16_t* XB = WSP(bf16_t, WS_XB);
            for (int row = gw; row < S; row += NGW) {
                f32x4 v[8]; float* xr = XA + (size_t)row * D;
#pragma unroll
                for (int j = 0; j < 8; ++j) v[j] = *((const f32x4*)xr + lane + 64 * j);
                float mu_, rs_; ln_row(v, lg, lb, lane, mu_, rs_);
                if (lane == 0) { float* st = WSP(float, WS_ST2); st[2 * row] = mu_; st[2 * row + 1] = rs_; }
#pragma unroll
                for (int j = 0; j < 8; ++j) *((u32x2*)(XB + (size_t)row * D) + lane + 64 * j) = pg8::pack4(v[j]);
            }
        }
        SEAM(pb + 9);
    } else {
        if (IN(pb + 6)) {
            const int tid = tid_opaque(), lane = tid & 63, wave = tid >> 6, G = gridDim.x, bx = blockIdx.x;
            const int RPW = (S + G - 1) / G, r0 = bx * RPW, r1 = (r0 + RPW < S) ? r0 + RPW : S, na = 2 * (r1 - r0);
            LAS int* tab = (LAS int*)lds;
            LAS int* basee = (LAS int*)(lds + 32768);
            LAS int* asel = (LAS int*)(lds + 33024);
            LAS int* adst = (LAS int*)(lds + 35072);
            const int* wgcnt = WSP(const int, WS_WGCNT); const int* sel = WSP(const int, WS_SEL);
            for (int i = tid; i < G * NE; i += 512) tab[i] = wgcnt[i];
            for (int i = tid; i < na; i += 512) asel[i] = sel[2 * r0 + i];
            __syncthreads();
            if (tid < NE) { int tot = 0, pre = 0; for (int w = 0; w < G; ++w) { const int c = tab[w * NE + tid]; pre += (w < bx) ? c : 0; tot += c; } basee[32 + tid] = tot; basee[40 + tid] = pre; }
            __syncthreads();
            if (tid == 0) { int p = 0; for (int e = 0; e < NE; ++e) { basee[8 + e] = p; basee[e] = 256 * p + basee[40 + e]; p += (basee[32 + e] + 255) >> 8; } basee[16] = p;
                if (bx == 0) { int* moemeta = WSP(int, WS_MOEMETA); for (int e = 0; e <= NE; ++e) moemeta[e] = basee[8 + e]; } }
            __syncthreads();
            if (tid < NE) { int rk = basee[tid]; for (int i = 0; i < na; ++i) if (asel[i] == tid) adst[i] = rk++; }
            __syncthreads();
            int* dest = WSP(int, WS_DEST); const unsigned char* X8 = WSP(const unsigned char, WS_X8); unsigned char* xs = WSP(unsigned char, WS_XS);
            for (int i = tid; i < na; i += 512) dest[2 * r0 + i] = adst[i];
            if (bx < NE) {
                const int rb = 256 * basee[8 + bx] + basee[32 + bx], re = 256 * basee[9 + bx];
                for (int i = rb * 128 + tid; i < re * 128; i += 512) ((u32x4*)xs)[i] = (u32x4){0u, 0u, 0u, 0u};
            }
            for (int a = wave; a < na; a += NWAVES) { const u32x4* s4 = (const u32x4*)(X8 + (size_t)(r0 + (a >> 1)) * D); u32x4* d4 = (u32x4*)(xs + (size_t)adst[a] * D);
#pragma unroll
                for (int j = 0; j < 2; ++j) d4[lane + 64 * j] = s4[lane + 64 * j]; }
        }
        SEAM(pb + 6);
        if (IN(pb + 7)) {
            LAS int* utab = (LAS int*)(lds + MISC_OFF + 1024);
            const int nun = moe_unit_table(WSP(const int, WS_MOEMETA), 2 * FFE / 256, utab);
            pg8::TableOrder To{utab, nun};
            pg8::Gemm g{WSP(const bf16_t, WS_XS), WSP(const bf16_t, WS_WMGU), D};
            pg8::EpiSwiglu6 E{WSP(unsigned char, WS_H), FFE};
            for (int rep = 0; rep < PROBE_MOEUP; ++rep) pg8::gemm_phase<pg8::EpiSwiglu6, pg8::TableOrder, true, true, 2>(lds, g, To, E);
        }
        SEAM(pb + 7);
        if (IN(pb + 8)) {
            LAS int* utab = (LAS int*)(lds + MISC_OFF + 1024);
            const int nun = moe_unit_table_k(WSP(const int, WS_MOEMETA), D / 256, utab, WSP(unsigned char, WS_TAILMAP));
            pg8::TableOrderK To{utab, nun};
            pg8::Gemm g{WSP(const bf16_t, WS_H), WSP(const bf16_t, WS_WMD), FFE};
            pg8::EpiBf16OutK E{WSP(bf16_t, WS_XS), WSP(bf16_t, WS_YP)};
            pg8::gemm_phase<pg8::EpiBf16OutK, pg8::TableOrderK, true, true, 2>(lds, g, To, E);
        }
        SEAM(pb + 8);
        if (IN(pb + 9)) {
            const int tid = tid_opaque(), lane = tid & 63, gw = blockIdx.x * NWAVES + (tid >> 6), NGW = gridDim.x * NWAVES;
            const float* lg = args.in[19] + L * D; const float* lb = args.in[20] + L * D;
            const int* dest = WSP(const int, WS_DEST); const float* gate = WSP(const float, WS_GATE); const float* XA = WSP(const float, WS_XA); const bf16_t* ys = WSP(const bf16_t, WS_XS);
            const float* st1 = WSP(const float, WS_ST1); const float* g1p = args.in[10] + L * D; const float* b1p = args.in[11] + L * D;
            for (int row = gw; row < S; row += NGW) {
                const int d0 = dest[2 * row], d1 = dest[2 * row + 1]; const float g0 = gate[2 * row], g1 = gate[2 * row + 1]; const float mu1 = st1[2 * row], rs1 = st1[2 * row + 1];
                f32x4 v[8]; const float* xr = XA + (size_t)row * D; const u32x2* y0 = (const u32x2*)(ys + (size_t)d0 * D); const u32x2* y1 = (const u32x2*)(ys + (size_t)d1 * D);
                const u32x2 m0 = *(const u32x2*)(WSP(const unsigned char, WS_TAILMAP) + (d0 >> 8) * 8), m1 = *(const u32x2*)(WSP(const unsigned char, WS_TAILMAP) + (d1 >> 8) * 8);
                const bool anyt = (m0.x | m0.y | m1.x | m1.y) != 0u;
#pragma unroll
                for (int j = 0; j < 8; ++j) { const f32x4 yv = *((const f32x4*)xr + lane + 64 * j); const f32x4 x = (yv - mu1) * rs1 * *((const f32x4*)g1p + lane + 64 * j) + *((const f32x4*)b1p + lane + 64 * j); const u32x2 a = y0[lane + 64 * j], b = y1[lane + 64 * j];
                    f32x4 fa = {__uint_as_float(a.x << 16), __uint_as_float(a.x & 0xffff0000u), __uint_as_float(a.y << 16), __uint_as_float(a.y & 0xffff0000u)};
                    f32x4 fb = {__uint_as_float(b.x << 16), __uint_as_float(b.x & 0xffff0000u), __uint_as_float(b.y << 16), __uint_as_float(b.y & 0xffff0000u)};
                    if (anyt) {
                        const int t0 = (int)(((j < 4 ? m0.x : m0.y) >> (8 * (j & 3))) & 255u), t1 = (int)(((j < 4 ? m1.x : m1.y) >> (8 * (j & 3))) & 255u);
                        if (t0 | t1) {
                            const int nwg_ = WSP(const int, WS_MOEMETA)[NE] * (D / 256), G_ = gridDim.x, Tn_ = nwg_ - (nwg_ / G_) * G_, SK = Tn_ * 7 <= G_ ? 7 : (Tn_ * 4 <= G_ ? 4 : 2);
                            if (t0) fa = tail_sum(WSP(const bf16_t, WS_YP), t0, d0, lane, SK);
                            if (t1) fb = tail_sum(WSP(const bf16_t, WS_YP), t1, d1, lane, SK);
                        }
                    }
                    v[j] = x * ALPHA + (fa * g0 + fb * g1); }
                float mu_, rs_; ln_row(v, lg, lb, lane, mu_, rs_);
#pragma unroll
                for (int j = 0; j < 8; ++j) *((f32x4*)(args.out + (size_t)row * D) + lane + 64 * j) = v[j];
            }
        }
    }
}

__global__ void __launch_bounds__(NWAVES * 64, 2) fwd(Args args) {
    extern __shared__ __attribute__((aligned(16))) unsigned char lds_raw[];
    LAS unsigned char* lds = (LAS unsigned char*)lds_raw;
    volatile LAS unsigned* MISC = (volatile LAS unsigned*)(lds + MISC_OFF);
    for (int u = tid_opaque(); u < (LDS_BYTES - MISC_OFF) / 4; u += NWAVES * 64) MISC[u] = 0u;
    __syncthreads();
    (void)xcd_barrier_post(WSP(unsigned, WS_CTL) + CW_BAR, MISC + 8);
    const int lo = args.ph_lo, hi = args.ph_hi;

    if (IN(0)) {
        const int tid = tid_opaque(), lane = tid & 63, wave = tid >> 6, G = gridDim.x, bx = blockIdx.x, gw = bx * NWAVES + wave, NGW = G * NWAVES;
        unsigned char* ws = args.ws;
        LAS unsigned* scr = (LAS unsigned*)(lds + wave * 16640);
        for (int rep = 0; rep < PROBE_PRO; ++rep) {
        int cursor = 0;
        for (int l = 0; l < DEPTH; ++l) {
            tr_matrix(args.in[1] + (size_t)l * D * IN_COLS, nullptr, IN_COLS, D, (bf16_t*)(ws + WS_WIN + l * SZ_WIN), IN_PAD, 1, nullptr, nullptr, scr, lane, gw, NGW, cursor);
            tr_matrix(args.in[3] + (size_t)l * QLORA * QCOLS, nullptr, QCOLS, QLORA, (bf16_t*)(ws + WS_WQ + l * SZ_WQ), QCOLS, 2, args.in[2] + l * QLORA, nullptr, scr, lane, gw, NGW, cursor);
            tr_matrix(args.in[5] + (size_t)l * KVLORA * KVCOLS, nullptr, KVCOLS, KVLORA, (bf16_t*)(ws + WS_WKV + l * SZ_WKV), KVCOLS, 0, args.in[4] + l * KVLORA, nullptr, scr, lane, gw, NGW, cursor);
            tr_matrix(args.in[9] + (size_t)l * D * D, nullptr, D, D, (bf16_t*)(ws + WS_WOUT + l * SZ_WOUT), D, 0, args.in[7] + l * 1024, args.in[8] + l * 1024, scr, lane, gw, NGW, cursor);
        }
        tr_matrix6(args.in[12], args.in[13], FF, ws + WS_WGU, 2 * FF, scr, lane, gw, NGW, cursor);
        tr_matrix6c(args.in[14], D, FF, ws + WS_WD, D, scr, lane, gw, NGW, cursor);
        { const f32x4* x4 = (const f32x4*)args.in[0]; u32x2* o2 = (u32x2*)(ws + WS_XB);
          for (size_t i = (size_t)bx * 512 + tid; i < (size_t)S * D / 4; i += (size_t)G * 512) o2[i] = pg8::pack4(x4[i]); }
        { float* coss = (float*)(ws + WS_COSS); float* sins = (float*)(ws + WS_SINS); float* cosm = (float*)(ws + WS_COSM); float* sinm = (float*)(ws + WS_SINM);
          for (int i = bx * 512 + tid; i < S * 64; i += G * 512) { const int pos = i >> 6, k = i & 63; float sn, cs; sincos_acc((float)pos * INVF[k], sn, cs); coss[i] = cs; sins[i] = sn; }
          for (int i = bx * 512 + tid; i < S * 32; i += G * 512) { const int pos = i >> 5, k = i & 31; float sn, cs; sincos_acc((float)pos * INVF[2 * k], sn, cs); cosm[i] = cs; sinm[i] = sn; } }
        }
    }
    SEAM(0);
    layer_phases<0>(args, lds, (char*)lds_raw, lo, hi);
    layer_phases<1>(args, lds, (char*)lds_raw, lo, hi);
}
#undef IN
#undef SEAM

#ifndef MK_SPLIT
#define MK_SPLIT 0
#endif
extern "C" void kernel_launch(void* const* d_in, const int* in_sizes, int n_in, void* d_out, int out_size, void* d_ws, size_t ws_size, hipStream_t stream) {
    static int grid = 0;
    if (grid == 0) {
        if (n_in != 21 || out_size != S * D || ws_size < WS_END2) { fprintf(stderr, "kernel_launch: unexpected shapes: n_in %d out %d ws %zu (need %zu)\n", n_in, out_size, ws_size, (size_t)WS_END2); grid = -1; return; }
        int dev = 0, cus = 0, per_cu = 0;
        if (hipGetDevice(&dev) != hipSuccess || hipDeviceGetAttribute(&cus, hipDeviceAttributeMultiprocessorCount, dev) != hipSuccess) { grid = -1; return; }
        if (hipFuncSetAttribute((const void*)fwd, hipFuncAttributeMaxDynamicSharedMemorySize, LDS_BYTES) != hipSuccess) { fprintf(stderr, "kernel_launch: hipFuncSetAttribute failed\n"); grid = -1; return; }
        if (hipOccupancyMaxActiveBlocksPerMultiprocessor(&per_cu, (const void*)fwd, NWAVES * 64, LDS_BYTES) != hipSuccess || per_cu < 1) fprintf(stderr, "kernel_launch: occupancy query says %d\n", per_cu);
        (void)hipGetLastError();
        grid = cus;
    }
    if (grid < 0) return;
    (void)hipMemsetAsync((char*)d_ws + WS_CTL, 0, CTL_ZERO_BYTES, stream);
    Args a{};
    for (int i = 0; i < 21; ++i) a.in[i] = (const float*)d_in[i];
    a.out = (float*)d_out; a.ws = (unsigned char*)d_ws;
#if MK_SPLIT
    for (int p = 0; p < NPHASE; ++p) { a.ph_lo = p; a.ph_hi = p + 1; hipLaunchKernelGGL(fwd, dim3(grid), dim3(NWAVES * 64), LDS_BYTES, stream, a); }
#else
    a.ph_lo = 0; a.ph_hi = NPHASE; hipLaunchKernelGGL(fwd, dim3(grid), dim3(NWAVES * 64), LDS_BYTES, stream, a);
#endif
    const hipError_t le = hipPeekAtLastError();
    if (le != hipSuccess) fprintf(stderr, "kernel_launch: launch failed: %s\n", hipGetErrorName(le));
}
```

```cpp
#include <hip/hip_runtime.h>
#include <cstdio>
#include <cstdint>

#define LAS __attribute__((address_space(3)))
#define GAS __attribute__((address_space(1)))
typedef unsigned short bf16_t;
typedef short bf16x8 __attribute__((ext_vector_type(8)));
typedef short s16x4 __attribute__((ext_vector_type(4)));
typedef float f32x4 __attribute__((ext_vector_type(4)));
typedef float f32x16 __attribute__((ext_vector_type(16)));
typedef unsigned u32x4 __attribute__((ext_vector_type(4)));
typedef unsigned u32x2 __attribute__((ext_vector_type(2)));

constexpr int S = 16384, D = 2048, DEPTH = 2;
constexpr int IN_COLS = 2368, IN_PAD = 2560, QCOLS = 1536, KVCOLS = 2048, QLORA = 512, KVLORA = 256;
constexpr int FF = 5632, FFE = 7168, NE = 8;
constexpr int MOE_ROWS = 34816;
constexpr float ALPHA = 1.41421356237309515f, LN_EPS = 1e-5f, RMS_EPS = 1e-6f;
constexpr float SCALE_MLA = 0.07216878364870322f, SCALE_SWA = 0.08838834764831845f;

__device__ __forceinline__ unsigned cvt_pk_bf16(float lo, float hi) { unsigned r; asm volatile("v_cvt_pk_bf16_f32 %0, %1, %2" : "=v"(r) : "v"(lo), "v"(hi)); return r; }

__device__ __forceinline__ unsigned pk_fp8x4(float a, float b, float c, float d) { int w = 0; w = __builtin_amdgcn_cvt_pk_fp8_f32(a, b, w, false); w = __builtin_amdgcn_cvt_pk_fp8_f32(c, d, w, true); return (unsigned)w; }
typedef int v6i32 __attribute__((ext_vector_type(6)));
typedef unsigned u32x6 __attribute__((ext_vector_type(6)));
__device__ __forceinline__ u32x6 mx6_block(const f32x16 lo, const f32x16 hi, unsigned& sb) {
    float am = 0.f;
#pragma unroll
    for (int i = 0; i < 16; ++i) am = fmaxf(am, fmaxf(fabsf(lo[i]), fabsf(hi[i])));
    const unsigned bits = __float_as_uint(am);
    int e = (int)((bits >> 23) & 255u) - 126 - (((bits & 0x7fffffu) <= 0x700000u) ? 3 : 2);
    e = e < -120 ? -120 : e;
    const float scale = __uint_as_float((unsigned)(e + 127) << 23);
    sb = (unsigned)(e + 127) * 0x01010101u;
    u32x6 q;
    asm("v_cvt_scalef32_2xpk16_fp6_f32 %0, %1, %2, %3" : "=&v"(q) : "v"(lo), "v"(hi), "v"(scale));
    return q;
}
constexpr float X8_SCALE = 4.f, W8UP_SCALE = 64.f, W8DN_SCALE = 128.f, H8_SCALE = 16.f;
__device__ __forceinline__ int tid_opaque() { int t = threadIdx.x; asm volatile("" : "+v"(t)); return t; }

constexpr size_t MiB = 1u << 20;
constexpr size_t WS_CTL = 0, CTL_ZERO_BYTES = 1 * MiB;
constexpr size_t WS_COSM = 1 * MiB, WS_SINM = 3 * MiB, WS_COSS = 5 * MiB, WS_SINS = 9 * MiB;
constexpr size_t WS_PARTQ = 13 * MiB, WS_PARTKV = 14 * MiB, WS_PARTO = 15 * MiB;
constexpr size_t WS_SEL = 16 * MiB, WS_GATE = WS_SEL + 128 * 1024, WS_DEST = WS_GATE + 128 * 1024, WS_WGCNT = WS_DEST + 128 * 1024, WS_MOEMETA = WS_WGCNT + 32 * 1024, WS_ST1 = WS_MOEMETA + 4096, WS_ST2 = WS_ST1 + 128 * 1024;
constexpr size_t WS_W = 17 * MiB;
constexpr size_t SZ_WIN = (size_t)IN_PAD * D * 2, SZ_WQ = (size_t)QCOLS * QLORA * 2, SZ_WKV = (size_t)KVCOLS * KVLORA * 2, SZ_WOUT = (size_t)D * D * 2;
constexpr size_t WS_WIN = WS_W, WS_WQ = WS_WIN + 2 * SZ_WIN, WS_WKV = WS_WQ + 2 * SZ_WQ, WS_WOUT = WS_WKV + 2 * SZ_WKV;
constexpr size_t WS_WGU = WS_WOUT + 2 * SZ_WOUT, WS_WD = WS_WGU + (size_t)2 * FF * D, WS_WMGU = WS_WD + (size_t)D * FF;
constexpr size_t WS_WMD = WS_WMGU + (size_t)NE * 2 * FFE * D, WS_XA = WS_WMD + (size_t)NE * D * FFE;
constexpr size_t WS_XB = WS_XA + (size_t)S * D * 4, WS_X8 = WS_XB + (size_t)S * D * 2, WS_SCR = WS_X8 + (size_t)S * D;
constexpr size_t WS_CQ = WS_SCR, WS_CKV = WS_CQ + (size_t)S * 512 * 2, WS_KPE = WS_CKV + (size_t)S * 256 * 2, WS_QS = WS_KPE + (size_t)S * 64 * 2;
constexpr size_t WS_KS = WS_QS + (size_t)S * 1024 * 2, WS_VS = WS_KS + (size_t)S * 256 * 2, WS_Q = WS_VS + (size_t)S * 256 * 2, WS_KV = WS_Q + (size_t)S * QCOLS * 2;
constexpr size_t WS_OBUF = WS_KV + (size_t)S * KVCOLS * 2, WS_ATT_END = WS_OBUF + (size_t)S * D * 2;
constexpr size_t WS_XS = WS_SCR, WS_H = WS_XS + (size_t)MOE_ROWS * D * 2, WS_END0 = WS_H + (size_t)MOE_ROWS * FFE, WS_END = WS_END0 > WS_ATT_END ? WS_END0 : WS_ATT_END;
constexpr size_t WS_YP = (WS_END + 255) / 256 * 256, WS_END2 = WS_YP + (size_t)7 * 128 * 65536 * 2;
constexpr size_t WS_VT = (WS_END2 + 255) / 256 * 256, WS_END3 = WS_VT + (size_t)8 * 128 * S;
constexpr size_t WS_TAILMAP = WS_CTL + 512 * 1024;
static_assert(WS_H + (size_t)S * FF <= WS_END, "scratch union");
static_assert(WS_WIN % 256 == 0 && WS_XA % 256 == 0 && WS_H % 256 == 0 && WS_Q % 256 == 0, "alignment");
constexpr int CW_TMO = 0, CW_BAR = 4096;

#define XB_TMO      128
#define XB_XCNT(j)  (256  + 64 * (j))
#define XB_XSUB(j)  (1280 + 64 * (j))
#define XB_XGEN(j)  (2304 + 64 * (j))
#define XB_TOP      3328
#define XB_TOPGEN   3392
#define XCD_BAR_WORDS 3456
#define XB_SPIN_CAP (1u << 18)
__device__ __forceinline__ unsigned xb_ld(unsigned* p)              { return __hip_atomic_load(p, __ATOMIC_RELAXED, __HIP_MEMORY_SCOPE_AGENT); }
__device__ __forceinline__ unsigned xb_add(unsigned* p, unsigned v) { return __hip_atomic_fetch_add(p, v, __ATOMIC_RELAXED, __HIP_MEMORY_SCOPE_AGENT); }
__device__ __forceinline__ unsigned xb_xcc_id() { return (unsigned)__builtin_amdgcn_s_getreg((3 << 11) | 20) & 0xFu; }
#define XB_SPIN(cond, bar) do { unsigned _sp = 0; while (cond) { __builtin_amdgcn_s_sleep(1); \
    if ((++_sp & 255u) == 0u) { if (xb_ld(&(bar)[XB_TMO])) break; if (_sp > XB_SPIN_CAP) { atomicAdd(&(bar)[XB_TMO], 1u); break; } } } } while (0)
struct XcdBarrier { unsigned* bar; unsigned x; volatile LAS unsigned* st; };
__device__ __forceinline__ XcdBarrier xcd_barrier_post(unsigned* bar, volatile LAS unsigned* st) {
    XcdBarrier b; b.bar = bar; b.x = xb_xcc_id(); b.st = st;
    if (threadIdx.x == 0) (void)xb_add(&bar[XB_XCNT(b.x)], 1u);
    return b;
}
__device__ __forceinline__ void xcd_barrier_complete(unsigned* bar, unsigned x, unsigned& nloc, unsigned& nx) {
    const unsigned G = gridDim.x * gridDim.y * gridDim.z;
    unsigned sum, cnt, mine, sp = 0u;
    for (;;) {
        sum = 0u; cnt = 0u; mine = 0u;
#pragma unroll
        for (unsigned j = 0; j < 16; ++j) { const unsigned c = xb_ld(&bar[XB_XCNT(j)]); sum += c; cnt += (c > 0u) ? 1u : 0u; mine = (j == x) ? c : mine; }
        if (sum == G) break;
        __builtin_amdgcn_s_sleep(1);
        if ((++sp & 255u) == 0u) { if (xb_ld(&bar[XB_TMO])) break; if (sp > XB_SPIN_CAP) { atomicAdd(&bar[XB_TMO], 1u); break; } }
    }
    nloc = mine > 0u ? mine : 1u; nx = cnt > 0u ? cnt : 1u;
}
__device__ __forceinline__ void xcd_barrier(const XcdBarrier& b) {
    asm volatile("s_waitcnt vmcnt(0)" ::: "memory");
    __syncthreads();
    if (threadIdx.x == 0) {
        unsigned* bar = b.bar;
        __builtin_amdgcn_s_waitcnt(0);
        unsigned nloc = b.st[0], nx = b.st[1];
        if (nloc == 0u) { xcd_barrier_complete(bar, b.x, nloc, nx); b.st[0] = nloc; b.st[1] = nx; }
        const unsigned old = xb_add(&bar[XB_XSUB(b.x)], 1u);
        const unsigned gen = old / nloc;
        if (old + 1u == (gen + 1u) * nloc) {
            __builtin_amdgcn_fence(__ATOMIC_RELEASE, "agent");
            asm volatile("s_waitcnt vmcnt(0)" ::: "memory");
            const unsigned og = xb_add(&bar[XB_TOP], 1u);
            const unsigned tg = og / nx;
            if (og + 1u == (tg + 1u) * nx) xb_add(&bar[XB_TOPGEN], 1u);
            else XB_SPIN(xb_ld(&bar[XB_TOPGEN]) == tg, bar);
            __builtin_amdgcn_fence(__ATOMIC_ACQUIRE, "agent");
            xb_add(&bar[XB_XGEN(b.x)], 1u);
            asm volatile("s_waitcnt vmcnt(0)" ::: "memory");
        } else {
            XB_SPIN(xb_ld(&bar[XB_XGEN(b.x)]) == gen, bar);
            __builtin_amdgcn_fence(__ATOMIC_ACQUIRE, "agent");
            asm volatile("s_waitcnt vmcnt(0)" ::: "memory");
        }
    }
    __syncthreads();
}

namespace pg8 {
constexpr int BM = 256, BK = 64, HALF = 128, HTB = HALF * BK * 2, STAGE_BYTES = 8 * HTB, NXCD = 8, WGM = 8;
__host__ __device__ __forceinline__ int lds_byte(int r, int c) { const int st = (r >> 4) * 2 + (c >> 5), rr = r & 15, cc = c & 31, ob = rr * 64 + cc * 2; return st * 1024 + (ob ^ (((ob >> 9) & 1) << 5)); }
__host__ __device__ __forceinline__ void stage_rc(int b, int& R, int& C) { const int st = b / 1024, sb = b % 1024, swz = sb ^ (((sb >> 9) & 1) << 5); R = (st >> 1) * 16 + swz / 64; C = (st & 1) * 32 + (swz % 64) / 2; }
__host__ __device__ __forceinline__ int perm32(int rho) { const int n = rho >> 4, i = rho & 15; return 8 * (i >> 2) + 4 * n + (i & 3); }
struct Unit { int pm, pn, aux, kx; };
struct Gemm { const bf16_t* A; const bf16_t* Bt; int K; };
struct StaticOrder {
    static constexpr bool KSPLIT = false;
    int nM, nN, nwg, G, c;
    __device__ void init(int M, int N, int G_, int c_) { nM = M / BM; nN = N / BM; nwg = nM * nN; G = G_; c = c_; }
    __device__ bool next(int i, Unit& u) const {
        const long L = (long)i * G + c; if (L >= nwg) return false;
        int wgid = (int)L; { const int q = nwg / NXCD, r = nwg % NXCD, xcd = wgid % NXCD, off = wgid / NXCD; wgid = (xcd < r ? xcd * (q + 1) : r * (q + 1) + (xcd - r) * q) + off; }
        const int nig = WGM * nN, gid = wgid / nig, fm = gid * WGM, gsz = (nM - fm) < WGM ? (nM - fm) : WGM;
        u.pm = fm + ((wgid % nig) % gsz); u.pn = (wgid % nig) / gsz; u.aux = u.pn; return true;
    }
};
struct MoeOrder {
    static constexpr bool KSPLIT = false;
    int pb[9], NT, G, c, nwg;
    __device__ __forceinline__ bool next(int i, Unit& u) const { return at((long)i * G + c, u); }
    __device__ __forceinline__ bool at(long L, Unit& u) const {
        if (L >= nwg) return false;
        int wgid = (int)L; { const int q = nwg / NXCD, r = nwg % NXCD, xcd = wgid % NXCD, off = wgid / NXCD; wgid = (xcd < r ? xcd * (q + 1) : r * (q + 1) + (xcd - r) * q) + off; }
        int e = 0;
#pragma unroll
        for (int k = 1; k < 8; ++k) e += (wgid >= pb[k] * NT) ? 1 : 0;
        int pbe = pb[0], pbn = pb[1];
#pragma unroll
        for (int k = 1; k < 8; ++k) { if (e == k) { pbe = pb[k]; pbn = pb[k + 1]; } }
        const int l = wgid - pbe * NT, Pe = pbn - pbe;
        const int nig = WGM * NT, gid = l / nig, fm = gid * WGM, gsz = (Pe - fm) < WGM ? (Pe - fm) : WGM;
        u.pm = pbe + fm + ((l % nig) % gsz); const int pn = (l % nig) / gsz; u.pn = e * NT + pn; u.aux = pn; return true;
    }
};

struct TableOrder {
    static constexpr bool KSPLIT = false;
    const LAS int* tab; int n;
    __device__ __forceinline__ bool next(int i, Unit& u) const {
        if (i >= n) return false;
        u.pm = __builtin_amdgcn_readfirstlane(tab[4 * i]); u.pn = __builtin_amdgcn_readfirstlane(tab[4 * i + 1]); u.aux = __builtin_amdgcn_readfirstlane(tab[4 * i + 2]); return true;
    }
};
struct TableOrderK {
    static constexpr bool KSPLIT = true;
    const LAS int* tab; int n;
    __device__ __forceinline__ bool next(int i, Unit& u) const {
        if (i >= n) return false;
        u.pm = __builtin_amdgcn_readfirstlane(tab[4 * i]); u.pn = __builtin_amdgcn_readfirstlane(tab[4 * i + 1]); u.aux = __builtin_amdgcn_readfirstlane(tab[4 * i + 2]); u.kx = __builtin_amdgcn_readfirstlane(tab[4 * i + 3]); return true;
    }
};
typedef int v8i32 __attribute__((ext_vector_type(8)));
template <class Epi, class Sched, bool ALIGN_EPI, bool SP2, int FMT = 0>
__device__ __forceinline__ void gemm_phase(LAS unsigned char* lds, const Gemm g, const Sched& S, const Epi& E) {
    const int tid = tid_opaque(), wid = __builtin_amdgcn_readfirstlane(tid >> 6), lane = tid & 63, wr = wid >> 2, wc = wid & 3, fr = lane & 15, fq = lane >> 4;
    constexpr bool F8 = (FMT != 0);
    const int K = g.K, RB = F8 ? K : 2 * K, nt = RB / 128;
    unsigned voffA, voffB;
    { int R, C; stage_rc(tid * 16, R, C); const int Rb = Epi::PERM ? ((R & ~31) + perm32(R & 31)) : R; voffA = (unsigned)(R * RB + C * 2); voffB = (unsigned)(Rb * RB + C * 2); }
    const size_t rstep = (size_t)64 * RB;
    const size_t kstep = (size_t)(BK * 2);
    const size_t hstep = (size_t)HALF * RB;
    const size_t tstep = 2 * hstep;
    const unsigned ldsw = (unsigned)wid * 1024u;
    const int aoff = lds_byte(wr * 64 + fr, fq * 8), boff = lds_byte(wc * 32 + fr, fq * 8);
#define PG8_SA(b, h) (((b) * 2 + (h)) * HTB)
#define PG8_SB(b, h) ((4 + (b) * 2 + (h)) * HTB)
#define PG8_STAGE(bufoff, gbase, voff) do { _Pragma("unroll") for (int _i = 0; _i < 2; ++_i) \
        __builtin_amdgcn_global_load_lds((const unsigned*)((const char*)(gbase) + _i * rstep + (voff)), (LAS unsigned*)(lds + (bufoff) + ldsw + _i * 8192), 16, 0, 0); } while (0)
#define PG8_LDA(dst, b, h) do { _Pragma("unroll") for (int m = 0; m < 4; ++m) _Pragma("unroll") for (int k = 0; k < 2; ++k) dst[m][k] = *(const LAS bf16x8*)(lds + PG8_SA(b, h) + aoff + m * 2048 + k * 1024); } while (0)
#define PG8_LDB(dst, b, h) do { _Pragma("unroll") for (int n = 0; n < 2; ++n) _Pragma("unroll") for (int k = 0; k < 2; ++k) dst[n][k] = *(const LAS bf16x8*)(lds + PG8_SB(b, h) + boff + n * 2048 + k * 1024); } while (0)
#define PG8_CAT(x) __builtin_shufflevector(__builtin_bit_cast(u32x4, x[0]), __builtin_bit_cast(u32x4, x[1]), 0, 1, 2, 3, 4, 5, 6, 7)
#define PG8_D6(x) __builtin_bit_cast(v6i32, __builtin_shufflevector(__builtin_bit_cast(u32x4, x[0]), __builtin_bit_cast(u32x4, x[1]), 0, 1, 2, 3, 4, 5))
#define PG8_S6(x) ((int)__builtin_bit_cast(u32x4, x[1])[2])
#define PG8_MMA(ai, bj, At, Bt) do { __builtin_amdgcn_s_setprio(1); if constexpr (FMT == 1) { _Pragma("unroll") for (int m = 0; m < 4; ++m) _Pragma("unroll") for (int n = 0; n < 2; ++n) \
        asm volatile("v_mfma_f32_16x16x128_f8f6f4 %0, %1, %2, %0" : "+v"(acc[ai][bj][m][n]) : "v"(__builtin_bit_cast(v8i32, PG8_CAT(Bt[n]))), "v"(__builtin_bit_cast(v8i32, PG8_CAT(At[m])))); } \
        else if constexpr (FMT == 2) { _Pragma("unroll") for (int m = 0; m < 4; ++m) _Pragma("unroll") for (int n = 0; n < 2; ++n) \
        acc[ai][bj][m][n] = __builtin_amdgcn_mfma_scale_f32_16x16x128_f8f6f4(__builtin_bit_cast(v8i32, PG8_CAT(Bt[n])), __builtin_bit_cast(v8i32, PG8_CAT(At[m])), acc[ai][bj][m][n], 2, 2, 0, PG8_S6(Bt[n]), 0, PG8_S6(At[m])); } \
        else { _Pragma("unroll") for (int m = 0; m < 4; ++m) _Pragma("unroll") for (int n = 0; n < 2; ++n) _Pragma("unroll") for (int k = 0; k < 2; ++k) \
        acc[ai][bj][m][n] = __builtin_amdgcn_mfma_f32_16x16x32_bf16(Bt[n][k], At[m][k], acc[ai][bj][m][n], 0, 0, 0); } __builtin_amdgcn_s_setprio(0); } while (0)
#define PG8_WAIT_V(n) asm volatile("s_waitcnt vmcnt(" #n ")" ::: "memory")
#define PG8_WAIT_L(n) asm volatile("s_waitcnt lgkmcnt(" #n ")" ::: "memory")
#define PG8_BAR __builtin_amdgcn_s_barrier()
#define PG8_SCHED __builtin_amdgcn_sched_barrier(0)
    Unit cur, nxt; int ui = 0;
    if (!S.next(0, cur)) return;
    constexpr bool KS = Sched::KSPLIT;
    auto k_off = [&](const Unit& u) -> size_t { if constexpr (KS) { if (u.kx) return (size_t)((u.kx >> 8) & 255) * (size_t)(nt / (u.kx >> 16)) * 128; } return 0; };
    auto k_cnt = [&](const Unit& u) -> int { if constexpr (KS) { if (u.kx) return nt / (u.kx >> 16); } return nt; };
    int ntc = k_cnt(cur);
    f32x4 acc[2][2][4][2];
#pragma unroll
    for (int a = 0; a < 2; ++a)
#pragma unroll
        for (int b = 0; b < 2; ++b)
#pragma unroll
            for (int m = 0; m < 4; ++m)
#pragma unroll
                for (int n = 0; n < 2; ++n) acc[a][b][m][n] = (f32x4){0.f, 0.f, 0.f, 0.f};
    bf16x8 At[4][2], B0[2][2], B1[2][2];
    const char* cA = (const char*)g.A + (size_t)cur.pm * tstep + k_off(cur); const char* cB = (const char*)g.Bt + (size_t)cur.pn * tstep + k_off(cur);
    if constexpr (SP2) {
        PG8_STAGE(PG8_SB(0, 0), cB, voffB); PG8_STAGE(PG8_SB(0, 1), cB + hstep, voffB); PG8_STAGE(PG8_SA(0, 0), cA, voffA); PG8_STAGE(PG8_SA(0, 1), cA + hstep, voffA);
        if (wr == 1) PG8_BAR;
        PG8_WAIT_V(2); PG8_BAR;
        PG8_STAGE(PG8_SB(1, 0), cB + kstep, voffB); PG8_STAGE(PG8_SA(1, 0), cA + kstep, voffA); PG8_STAGE(PG8_SB(1, 1), cB + hstep + kstep, voffB);
        PG8_WAIT_V(6); PG8_BAR;
    } else {
        PG8_STAGE(PG8_SB(0, 0), cB, voffB); PG8_STAGE(PG8_SA(0, 0), cA, voffA); PG8_STAGE(PG8_SB(0, 1), cB + hstep, voffB); PG8_STAGE(PG8_SA(0, 1), cA + hstep, voffA);
        if (wr == 1) PG8_BAR;
        PG8_WAIT_V(4); PG8_BAR;
        PG8_STAGE(PG8_SB(1, 0), cB + kstep, voffB); PG8_STAGE(PG8_SA(1, 0), cA + kstep, voffA); PG8_STAGE(PG8_SB(1, 1), cB + hstep + kstep, voffB);
        PG8_WAIT_V(6); PG8_BAR;
    }
    for (;;) {
        const bool has_next = S.next(ui + 1, nxt);
        const char* nA = has_next ? (const char*)g.A + (size_t)nxt.pm * tstep + k_off(nxt) : cA; const char* nB = has_next ? (const char*)g.Bt + (size_t)nxt.pn * tstep + k_off(nxt) : cB;
        for (int t = 0; t < ntc; t += 2) {
            if constexpr (Epi::MID_T >= 0) { if (t == Epi::MID_T) { const int l2 = tid_opaque() & 63; E.mid(acc, cur, wr, wc, l2 & 15, l2 >> 4); } }
            const bool last = (t == ntc - 2);
            const char* a1 = cA + (size_t)(t + 1) * kstep;
            const char* a2 = last ? nA : cA + (size_t)(t + 2) * kstep; const char* b2 = last ? nB : cB + (size_t)(t + 2) * kstep;
            const char* a3 = a2 + kstep; const char* b3 = b2 + kstep;
            if constexpr (SP2) {
            PG8_LDB(B0, 0, 0); PG8_LDB(B1, 0, 1); PG8_SCHED; PG8_LDA(At, 0, 0); PG8_STAGE(PG8_SA(1, 1), a1 + hstep, voffA);
            PG8_WAIT_V(8); PG8_WAIT_L(0); PG8_BAR; PG8_MMA(0, 0, At, B0); PG8_MMA(0, 1, At, B1); PG8_BAR; PG8_SCHED;
            PG8_LDA(At, 0, 1); PG8_STAGE(PG8_SB(0, 0), b2, voffB); PG8_STAGE(PG8_SB(0, 1), b2 + hstep, voffB); PG8_STAGE(PG8_SA(0, 0), a2, voffA);
            PG8_WAIT_V(8); PG8_WAIT_L(0); PG8_BAR; PG8_MMA(1, 0, At, B0); PG8_MMA(1, 1, At, B1); PG8_BAR; PG8_SCHED;
            PG8_LDB(B0, 1, 0); PG8_LDB(B1, 1, 1); PG8_SCHED; PG8_LDA(At, 1, 0); PG8_STAGE(PG8_SA(0, 1), a2 + hstep, voffA);
            PG8_WAIT_V(8); PG8_WAIT_L(0); PG8_BAR; PG8_MMA(0, 0, At, B0); PG8_MMA(0, 1, At, B1); PG8_BAR; PG8_SCHED;
            PG8_LDA(At, 1, 1); PG8_STAGE(PG8_SB(1, 0), b3, voffB); PG8_STAGE(PG8_SB(1, 1), b3 + hstep, voffB); PG8_STAGE(PG8_SA(1, 0), a3, voffA);
            PG8_WAIT_V(8); PG8_WAIT_L(0); PG8_BAR; PG8_MMA(1, 0, At, B0); PG8_MMA(1, 1, At, B1); PG8_BAR; PG8_SCHED;
            } else {
            PG8_LDB(B0, 0, 0); PG8_SCHED; PG8_LDA(At, 0, 0); PG8_STAGE(PG8_SA(1, 1), a1 + hstep, voffA);
            PG8_WAIT_L(8); PG8_BAR; PG8_WAIT_L(0); PG8_MMA(0, 0, At, B0); PG8_BAR; PG8_SCHED;
            PG8_LDB(B1, 0, 1); PG8_STAGE(PG8_SB(0, 0), b2, voffB);
            PG8_BAR; PG8_WAIT_L(0); PG8_MMA(0, 1, At, B1); PG8_BAR;
            PG8_LDA(At, 0, 1); PG8_STAGE(PG8_SA(0, 0), a2, voffA);
            PG8_BAR; PG8_WAIT_L(0); PG8_MMA(1, 0, At, B0); PG8_BAR; PG8_SCHED;
            PG8_STAGE(PG8_SB(0, 1), b2 + hstep, voffB);
            PG8_WAIT_V(6); PG8_BAR; PG8_MMA(1, 1, At, B1); PG8_BAR;
            PG8_LDB(B0, 1, 0); PG8_SCHED; PG8_LDA(At, 1, 0); PG8_STAGE(PG8_SA(0, 1), a2 + hstep, voffA);
            PG8_WAIT_L(8); PG8_BAR; PG8_WAIT_L(0); PG8_MMA(0, 0, At, B0); PG8_BAR; PG8_SCHED;
            PG8_LDB(B1, 1, 1); PG8_STAGE(PG8_SB(1, 0), b3, voffB);
            PG8_BAR; PG8_WAIT_L(0); PG8_MMA(0, 1, At, B1); PG8_BAR;
            PG8_LDA(At, 1, 1); PG8_STAGE(PG8_SA(1, 0), a3, voffA);
            PG8_BAR; PG8_WAIT_L(0); PG8_MMA(1, 0, At, B0); PG8_BAR; PG8_SCHED;
            PG8_STAGE(PG8_SB(1, 1), b3 + hstep, voffB);
            PG8_WAIT_V(6); PG8_BAR; PG8_MMA(1, 1, At, B1); PG8_BAR;
            }
        }
        if constexpr (ALIGN_EPI) { if (wr == 0) PG8_BAR; }
        if constexpr (F8) asm volatile("s_nop 15\n\ts_nop 15" ::: "memory");
        { const int l2 = tid_opaque() & 63; E(acc, cur, wr, wc, l2 & 15, l2 >> 4); }
        if (!has_next) break;
#pragma unroll
        for (int a = 0; a < 2; ++a)
#pragma unroll
            for (int b = 0; b < 2; ++b)
#pragma unroll
                for (int m = 0; m < 4; ++m)
#pragma unroll
                    for (int n = 0; n < 2; ++n) acc[a][b][m][n] = (f32x4){0.f, 0.f, 0.f, 0.f};
        cur = nxt; cA = nA; cB = nB; ++ui; ntc = k_cnt(cur);
        if constexpr (ALIGN_EPI) { if (wr == 1) PG8_BAR; }
    }
    PG8_WAIT_V(0);
    if constexpr (!ALIGN_EPI) { if (wr == 0) PG8_BAR; }
    PG8_BAR;
#undef PG8_SA
#undef PG8_SB
#undef PG8_STAGE
#undef PG8_LDA
#undef PG8_LDB
#undef PG8_MMA
#undef PG8_CAT
#undef PG8_D6
#undef PG8_S6
#undef PG8_WAIT_V
#undef PG8_WAIT_L
#undef PG8_BAR
#undef PG8_SCHED
}

__device__ __forceinline__ u32x4 pack8(const f32x4 a, const f32x4 b) { u32x4 w; w.x = cvt_pk_bf16(a[0], a[1]); w.y = cvt_pk_bf16(a[2], a[3]); w.z = cvt_pk_bf16(b[0], b[1]); w.w = cvt_pk_bf16(b[2], b[3]); return w; }
__device__ __forceinline__ u32x2 pack4(const f32x4 a) { u32x2 w; w.x = cvt_pk_bf16(a[0], a[1]); w.y = cvt_pk_bf16(a[2], a[3]); return w; }

constexpr int RM_BITS = 4;
template <int B = RM_BITS>
__device__ __forceinline__ f32x4 rmant(const f32x4 v) {
    f32x4 r;
#pragma unroll
    for (int i = 0; i < 4; ++i) r[i] = __uint_as_float((__float_as_uint(v[i]) + (1u << (22 - B))) & ~((1u << (23 - B)) - 1u));
    return r;
}

struct EpiInProj {
    static constexpr int MID_T = -1;
    static constexpr bool PERM = true;
    bf16_t *cq, *ckv, *kpe, *qs, *ks, *vs; float *partq, *partkv; const float *cosm, *sinm, *coss, *sins;
    __device__ __forceinline__ void operator()(const f32x4 (&acc)[2][2][4][2], const Unit& u, int wr, int wc, int fr, int fq) const {
        const int row0 = u.pm * BM + wr * 64 + fr;
#pragma unroll
        for (int bj = 0; bj < 2; ++bj) {
            const int tc0 = u.aux * BM + bj * HALF + wc * 32 + fq * 8;
            if (tc0 < 768) {
                bf16_t* base; float* part; int ld, col, ps;
                if (tc0 < 512) { base = cq; ld = 512; col = tc0; part = partq; ps = 16; } else { base = ckv; ld = 256; col = tc0 - 512; part = partkv; ps = 8; }
#pragma unroll
                for (int ai = 0; ai < 2; ++ai)
#pragma unroll
                    for (int m = 0; m < 4; ++m) { const int row = row0 + ai * HALF + m * 16; const f32x4 v0 = acc[ai][bj][m][0], v1 = acc[ai][bj][m][1];
                        *(u32x4*)(base + (size_t)row * ld + col) = pack8(v0, v1);
                        float ss = (v0[0] * v0[0] + v0[1] * v0[1]) + (v0[2] * v0[2] + v0[3] * v0[3]) + (v1[0] * v1[0] + v1[1] * v1[1]) + (v1[2] * v1[2] + v1[3] * v1[3]);
                        ss += __shfl_xor(ss, 16); ss += __shfl_xor(ss, 32);
                        if (fq == 0) part[(size_t)row * ps + (col >> 5)] = ss; }
            } else if (tc0 < 2112) {
                bf16_t* base; const float *ct, *st; int ld, col, half, tw, g;
                if (tc0 < 832) { g = (tc0 - 768) >> 3; base = kpe; ld = 64; col = 4 * g; half = 32; ct = cosm; st = sinm; tw = 32; }
                else if (tc0 < 1856) { const int j = tc0 - 832; g = (j & 127) >> 3; base = qs; ld = 1024; col = (j >> 7) * 128 + 4 * g; half = 64; ct = coss; st = sins; tw = 64; }
                else { const int j = tc0 - 1856; g = (j & 127) >> 3; base = ks; ld = 256; col = (j >> 7) * 128 + 4 * g; half = 64; ct = coss; st = sins; tw = 64; }
#pragma unroll
                for (int ai = 0; ai < 2; ++ai)
#pragma unroll
                    for (int m = 0; m < 4; ++m) { const int row = row0 + ai * HALF + m * 16; const f32x4 x1 = acc[ai][bj][m][0], x2 = acc[ai][bj][m][1];
                        const f32x4 c = *(const f32x4*)(ct + (size_t)row * tw + 4 * g), s = *(const f32x4*)(st + (size_t)row * tw + 4 * g);
                        const f32x4 o1 = x1 * c - x2 * s, o2 = x2 * c + x1 * s;
                        if (tc0 < 832) { unsigned char* kp = (unsigned char*)kpe + (size_t)row * 64 + col;
                            *(unsigned*)kp = pk_fp8x4(o1[0], o1[1], o1[2], o1[3]); *(unsigned*)(kp + 32) = pk_fp8x4(o2[0], o2[1], o2[2], o2[3]); }
                        else { *(u32x2*)(base + (size_t)row * ld + col) = pack4(o1); *(u32x2*)(base + (size_t)row * ld + col + half) = pack4(o2); } }
            } else if (tc0 < 2368) {
                const int col = tc0 - 2112;
#pragma unroll
                for (int ai = 0; ai < 2; ++ai)
#pragma unroll
                    for (int m = 0; m < 4; ++m) { const int row = row0 + ai * HALF + m * 16; *(u32x4*)(vs + (size_t)row * 256 + col) = pack8(acc[ai][bj][m][0], acc[ai][bj][m][1]); }
            }
        }
    }
};
struct EpiQ {
    static constexpr int MID_T = -1;
    static constexpr bool PERM = true;
    bf16_t* q; const float *partq, *cosm, *sinm;
    __device__ __forceinline__ void operator()(const f32x4 (&acc)[2][2][4][2], const Unit& u, int wr, int wc, int fr, int fq) const {
        const int row0 = u.pm * BM + wr * 64 + fr;
        float rs[2][4];
#pragma unroll
        for (int ai = 0; ai < 2; ++ai)
#pragma unroll
            for (int m = 0; m < 4; ++m) { const f32x4* p = (const f32x4*)(partq + (size_t)(row0 + ai * HALF + m * 16) * 16); const f32x4 s = (p[0] + p[1]) + (p[2] + p[3]);
                rs[ai][m] = 1.0f / sqrtf(((s[0] + s[1]) + (s[2] + s[3])) * (1.0f / 512.0f) + RMS_EPS); }
#pragma unroll
        for (int bj = 0; bj < 2; ++bj) {
            const int tc0 = u.aux * BM + bj * HALF + wc * 32 + fq * 8, head = tc0 / 192, j = tc0 - head * 192;
            if (j < 128) {
#pragma unroll
                for (int ai = 0; ai < 2; ++ai)
#pragma unroll
                    for (int m = 0; m < 4; ++m) { const int row = row0 + ai * HALF + m * 16; *(u32x4*)(q + (size_t)row * QCOLS + tc0) = pack8(rmant(acc[ai][bj][m][0] * rs[ai][m]), rmant(acc[ai][bj][m][1] * rs[ai][m])); }
            } else {
                const int g = (j - 128) >> 3, col = head * 192 + 128 + 4 * g;
#pragma unroll
                for (int ai = 0; ai < 2; ++ai)
#pragma unroll
                    for (int m = 0; m < 4; ++m) { const int row = row0 + ai * HALF + m * 16; const f32x4 x1 = acc[ai][bj][m][0] * rs[ai][m], x2 = acc[ai][bj][m][1] * rs[ai][m];
                        const f32x4 c = *(const f32x4*)(cosm + (size_t)row * 32 + 4 * g), s = *(const f32x4*)(sinm + (size_t)row * 32 + 4 * g);
                        const f32x4 r1 = x1 * c - x2 * s, r2 = x2 * c + x1 * s; unsigned char* q8 = (unsigned char*)(q + (size_t)row * QCOLS + head * 192 + 128) + 4 * g;
                        *(unsigned*)q8 = pk_fp8x4(r1[0], r1[1], r1[2], r1[3]); *(unsigned*)(q8 + 32) = pk_fp8x4(r2[0], r2[1], r2[2], r2[3]); }
            }
        }
    }
};
struct EpiKV {
    static constexpr int MID_T = -1;
    static constexpr bool PERM = true;
    bf16_t* kv; const float* partkv; unsigned char* vt;
    __device__ __forceinline__ void operator()(const f32x4 (&acc)[2][2][4][2], const Unit& u, int wr, int wc, int fr, int fq) const {
        const int row0 = u.pm * BM + wr * 64 + fr;
#pragma unroll
        for (int ai = 0; ai < 2; ++ai)
#pragma unroll
            for (int m = 0; m < 4; ++m) { const int row = row0 + ai * HALF + m * 16; const f32x4* p = (const f32x4*)(partkv + (size_t)row * 8); const f32x4 s = p[0] + p[1];
                const float rs = 1.0f / sqrtf(((s[0] + s[1]) + (s[2] + s[3])) * (1.0f / 256.0f) + RMS_EPS);
                { const int col = u.aux * BM + wc * 32 + fq * 8; *(u32x4*)(kv + (size_t)row * KVCOLS + col) = pack8(rmant(acc[ai][0][m][0] * rs), rmant(acc[ai][0][m][1] * rs)); }
                { const f32x4 v0 = acc[ai][1][m][0] * rs, v1 = acc[ai][1][m][1] * rs; const unsigned w0 = pk_fp8x4(v0[0], v0[1], v0[2], v0[3]), w1 = pk_fp8x4(v1[0], v1[1], v1[2], v1[3]);
                  unsigned char* o = vt + ((size_t)(u.aux * 128 + wc * 32 + fq * 8)) * S + row;
#pragma unroll
                  for (int i = 0; i < 4; ++i) { o[(size_t)i * S] = (unsigned char)(w0 >> (8 * i)); o[(size_t)(4 + i) * S] = (unsigned char)(w1 >> (8 * i)); } } }
    }
};
struct EpiResid {
    static constexpr int MID_T = -1;
    static constexpr bool PERM = true;
    const float* xin; float* y; float sc;
    __device__ __forceinline__ void operator()(const f32x4 (&acc)[2][2][4][2], const Unit& u, int wr, int wc, int fr, int fq) const {
        const int row0 = u.pm * BM + wr * 64 + fr;
#pragma unroll
        for (int ai = 0; ai < 2; ++ai)
#pragma unroll
            for (int m = 0; m < 4; ++m) { const size_t ro = (size_t)(row0 + ai * HALF + m * 16) * D;
#pragma unroll
                for (int bj = 0; bj < 2; ++bj) { const size_t o = ro + u.aux * BM + bj * HALF + wc * 32 + fq * 8;
                    const f32x4 a0 = *(const f32x4*)(xin + o), a1 = *(const f32x4*)(xin + o + 4);
                    *(f32x4*)(y + o) = a0 * ALPHA + acc[ai][bj][m][0] * sc; *(f32x4*)(y + o + 4) = a1 * ALPHA + acc[ai][bj][m][1] * sc; }
                asm volatile("" ::: "memory"); }
    }
};
struct EpiResidLN {
    static constexpr int MID_T = -1;
    static constexpr bool PERM = true, PROBE2 = false;
    const float* yin; float* y; float sc; const float* st; const float* g; const float* b;
    __device__ __forceinline__ void operator()(const f32x4 (&acc)[2][2][4][2], const Unit& u, int wr, int wc, int fr, int fq) const {
        const int row0 = u.pm * BM + wr * 64 + fr, col0 = u.aux * BM + wc * 32 + fq * 8;
        f32x4 gg[2][2], bb[2][2];
#pragma unroll
        for (int bj = 0; bj < 2; ++bj)
#pragma unroll
            for (int n = 0; n < 2; ++n) { gg[bj][n] = *(const f32x4*)(g + col0 + bj * HALF + 4 * n); bb[bj][n] = *(const f32x4*)(b + col0 + bj * HALF + 4 * n); }
#pragma unroll
        for (int ai = 0; ai < 2; ++ai)
#pragma unroll
            for (int m = 0; m < 4; ++m) { const int row = row0 + ai * HALF + m * 16; const size_t ro = (size_t)row * D; const float mu = st[2 * row], rs = st[2 * row + 1];
#pragma unroll
                for (int bj = 0; bj < 2; ++bj) { const size_t o = ro + col0 + bj * HALF;
                    const f32x4 a0 = *(const f32x4*)(yin + o), a1 = *(const f32x4*)(yin + o + 4);
                    const f32x4 x0 = (a0 - mu) * rs * gg[bj][0] + bb[bj][0], x1 = (a1 - mu) * rs * gg[bj][1] + bb[bj][1];
                    *(f32x4*)(y + o) = x0 * ALPHA + acc[ai][bj][m][0] * sc; *(f32x4*)(y + o + 4) = x1 * ALPHA + acc[ai][bj][m][1] * sc; }
                asm volatile("" ::: "memory"); }
    }
};
template <bool LNIN> struct EpiOutProj {
    static constexpr bool PERM = true, PROBE2 = false; static constexpr int MID_T = 16;
    const float* xin; float* y; const float* parto; const float* st; const float* g; const float* b;
    __device__ __forceinline__ void sums(int row, float& a, float& c) const { const f32x4* p = (const f32x4*)(parto + (size_t)row * 16); const f32x4 u = p[0] + p[1], v = p[2] + p[3];
        a = ((u[0] + u[1]) + (u[2] + u[3])) * (1.0f / 1024.0f) + RMS_EPS; c = ((v[0] + v[1]) + (v[2] + v[3])) * (1.0f / 1024.0f) + RMS_EPS; }
    __device__ __forceinline__ void mid(f32x4 (&acc)[2][2][4][2], const Unit& u, int wr, int wc, int fr, int fq) const {
        const int row0 = u.pm * BM + wr * 64 + fr;
#pragma unroll
        for (int ai = 0; ai < 2; ++ai)
#pragma unroll
            for (int m = 0; m < 4; ++m) { float a, c; sums(row0 + ai * HALF + m * 16, a, c); const float r = sqrtf(c / a);
#pragma unroll
                for (int bj = 0; bj < 2; ++bj) { acc[ai][bj][m][0] *= r; acc[ai][bj][m][1] *= r; } }
    }
    __device__ __forceinline__ void operator()(const f32x4 (&acc)[2][2][4][2], const Unit& u, int wr, int wc, int fr, int fq) const {
        const int row0 = u.pm * BM + wr * 64 + fr, col0 = u.aux * BM + wc * 32 + fq * 8;
        f32x4 gg[2][2], bb[2][2];
        if (LNIN) {
#pragma unroll
            for (int bj = 0; bj < 2; ++bj)
#pragma unroll
                for (int n = 0; n < 2; ++n) { gg[bj][n] = *(const f32x4*)(g + col0 + bj * HALF + 4 * n); bb[bj][n] = *(const f32x4*)(b + col0 + bj * HALF + 4 * n); }
        }
#pragma unroll
        for (int ai = 0; ai < 2; ++ai)
#pragma unroll
            for (int m = 0; m < 4; ++m) { const int row = row0 + ai * HALF + m * 16; const size_t ro = (size_t)row * D; float a, c; sums(row, a, c); const float rsw = 1.0f / sqrtf(c);
                float mu = 0.f, rs = 1.f; if (LNIN) { mu = st[2 * row]; rs = st[2 * row + 1]; }
#pragma unroll
                for (int bj = 0; bj < 2; ++bj) { const size_t o = ro + col0 + bj * HALF;
                    f32x4 x0 = *(const f32x4*)(xin + o), x1 = *(const f32x4*)(xin + o + 4);
                    if (LNIN) { x0 = (x0 - mu) * rs * gg[bj][0] + bb[bj][0]; x1 = (x1 - mu) * rs * gg[bj][1] + bb[bj][1]; }
                    *(f32x4*)(y + o) = x0 * ALPHA + acc[ai][bj][m][0] * rsw; *(f32x4*)(y + o + 4) = x1 * ALPHA + acc[ai][bj][m][1] * rsw; }
                asm volatile("" ::: "memory"); }
    }
};
struct EpiSwiglu8 {
    static constexpr int MID_T = -1;
    static constexpr bool PERM = true;
    unsigned char* h; int ldh; float sc;
    __device__ __forceinline__ void operator()(const f32x4 (&acc)[2][2][4][2], const Unit& u, int wr, int wc, int fr, int fq) const {
        const int row0 = u.pm * BM + wr * 64 + fr, col = u.aux * HALF + wc * 32 + fq * 8;
#pragma unroll
        for (int ai = 0; ai < 2; ++ai)
#pragma unroll
            for (int m = 0; m < 4; ++m) { f32x4 r0, r1;
#pragma unroll
                for (int k = 0; k < 4; ++k) { const float g0 = acc[ai][0][m][0][k] * sc, g1 = acc[ai][0][m][1][k] * sc;
                    r0[k] = __builtin_amdgcn_fmed3f(g0 * __builtin_amdgcn_rcpf(1.0f + __builtin_amdgcn_exp2f(-1.4426950408889634f * g0)) * (acc[ai][1][m][0][k] * (sc * H8_SCALE)), -448.f, 448.f);
                    r1[k] = __builtin_amdgcn_fmed3f(g1 * __builtin_amdgcn_rcpf(1.0f + __builtin_amdgcn_exp2f(-1.4426950408889634f * g1)) * (acc[ai][1][m][1][k] * (sc * H8_SCALE)), -448.f, 448.f); }
                u32x2 w; w.x = pk_fp8x4(r0[0], r0[1], r0[2], r0[3]); w.y = pk_fp8x4(r1[0], r1[1], r1[2], r1[3]);
                *(u32x2*)(h + (size_t)(row0 + ai * HALF + m * 16) * ldh + col) = w; }
    }
};
struct EpiSwiglu6 {
    static constexpr bool PERM = true, PROBE2 = false; static constexpr int MID_T = -1;
    unsigned char* h; int ldh;
    __device__ __forceinline__ void operator()(const f32x4 (&acc)[2][2][4][2], const Unit& u, int wr, int wc, int fr, int fq) const {
#pragma unroll
        for (int ai = 0; ai < 2; ++ai) {
            float v[4][8];
#pragma unroll
            for (int m = 0; m < 4; ++m)
#pragma unroll
                for (int c = 0; c < 8; ++c) { const float g = acc[ai][0][m][c >> 2][c & 3], uu = acc[ai][1][m][c >> 2][c & 3];
                    v[m][c] = g * __builtin_amdgcn_rcpf(1.0f + __builtin_amdgcn_exp2f(-1.4426950408889634f * g)) * uu; }
            float s1[2][2][8];
#pragma unroll
            for (int mm = 0; mm < 2; ++mm)
#pragma unroll
                for (int c = 0; c < 8; ++c) { auto r = __builtin_amdgcn_permlane32_swap(__float_as_uint(v[mm][c]), __float_as_uint(v[mm + 2][c]), false, false);
                    s1[mm][0][c] = __uint_as_float(r[0]); s1[mm][1][c] = __uint_as_float(r[1]); }
            f32x16 lo, hi;
#pragma unroll
            for (int hh = 0; hh < 2; ++hh)
#pragma unroll
                for (int c = 0; c < 8; ++c) { auto r = __builtin_amdgcn_permlane16_swap(__float_as_uint(s1[0][hh][c]), __float_as_uint(s1[1][hh][c]), false, false);
                    if (hh == 0) { lo[c] = __uint_as_float(r[0]); lo[8 + c] = __uint_as_float(r[1]); } else { hi[c] = __uint_as_float(r[0]); hi[8 + c] = __uint_as_float(r[1]); } }
            unsigned sb; const u32x6 q = mx6_block(lo, hi, sb);
            unsigned char* o = h + (size_t)(u.pm * BM + ai * HALF + wr * 64 + fq * 16 + fr) * ldh + u.aux * 128 + 16 * wc;
            *(u32x4*)o = (u32x4){q[0], q[1], q[2], q[3]}; *(u32x4*)(o + 64) = (u32x4){q[4], q[5], sb, 0u};
        }
    }
};
struct EpiBf16Out {
    static constexpr int MID_T = -1;
    static constexpr bool PERM = true;
    bf16_t* o; int ld; float sc;
    __device__ __forceinline__ void operator()(const f32x4 (&acc)[2][2][4][2], const Unit& u, int wr, int wc, int fr, int fq) const {
        const int row0 = u.pm * BM + wr * 64 + fr;
#pragma unroll
        for (int ai = 0; ai < 2; ++ai)
#pragma unroll
            for (int m = 0; m < 4; ++m)
#pragma unroll
                for (int bj = 0; bj < 2; ++bj) *(u32x4*)(o + (size_t)(row0 + ai * HALF + m * 16) * ld + u.aux * BM + bj * HALF + wc * 32 + fq * 8) = pack8(acc[ai][bj][m][0] * sc, acc[ai][bj][m][1] * sc);
    }
};
struct EpiBf16OutK {
    static constexpr int MID_T = -1;
    static constexpr bool PERM = true;
    bf16_t* o; bf16_t* yp;
    __device__ __forceinline__ void operator()(const f32x4 (&acc)[2][2][4][2], const Unit& u, int wr, int wc, int fr, int fq) const {
        bf16_t* base; int ld;
        if (u.kx) { base = yp + ((size_t)(((u.kx >> 8) & 255) * 128 + (u.kx & 255) - 1) * 256 + wr * 64 + fr) * 256; ld = 256; }
        else { base = o + (size_t)(u.pm * BM + wr * 64 + fr) * D + u.aux * BM; ld = D; }
#pragma unroll
        for (int ai = 0; ai < 2; ++ai)
#pragma unroll
            for (int m = 0; m < 4; ++m)
#pragma unroll
                for (int bj = 0; bj < 2; ++bj) *(u32x4*)(base + (size_t)(ai * HALF + m * 16) * ld + bj * HALF + wc * 32 + fq * 8) = pack8(acc[ai][bj][m][0], acc[ai][bj][m][1]);
    }
};
}

namespace att {
constexpr int NW = 8, QBLK = 32, KVBLK = 64;
constexpr float THR = 8.f;
constexpr int PPITCH = 80;
constexpr int VPITCH = 80;
constexpr float THR8 = 3.f;
constexpr float PK8 = 4.f;
constexpr int SHM_V = KVBLK * 128 * 2, SHM_K = KVBLK * 272, SHM_P = KVBLK * PPITCH;
constexpr int OFF_V = 0, OFF_K = 3 * SHM_V, OFF_P = OFF_K + 2 * SHM_K,     OFF_WS = OFF_P + 2 * SHM_P, OFF_QP = OFF_WS + NW * 64 * 4, SHM_ATTN = OFF_QP + NW * 4096;
typedef LAS const char* lptr;
typedef short v4i16_t __attribute__((ext_vector_type(4)));
#define SBAR() __builtin_amdgcn_sched_barrier(0)
#define PIN(x) asm volatile("" : "+v"(x))
__device__ __forceinline__ int crow(int r, int hi) { return (r & 3) + 8 * (r >> 2) + 4 * hi; }
__device__ __forceinline__ bf16x8 ldk(lptr p) { return *(const LAS bf16x8*)p; }
__device__ __forceinline__ s16x4 vtr(lptr p) { return __builtin_bit_cast(s16x4, __builtin_amdgcn_ds_read_tr16_b64_v4i16((LAS v4i16_t*)p)); }
__device__ __forceinline__ int v_st(int k, int c) { const int kk = (k & ~0xC) | ((k & 4) << 1) | ((k & 8) >> 1); return ((kk >> 3) * 4 + (c >> 5)) * 512 + ((kk & 7) * 32 + (c & 31)) * 2; }
__device__ __forceinline__ int v_rd_base(int lane) { return ((lane & 3) << 3) | (((lane >> 2) & 3) << 6) | (((lane >> 4) & 1) << 5) | (((lane >> 5) & 1) << 8); }
__device__ __forceinline__ bf16x8 pk4(float a0, float a1, float a2, float a3, float a4, float a5, float a6, float a7) {
  const unsigned x0 = cvt_pk_bf16(a0, a1), x1 = cvt_pk_bf16(a2, a3), y0 = cvt_pk_bf16(a4, a5), y1 = cvt_pk_bf16(a6, a7);
  auto r0 = __builtin_amdgcn_permlane32_swap(x0, y0, false, false); auto r1 = __builtin_amdgcn_permlane32_swap(x1, y1, false, false);
  u32x4 w = {r0[0], r1[0], r0[1], r1[1]}; return __builtin_bit_cast(bf16x8, w);
}
constexpr int PD = 3;
__device__ __forceinline__ bf16x8 kfrag(lptr kb, int n) { const int d0 = n >> 1, h = n & 1; return ldk(kb + h * (32 * 272) + d0 * 32); }
typedef int v8i32_t __attribute__((ext_vector_type(8)));
__device__ __forceinline__ v8i32_t cat8(const bf16x8 a, const bf16x8 b) { return __builtin_bit_cast(v8i32_t, __builtin_shufflevector(__builtin_bit_cast(u32x4, a), __builtin_bit_cast(u32x4, b), 0, 1, 2, 3, 4, 5, 6, 7)); }
template <int NQ, bool DO_QK, bool DO_FIN>
__device__ __forceinline__ void phaseA(f32x16& C0, f32x16& C1, const f32x16& P0, const f32x16& P1, float alphaP, float& l_reg, bf16x8 (&pa)[4],
                                       lptr kb, lptr pb, const bf16x8 (&rq)[2], const bf16x8 (&qr)[8]) {
  constexpr bool R8 = NQ > 8;
  constexpr int NN = 16, NF = NN + (R8 ? 2 : 0);
  float s0 = 0.f, s1 = 0.f, s2 = 0.f, s3 = 0.f;
  bf16x8 f[NN + PD]; bf16x8 ra[2][2]; u32x4 pw[2] = {};
  if (DO_QK) {
#pragma unroll
    for (int n = 0; n < PD; ++n) f[n] = kfrag(kb, n);
  }
#pragma unroll
  for (int n = 0; n < NF; ++n) {
    if (DO_QK) {
      if (n < NN) {
        if (n + PD < NN) f[n + PD] = kfrag(kb, n + PD);
        if (R8) { if (n == 11) { ra[0][0] = ldk(pb); ra[0][1] = ldk(pb + 16); } if (n == 13) { ra[1][0] = ldk(pb + 32 * PPITCH); ra[1][1] = ldk(pb + 32 * PPITCH + 16); } }
        const bf16x8 qf = qr[n >> 1];
        if (n == 0)            C0 = __builtin_amdgcn_mfma_f32_32x32x16_bf16(f[n], qf, f32x16{}, 0, 0, 0);
        else if (n == 1)       C1 = __builtin_amdgcn_mfma_f32_32x32x16_bf16(f[n], qf, f32x16{}, 0, 0, 0);
        else if ((n & 1) == 0) C0 = __builtin_amdgcn_mfma_f32_32x32x16_bf16(f[n], qf, C0, 0, 0, 0);
        else                   C1 = __builtin_amdgcn_mfma_f32_32x32x16_bf16(f[n], qf, C1, 0, 0, 0);
      } else if (R8) {
        const int h = n - NN;
        if (h == 0) C0 = __builtin_amdgcn_mfma_scale_f32_32x32x64_f8f6f4(cat8(ra[0][0], ra[0][1]), cat8(rq[0], rq[1]), C0, 0, 0, 0, 0x7F7F7F7F, 0, 0x7F7F7F7F);
        else        C1 = __builtin_amdgcn_mfma_scale_f32_32x32x64_f8f6f4(cat8(ra[1][0], ra[1][1]), cat8(rq[0], rq[1]), C1, 0, 0, 0, 0x7F7F7F7F, 0, 0x7F7F7F7F);
      }
    }
    if (DO_FIN) {
#pragma unroll
      for (int e = n * 32 / NF; e < (n + 1) * 32 / NF; ++e) { const float v = e < 16 ? P0[e & 15] : P1[e & 15]; if ((e & 3) == 0) s0 += v; else if ((e & 3) == 1) s1 += v; else if ((e & 3) == 2) s2 += v; else s3 += v; }
      PIN(s0); PIN(s1); PIN(s2); PIN(s3);
      if (R8) {
        if (n == NF / 8 || n == 3 * NF / 8 || n == 5 * NF / 8 || n == 7 * NF / 8) {
          const int m = (n == NF / 8) ? 0 : (n == 3 * NF / 8) ? 1 : (n == 5 * NF / 8) ? 2 : 3;
          const unsigned X = pk_fp8x4(P0[4 * m], P0[4 * m + 1], P0[4 * m + 2], P0[4 * m + 3]), Y = pk_fp8x4(P1[4 * m], P1[4 * m + 1], P1[4 * m + 2], P1[4 * m + 3]);
          auto r = __builtin_amdgcn_permlane32_swap(X, Y, false, false);
          pw[m >> 1][2 * (m & 1)] = r[0]; pw[m >> 1][2 * (m & 1) + 1] = r[1]; PIN(pw[m >> 1]);
          if (m == 1) pa[0] = __builtin_bit_cast(bf16x8, pw[0]);
          if (m == 3) pa[1] = __builtin_bit_cast(bf16x8, pw[1]);
        }
      } else {
      if (n == NF / 8)     { pa[0] = pk4(P0[0], P0[1], P0[2], P0[3], P0[4], P0[5], P0[6], P0[7]); PIN(pa[0]); }
      if (n == 3 * NF / 8) { pa[1] = pk4(P0[8], P0[9], P0[10], P0[11], P0[12], P0[13], P0[14], P0[15]); PIN(pa[1]); }
      if (n == 5 * NF / 8) { pa[2] = pk4(P1[0], P1[1], P1[2], P1[3], P1[4], P1[5], P1[6], P1[7]); PIN(pa[2]); }
      if (n == 7 * NF / 8) { pa[3] = pk4(P1[8], P1[9], P1[10], P1[11], P1[12], P1[13], P1[14], P1[15]); PIN(pa[3]); }
      }
    }
    SBAR();
  }
  if (DO_FIN) { float ps = (s0 + s1) + (s2 + s3); auto rr = __builtin_amdgcn_permlane32_swap(__float_as_uint(ps), __float_as_uint(ps), false, false);
    ps = __uint_as_float(rr[0]) + __uint_as_float(rr[1]); l_reg = l_reg * alphaP + ps; }
}
template <bool R8, bool MASK, bool DO_PV, bool DO_SM>
__device__ __forceinline__ void phaseB(f32x16 (&o)[4], const bf16x8 (&pa)[4], f32x16& C0, f32x16& C1, float& m_reg, float& alpha, lptr vb, float Cs, float thr_raw, int qi, int k0, int hi) {
  s16x4 vl[16 + PD], vh[16 + PD]; bf16x8 fa[4][2];
  if (DO_PV && !R8) {
#pragma unroll
    for (int n = 0; n < PD; ++n) { const int d0 = n & 3, ks = n >> 2; vl[n] = vtr(vb + d0 * 512 + ks * 4096); vh[n] = vtr(vb + d0 * 512 + ks * 4096 + 2048); }
  }
  if (DO_PV && R8) { fa[0][0] = ldk(vb); fa[0][1] = ldk(vb + 16); }
  float mx = -3.0e38f, mnC = 0.f;
#pragma unroll
  for (int n = 0; n < 16; ++n) {
    if (DO_PV && R8) {
      if ((n & 3) == 1 && n < 12) { const int db = (n >> 2) + 1; fa[db][0] = ldk(vb + db * 32 * VPITCH); fa[db][1] = ldk(vb + db * 32 * VPITCH + 16); }
      if ((n & 3) == 0) { const int db = n >> 2; o[db] = __builtin_amdgcn_mfma_scale_f32_32x32x64_f8f6f4(cat8(fa[db][0], fa[db][1]), cat8(pa[0], pa[1]), o[db], 0, 0, 0, 0x7F7F7F7F, 0, 0x7F7F7F7F); }
    }
    if (DO_PV && !R8) {
      const int d0 = n & 3, ks = n >> 2;
      if (n + PD < 16) { const int d1 = (n + PD) & 3, k1 = (n + PD) >> 2; vl[n + PD] = vtr(vb + d1 * 512 + k1 * 4096); vh[n + PD] = vtr(vb + d1 * 512 + k1 * 4096 + 2048); }
      const bf16x8 vf = (bf16x8){vl[n][0], vl[n][1], vl[n][2], vl[n][3], vh[n][0], vh[n][1], vh[n][2], vh[n][3]};
      o[d0] = __builtin_amdgcn_mfma_f32_32x32x16_bf16(pa[ks], vf, o[d0], 0, 0, 0);
    }
    if (DO_SM) {
      if (n < 4) {
#pragma unroll
        for (int e = n * 8; e < n * 8 + 8; ++e) {
          if (MASK) { const int d = qi - (k0 + (e < 16 ? 0 : 32) + crow(e & 15, hi)); if (d > 128 || d < -128) { if (e < 16) C0[e & 15] = -1e30f; else C1[e & 15] = -1e30f; } }
          mx = fmaxf(mx, e < 16 ? C0[e & 15] : C1[e & 15]); }
        PIN(mx);
      } else if (n == 4) {
        auto rr = __builtin_amdgcn_permlane32_swap(__float_as_uint(mx), __float_as_uint(mx), false, false);
        const float pmax = fmaxf(__uint_as_float(rr[0]), __uint_as_float(rr[1]));
        const bool keep = __all(pmax - m_reg <= thr_raw);
        const float mn = keep ? m_reg : fmaxf(m_reg, pmax);
        alpha = __builtin_amdgcn_exp2f((m_reg - mn) * Cs); m_reg = mn; mnC = -mn * Cs + (R8 ? PK8 : 0.f); PIN(alpha); PIN(mnC);
      } else {
#pragma unroll
        for (int e = (n - 5) * 32 / 11; e < (n - 4) * 32 / 11; ++e) {
          if (e < 16) C0[e] = __builtin_amdgcn_exp2f(fmaf(C0[e], Cs, mnC)); else C1[e - 16] = __builtin_amdgcn_exp2f(fmaf(C1[e - 16], Cs, mnC)); }
        if ((n - 5) * 32 / 11 < 16) PIN(C0); if ((n - 4) * 32 / 11 > 16) PIN(C1);
      }
    }
    SBAR();
  }
}

template <int DQK, bool MASK, int LDQ, int LDK, int LDP, int LDV, int LDO>
__device__ __forceinline__ void attn_body(const bf16_t* __restrict__ Qb, const bf16_t* __restrict__ Kb, const bf16_t* __restrict__ Pb, const bf16_t* __restrict__ Vb,
                                          bf16_t* __restrict__ Ob, float* __restrict__ ssq, int q0, int kstart, int NT, float scale, float sink_raw, LAS char* lds) {
  constexpr int NQ = DQK / 16;
  constexpr bool R8 = NQ > 8;
  const float Cs = scale * 1.4426950408889634f, thr_raw = (R8 ? THR8 : THR) / scale;
  const int tid = tid_opaque(), wid = tid >> 6, lane = tid & 63, r32 = lane & 31, hi = lane >> 5;
  LAS char* V_lds = lds + OFF_V; LAS char* K_lds = lds + OFF_K; LAS char* P_lds = lds + OFF_P;
  LAS float* ws = (LAS float*)(lds + OFF_WS) + wid * 64; LAS float* li_l = ws; LAS float* al_l = ws + 32;
  float m_reg = MASK ? sink_raw : -1e30f, l_reg = MASK ? 1.f : 0.f; f32x16 o[4] = {}; bf16x8 qr[8];
  const bf16_t* Qw = Qb + (long)(wid * QBLK + r32) * LDQ + hi * 8;
  LAS char* Qp = lds + OFF_QP + wid * 4096 + lane * 16;
#pragma unroll
  for (int d0 = 0; d0 < 8; ++d0) qr[d0] = *reinterpret_cast<const bf16x8*>(Qw + d0 * 16);
  bf16x8 rq[2] = {};
  if (NQ > 8) {
    const unsigned char* q8 = (const unsigned char*)(Qb + (long)(wid * QBLK + r32) * LDQ + 128) + hi * 32;
    rq[0] = *reinterpret_cast<const bf16x8*>(q8); rq[1] = *reinterpret_cast<const bf16x8*>(q8 + 16);
  }
  const int sr = tid >> 4, sc = (tid & 15) * 8, vst0 = v_st(sr, sc), vst1 = v_st(32 + sr, sc);
  const int pr = tid >> 3, pc = (tid & 7) * 8;
  const lptr kb0 = (lptr)K_lds + r32 * 272 + hi * 16, pb0 = (lptr)P_lds + r32 * PPITCH + hi * 32, vb0 = R8 ? (lptr)V_lds + r32 * VPITCH + hi * 32 : (lptr)V_lds + v_rd_base(lane);
  const int qi = q0 + wid * QBLK + r32;
  bf16x8 vs0, vs1, ks0, ks1; u32x2 ps0;
  const unsigned voff0 = sr * LDV + sc, voff1 = (32 + sr) * LDV + sc, koff0 = sr * LDK + sc, koff1 = (32 + sr) * LDK + sc, poff = pr * LDP + pc, voff8 = (unsigned)(tid >> 2) * LDV + (tid & 3) * 16;
#define SLOAD(k0) do { const bf16_t* Kt = Kb + (long)(k0) * LDK; \
    if (R8) { vs0 = *reinterpret_cast<const bf16x8*>((const unsigned char*)Vb + (long)(k0) + voff8); } \
    else { const bf16_t* Vt = Vb + (long)(k0) * LDV; vs0 = *reinterpret_cast<const bf16x8*>(Vt + voff0); vs1 = *reinterpret_cast<const bf16x8*>(Vt + voff1); } \
    ks0 = *reinterpret_cast<const bf16x8*>(Kt + koff0); ks1 = *reinterpret_cast<const bf16x8*>(Kt + koff1); \
    if (NQ > 8) { const unsigned char* Pt = (const unsigned char*)Pb + (long)(k0) * LDP; ps0 = *reinterpret_cast<const u32x2*>(Pt + poff); } } while (0)
#define SWRITE(kb_, vo_) do { if (R8) { *(LAS bf16x8*)(V_lds + (vo_) + (tid >> 2) * VPITCH + (tid & 3) * 16) = vs0; } else { *(LAS bf16x8*)(V_lds + (vo_) + vst0) = vs0; *(LAS bf16x8*)(V_lds + (vo_) + vst1) = vs1; } \
    *(LAS bf16x8*)(K_lds + (kb_) * SHM_K + sr * 272 + sc * 2) = ks0; *(LAS bf16x8*)(K_lds + (kb_) * SHM_K + (32 + sr) * 272 + sc * 2) = ks1; \
    if (NQ > 8) *(LAS u32x2*)(P_lds + (kb_) * SHM_P + pr * PPITCH + pc) = ps0; } while (0)
#define SWAIT() asm volatile("s_waitcnt vmcnt(0)" ::: "memory")
#define RESC(a) do { if (__any((a) < 1.f)) { if (R8) { _Pragma("unroll") for (int d = 0; d < 4; ++d) o[d] *= (a); } else { if (hi == 0) al_l[r32] = (a); asm volatile("s_waitcnt lgkmcnt(0)" ::: "memory"); \
    _Pragma("unroll") for (int d = 0; d < 4; ++d) _Pragma("unroll") for (int r = 0; r < 16; ++r) o[d][r] *= al_l[crow(r, hi)]; } } } while (0)
#define ROTV() do { const int t_ = vprev; vprev = vcur; vcur = vnext; vnext = t_; } while (0)
  f32x16 pA0, pA1, pB0, pB1; float alA = 1.f, alB = 1.f; bf16x8 pa[4];
  int vprev = 0, vcur = SHM_V, vnext = 2 * SHM_V;
  SLOAD(kstart); SWAIT(); SWRITE(0, 0); __syncthreads();
  SLOAD(kstart + KVBLK);
  phaseA<NQ, true, false>(pA0, pA1, pA0, pA1, 1.f, l_reg, pa, kb0, pb0, rq, qr);
  SWAIT(); SWRITE(1, SHM_V);
  phaseB<R8, MASK, false, true>(o, pa, pA0, pA1, m_reg, alA, vb0, Cs, thr_raw, qi, kstart, hi);
  __syncthreads();
  for (int j = 1; j + 1 < NT; j += 2) {
    SBAR(); SLOAD(kstart + (j + 1) * KVBLK); SBAR();
    phaseA<NQ, true, true>(pB0, pB1, pA0, pA1, alA, l_reg, pa, kb0 + SHM_K, pb0 + SHM_P, rq, qr);
    SWAIT(); SWRITE(0, vnext);
    phaseB<R8, MASK, true, true>(o, pa, pB0, pB1, m_reg, alB, vb0 + vprev, Cs, thr_raw, qi, kstart + j * KVBLK, hi);
    RESC(alB); ROTV(); __syncthreads();
    SBAR(); if (j + 2 < NT) SLOAD(kstart + (j + 2) * KVBLK); SBAR();
    phaseA<NQ, true, true>(pA0, pA1, pB0, pB1, alB, l_reg, pa, kb0, pb0, rq, qr);
    if (j + 2 < NT) { SWAIT(); SWRITE(1, vnext); }
    phaseB<R8, MASK, true, true>(o, pa, pA0, pA1, m_reg, alA, vb0 + vprev, Cs, thr_raw, qi, kstart + (j + 1) * KVBLK, hi);
    RESC(alA); ROTV(); __syncthreads();
  }
  SBAR(); phaseA<NQ, true, true>(pB0, pB1, pA0, pA1, alA, l_reg, pa, kb0 + SHM_K, pb0 + SHM_P, rq, qr);
  phaseB<R8, MASK, true, true>(o, pa, pB0, pB1, m_reg, alB, vb0 + vprev, Cs, thr_raw, qi, kstart + (NT - 1) * KVBLK, hi);
  RESC(alB); ROTV();
  phaseA<NQ, false, true>(pA0, pA1, pB0, pB1, alB, l_reg, pa, kb0, pb0, rq, qr);
  phaseB<R8, MASK, true, false>(o, pa, pA0, pA1, m_reg, alA, vb0 + vprev, Cs, thr_raw, qi, 0, hi);
  if (R8) {
    const float rl = __builtin_amdgcn_rcpf(l_reg); float sq = 0.f; bf16_t* Orow = Ob + (long)(wid * QBLK + r32) * LDO + 4 * hi;
#pragma unroll
    for (int db = 0; db < 4; ++db)
#pragma unroll
      for (int g = 0; g < 4; ++g) { const float v0 = o[db][4 * g] * rl, v1 = o[db][4 * g + 1] * rl, v2 = o[db][4 * g + 2] * rl, v3 = o[db][4 * g + 3] * rl; sq += (v0 * v0 + v1 * v1) + (v2 * v2 + v3 * v3);
        u32x2 w; w.x = cvt_pk_bf16(v0, v1); w.y = cvt_pk_bf16(v2, v3); *(u32x2*)(Orow + db * 32 + 8 * g) = w; }
    auto rr = __builtin_amdgcn_permlane32_swap(__float_as_uint(sq), __float_as_uint(sq), false, false); sq = __uint_as_float(rr[0]) + __uint_as_float(rr[1]);
    if (hi == 0) ssq[(long)(wid * QBLK + r32) * 16] = sq;
  } else {
  if (hi == 0) li_l[r32] = l_reg; asm volatile("s_waitcnt lgkmcnt(0)" ::: "memory");
  bf16_t* Ow = Ob + (long)(wid * QBLK) * LDO;
#pragma unroll
  for (int r = 0; r < 16; ++r) { const int orow = crow(r, hi); const float rl = __builtin_amdgcn_rcpf(li_l[orow]); float sq = 0.f;
#pragma unroll
    for (int d0 = 0; d0 < 4; ++d0) { const float v = o[d0][r] * rl; sq += v * v; Ow[(long)orow * LDO + d0 * 32 + r32] = (bf16_t)(cvt_pk_bf16(v, v) & 0xffffu); }
#pragma unroll
    for (int s = 1; s < 32; s <<= 1) sq += __shfl_xor(sq, s);
    if (r32 == 0) ssq[(long)(wid * QBLK + orow) * 16] = sq; }
  }
  __syncthreads();
#undef SLOAD
#undef SWRITE
#undef SWAIT
#undef RESC
#undef ROTV
}
#undef SBAR
#undef PIN
}

constexpr int NWAVES = 8;
#ifndef PROBE_ATT
#define PROBE_ATT 1
#endif
#ifndef PROBE_PRO
#define PROBE_PRO 1
#endif
#ifndef PROBE_MOEUP
#define PROBE_MOEUP 1
#endif
constexpr int RING_BYTES = 133120;
constexpr int MISC_OFF = 139264, LDS_BYTES = 147456;
static_assert(att::SHM_ATTN <= MISC_OFF && RING_BYTES <= MISC_OFF, "LDS map");
constexpr int NPHASE = 21;

__device__ const float INVF[64] = {
 1.000000000e+00f, 8.659643531e-01f, 7.498942018e-01f, 6.493816376e-01f, 5.623413324e-01f, 4.869675338e-01f, 4.216965139e-01f, 3.651741147e-01f, 3.162277639e-01f, 2.738419771e-01f, 2.371373773e-01f, 2.053525001e-01f, 1.778279394e-01f, 1.539926529e-01f, 1.333521456e-01f, 1.154781953e-01f,
 1.000000015e-01f, 8.659642935e-02f, 7.498942316e-02f, 6.493816525e-02f, 5.623413250e-02f, 4.869675264e-02f, 4.216964915e-02f, 3.651741147e-02f, 3.162277490e-02f, 2.738419548e-02f, 2.371373773e-02f, 2.053525113e-02f, 1.778279431e-02f, 1.539926510e-02f, 1.333521400e-02f, 1.154781971e-02f,
 9.999999776e-03f, 8.659643121e-03f, 7.498942316e-03f, 6.493816152e-03f, 5.623413250e-03f, 4.869675264e-03f, 4.216964822e-03f, 3.651741194e-03f, 3.162277630e-03f, 2.738419687e-03f, 2.371373819e-03f, 2.053525066e-03f, 1.778279431e-03f, 1.539926510e-03f, 1.333521446e-03f, 1.154782018e-03f,
 1.000000047e-03f, 8.659643354e-04f, 7.498941850e-04f, 6.493816036e-04f, 5.623413017e-04f, 4.869675322e-04f, 4.216965172e-04f, 3.651741135e-04f, 3.162277571e-04f, 2.738419571e-04f, 2.371373703e-04f, 2.053525095e-04f, 1.778279402e-04f, 1.539926598e-04f, 1.333521504e-04f, 1.154782003e-04f };

struct Args { const float* in[21]; float* out; unsigned char* ws; int ph_lo, ph_hi; };

__device__ __forceinline__ float wave_sum(float v) {
#pragma unroll
    for (int o = 1; o < 64; o <<= 1) v += __shfl_xor(v, o);
    return v;
}
__device__ __forceinline__ void sincos_acc(float ang, float& sn, float& cs) {
    const double a = (double)ang;
    const double n = __builtin_rint(a * 0.63661977236758134308);
    double r = __builtin_fma(-n, 1.57079632679489655800, a); r = __builtin_fma(-n, 6.12323399573676603587e-17, r);
    const double r2 = r * r;
    double sp = 1.0 / 6227020800.0; sp = __builtin_fma(sp, r2, -1.0 / 39916800.0); sp = __builtin_fma(sp, r2, 1.0 / 362880.0); sp = __builtin_fma(sp, r2, -1.0 / 5040.0);
    sp = __builtin_fma(sp, r2, 1.0 / 120.0); sp = __builtin_fma(sp, r2, -1.0 / 6.0); sp = __builtin_fma(sp * r2, r, r);
    double cp = 1.0 / 479001600.0; cp = __builtin_fma(cp, r2, -1.0 / 3628800.0); cp = __builtin_fma(cp, r2, 1.0 / 40320.0); cp = __builtin_fma(cp, r2, -1.0 / 720.0);
    cp = __builtin_fma(cp, r2, 1.0 / 24.0); cp = __builtin_fma(cp, r2, -0.5); cp = __builtin_fma(cp, r2, 1.0);
    const int q = ((int)n) & 3;
    const double s_ = (q & 1) ? cp : sp, c_ = (q & 1) ? sp : cp;
    sn = (float)((q & 2) ? -s_ : s_); cs = (float)(((q + 1) & 2) ? -c_ : c_);
}

__device__ __forceinline__ int src_quad(int kind, int n, int coff) {
    if (kind == 0) return coff + n;
    if (kind == 1) {
        if (n < 768 || (n >= 2112 && n < 2368)) return n;
        if (n >= 2368) return -1;
        int base, half, j;
        if (n < 832) { base = 768; half = 32; j = n - 768; } else if (n < 1856) { j = (n - 832) & 127; base = n - j; half = 64; } else { j = (n - 1856) & 127; base = n - j; half = 64; }
        const int g = j >> 3, e = j & 7; return base + (e < 4 ? 4 * g : half + 4 * g);
    }
    { const int head = n / 192, j = n - head * 192; if (j < 128) return n; const int jj = j - 128, g = jj >> 3, e = jj & 7; return head * 192 + 128 + (e < 4 ? 4 * g : 32 + 4 * g); }
}
__device__ __forceinline__ void tr_item(const float* __restrict__ src, int Nsrc, int K, bf16_t* __restrict__ dst, int k0, int n0, int kind, int coff,
                                        const float* __restrict__ gain, const float* __restrict__ gain2, LAS unsigned* scr, int lane) {
    const int nl = 4 * (lane & 15), ks = lane >> 4;
    const int sq = src_quad(kind, n0 + nl, coff);
#pragma unroll 4
    for (int r = 0; r < 16; ++r) {
        const int k = k0 + 8 * r + 2 * ks;
        f32x4 a = (f32x4){0.f, 0.f, 0.f, 0.f}, b = a;
        if (sq >= 0) { a = *(const f32x4*)(src + (size_t)k * Nsrc + sq); b = *(const f32x4*)(src + (size_t)(k + 1) * Nsrc + sq); }
        if (gain) { const float ga = (gain2 && k >= 1024) ? gain2[k - 1024] : gain[k], gb = (gain2 && k + 1 >= 1024) ? gain2[k + 1 - 1024] : gain[k + 1]; a *= ga; b *= gb; }
#pragma unroll
        for (int j = 0; j < 4; ++j) scr[(nl + j) * 65 + 4 * r + ks] = cvt_pk_bf16(a[j], b[j]);
    }
    asm volatile("s_waitcnt lgkmcnt(0)" ::: "memory");
#pragma unroll 4
    for (int it = 0; it < 16; ++it) {
        const int row = it * 4 + (lane >> 4), ch = lane & 15;
        const LAS unsigned* p = scr + row * 65 + 4 * ch;
        u32x4 w; w.x = p[0]; w.y = p[1]; w.z = p[2]; w.w = p[3];
        *(u32x4*)(dst + (size_t)(n0 + row) * K + k0 + 8 * ch) = w;
    }
    asm volatile("s_waitcnt lgkmcnt(0)" ::: "memory");
}
__device__ __forceinline__ void tr_item8(const float* __restrict__ src, int Nsrc, int K, unsigned char* __restrict__ dst, int k0, int n0, int scol, float scale, LAS unsigned* scr, int lane) {
    const int nl = 4 * (lane & 15), ks = lane >> 4;
#pragma unroll 4
    for (int r = 0; r < 16; ++r) {
        const int k = k0 + 16 * r + 4 * ks; const float* p = src + (size_t)k * Nsrc + scol + nl;
        const f32x4 a = *(const f32x4*)p * scale, b = *(const f32x4*)(p + Nsrc) * scale, c = *(const f32x4*)(p + 2 * (size_t)Nsrc) * scale, d = *(const f32x4*)(p + 3 * (size_t)Nsrc) * scale;
#pragma unroll
        for (int j = 0; j < 4; ++j) scr[(nl + j) * 65 + 4 * r + ks] = pk_fp8x4(a[j], b[j], c[j], d[j]);
    }
    asm volatile("s_waitcnt lgkmcnt(0)" ::: "memory");
#pragma unroll 4
    for (int it = 0; it < 16; ++it) {
        const int row = it * 4 + (lane >> 4), ch = lane & 15;
        const LAS unsigned* p = scr + row * 65 + 4 * ch;
        u32x4 w; w.x = p[0]; w.y = p[1]; w.z = p[2]; w.w = p[3];
        *(u32x4*)(dst + (size_t)(n0 + row) * K + k0 + 16 * ch) = w;
    }
    asm volatile("s_waitcnt lgkmcnt(0)" ::: "memory");
}
__device__ __forceinline__ void tr_item6(const float* __restrict__ src, int Nsrc, unsigned char* __restrict__ dst, int t, int n0, int scol, LAS unsigned* scr, int lane) {
    const int nl = 4 * (lane & 15), ks = lane >> 4;
    f32x4 a[16], b[16];
#pragma unroll
    for (int r = 0; r < 16; ++r) {
        const int kk = 8 * r + 2 * ks, k = 16 * t + 256 * (kk >> 4) + (kk & 15); const float* p = src + (size_t)k * Nsrc + scol + nl;
        a[r] = __builtin_nontemporal_load((const f32x4*)p); b[r] = __builtin_nontemporal_load((const f32x4*)(p + Nsrc));
    }
#pragma unroll
    for (int r = 0; r < 16; ++r) {
#pragma unroll
        for (int j = 0; j < 4; ++j) scr[(nl + j) * 65 + 4 * r + ks] = cvt_pk_bf16(a[r][j], b[r][j]);
    }
    asm volatile("s_waitcnt lgkmcnt(0)" ::: "memory");
#pragma unroll 1
    for (int it = 0; it < 4; ++it) {
        const int pidx = it * 64 + lane, n = pidx >> 2, g = pidx & 3;
        const LAS unsigned* p = scr + n * 65 + 2 * g;
        f32x16 lo, hi;
#pragma unroll
        for (int j = 0; j < 8; ++j) { const unsigned d0 = p[8 * j], d1 = p[8 * j + 1];
            const float x0 = __uint_as_float(d0 << 16), x1 = __uint_as_float(d0 & 0xffff0000u), x2 = __uint_as_float(d1 << 16), x3 = __uint_as_float(d1 & 0xffff0000u);
            if (j < 4) { lo[4 * j] = x0; lo[4 * j + 1] = x1; lo[4 * j + 2] = x2; lo[4 * j + 3] = x3; } else { hi[4 * (j - 4)] = x0; hi[4 * (j - 4) + 1] = x1; hi[4 * (j - 4) + 2] = x2; hi[4 * (j - 4) + 3] = x3; } }
        unsigned sb; const u32x6 q = mx6_block(lo, hi, sb);
        unsigned char* o = dst + (size_t)(n0 + n) * 2048 + t * 128 + 16 * g;
        *(u32x4*)o = (u32x4){q[0], q[1], q[2], q[3]}; *(u32x4*)(o + 64) = (u32x4){q[4], q[5], sb, 0u};
    }
    asm volatile("s_waitcnt lgkmcnt(0)" ::: "memory");
}
__device__ __forceinline__ void tr_item6c(const float* __restrict__ src, int Nsrc, int K, unsigned char* __restrict__ dst, int t, int n0, LAS unsigned* scr, int lane) {
    const int nl = 4 * (lane & 15), ks = lane >> 4;
    f32x4 a[16], b[16];
#pragma unroll
    for (int r = 0; r < 16; ++r) {
        const int k = 128 * t + 8 * r + 2 * ks; const float* p = src + (size_t)k * Nsrc + n0 + nl;
        a[r] = __builtin_nontemporal_load((const f32x4*)p); b[r] = __builtin_nontemporal_load((const f32x4*)(p + Nsrc));
    }
#pragma unroll
    for (int r = 0; r < 16; ++r) {
#pragma unroll
        for (int j = 0; j < 4; ++j) scr[(nl + j) * 65 + 4 * r + ks] = cvt_pk_bf16(a[r][j], b[r][j]);
    }
    asm volatile("s_waitcnt lgkmcnt(0)" ::: "memory");
#pragma unroll 1
    for (int it = 0; it < 4; ++it) {
        const int pidx = it * 64 + lane, n = pidx >> 2, g = pidx & 3;
        const LAS unsigned* p = scr + n * 65 + 16 * g;
        f32x16 lo, hi;
#pragma unroll
        for (int j = 0; j < 8; ++j) { const unsigned d0 = p[j], d1 = p[8 + j];
            lo[2 * j] = __uint_as_float(d0 << 16); lo[2 * j + 1] = __uint_as_float(d0 & 0xffff0000u); hi[2 * j] = __uint_as_float(d1 << 16); hi[2 * j + 1] = __uint_as_float(d1 & 0xffff0000u); }
        unsigned sb; const u32x6 q = mx6_block(lo, hi, sb);
        unsigned char* o = dst + (size_t)(n0 + n) * K + t * 128 + 16 * g;
        *(u32x4*)o = (u32x4){q[0], q[1], q[2], q[3]}; *(u32x4*)(o + 64) = (u32x4){q[4], q[5], sb, 0u};
    }
    asm volatile("s_waitcnt lgkmcnt(0)" ::: "memory");
}
__device__ __forceinline__ void tr_matrix6c(const float* src, int Nsrc, int K, unsigned char* dst, int Ndst, LAS unsigned* scr, int lane, int gw, int NGW, int& cursor) {
    const int nb = Ndst / 64, items = (K / 128) * nb;
    int it = (gw - (cursor % NGW) + NGW) % NGW;
    for (; it < items; it += NGW) tr_item6c(src, Nsrc, K, dst, it / nb, (it % nb) * 64, scr, lane);
    cursor += items;
}
__device__ __forceinline__ void tr_matrix6(const float* src, const float* src2, int Nsrc, unsigned char* dst, int Ndst, LAS unsigned* scr, int lane, int gw, int NGW, int& cursor) {
    const int nb = Ndst / 64, items = 16 * nb;
    int it = (gw - (cursor % NGW) + NGW) % NGW;
    for (; it < items; it += NGW) {
        const int t = it / nb, n0 = (it % nb) * 64, tile = n0 >> 8, j0 = n0 & 255;
        tr_item6(j0 < 128 ? src : src2, Nsrc, dst, t, n0, 128 * tile + (j0 & 127), scr, lane);
    }
    cursor += items;
}
__device__ __forceinline__ void tr_matrix8(const float* src, const float* src2, int Nsrc, int K, unsigned char* dst, int Ndst, int inter, float scale, LAS unsigned* scr, int lane, int gw, int NGW, int& cursor) {
    const int nb = Ndst / 64, items = (K / 256) * nb;
    int it = (gw - (cursor % NGW) + NGW) % NGW;
    for (; it < items; it += NGW) {
        const int kb = it / nb, n0 = (it % nb) * 64;
        if (inter) { const int tile = n0 >> 8, j0 = n0 & 255; tr_item8(j0 < 128 ? src : src2, Nsrc, K, dst, kb * 256, n0, 128 * tile + (j0 & 127), scale, scr, lane); }
        else tr_item8(src, Nsrc, K, dst, kb * 256, n0, n0, scale, scr, lane);
    }
    cursor += items;
}
__device__ __forceinline__ void tr_matrix(const float* src, const float* src2, int Nsrc, int K, bf16_t* dst, int Ndst, int kind, const float* gain, const float* gain2,
                                          LAS unsigned* scr, int lane, int gw, int NGW, int& cursor) {
    const int nb = Ndst / 64, items = (K / 128) * nb;
    int it = (gw - (cursor % NGW) + NGW) % NGW;
    for (; it < items; it += NGW) {
        const int kb = it / nb, n0 = (it % nb) * 64;
        if (kind == 3) { const int tile = n0 >> 8, j0 = n0 & 255; tr_item(j0 < 128 ? src : src2, Nsrc, K, dst, kb * 128, n0, 0, 128 * tile + (j0 & 127) - n0, nullptr, nullptr, scr, lane); }
        else tr_item(src, Nsrc, K, dst, kb * 128, n0, kind, 0, gain, gain2, scr, lane);
    }
    cursor += items;
}

constexpr int MOE_GU_ITEMS = 16 * (2 * FFE / 64), MOE_D_ITEMS = (FFE / 128) * (D / 64), MOE_E_ITEMS = MOE_GU_ITEMS + MOE_D_ITEMS, MOE_ITEMS = NE * MOE_E_ITEMS;
__device__ __forceinline__ void moe_conv_item(const Args& args, int j, LAS unsigned* scr, int lane) {
    const int e = j / MOE_E_ITEMS, r = j - e * MOE_E_ITEMS;
    if (r < MOE_GU_ITEMS) {
        constexpr int nb = 2 * FFE / 64;
        const int t = r / nb, n0 = (r % nb) * 64, tile = n0 >> 8, j0 = n0 & 255;
        tr_item6((j0 < 128 ? args.in[16] : args.in[17]) + (size_t)e * D * FFE, FFE, args.ws + WS_WMGU + (size_t)e * 2 * FFE * D, t, n0, 128 * tile + (j0 & 127), scr, lane);
    } else {
        const int r2 = r - MOE_GU_ITEMS, t = r2 / (D / 64), n0 = (r2 % (D / 64)) * 64;
        tr_item6c(args.in[18] + (size_t)e * FFE * D, D, FFE, args.ws + WS_WMD + (size_t)e * D * FFE, t, n0, scr, lane);
    }
}
__device__ __forceinline__ void moe_conv_burst(const Args& args, LAS unsigned char* lds, int part, int nparts) {
    const int tid = tid_opaque(), lane = tid & 63, wave = tid >> 6, gw = blockIdx.x * NWAVES + wave, NGW = gridDim.x * NWAVES;
    LAS unsigned* scr = (LAS unsigned*)(lds + wave * 16640);
    const int per = (MOE_ITEMS + NGW - 1) / NGW, i0 = per * part / nparts, i1 = per * (part + 1) / nparts;
    __syncthreads();
    for (int i = i0; i < i1; ++i) { const int j = gw + i * NGW; if (j < MOE_ITEMS) moe_conv_item(args, j, scr, lane); }
    __syncthreads();
}

__device__ __forceinline__ void ln_row(f32x4 (&v)[8], const float* __restrict__ g, const float* __restrict__ b, int lane, float& mean_o, float& rstd_o) {
    float s = 0.f;
#pragma unroll
    for (int j = 0; j < 8; ++j) s += (v[j][0] + v[j][1]) + (v[j][2] + v[j][3]);
    const float mean = wave_sum(s) * (1.f / D); float s2 = 0.f;
#pragma unroll
    for (int j = 0; j < 8; ++j) { v[j] = v[j] - mean; s2 += (v[j][0] * v[j][0] + v[j][1] * v[j][1]) + (v[j][2] * v[j][2] + v[j][3] * v[j][3]); }
    const float rstd = 1.f / sqrtf(wave_sum(s2) * (1.f / D) + LN_EPS); mean_o = mean; rstd_o = rstd;
#pragma unroll
    for (int j = 0; j < 8; ++j) { const f32x4 gg = *((const f32x4*)g + lane + 64 * j), bb = *((const f32x4*)b + lane + 64 * j); v[j] = v[j] * rstd * gg + bb; }
}

#define WSP(T, off) ((T*)(args.ws + (off)))
#define IN(k) (lo <= (k) && (k) < hi)
#define SEAM(k) do { if (IN(k) && IN((k) + 1)) { XcdBarrier b_; b_.bar = WSP(unsigned, WS_CTL) + CW_BAR; b_.x = xb_xcc_id(); b_.st = (volatile LAS unsigned*)(lds + MISC_OFF) + 8; xcd_barrier(b_); } } while (0)

__device__ __forceinline__ int moe_unit_table(const int* moemeta, int NT, LAS int* utab) {
    const int tid = tid_opaque();
    pg8::MoeOrder Mo;
#pragma unroll
    for (int e = 0; e <= NE; ++e) Mo.pb[e] = moemeta[e];
    Mo.NT = NT; Mo.G = gridDim.x; Mo.c = blockIdx.x; Mo.nwg = Mo.pb[NE] * NT;
    if (tid < 64) { pg8::Unit u; u.pm = 0; u.pn = 0; u.aux = 0; Mo.next(tid, u); utab[4 * tid] = u.pm; utab[4 * tid + 1] = u.pn; utab[4 * tid + 2] = u.aux; }
    __syncthreads();
    const int left = Mo.nwg - Mo.c; int n = left <= 0 ? 0 : (left + Mo.G - 1) / Mo.G;
    return __builtin_amdgcn_readfirstlane(n < 64 ? n : 64);
}
__device__ __forceinline__ f32x4 tail_sum(const bf16_t* yp, int t, int d, int lane, int SK) {
    f32x4 acc = {0.f, 0.f, 0.f, 0.f};
    for (int q = 0; q < SK; ++q) { const u32x2 a = *((const u32x2*)(yp + ((size_t)(q * 128 + t - 1) * 256 + (d & 255)) * 256) + lane);
        acc += (f32x4){__uint_as_float(a.x << 16), __uint_as_float(a.x & 0xffff0000u), __uint_as_float(a.y << 16), __uint_as_float(a.y & 0xffff0000u)}; }
    return acc;
}
__device__ __forceinline__ int moe_tail_split(int nwg, int G, int& Rf, int& Tn) {
    Rf = nwg / G; Tn = nwg - Rf * G;
    return Tn == 0 ? 1 : (Tn * 7 <= G ? 7 : (Tn * 4 <= G ? 4 : (Tn * 2 <= G ? 2 : 1)));
}
__device__ __forceinline__ int moe_unit_table_k(const int* moemeta, int NT, LAS int* utab, unsigned char* tailmap) {
    const int tid = tid_opaque();
    pg8::MoeOrder Mo;
#pragma unroll
    for (int e = 0; e <= NE; ++e) Mo.pb[e] = moemeta[e];
    Mo.NT = NT; Mo.G = gridDim.x; Mo.c = blockIdx.x; Mo.nwg = Mo.pb[NE] * NT;
    int Rf, Tn; const int SK = moe_tail_split(Mo.nwg, Mo.G, Rf, Tn);
    const int R = Rf < 63 ? Rf : 63;
    const bool piece = SK > 1 ? (Mo.c < Tn * SK) : (Mo.c < Tn);
    if (tid < 64) {
        long Lq = -1; int kx = 0, mark = 0;
        if (tid < R) Lq = (long)tid * Mo.G + Mo.c;
        else if (tid == R && piece) {
            if (SK == 1) Lq = (long)Rf * Mo.G + Mo.c;
            else { const int j = Mo.c / SK, q = Mo.c - j * SK; Lq = (long)Rf * Mo.G + j; kx = (1 + j) | (q << 8) | (SK << 16); mark = (q == 0) ? 1 + j : 0; }
        }
        pg8::Unit u; u.pm = 0; u.pn = 0; u.aux = 0; u.kx = 0;
        if (Lq >= 0) Mo.at(Lq, u);
        if (mark) tailmap[u.pm * 8 + u.aux] = (unsigned char)mark;
        utab[4 * tid] = u.pm; utab[4 * tid + 1] = u.pn; utab[4 * tid + 2] = u.aux; utab[4 * tid + 3] = kx;
    }
    __syncthreads();
    return __builtin_amdgcn_readfirstlane(R + (piece ? 1 : 0));
}
template <int L>
__device__ __forceinline__ void layer_phases(const Args& args, LAS unsigned char* lds, char* lds_gen, int lo, int hi) {
    constexpr int pb = 1 + 10 * L;
    if (IN(pb + 0)) {
        const int G = gridDim.x, bx = blockIdx.x;
        pg8::Gemm g{WSP(const bf16_t, WS_XB), WSP(const bf16_t, WS_WIN + L * SZ_WIN), D}; pg8::StaticOrder So; So.init(S, 2048, G, bx);
        pg8::EpiInProj E{WSP(bf16_t, WS_CQ), WSP(bf16_t, WS_CKV), WSP(bf16_t, WS_KPE), WSP(bf16_t, WS_QS), WSP(bf16_t, WS_KS), WSP(bf16_t, WS_VS), WSP(float, WS_PARTQ), WSP(float, WS_PARTKV),
                         WSP(const float, WS_COSM), WSP(const float, WS_SINM), WSP(const float, WS_COSS), WSP(const float, WS_SINS)};
        pg8::gemm_phase<pg8::EpiInProj, pg8::StaticOrder, true, true>(lds, g, So, E);
    }
    SEAM(pb + 0);
    if (IN(pb + 1)) {
        const int G = gridDim.x, bx = blockIdx.x;
        LAS int* utab = (LAS int*)(lds + MISC_OFF + 1024);
        LAS int* ucnt = (LAS int*)(lds + MISC_OFF + 1024 + 3072);
        if (tid_opaque() == 0) {
            int nl = 0, nq = 0, nk = 0;
            if (G == 256) {
                if (bx < 128) { utab[0] = bx >> 1; utab[1] = 8 + (bx & 1); utab[2] = 8 + (bx & 1); nl = 1; utab[128] = bx >> 3; utab[129] = bx & 7; utab[130] = bx & 7; nk = 1; }
                else { const int c = bx - 128;
                    for (int i = 0; i < 3; ++i) { const int u = 3 * c + i; utab[64 + 4 * i] = u / 6; utab[65 + 4 * i] = u % 6; utab[66 + 4 * i] = u % 6; }
                    nq = 3;
                    for (int i = 0; i < 3; ++i) { const int u = 128 + 3 * c + i; utab[128 + 4 * i] = u >> 3; utab[129 + 4 * i] = u & 7; utab[130 + 4 * i] = u & 7; }
                    nk = 3; }
            } else {
                for (int u = bx; u < 128 && nl < 16; u += G, ++nl) { utab[4 * nl] = u >> 1; utab[4 * nl + 1] = 8 + (u & 1); utab[4 * nl + 2] = 8 + (u & 1); }
                for (int u = bx; u < 384 && nq < 16; u += G, ++nq) { utab[64 + 4 * nq] = u / 6; utab[65 + 4 * nq] = u % 6; utab[66 + 4 * nq] = u % 6; }
                for (int u = bx; u < 512 && nk < 16; u += G, ++nk) { utab[128 + 4 * nk] = u >> 3; utab[129 + 4 * nk] = u & 7; utab[130 + 4 * nk] = u & 7; }
            }
            ucnt[0] = nl; ucnt[1] = nq; ucnt[2] = nk;
        }
        __syncthreads();
        { pg8::TableOrder To{utab, __builtin_amdgcn_readfirstlane(ucnt[0])};
          pg8::Gemm g{WSP(const bf16_t, WS_XB), WSP(const bf16_t, WS_WIN + L * SZ_WIN), D};
          pg8::EpiInProj E{WSP(bf16_t, WS_CQ), WSP(bf16_t, WS_CKV), WSP(bf16_t, WS_KPE), WSP(bf16_t, WS_QS), WSP(bf16_t, WS_KS), WSP(bf16_t, WS_VS), WSP(float, WS_PARTQ), WSP(float, WS_PARTKV),
                           WSP(const float, WS_COSM), WSP(const float, WS_SINM), WSP(const float, WS_COSS), WSP(const float, WS_SINS)};
          pg8::gemm_phase<pg8::EpiInProj, pg8::TableOrder, true, true>(lds, g, To, E); }
        { pg8::TableOrder To{utab + 64, __builtin_amdgcn_readfirstlane(ucnt[1])};
          pg8::Gemm g{WSP(const bf16_t, WS_CQ), WSP(const bf16_t, WS_WQ + L * SZ_WQ), QLORA};
          pg8::EpiQ E{WSP(bf16_t, WS_Q), WSP(const float, WS_PARTQ), WSP(const float, WS_COSM), WSP(const float, WS_SINM)};
          pg8::gemm_phase<pg8::EpiQ, pg8::TableOrder, true, true>(lds, g, To, E); }
        { pg8::TableOrder To{utab + 128, __builtin_amdgcn_readfirstlane(ucnt[2])};
          pg8::Gemm g{WSP(const bf16_t, WS_CKV), WSP(const bf16_t, WS_WKV + L * SZ_WKV), KVLORA};
          pg8::EpiKV E{WSP(bf16_t, WS_KV), WSP(const float, WS_PARTKV), WSP(unsigned char, WS_VT)};
          pg8::gemm_phase<pg8::EpiKV, pg8::TableOrder, true, true>(lds, g, To, E); }
    }
    SEAM(pb + 1);
    if (IN(pb + 2)) {
        const int G = gridDim.x, bx = blockIdx.x;
        const int slot = bx % 3; bool pending = true;
        for (int step = 0; ; ++step) {
            const int u = bx + step * G; const bool more = u < 512;
            if (pending && (step == slot || !more)) { moe_conv_burst(args, lds, L, DEPTH); pending = false; }
            if (!more) break;
            const int r = u / 256, c = u % 256, head = 4 * r + ((c & 7) >> 1), qblk = (c >> 3) + 32 * (c & 1);
            att::attn_body<192, false, QCOLS, KVCOLS, 64, S, D>(WSP(const bf16_t, WS_Q) + (size_t)qblk * 256 * QCOLS + head * 192, WSP(const bf16_t, WS_KV) + head * 256, WSP(const bf16_t, WS_KPE),
                (const bf16_t*)(args.ws + WS_VT + (size_t)head * 128 * S), WSP(bf16_t, WS_OBUF) + (size_t)qblk * 256 * D + head * 128, WSP(float, WS_PARTO) + (size_t)qblk * 256 * 16 + head, qblk * 256, 0, S / 64, SCALE_MLA, 0.f, (LAS char*)lds);
        }
        for (int u = bx; u < 512; u += G) {
            const int head = u >> 6, qblk = u & 63;
            int t0 = 4 * qblk - 2, t1 = 4 * qblk + 5; if (t0 < 0) t0 = 0; if (t1 > S / 64 - 1) t1 = S / 64 - 1;
            const float sk = (args.in[6] + L * 8)[head];
            att::attn_body<128, true, 1024, 256, 64, 256, D>(WSP(const bf16_t, WS_QS) + (size_t)qblk * 256 * 1024 + head * 128, WSP(const bf16_t, WS_KS) + (head >> 2) * 128, nullptr, WSP(const bf16_t, WS_VS) + (head >> 2) * 128,
                WSP(bf16_t, WS_OBUF) + (size_t)qblk * 256 * D + 1024 + head * 128, WSP(float, WS_PARTO) + (size_t)qblk * 256 * 16 + 8 + head, qblk * 256, t0 * 64, t1 - t0 + 1, SCALE_SWA, sk / SCALE_SWA, (LAS char*)lds);
        }
    }
    SEAM(pb + 2);
    if (IN(pb + 4)) {
        const int G = gridDim.x, bx = blockIdx.x;
        pg8::Gemm g{WSP(const bf16_t, WS_OBUF), WSP(const bf16_t, WS_WOUT + L * SZ_WOUT), D}; pg8::StaticOrder So; So.init(S, D, G, bx);
        if constexpr (L == 0) { pg8::EpiOutProj<false> E{args.in[0], WSP(float, WS_XA), WSP(const float, WS_PARTO), nullptr, nullptr, nullptr}; pg8::gemm_phase<pg8::EpiOutProj<false>, pg8::StaticOrder, true, true>(lds, g, So, E); }
        else { pg8::EpiOutProj<true> E{WSP(const float, WS_XA), WSP(float, WS_XA), WSP(const float, WS_PARTO), WSP(const float, WS_ST2), args.in[19] + (L - 1) * D, args.in[20] + (L - 1) * D};
               pg8::gemm_phase<pg8::EpiOutProj<true>, pg8::StaticOrder, true, true>(lds, g, So, E); }
    }
    SEAM(pb + 4);
    if (IN(pb + 5)) {
        const int tid = tid_opaque(), lane = tid & 63, wave = tid >> 6, G = gridDim.x, bx = blockIdx.x;
        const float* lg = args.in[10] + L * D; const float* lb = args.in[11] + L * D;
        float* XA = WSP(float, WS_XA); unsigned* X8 = WSP(unsigned, WS_X8);
        const int RPW = (S + G - 1) / G, r0 = bx * RPW, r1 = (r0 + RPW < S) ? r0 + RPW : S;
        LAS float* wr_l = (LAS float*)lds; LAS int* hist = (LAS int*)(lds + 65536);
        if (L == 1) { const float* wrg = args.in[15]; for (int i = tid; i < D * NE; i += 512) wr_l[i] = wrg[i]; if (tid < NE) hist[tid] = 0; __syncthreads(); }
        for (int row = r0 + wave; row < r1; row += NWAVES) {
            f32x4 v[8]; float* xr = XA + (size_t)row * D;
#pragma unroll
            for (int j = 0; j < 8; ++j) v[j] = *((const f32x4*)xr + lane + 64 * j);
            float mu_, rs_; ln_row(v, lg, lb, lane, mu_, rs_);
            if (lane == 0) { float* st = WSP(float, WS_ST1); st[2 * row] = mu_; st[2 * row + 1] = rs_; }
            { f32x16 lo, hi;
#pragma unroll
              for (int j = 0; j < 4; ++j)
#pragma unroll
                  for (int c = 0; c < 4; ++c) { lo[4 * j + c] = v[j][c]; hi[4 * j + c] = v[4 + j][c]; }
              unsigned sb; const u32x6 q = mx6_block(lo, hi, sb);
              unsigned char* o = (unsigned char*)X8 + (size_t)row * D + (lane >> 2) * 128 + 16 * (lane & 3);
              *(u32x4*)o = (u32x4){q[0], q[1], q[2], q[3]}; *(u32x4*)(o + 64) = (u32x4){q[4], q[5], sb, 0u}; }
            if (L == 1) {
                float q0 = 0.f, q1 = 0.f, q2 = 0.f, q3 = 0.f, q4 = 0.f, q5 = 0.f, q6 = 0.f, q7 = 0.f;
#pragma unroll
                for (int j = 0; j < 8; ++j)
#pragma unroll
                    for (int k = 0; k < 4; ++k) { const LAS f32x4* w = (const LAS f32x4*)(wr_l + (size_t)(4 * (lane + 64 * j) + k) * NE); const f32x4 w0 = w[0], w1 = w[1]; const float xv = v[j][k];
                        q0 += xv * w0[0]; q1 += xv * w0[1]; q2 += xv * w0[2]; q3 += xv * w0[3]; q4 += xv * w1[0]; q5 += xv * w1[1]; q6 += xv * w1[2]; q7 += xv * w1[3]; }
                q0 = wave_sum(q0); q1 = wave_sum(q1); q2 = wave_sum(q2); q3 = wave_sum(q3); q4 = wave_sum(q4); q5 = wave_sum(q5); q6 = wave_sum(q6); q7 = wave_sum(q7);
                int e0 = 0; float l0 = q0;
                if (q1 > l0) { l0 = q1; e0 = 1; } if (q2 > l0) { l0 = q2; e0 = 2; } if (q3 > l0) { l0 = q3; e0 = 3; } if (q4 > l0) { l0 = q4; e0 = 4; } if (q5 > l0) { l0 = q5; e0 = 5; } if (q6 > l0) { l0 = q6; e0 = 6; } if (q7 > l0) { l0 = q7; e0 = 7; }
                int e1 = -1; float l1 = -3.0e38f;
                if (e0 != 0 && q0 > l1) { l1 = q0; e1 = 0; } if (e0 != 1 && q1 > l1) { l1 = q1; e1 = 1; } if (e0 != 2 && q2 > l1) { l1 = q2; e1 = 2; } if (e0 != 3 && q3 > l1) { l1 = q3; e1 = 3; }
                if (e0 != 4 && q4 > l1) { l1 = q4; e1 = 4; } if (e0 != 5 && q5 > l1) { l1 = q5; e1 = 5; } if (e0 != 6 && q6 > l1) { l1 = q6; e1 = 6; } if (e0 != 7 && q7 > l1) { l1 = q7; e1 = 7; }
                const float t = __expf(l1 - l0), g0 = 1.0f / (1.0f + t), g1 = t / (1.0f + t);
                if (lane == 0) { int* sel = WSP(int, WS_SEL); float* gate = WSP(float, WS_GATE); sel[2 * row] = e0; sel[2 * row + 1] = e1; gate[2 * row] = g0; gate[2 * row + 1] = g1;
                    __hip_atomic_fetch_add(hist + e0, 1, __ATOMIC_RELAXED, __HIP_MEMORY_SCOPE_WORKGROUP); __hip_atomic_fetch_add(hist + e1, 1, __ATOMIC_RELAXED, __HIP_MEMORY_SCOPE_WORKGROUP); }
            }
        }
        if (L == 1) { __syncthreads(); if (tid < NE) WSP(int, WS_WGCNT)[bx * NE + tid] = hist[tid]; }
    }
    SEAM(pb + 5);
    if constexpr (L == 0) {
        if (IN(pb + 7)) {
            const int G = gridDim.x, bx = blockIdx.x;
            pg8::Gemm g{WSP(const bf16_t, WS_X8), WSP(const bf16_t, WS_WGU), D}; pg8::StaticOrder So; So.init(S, 2 * FF, G, bx);
            pg8::EpiSwiglu6 E{WSP(unsigned char, WS_H), FF};
            pg8::gemm_phase<pg8::EpiSwiglu6, pg8::StaticOrder, true, true, 2>(lds, g, So, E);
        }
        SEAM(pb + 7);
        if (IN(pb + 8)) {
            const int G = gridDim.x, bx = blockIdx.x;
            pg8::Gemm g{WSP(const bf16_t, WS_H), WSP(const bf16_t, WS_WD), FF}; pg8::StaticOrder So; So.init(S, D, G, bx);
            pg8::EpiResidLN E{WSP(const float, WS_XA), WSP(float, WS_XA), 1.0f, WSP(const float, WS_ST1), args.in[10] + L * D, args.in[11] + L * D};
            pg8::gemm_phase<pg8::EpiResidLN, pg8::StaticOrder, true, true, 2>(lds, g, So, E);
        }
        SEAM(pb + 8);
        if (IN(pb + 9)) {
            const int tid = tid_opaque(), lane = tid & 63, gw = blockIdx.x * NWAVES + (tid >> 6), NGW = gridDim.x * NWAVES;
            const float* lg = args.in[19] + L * D; const float* lb = args.in[20] + L * D; float* XA = WSP(float, WS_XA); bf16_t* XB = WSP(bf16_t, WS_XB);
            for (int row = gw; row < S; row += NGW) {
                f32x4 v[8]; float* xr = XA + (size_t)row * D;
#pragma unroll
                for (int j = 0; j < 8; ++j) v[j] = *((const f32x4*)xr + lane + 64 * j);
                float mu_, rs_; ln_row(v, lg, lb, lane, mu_, rs_);
                if (lane == 0) { float* st = WSP(float, WS_ST2); st[2 * row] = mu_; st[2 * row + 1] = rs_; }
#pragma unroll
                for (int j = 0; j < 8; ++j) *((u32x2*)(XB + (size_t)row * D) + lane + 64 * j) = pg8::pack4(v[j]);
            }
        }
        SEAM(pb + 9);
    } else {
        if (IN(pb + 6)) {
            const int tid = tid_opaque(), lane = tid & 63, wave = tid >> 6, G = gridDim.x, bx = blockIdx.x;
            const int RPW = (S + G - 1) / G, r0 = bx * RPW, r1 = (r0 + RPW < S) ? r0 + RPW : S, na = 2 * (r1 - r0);
            LAS int* tab = (LAS int*)lds;
            LAS int* basee = (LAS int*)(lds + 32768);
            LAS int* asel = (LAS int*)(lds + 33024);
            LAS int* adst = (LAS int*)(lds + 35072);
            const int* wgcnt = WSP(const int, WS_WGCNT); const int* sel = WSP(const int, WS_SEL);
            for (int i = tid; i < G * NE; i += 512) tab[i] = wgcnt[i];
            for (int i = tid; i < na; i += 512) asel[i] = sel[2 * r0 + i];
            __syncthreads();
            if (tid < NE) { int tot = 0, pre = 0; for (int w = 0; w < G; ++w) { const int c = tab[w * NE + tid]; pre += (w < bx) ? c : 0; tot += c; } basee[32 + tid] = tot; basee[40 + tid] = pre; }
            __syncthreads();
            if (tid == 0) { int p = 0; for (int e = 0; e < NE; ++e) { basee[8 + e] = p; basee[e] = 256 * p + basee[40 + e]; p += (basee[32 + e] + 255) >> 8; } basee[16] = p;
                if (bx == 0) { int* moemeta = WSP(int, WS_MOEMETA); for (int e = 0; e <= NE; ++e) moemeta[e] = basee[8 + e]; } }
            __syncthreads();
            if (tid < NE) { int rk = basee[tid]; for (int i = 0; i < na; ++i) if (asel[i] == tid) adst[i] = rk++; }
            __syncthreads();
            int* dest = WSP(int, WS_DEST); const unsigned char* X8 = WSP(const unsigned char, WS_X8); unsigned char* xs = WSP(unsigned char, WS_XS);
            for (int i = tid; i < na; i += 512) dest[2 * r0 + i] = adst[i];
            if (bx < NE) {
                const int rb = 256 * basee[8 + bx] + basee[32 + bx], re = 256 * basee[9 + bx];
                for (int i = rb * 128 + tid; i < re * 128; i += 512) ((u32x4*)xs)[i] = (u32x4){0u, 0u, 0u, 0u};
            }
            for (int a = wave; a < na; a += NWAVES) { const u32x4* s4 = (const u32x4*)(X8 + (size_t)(r0 + (a >> 1)) * D); u32x4* d4 = (u32x4*)(xs + (size_t)adst[a] * D);
#pragma unroll
                for (int j = 0; j < 2; ++j) d4[lane + 64 * j] = s4[lane + 64 * j]; }
        }
        SEAM(pb + 6);
        if (IN(pb + 7)) {
            LAS int* utab = (LAS int*)(lds + MISC_OFF + 1024);
            const int nun = moe_unit_table(WSP(const int, WS_MOEMETA), 2 * FFE / 256, utab);
            pg8::TableOrder To{utab, nun};
            pg8::Gemm g{WSP(const bf16_t, WS_XS), WSP(const bf16_t, WS_WMGU), D};
            pg8::EpiSwiglu6 E{WSP(unsigned char, WS_H), FFE};
            for (int rep = 0; rep < PROBE_MOEUP; ++rep) pg8::gemm_phase<pg8::EpiSwiglu6, pg8::TableOrder, true, true, 2>(lds, g, To, E);
        }
        SEAM(pb + 7);
        if (IN(pb + 8)) {
            LAS int* utab = (LAS int*)(lds + MISC_OFF + 1024);
            const int nun = moe_unit_table_k(WSP(const int, WS_MOEMETA), D / 256, utab, WSP(unsigned char, WS_TAILMAP));
            pg8::TableOrderK To{utab, nun};
            pg8::Gemm g{WSP(const bf16_t, WS_H), WSP(const bf16_t, WS_WMD), FFE};
            pg8::EpiBf16OutK E{WSP(bf16_t, WS_XS), WSP(bf16_t, WS_YP)};
            pg8::gemm_phase<pg8::EpiBf16OutK, pg8::TableOrderK, true, true, 2>(lds, g, To, E);
        }
        SEAM(pb + 8);
        if (IN(pb + 9)) {
            const int tid = tid_opaque(), lane = tid & 63, gw = blockIdx.x * NWAVES + (tid >> 6), NGW = gridDim.x * NWAVES;
            const float* lg = args.in[19] + L * D; const float* lb = args.in[20] + L * D;
            const int* dest = WSP(const int, WS_DEST); const float* gate = WSP(const float, WS_GATE); const float* XA = WSP(const float, WS_XA); const bf16_t* ys = WSP(const bf16_t, WS_XS);
            const float* st1 = WSP(const float, WS_ST1); const float* g1p = args.in[10] + L * D; const float* b1p = args.in[11] + L * D;
            for (int row = gw; row < S; row += NGW) {
                const int d0 = dest[2 * row], d1 = dest[2 * row + 1]; const float g0 = gate[2 * row], g1 = gate[2 * row + 1]; const float mu1 = st1[2 * row], rs1 = st1[2 * row + 1];
                f32x4 v[8]; const float* xr = XA + (size_t)row * D; const u32x2* y0 = (const u32x2*)(ys + (size_t)d0 * D); const u32x2* y1 = (const u32x2*)(ys + (size_t)d1 * D);
                const u32x2 m0 = *(const u32x2*)(WSP(const unsigned char, WS_TAILMAP) + (d0 >> 8) * 8), m1 = *(const u32x2*)(WSP(const unsigned char, WS_TAILMAP) + (d1 >> 8) * 8);
                const bool anyt = (m0.x | m0.y | m1.x | m1.y) != 0u;
#pragma unroll
                for (int j = 0; j < 8; ++j) { const f32x4 yv = *((const f32x4*)xr + lane + 64 * j); const f32x4 x = (yv - mu1) * rs1 * *((const f32x4*)g1p + lane + 64 * j) + *((const f32x4*)b1p + lane + 64 * j); const u32x2 a = y0[lane + 64 * j], b = y1[lane + 64 * j];
                    f32x4 fa = {__uint_as_float(a.x << 16), __uint_as_float(a.x & 0xffff0000u), __uint_as_float(a.y << 16), __uint_as_float(a.y & 0xffff0000u)};
                    f32x4 fb = {__uint_as_float(b.x << 16), __uint_as_float(b.x & 0xffff0000u), __uint_as_float(b.y << 16), __uint_as_float(b.y & 0xffff0000u)};
                    if (anyt) {
                        const int t0 = (int)(((j < 4 ? m0.x : m0.y) >> (8 * (j & 3))) & 255u), t1 = (int)(((j < 4 ? m1.x : m1.y) >> (8 * (j & 3))) & 255u);
                        if (t0 | t1) {
                            const int nwg_ = WSP(const int, WS_MOEMETA)[NE] * (D / 256), G_ = gridDim.x, Tn_ = nwg_ - (nwg_ / G_) * G_, SK = Tn_ * 7 <= G_ ? 7 : (Tn_ * 4 <= G_ ? 4 : 2);
                            if (t0) fa = tail_sum(WSP(const bf16_t, WS_YP), t0, d0, lane, SK);
                            if (t1) fb = tail_sum(WSP(const bf16_t, WS_YP), t1, d1, lane, SK);
                        }
                    }
                    v[j] = x * ALPHA + (fa * g0 + fb * g1); }
                float mu_, rs_; ln_row(v, lg, lb, lane, mu_, rs_);
#pragma unroll
                for (int j = 0; j < 8; ++j) *((f32x4*)(args.out + (size_t)row * D) + lane + 64 * j) = v[j];
            }
        }
    }
}

__global__ void __launch_bounds__(NWAVES * 64, 2) fwd(Args args) {
    extern __shared__ __attribute__((aligned(16))) unsigned char lds_raw[];
    LAS unsigned char* lds = (LAS unsigned char*)lds_raw;
    volatile LAS unsigned* MISC = (volatile LAS unsigned*)(lds + MISC_OFF);
    for (int u = tid_opaque(); u < (LDS_BYTES - MISC_OFF) / 4; u += NWAVES * 64) MISC[u] = 0u;
    __syncthreads();
    (void)xcd_barrier_post(WSP(unsigned, WS_CTL) + CW_BAR, MISC + 8);
    const int lo = args.ph_lo, hi = args.ph_hi;

    if (IN(0)) {
        const int tid = tid_opaque(), lane = tid & 63, wave = tid >> 6, G = gridDim.x, bx = blockIdx.x, gw = bx * NWAVES + wave, NGW = G * NWAVES;
        unsigned char* ws = args.ws;
        LAS unsigned* scr = (LAS unsigned*)(lds + wave * 16640);
        for (int rep = 0; rep < PROBE_PRO; ++rep) {
        int cursor = 0;
        for (int l = 0; l < DEPTH; ++l) {
            tr_matrix(args.in[1] + (size_t)l * D * IN_COLS, nullptr, IN_COLS, D, (bf16_t*)(ws + WS_WIN + l * SZ_WIN), IN_PAD, 1, nullptr, nullptr, scr, lane, gw, NGW, cursor);
            tr_matrix(args.in[3] + (size_t)l * QLORA * QCOLS, nullptr, QCOLS, QLORA, (bf16_t*)(ws + WS_WQ + l * SZ_WQ), QCOLS, 2, args.in[2] + l * QLORA, nullptr, scr, lane, gw, NGW, cursor);
            tr_matrix(args.in[5] + (size_t)l * KVLORA * KVCOLS, nullptr, KVCOLS, KVLORA, (bf16_t*)(ws + WS_WKV + l * SZ_WKV), KVCOLS, 0, args.in[4] + l * KVLORA, nullptr, scr, lane, gw, NGW, cursor);
            tr_matrix(args.in[9] + (size_t)l * D * D, nullptr, D, D, (bf16_t*)(ws + WS_WOUT + l * SZ_WOUT), D, 0, args.in[7] + l * 1024, args.in[8] + l * 1024, scr, lane, gw, NGW, cursor);
        }
        tr_matrix6(args.in[12], args.in[13], FF, ws + WS_WGU, 2 * FF, scr, lane, gw, NGW, cursor);
        tr_matrix6c(args.in[14], D, FF, ws + WS_WD, D, scr, lane, gw, NGW, cursor);
        { const f32x4* x4 = (const f32x4*)args.in[0]; u32x2* o2 = (u32x2*)(ws + WS_XB);
          for (size_t i = (size_t)bx * 512 + tid; i < (size_t)S * D / 4; i += (size_t)G * 512) o2[i] = pg8::pack4(x4[i]); }
        { float* coss = (float*)(ws + WS_COSS); float* sins = (float*)(ws + WS_SINS); float* cosm = (float*)(ws + WS_COSM); float* sinm = (float*)(ws + WS_SINM);
          for (int i = bx * 512 + tid; i < S * 64; i += G * 512) { const int pos = i >> 6, k = i & 63; float sn, cs; sincos_acc((float)pos * INVF[k], sn, cs); coss[i] = cs; sins[i] = sn; }
          for (int i = bx * 512 + tid; i < S * 32; i += G * 512) { const int pos = i >> 5, k = i & 31; float sn, cs; sincos_acc((float)pos * INVF[2 * k], sn, cs); cosm[i] = cs; sinm[i] = sn; } }
        }
    }
    SEAM(0);
    layer_phases<0>(args, lds, (char*)lds_raw, lo, hi);
    layer_phases<1>(args, lds, (char*)lds_raw, lo, hi);
}
#undef IN
#undef SEAM

#ifndef MK_SPLIT
#define MK_SPLIT 0
#endif
extern "C" void kernel_launch(void* const* d_in, const int* in_sizes, int n_in, void* d_out, int out_size, void* d_ws, size_t ws_size, hipStream_t stream) {
    static int grid = 0;
    if (grid == 0) {
        if (n_in != 21 || out_size != S * D || ws_size < WS_END3) { fprintf(stderr, "kernel_launch: unexpected shapes: n_in %d out %d ws %zu (need %zu)\n", n_in, out_size, ws_size, (size_t)WS_END3); grid = -1; return; }
        int dev = 0, cus = 0, per_cu = 0;
        if (hipGetDevice(&dev) != hipSuccess || hipDeviceGetAttribute(&cus, hipDeviceAttributeMultiprocessorCount, dev) != hipSuccess) { grid = -1; return; }
        if (hipFuncSetAttribute((const void*)fwd, hipFuncAttributeMaxDynamicSharedMemorySize, LDS_BYTES) != hipSuccess) { fprintf(stderr, "kernel_launch: hipFuncSetAttribute failed\n"); grid = -1; return; }
        if (hipOccupancyMaxActiveBlocksPerMultiprocessor(&per_cu, (const void*)fwd, NWAVES * 64, LDS_BYTES) != hipSuccess || per_cu < 1) fprintf(stderr, "kernel_launch: occupancy query says %d\n", per_cu);
        (void)hipGetLastError();
        grid = cus;
    }
    if (grid < 0) return;
    (void)hipMemsetAsync((char*)d_ws + WS_CTL, 0, CTL_ZERO_BYTES, stream);
    Args a{};
    for (int i = 0; i < 21; ++i) a.in[i] = (const float*)d_in[i];
    a.out = (float*)d_out; a.ws = (unsigned char*)d_ws;
#if MK_SPLIT
    for (int p = 0; p < NPHASE; ++p) { a.ph_lo = p; a.ph_hi = p + 1; hipLaunchKernelGGL(fwd, dim3(grid), dim3(NWAVES * 64), LDS_BYTES, stream, a); }
#else
    a.ph_lo = 0; a.ph_hi = NPHASE; hipLaunchKernelGGL(fwd, dim3(grid), dim3(NWAVES * 64), LDS_BYTES, stream, a);
#endif
    const hipError_t le = hipPeekAtLastError();
    if (le != hipSuccess) fprintf(stderr, "kernel_launch: launch failed: %s\n", hipGetErrorName(le));
}
```

```cpp
#include <hip/hip_runtime.h>
#include <cstdio>
#include <cstdint>

#define LAS __attribute__((address_space(3)))
#define GAS __attribute__((address_space(1)))
typedef unsigned short bf16_t;
typedef short bf16x8 __attribute__((ext_vector_type(8)));
typedef short s16x4 __attribute__((ext_vector_type(4)));
typedef float f32x4 __attribute__((ext_vector_type(4)));
typedef float f32x16 __attribute__((ext_vector_type(16)));
typedef unsigned u32x4 __attribute__((ext_vector_type(4)));
typedef unsigned u32x2 __attribute__((ext_vector_type(2)));

constexpr int S = 16384, D = 2048, DEPTH = 2;
constexpr int IN_COLS = 2368, IN_PAD = 2560, QCOLS = 1536, KVCOLS = 2048, QLORA = 512, KVLORA = 256;
constexpr int FF = 5632, FFE = 7168, NE = 8;
constexpr int MOE_ROWS = 34816;
constexpr float ALPHA = 1.41421356237309515f, LN_EPS = 1e-5f, RMS_EPS = 1e-6f;
constexpr float SCALE_MLA = 0.07216878364870322f, SCALE_SWA = 0.08838834764831845f;

__device__ __forceinline__ unsigned cvt_pk_bf16(float lo, float hi) { unsigned r; asm volatile("v_cvt_pk_bf16_f32 %0, %1, %2" : "=v"(r) : "v"(lo), "v"(hi)); return r; }

__device__ __forceinline__ unsigned pk_fp8x4(float a, float b, float c, float d) { int w = 0; w = __builtin_amdgcn_cvt_pk_fp8_f32(a, b, w, false); w = __builtin_amdgcn_cvt_pk_fp8_f32(c, d, w, true); return (unsigned)w; }
typedef int v6i32 __attribute__((ext_vector_type(6)));
typedef unsigned u32x6 __attribute__((ext_vector_type(6)));
__device__ __forceinline__ u32x6 mx6_block(const f32x16 lo, const f32x16 hi, unsigned& sb) {
    float am = 0.f;
#pragma unroll
    for (int i = 0; i < 16; ++i) am = fmaxf(am, fmaxf(fabsf(lo[i]), fabsf(hi[i])));
    const unsigned bits = __float_as_uint(am);
    int e = (int)((bits >> 23) & 255u) - 126 - (((bits & 0x7fffffu) <= 0x700000u) ? 3 : 2);
    e = e < -120 ? -120 : e;
    const float scale = __uint_as_float((unsigned)(e + 127) << 23);
    sb = (unsigned)(e + 127) * 0x01010101u;
    u32x6 q;
    asm("v_cvt_scalef32_2xpk16_fp6_f32 %0, %1, %2, %3" : "=&v"(q) : "v"(lo), "v"(hi), "v"(scale));
    return q;
}
constexpr float X8_SCALE = 4.f, W8UP_SCALE = 64.f, W8DN_SCALE = 128.f, H8_SCALE = 16.f;
__device__ __forceinline__ int tid_opaque() { int t = threadIdx.x; asm volatile("" : "+v"(t)); return t; }

constexpr size_t MiB = 1u << 20;
constexpr size_t WS_CTL = 0, CTL_ZERO_BYTES = 1 * MiB;
constexpr size_t WS_COSM = 1 * MiB, WS_SINM = 3 * MiB, WS_COSS = 5 * MiB, WS_SINS = 9 * MiB;
constexpr size_t WS_PARTQ = 13 * MiB, WS_PARTKV = 14 * MiB, WS_PARTO = 15 * MiB;
constexpr size_t WS_SEL = 16 * MiB, WS_GATE = WS_SEL + 128 * 1024, WS_DEST = WS_GATE + 128 * 1024, WS_WGCNT = WS_DEST + 128 * 1024, WS_MOEMETA = WS_WGCNT + 32 * 1024, WS_ST1 = WS_MOEMETA + 4096, WS_ST2 = WS_ST1 + 128 * 1024;
constexpr size_t WS_W = 17 * MiB;
constexpr size_t SZ_WIN = (size_t)IN_PAD * D * 2, SZ_WQ = (size_t)QCOLS * QLORA * 2, SZ_WKV = (size_t)KVCOLS * KVLORA * 2, SZ_WOUT = (size_t)D * D * 2;
constexpr size_t WS_WIN = WS_W, WS_WQ = WS_WIN + 2 * SZ_WIN, WS_WKV = WS_WQ + 2 * SZ_WQ, WS_WOUT = WS_WKV + 2 * SZ_WKV;
constexpr size_t WS_WGU = WS_WOUT + 2 * SZ_WOUT, WS_WD = WS_WGU + (size_t)2 * FF * D, WS_WMGU = WS_WD + (size_t)D * FF;
constexpr size_t WS_WMD = WS_WMGU + (size_t)NE * 2 * FFE * D, WS_XA = WS_WMD + (size_t)NE * D * FFE;
constexpr size_t WS_XB = WS_XA + (size_t)S * D * 4, WS_X8 = WS_XB + (size_t)S * D * 2, WS_SCR = WS_X8 + (size_t)S * D;
constexpr size_t WS_CQ = WS_SCR, WS_CKV = WS_CQ + (size_t)S * 512 * 2, WS_KPE = WS_CKV + (size_t)S * 256 * 2, WS_QS = WS_KPE + (size_t)S * 64 * 2;
constexpr size_t WS_KS = WS_QS + (size_t)S * 1024 * 2, WS_VS = WS_KS + (size_t)S * 256 * 2, WS_Q = WS_VS + (size_t)S * 256 * 2, WS_KV = WS_Q + (size_t)S * QCOLS * 2;
constexpr size_t WS_OBUF = WS_KV + (size_t)S * KVCOLS * 2, WS_ATT_END = WS_OBUF + (size_t)S * D * 2;
constexpr size_t WS_XS = WS_SCR, WS_H = WS_XS + (size_t)MOE_ROWS * D * 2, WS_END0 = WS_H + (size_t)MOE_ROWS * FFE, WS_END = WS_END0 > WS_ATT_END ? WS_END0 : WS_ATT_END;
constexpr size_t WS_YP = (WS_END + 255) / 256 * 256, WS_END2 = WS_YP + (size_t)7 * 128 * 65536 * 2;
constexpr size_t WS_VT = (WS_END2 + 255) / 256 * 256, WS_END3 = WS_VT + (size_t)8 * 128 * S;
constexpr size_t WS_KN8 = (WS_END3 + 255) / 256 * 256, WS_END4 = WS_KN8 + (size_t)S * 512;
constexpr size_t WS_TAILMAP = WS_CTL + 512 * 1024;
static_assert(WS_H + (size_t)S * FF <= WS_END, "scratch union");
static_assert(WS_WIN % 256 == 0 && WS_XA % 256 == 0 && WS_H % 256 == 0 && WS_Q % 256 == 0, "alignment");
constexpr int CW_TMO = 0, CW_BAR = 4096;

#define XB_TMO      128
#define XB_XCNT(j)  (256  + 64 * (j))
#define XB_XSUB(j)  (1280 + 64 * (j))
#define XB_XGEN(j)  (2304 + 64 * (j))
#define XB_TOP      3328
#define XB_TOPGEN   3392
#define XCD_BAR_WORDS 3456
#define XB_SPIN_CAP (1u << 18)
__device__ __forceinline__ unsigned xb_ld(unsigned* p)              { return __hip_atomic_load(p, __ATOMIC_RELAXED, __HIP_MEMORY_SCOPE_AGENT); }
__device__ __forceinline__ unsigned xb_add(unsigned* p, unsigned v) { return __hip_atomic_fetch_add(p, v, __ATOMIC_RELAXED, __HIP_MEMORY_SCOPE_AGENT); }
__device__ __forceinline__ unsigned xb_xcc_id() { return (unsigned)__builtin_amdgcn_s_getreg((3 << 11) | 20) & 0xFu; }
#define XB_SPIN(cond, bar) do { unsigned _sp = 0; while (cond) { __builtin_amdgcn_s_sleep(1); \
    if ((++_sp & 255u) == 0u) { if (xb_ld(&(bar)[XB_TMO])) break; if (_sp > XB_SPIN_CAP) { atomicAdd(&(bar)[XB_TMO], 1u); break; } } } } while (0)
struct XcdBarrier { unsigned* bar; unsigned x; volatile LAS unsigned* st; };
__device__ __forceinline__ XcdBarrier xcd_barrier_post(unsigned* bar, volatile LAS unsigned* st) {
    XcdBarrier b; b.bar = bar; b.x = xb_xcc_id(); b.st = st;
    if (threadIdx.x == 0) (void)xb_add(&bar[XB_XCNT(b.x)], 1u);
    return b;
}
__device__ __forceinline__ void xcd_barrier_complete(unsigned* bar, unsigned x, unsigned& nloc, unsigned& nx) {
    const unsigned G = gridDim.x * gridDim.y * gridDim.z;
    unsigned sum, cnt, mine, sp = 0u;
    for (;;) {
        sum = 0u; cnt = 0u; mine = 0u;
#pragma unroll
        for (unsigned j = 0; j < 16; ++j) { const unsigned c = xb_ld(&bar[XB_XCNT(j)]); sum += c; cnt += (c > 0u) ? 1u : 0u; mine = (j == x) ? c : mine; }
        if (sum == G) break;
        __builtin_amdgcn_s_sleep(1);
        if ((++sp & 255u) == 0u) { if (xb_ld(&bar[XB_TMO])) break; if (sp > XB_SPIN_CAP) { atomicAdd(&bar[XB_TMO], 1u); break; } }
    }
    nloc = mine > 0u ? mine : 1u; nx = cnt > 0u ? cnt : 1u;
}
__device__ __forceinline__ void xcd_barrier(const XcdBarrier& b) {
    asm volatile("s_waitcnt vmcnt(0)" ::: "memory");
    __syncthreads();
    if (threadIdx.x == 0) {
        unsigned* bar = b.bar;
        __builtin_amdgcn_s_waitcnt(0);
        unsigned nloc = b.st[0], nx = b.st[1];
        if (nloc == 0u) { xcd_barrier_complete(bar, b.x, nloc, nx); b.st[0] = nloc; b.st[1] = nx; }
        const unsigned old = xb_add(&bar[XB_XSUB(b.x)], 1u);
        const unsigned gen = old / nloc;
        if (old + 1u == (gen + 1u) * nloc) {
            __builtin_amdgcn_fence(__ATOMIC_RELEASE, "agent");
            asm volatile("s_waitcnt vmcnt(0)" ::: "memory");
            const unsigned og = xb_add(&bar[XB_TOP], 1u);
            const unsigned tg = og / nx;
            if (og + 1u == (tg + 1u) * nx) xb_add(&bar[XB_TOPGEN], 1u);
            else XB_SPIN(xb_ld(&bar[XB_TOPGEN]) == tg, bar);
            __builtin_amdgcn_fence(__ATOMIC_ACQUIRE, "agent");
            xb_add(&bar[XB_XGEN(b.x)], 1u);
            asm volatile("s_waitcnt vmcnt(0)" ::: "memory");
        } else {
            XB_SPIN(xb_ld(&bar[XB_XGEN(b.x)]) == gen, bar);
            __builtin_amdgcn_fence(__ATOMIC_ACQUIRE, "agent");
            asm volatile("s_waitcnt vmcnt(0)" ::: "memory");
        }
    }
    __syncthreads();
}

namespace pg8 {
constexpr int BM = 256, BK = 64, HALF = 128, HTB = HALF * BK * 2, STAGE_BYTES = 8 * HTB, NXCD = 8, WGM = 8;
__host__ __device__ __forceinline__ int lds_byte(int r, int c) { const int st = (r >> 4) * 2 + (c >> 5), rr = r & 15, cc = c & 31, ob = rr * 64 + cc * 2; return st * 1024 + (ob ^ (((ob >> 9) & 1) << 5)); }
__host__ __device__ __forceinline__ void stage_rc(int b, int& R, int& C) { const int st = b / 1024, sb = b % 1024, swz = sb ^ (((sb >> 9) & 1) << 5); R = (st >> 1) * 16 + swz / 64; C = (st & 1) * 32 + (swz % 64) / 2; }
__host__ __device__ __forceinline__ int perm32(int rho) { const int n = rho >> 4, i = rho & 15; return 8 * (i >> 2) + 4 * n + (i & 3); }
struct Unit { int pm, pn, aux, kx; };
struct Gemm { const bf16_t* A; const bf16_t* Bt; int K; };
struct StaticOrder {
    static constexpr bool KSPLIT = false;
    int nM, nN, nwg, G, c;
    __device__ void init(int M, int N, int G_, int c_) { nM = M / BM; nN = N / BM; nwg = nM * nN; G = G_; c = c_; }
    __device__ bool next(int i, Unit& u) const {
        const long L = (long)i * G + c; if (L >= nwg) return false;
        int wgid = (int)L; { const int q = nwg / NXCD, r = nwg % NXCD, xcd = wgid % NXCD, off = wgid / NXCD; wgid = (xcd < r ? xcd * (q + 1) : r * (q + 1) + (xcd - r) * q) + off; }
        const int nig = WGM * nN, gid = wgid / nig, fm = gid * WGM, gsz = (nM - fm) < WGM ? (nM - fm) : WGM;
        u.pm = fm + ((wgid % nig) % gsz); u.pn = (wgid % nig) / gsz; u.aux = u.pn; return true;
    }
};
struct MoeOrder {
    static constexpr bool KSPLIT = false;
    int pb[9], NT, G, c, nwg;
    __device__ __forceinline__ bool next(int i, Unit& u) const { return at((long)i * G + c, u); }
    __device__ __forceinline__ bool at(long L, Unit& u) const {
        if (L >= nwg) return false;
        int wgid = (int)L; { const int q = nwg / NXCD, r = nwg % NXCD, xcd = wgid % NXCD, off = wgid / NXCD; wgid = (xcd < r ? xcd * (q + 1) : r * (q + 1) + (xcd - r) * q) + off; }
        int e = 0;
#pragma unroll
        for (int k = 1; k < 8; ++k) e += (wgid >= pb[k] * NT) ? 1 : 0;
        int pbe = pb[0], pbn = pb[1];
#pragma unroll
        for (int k = 1; k < 8; ++k) { if (e == k) { pbe = pb[k]; pbn = pb[k + 1]; } }
        const int l = wgid - pbe * NT, Pe = pbn - pbe;
        const int nig = WGM * NT, gid = l / nig, fm = gid * WGM, gsz = (Pe - fm) < WGM ? (Pe - fm) : WGM;
        u.pm = pbe + fm + ((l % nig) % gsz); const int pn = (l % nig) / gsz; u.pn = e * NT + pn; u.aux = pn; return true;
    }
};

struct TableOrder {
    static constexpr bool KSPLIT = false;
    const LAS int* tab; int n;
    __device__ __forceinline__ bool next(int i, Unit& u) const {
        if (i >= n) return false;
        u.pm = __builtin_amdgcn_readfirstlane(tab[4 * i]); u.pn = __builtin_amdgcn_readfirstlane(tab[4 * i + 1]); u.aux = __builtin_amdgcn_readfirstlane(tab[4 * i + 2]); return true;
    }
};
struct TableOrderK {
    static constexpr bool KSPLIT = true;
    const LAS int* tab; int n;
    __device__ __forceinline__ bool next(int i, Unit& u) const {
        if (i >= n) return false;
        u.pm = __builtin_amdgcn_readfirstlane(tab[4 * i]); u.pn = __builtin_amdgcn_readfirstlane(tab[4 * i + 1]); u.aux = __builtin_amdgcn_readfirstlane(tab[4 * i + 2]); u.kx = __builtin_amdgcn_readfirstlane(tab[4 * i + 3]); return true;
    }
};
typedef int v8i32 __attribute__((ext_vector_type(8)));
template <class Epi, class Sched, bool ALIGN_EPI, bool SP2, int FMT = 0>
__device__ __forceinline__ void gemm_phase(LAS unsigned char* lds, const Gemm g, const Sched& S, const Epi& E) {
    const int tid = tid_opaque(), wid = __builtin_amdgcn_readfirstlane(tid >> 6), lane = tid & 63, wr = wid >> 2, wc = wid & 3, fr = lane & 15, fq = lane >> 4;
    constexpr bool F8 = (FMT != 0);
    const int K = g.K, RB = F8 ? K : 2 * K, nt = RB / 128;
    unsigned voffA, voffB;
    { int R, C; stage_rc(tid * 16, R, C); const int Rb = Epi::PERM ? ((R & ~31) + perm32(R & 31)) : R; voffA = (unsigned)(R * RB + C * 2); voffB = (unsigned)(Rb * RB + C * 2); }
    const size_t rstep = (size_t)64 * RB;
    const size_t kstep = (size_t)(BK * 2);
    const size_t hstep = (size_t)HALF * RB;
    const size_t tstep = 2 * hstep;
    const unsigned ldsw = (unsigned)wid * 1024u;
    const int aoff = lds_byte(wr * 64 + fr, fq * 8), boff = lds_byte(wc * 32 + fr, fq * 8);
#define PG8_SA(b, h) (((b) * 2 + (h)) * HTB)
#define PG8_SB(b, h) ((4 + (b) * 2 + (h)) * HTB)
#define PG8_STAGE(bufoff, gbase, voff) do { _Pragma("unroll") for (int _i = 0; _i < 2; ++_i) \
        __builtin_amdgcn_global_load_lds((const unsigned*)((const char*)(gbase) + _i * rstep + (voff)), (LAS unsigned*)(lds + (bufoff) + ldsw + _i * 8192), 16, 0, 0); } while (0)
#define PG8_LDA(dst, b, h) do { _Pragma("unroll") for (int m = 0; m < 4; ++m) _Pragma("unroll") for (int k = 0; k < 2; ++k) dst[m][k] = *(const LAS bf16x8*)(lds + PG8_SA(b, h) + aoff + m * 2048 + k * 1024); } while (0)
#define PG8_LDB(dst, b, h) do { _Pragma("unroll") for (int n = 0; n < 2; ++n) _Pragma("unroll") for (int k = 0; k < 2; ++k) dst[n][k] = *(const LAS bf16x8*)(lds + PG8_SB(b, h) + boff + n * 2048 + k * 1024); } while (0)
#define PG8_CAT(x) __builtin_shufflevector(__builtin_bit_cast(u32x4, x[0]), __builtin_bit_cast(u32x4, x[1]), 0, 1, 2, 3, 4, 5, 6, 7)
#define PG8_D6(x) __builtin_bit_cast(v6i32, __builtin_shufflevector(__builtin_bit_cast(u32x4, x[0]), __builtin_bit_cast(u32x4, x[1]), 0, 1, 2, 3, 4, 5))
#define PG8_S6(x) ((int)__builtin_bit_cast(u32x4, x[1])[2])
#define PG8_MMA(ai, bj, At, Bt) do { __builtin_amdgcn_s_setprio(1); if constexpr (FMT == 1) { _Pragma("unroll") for (int m = 0; m < 4; ++m) _Pragma("unroll") for (int n = 0; n < 2; ++n) \
        asm volatile("v_mfma_f32_16x16x128_f8f6f4 %0, %1, %2, %0" : "+v"(acc[ai][bj][m][n]) : "v"(__builtin_bit_cast(v8i32, PG8_CAT(Bt[n]))), "v"(__builtin_bit_cast(v8i32, PG8_CAT(At[m])))); } \
        else if constexpr (FMT == 2) { _Pragma("unroll") for (int m = 0; m < 4; ++m) _Pragma("unroll") for (int n = 0; n < 2; ++n) \
        acc[ai][bj][m][n] = __builtin_amdgcn_mfma_scale_f32_16x16x128_f8f6f4(__builtin_bit_cast(v8i32, PG8_CAT(Bt[n])), __builtin_bit_cast(v8i32, PG8_CAT(At[m])), acc[ai][bj][m][n], 2, 2, 0, PG8_S6(Bt[n]), 0, PG8_S6(At[m])); } \
        else { _Pragma("unroll") for (int m = 0; m < 4; ++m) _Pragma("unroll") for (int n = 0; n < 2; ++n) _Pragma("unroll") for (int k = 0; k < 2; ++k) \
        acc[ai][bj][m][n] = __builtin_amdgcn_mfma_f32_16x16x32_bf16(Bt[n][k], At[m][k], acc[ai][bj][m][n], 0, 0, 0); } __builtin_amdgcn_s_setprio(0); } while (0)
#define PG8_WAIT_V(n) asm volatile("s_waitcnt vmcnt(" #n ")" ::: "memory")
#define PG8_WAIT_L(n) asm volatile("s_waitcnt lgkmcnt(" #n ")" ::: "memory")
#define PG8_BAR __builtin_amdgcn_s_barrier()
#define PG8_SCHED __builtin_amdgcn_sched_barrier(0)
    Unit cur, nxt; int ui = 0;
    if (!S.next(0, cur)) return;
    constexpr bool KS = Sched::KSPLIT;
    auto k_off = [&](const Unit& u) -> size_t { if constexpr (KS) { if (u.kx) return (size_t)((u.kx >> 8) & 255) * (size_t)(nt / (u.kx >> 16)) * 128; } return 0; };
    auto k_cnt = [&](const Unit& u) -> int { if constexpr (KS) { if (u.kx) return nt / (u.kx >> 16); } return nt; };
    int ntc = k_cnt(cur);
    f32x4 acc[2][2][4][2];
#pragma unroll
    for (int a = 0; a < 2; ++a)
#pragma unroll
        for (int b = 0; b < 2; ++b)
#pragma unroll
            for (int m = 0; m < 4; ++m)
#pragma unroll
                for (int n = 0; n < 2; ++n) acc[a][b][m][n] = (f32x4){0.f, 0.f, 0.f, 0.f};
    bf16x8 At[4][2], B0[2][2], B1[2][2];
    const char* cA = (const char*)g.A + (size_t)cur.pm * tstep + k_off(cur); const char* cB = (const char*)g.Bt + (size_t)cur.pn * tstep + k_off(cur);
    if constexpr (SP2) {
        PG8_STAGE(PG8_SB(0, 0), cB, voffB); PG8_STAGE(PG8_SB(0, 1), cB + hstep, voffB); PG8_STAGE(PG8_SA(0, 0), cA, voffA); PG8_STAGE(PG8_SA(0, 1), cA + hstep, voffA);
        if (wr == 1) PG8_BAR;
        PG8_WAIT_V(2); PG8_BAR;
        PG8_STAGE(PG8_SB(1, 0), cB + kstep, voffB); PG8_STAGE(PG8_SA(1, 0), cA + kstep, voffA); PG8_STAGE(PG8_SB(1, 1), cB + hstep + kstep, voffB);
        PG8_WAIT_V(6); PG8_BAR;
    } else {
        PG8_STAGE(PG8_SB(0, 0), cB, voffB); PG8_STAGE(PG8_SA(0, 0), cA, voffA); PG8_STAGE(PG8_SB(0, 1), cB + hstep, voffB); PG8_STAGE(PG8_SA(0, 1), cA + hstep, voffA);
        if (wr == 1) PG8_BAR;
        PG8_WAIT_V(4); PG8_BAR;
        PG8_STAGE(PG8_SB(1, 0), cB + kstep, voffB); PG8_STAGE(PG8_SA(1, 0), cA + kstep, voffA); PG8_STAGE(PG8_SB(1, 1), cB + hstep + kstep, voffB);
        PG8_WAIT_V(6); PG8_BAR;
    }
    for (;;) {
        const bool has_next = S.next(ui + 1, nxt);
        const char* nA = has_next ? (const char*)g.A + (size_t)nxt.pm * tstep + k_off(nxt) : cA; const char* nB = has_next ? (const char*)g.Bt + (size_t)nxt.pn * tstep + k_off(nxt) : cB;
        for (int t = 0; t < ntc; t += 2) {
            if constexpr (Epi::MID_T >= 0) { if (t == Epi::MID_T) { const int l2 = tid_opaque() & 63; E.mid(acc, cur, wr, wc, l2 & 15, l2 >> 4); } }
            const bool last = (t == ntc - 2);
            const char* a1 = cA + (size_t)(t + 1) * kstep;
            const char* a2 = last ? nA : cA + (size_t)(t + 2) * kstep; const char* b2 = last ? nB : cB + (size_t)(t + 2) * kstep;
            const char* a3 = a2 + kstep; const char* b3 = b2 + kstep;
            if constexpr (SP2) {
            PG8_LDB(B0, 0, 0); PG8_LDB(B1, 0, 1); PG8_SCHED; PG8_LDA(At, 0, 0); PG8_STAGE(PG8_SA(1, 1), a1 + hstep, voffA);
            PG8_WAIT_V(8); PG8_WAIT_L(0); PG8_BAR; PG8_MMA(0, 0, At, B0); PG8_MMA(0, 1, At, B1); PG8_BAR; PG8_SCHED;
            PG8_LDA(At, 0, 1); PG8_STAGE(PG8_SB(0, 0), b2, voffB); PG8_STAGE(PG8_SB(0, 1), b2 + hstep, voffB); PG8_STAGE(PG8_SA(0, 0), a2, voffA);
            PG8_WAIT_V(8); PG8_WAIT_L(0); PG8_BAR; PG8_MMA(1, 0, At, B0); PG8_MMA(1, 1, At, B1); PG8_BAR; PG8_SCHED;
            PG8_LDB(B0, 1, 0); PG8_LDB(B1, 1, 1); PG8_SCHED; PG8_LDA(At, 1, 0); PG8_STAGE(PG8_SA(0, 1), a2 + hstep, voffA);
            PG8_WAIT_V(8); PG8_WAIT_L(0); PG8_BAR; PG8_MMA(0, 0, At, B0); PG8_MMA(0, 1, At, B1); PG8_BAR; PG8_SCHED;
            PG8_LDA(At, 1, 1); PG8_STAGE(PG8_SB(1, 0), b3, voffB); PG8_STAGE(PG8_SB(1, 1), b3 + hstep, voffB); PG8_STAGE(PG8_SA(1, 0), a3, voffA);
            PG8_WAIT_V(8); PG8_WAIT_L(0); PG8_BAR; PG8_MMA(1, 0, At, B0); PG8_MMA(1, 1, At, B1); PG8_BAR; PG8_SCHED;
            } else {
            PG8_LDB(B0, 0, 0); PG8_SCHED; PG8_LDA(At, 0, 0); PG8_STAGE(PG8_SA(1, 1), a1 + hstep, voffA);
            PG8_WAIT_L(8); PG8_BAR; PG8_WAIT_L(0); PG8_MMA(0, 0, At, B0); PG8_BAR; PG8_SCHED;
            PG8_LDB(B1, 0, 1); PG8_STAGE(PG8_SB(0, 0), b2, voffB);
            PG8_BAR; PG8_WAIT_L(0); PG8_MMA(0, 1, At, B1); PG8_BAR;
            PG8_LDA(At, 0, 1); PG8_STAGE(PG8_SA(0, 0), a2, voffA);
            PG8_BAR; PG8_WAIT_L(0); PG8_MMA(1, 0, At, B0); PG8_BAR; PG8_SCHED;
            PG8_STAGE(PG8_SB(0, 1), b2 + hstep, voffB);
            PG8_WAIT_V(6); PG8_BAR; PG8_MMA(1, 1, At, B1); PG8_BAR;
            PG8_LDB(B0, 1, 0); PG8_SCHED; PG8_LDA(At, 1, 0); PG8_STAGE(PG8_SA(0, 1), a2 + hstep, voffA);
            PG8_WAIT_L(8); PG8_BAR; PG8_WAIT_L(0); PG8_MMA(0, 0, At, B0); PG8_BAR; PG8_SCHED;
            PG8_LDB(B1, 1, 1); PG8_STAGE(PG8_SB(1, 0), b3, voffB);
            PG8_BAR; PG8_WAIT_L(0); PG8_MMA(0, 1, At, B1); PG8_BAR;
            PG8_LDA(At, 1, 1); PG8_STAGE(PG8_SA(1, 0), a3, voffA);
            PG8_BAR; PG8_WAIT_L(0); PG8_MMA(1, 0, At, B0); PG8_BAR; PG8_SCHED;
            PG8_STAGE(PG8_SB(1, 1), b3 + hstep, voffB);
            PG8_WAIT_V(6); PG8_BAR; PG8_MMA(1, 1, At, B1); PG8_BAR;
            }
        }
        if constexpr (ALIGN_EPI) { if (wr == 0) PG8_BAR; }
        if constexpr (F8) asm volatile("s_nop 15\n\ts_nop 15" ::: "memory");
        { const int l2 = tid_opaque() & 63; E(acc, cur, wr, wc, l2 & 15, l2 >> 4); }
        if (!has_next) break;
#pragma unroll
        for (int a = 0; a < 2; ++a)
#pragma unroll
            for (int b = 0; b < 2; ++b)
#pragma unroll
                for (int m = 0; m < 4; ++m)
#pragma unroll
                    for (int n = 0; n < 2; ++n) acc[a][b][m][n] = (f32x4){0.f, 0.f, 0.f, 0.f};
        cur = nxt; cA = nA; cB = nB; ++ui; ntc = k_cnt(cur);
        if constexpr (ALIGN_EPI) { if (wr == 1) PG8_BAR; }
    }
    PG8_WAIT_V(0);
    if constexpr (!ALIGN_EPI) { if (wr == 0) PG8_BAR; }
    PG8_BAR;
#undef PG8_SA
#undef PG8_SB
#undef PG8_STAGE
#undef PG8_LDA
#undef PG8_LDB
#undef PG8_MMA
#undef PG8_CAT
#undef PG8_D6
#undef PG8_S6
#undef PG8_WAIT_V
#undef PG8_WAIT_L
#undef PG8_BAR
#undef PG8_SCHED
}

__device__ __forceinline__ u32x4 pack8(const f32x4 a, const f32x4 b) { u32x4 w; w.x = cvt_pk_bf16(a[0], a[1]); w.y = cvt_pk_bf16(a[2], a[3]); w.z = cvt_pk_bf16(b[0], b[1]); w.w = cvt_pk_bf16(b[2], b[3]); return w; }
__device__ __forceinline__ u32x2 pack4(const f32x4 a) { u32x2 w; w.x = cvt_pk_bf16(a[0], a[1]); w.y = cvt_pk_bf16(a[2], a[3]); return w; }

constexpr int RM_BITS = 5;
template <int B = RM_BITS>
__device__ __forceinline__ f32x4 rmant(const f32x4 v) {
    f32x4 r;
#pragma unroll
    for (int i = 0; i < 4; ++i) r[i] = __uint_as_float((__float_as_uint(v[i]) + (1u << (22 - B))) & ~((1u << (23 - B)) - 1u));
    return r;
}

struct EpiInProj {
    static constexpr int MID_T = -1;
    static constexpr bool PERM = true;
    bf16_t *cq, *ckv, *kpe, *qs, *ks, *vs; float *partq, *partkv; const float *cosm, *sinm, *coss, *sins;
    __device__ __forceinline__ void operator()(const f32x4 (&acc)[2][2][4][2], const Unit& u, int wr, int wc, int fr, int fq) const {
        const int row0 = u.pm * BM + wr * 64 + fr;
#pragma unroll
        for (int bj = 0; bj < 2; ++bj) {
            const int tc0 = u.aux * BM + bj * HALF + wc * 32 + fq * 8;
            if (tc0 < 768) {
                bf16_t* base; float* part; int ld, col, ps;
                if (tc0 < 512) { base = cq; ld = 512; col = tc0; part = partq; ps = 16; } else { base = ckv; ld = 256; col = tc0 - 512; part = partkv; ps = 8; }
#pragma unroll
                for (int ai = 0; ai < 2; ++ai)
#pragma unroll
                    for (int m = 0; m < 4; ++m) { const int row = row0 + ai * HALF + m * 16; const f32x4 v0 = acc[ai][bj][m][0], v1 = acc[ai][bj][m][1];
                        *(u32x4*)(base + (size_t)row * ld + col) = pack8(v0, v1);
                        float ss = (v0[0] * v0[0] + v0[1] * v0[1]) + (v0[2] * v0[2] + v0[3] * v0[3]) + (v1[0] * v1[0] + v1[1] * v1[1]) + (v1[2] * v1[2] + v1[3] * v1[3]);
                        ss += __shfl_xor(ss, 16); ss += __shfl_xor(ss, 32);
                        if (fq == 0) part[(size_t)row * ps + (col >> 5)] = ss; }
            } else if (tc0 < 2112) {
                bf16_t* base; const float *ct, *st; int ld, col, half, tw, g;
                if (tc0 < 832) { g = (tc0 - 768) >> 3; base = kpe; ld = 64; col = 4 * g; half = 32; ct = cosm; st = sinm; tw = 32; }
                else if (tc0 < 1856) { const int j = tc0 - 832; g = (j & 127) >> 3; base = qs; ld = 1024; col = (j >> 7) * 128 + 4 * g; half = 64; ct = coss; st = sins; tw = 64; }
                else { const int j = tc0 - 1856; g = (j & 127) >> 3; base = ks; ld = 256; col = (j >> 7) * 128 + 4 * g; half = 64; ct = coss; st = sins; tw = 64; }
#pragma unroll
                for (int ai = 0; ai < 2; ++ai)
#pragma unroll
                    for (int m = 0; m < 4; ++m) { const int row = row0 + ai * HALF + m * 16; const f32x4 x1 = acc[ai][bj][m][0], x2 = acc[ai][bj][m][1];
                        const f32x4 c = *(const f32x4*)(ct + (size_t)row * tw + 4 * g), s = *(const f32x4*)(st + (size_t)row * tw + 4 * g);
                        const f32x4 o1 = x1 * c - x2 * s, o2 = x2 * c + x1 * s;
                        if (tc0 < 832) { unsigned char* kp = (unsigned char*)kpe + (size_t)row * 64 + col;
                            *(unsigned*)kp = pk_fp8x4(o1[0], o1[1], o1[2], o1[3]); *(unsigned*)(kp + 32) = pk_fp8x4(o2[0], o2[1], o2[2], o2[3]); }
                        else { *(u32x2*)(base + (size_t)row * ld + col) = pack4(o1); *(u32x2*)(base + (size_t)row * ld + col + half) = pack4(o2); } }
            } else if (tc0 < 2368) {
                const int col = tc0 - 2112;
#pragma unroll
                for (int ai = 0; ai < 2; ++ai)
#pragma unroll
                    for (int m = 0; m < 4; ++m) { const int row = row0 + ai * HALF + m * 16; *(u32x4*)(vs + (size_t)row * 256 + col) = pack8(acc[ai][bj][m][0], acc[ai][bj][m][1]); }
            }
        }
    }
};
struct EpiQ {
    static constexpr int MID_T = -1;
    static constexpr bool PERM = true;
    bf16_t* q; const float *partq, *cosm, *sinm;
    __device__ __forceinline__ void operator()(const f32x4 (&acc)[2][2][4][2], const Unit& u, int wr, int wc, int fr, int fq) const {
        const int row0 = u.pm * BM + wr * 64 + fr;
        float rs[2][4];
#pragma unroll
        for (int ai = 0; ai < 2; ++ai)
#pragma unroll
            for (int m = 0; m < 4; ++m) { const f32x4* p = (const f32x4*)(partq + (size_t)(row0 + ai * HALF + m * 16) * 16); const f32x4 s = (p[0] + p[1]) + (p[2] + p[3]);
                rs[ai][m] = 1.0f / sqrtf(((s[0] + s[1]) + (s[2] + s[3])) * (1.0f / 512.0f) + RMS_EPS); }
#pragma unroll
        for (int bj = 0; bj < 2; ++bj) {
            const int tc0 = u.aux * BM + bj * HALF + wc * 32 + fq * 8, head = tc0 / 192, j = tc0 - head * 192;
            if (j < 128) {
#pragma unroll
                for (int ai = 0; ai < 2; ++ai)
#pragma unroll
                    for (int m = 0; m < 4; ++m) { const int row = row0 + ai * HALF + m * 16; const f32x4 qa = acc[ai][bj][m][0] * rs[ai][m], qb = acc[ai][bj][m][1] * rs[ai][m];
                        if (j < 64) { u32x2 w; w.x = pk_fp8x4(qa[0], qa[1], qa[2], qa[3]); w.y = pk_fp8x4(qb[0], qb[1], qb[2], qb[3]);
                            *(u32x2*)((unsigned char*)(q + (size_t)row * QCOLS + head * 192 + 128) + 64 + j) = w; }
                        else *(u32x4*)(q + (size_t)row * QCOLS + tc0) = pack8(rmant(qa), rmant(qb)); }
            } else {
                const int g = (j - 128) >> 3, col = head * 192 + 128 + 4 * g;
#pragma unroll
                for (int ai = 0; ai < 2; ++ai)
#pragma unroll
                    for (int m = 0; m < 4; ++m) { const int row = row0 + ai * HALF + m * 16; const f32x4 x1 = acc[ai][bj][m][0] * rs[ai][m], x2 = acc[ai][bj][m][1] * rs[ai][m];
                        const f32x4 c = *(const f32x4*)(cosm + (size_t)row * 32 + 4 * g), s = *(const f32x4*)(sinm + (size_t)row * 32 + 4 * g);
                        const f32x4 r1 = x1 * c - x2 * s, r2 = x2 * c + x1 * s; unsigned char* q8 = (unsigned char*)(q + (size_t)row * QCOLS + head * 192 + 128) + 4 * g;
                        *(unsigned*)q8 = pk_fp8x4(r1[0], r1[1], r1[2], r1[3]); *(unsigned*)(q8 + 32) = pk_fp8x4(r2[0], r2[1], r2[2], r2[3]); }
            }
        }
    }
};
struct EpiKV {
    static constexpr int MID_T = -1;
    static constexpr bool PERM = true;
    bf16_t* kv; const float* partkv; unsigned char* vt; unsigned char* kn8;
    __device__ __forceinline__ void operator()(const f32x4 (&acc)[2][2][4][2], const Unit& u, int wr, int wc, int fr, int fq) const {
        const int row0 = u.pm * BM + wr * 64 + fr;
#pragma unroll
        for (int ai = 0; ai < 2; ++ai)
#pragma unroll
            for (int m = 0; m < 4; ++m) { const int row = row0 + ai * HALF + m * 16; const f32x4* p = (const f32x4*)(partkv + (size_t)row * 8); const f32x4 s = p[0] + p[1];
                const float rs = 1.0f / sqrtf(((s[0] + s[1]) + (s[2] + s[3])) * (1.0f / 256.0f) + RMS_EPS);
                { const f32x4 ka = acc[ai][0][m][0] * rs, kb_ = acc[ai][0][m][1] * rs; const int c = wc * 32 + fq * 8;
                  if (wc < 2) { u32x2 w; w.x = pk_fp8x4(ka[0], ka[1], ka[2], ka[3]); w.y = pk_fp8x4(kb_[0], kb_[1], kb_[2], kb_[3]); *(u32x2*)(kn8 + (size_t)row * 512 + u.aux * 64 + c) = w; }
                  else *(u32x4*)(kv + (size_t)row * KVCOLS + u.aux * BM + c) = pack8(rmant(ka), rmant(kb_)); }
                { const f32x4 v0 = acc[ai][1][m][0] * rs, v1 = acc[ai][1][m][1] * rs; const unsigned w0 = pk_fp8x4(v0[0], v0[1], v0[2], v0[3]), w1 = pk_fp8x4(v1[0], v1[1], v1[2], v1[3]);
                  unsigned char* o = vt + ((size_t)(u.aux * 128 + wc * 32 + fq * 8)) * S + row;
#pragma unroll
                  for (int i = 0; i < 4; ++i) { o[(size_t)i * S] = (unsigned char)(w0 >> (8 * i)); o[(size_t)(4 + i) * S] = (unsigned char)(w1 >> (8 * i)); } } }
    }
};
struct EpiResid {
    static constexpr int MID_T = -1;
    static constexpr bool PERM = true;
    const float* xin; float* y; float sc;
    __device__ __forceinline__ void operator()(const f32x4 (&acc)[2][2][4][2], const Unit& u, int wr, int wc, int fr, int fq) const {
        const int row0 = u.pm * BM + wr * 64 + fr;
#pragma unroll
        for (int ai = 0; ai < 2; ++ai)
#pragma unroll
            for (int m = 0; m < 4; ++m) { const size_t ro = (size_t)(row0 + ai * HALF + m * 16) * D;
#pragma unroll
                for (int bj = 0; bj < 2; ++bj) { const size_t o = ro + u.aux * BM + bj * HALF + wc * 32 + fq * 8;
                    const f32x4 a0 = *(const f32x4*)(xin + o), a1 = *(const f32x4*)(xin + o + 4);
                    *(f32x4*)(y + o) = a0 * ALPHA + acc[ai][bj][m][0] * sc; *(f32x4*)(y + o + 4) = a1 * ALPHA + acc[ai][bj][m][1] * sc; }
                asm volatile("" ::: "memory"); }
    }
};
struct EpiResidLN {
    static constexpr int MID_T = -1;
    static constexpr bool PERM = true, PROBE2 = false;
    const float* yin; float* y; float sc; const float* st; const float* g; const float* b;
    __device__ __forceinline__ void operator()(const f32x4 (&acc)[2][2][4][2], const Unit& u, int wr, int wc, int fr, int fq) const {
        const int row0 = u.pm * BM + wr * 64 + fr, col0 = u.aux * BM + wc * 32 + fq * 8;
        f32x4 gg[2][2], bb[2][2];
#pragma unroll
        for (int bj = 0; bj < 2; ++bj)
#pragma unroll
            for (int n = 0; n < 2; ++n) { gg[bj][n] = *(const f32x4*)(g + col0 + bj * HALF + 4 * n); bb[bj][n] = *(const f32x4*)(b + col0 + bj * HALF + 4 * n); }
#pragma unroll
        for (int ai = 0; ai < 2; ++ai)
#pragma unroll
            for (int m = 0; m < 4; ++m) { const int row = row0 + ai * HALF + m * 16; const size_t ro = (size_t)row * D; const float mu = st[2 * row], rs = st[2 * row + 1];
#pragma unroll
                for (int bj = 0; bj < 2; ++bj) { const size_t o = ro + col0 + bj * HALF;
                    const f32x4 a0 = *(const f32x4*)(yin + o), a1 = *(const f32x4*)(yin + o + 4);
                    const f32x4 x0 = (a0 - mu) * rs * gg[bj][0] + bb[bj][0], x1 = (a1 - mu) * rs * gg[bj][1] + bb[bj][1];
                    *(f32x4*)(y + o) = x0 * ALPHA + acc[ai][bj][m][0] * sc; *(f32x4*)(y + o + 4) = x1 * ALPHA + acc[ai][bj][m][1] * sc; }
                asm volatile("" ::: "memory"); }
    }
};
template <bool LNIN> struct EpiOutProj {
    static constexpr bool PERM = true, PROBE2 = false; static constexpr int MID_T = 16;
    const float* xin; float* y; const float* parto; const float* st; const float* g; const float* b;
    __device__ __forceinline__ void sums(int row, float& a, float& c) const { const f32x4* p = (const f32x4*)(parto + (size_t)row * 16); const f32x4 u = p[0] + p[1], v = p[2] + p[3];
        a = ((u[0] + u[1]) + (u[2] + u[3])) * (1.0f / 1024.0f) + RMS_EPS; c = ((v[0] + v[1]) + (v[2] + v[3])) * (1.0f / 1024.0f) + RMS_EPS; }
    __device__ __forceinline__ void mid(f32x4 (&acc)[2][2][4][2], const Unit& u, int wr, int wc, int fr, int fq) const {
        const int row0 = u.pm * BM + wr * 64 + fr;
#pragma unroll
        for (int ai = 0; ai < 2; ++ai)
#pragma unroll
            for (int m = 0; m < 4; ++m) { float a, c; sums(row0 + ai * HALF + m * 16, a, c); const float r = sqrtf(c / a);
#pragma unroll
                for (int bj = 0; bj < 2; ++bj) { acc[ai][bj][m][0] *= r; acc[ai][bj][m][1] *= r; } }
    }
    __device__ __forceinline__ void operator()(const f32x4 (&acc)[2][2][4][2], const Unit& u, int wr, int wc, int fr, int fq) const {
        const int row0 = u.pm * BM + wr * 64 + fr, col0 = u.aux * BM + wc * 32 + fq * 8;
        f32x4 gg[2][2], bb[2][2];
        if (LNIN) {
#pragma unroll
            for (int bj = 0; bj < 2; ++bj)
#pragma unroll
                for (int n = 0; n < 2; ++n) { gg[bj][n] = *(const f32x4*)(g + col0 + bj * HALF + 4 * n); bb[bj][n] = *(const f32x4*)(b + col0 + bj * HALF + 4 * n); }
        }
#pragma unroll
        for (int ai = 0; ai < 2; ++ai)
#pragma unroll
            for (int m = 0; m < 4; ++m) { const int row = row0 + ai * HALF + m * 16; const size_t ro = (size_t)row * D; float a, c; sums(row, a, c); const float rsw = 1.0f / sqrtf(c);
                float mu = 0.f, rs = 1.f; if (LNIN) { mu = st[2 * row]; rs = st[2 * row + 1]; }
#pragma unroll
                for (int bj = 0; bj < 2; ++bj) { const size_t o = ro + col0 + bj * HALF;
                    f32x4 x0 = *(const f32x4*)(xin + o), x1 = *(const f32x4*)(xin + o + 4);
                    if (LNIN) { x0 = (x0 - mu) * rs * gg[bj][0] + bb[bj][0]; x1 = (x1 - mu) * rs * gg[bj][1] + bb[bj][1]; }
                    *(f32x4*)(y + o) = x0 * ALPHA + acc[ai][bj][m][0] * rsw; *(f32x4*)(y + o + 4) = x1 * ALPHA + acc[ai][bj][m][1] * rsw; }
                asm volatile("" ::: "memory"); }
    }
};
struct EpiSwiglu8 {
    static constexpr int MID_T = -1;
    static constexpr bool PERM = true;
    unsigned char* h; int ldh; float sc;
    __device__ __forceinline__ void operator()(const f32x4 (&acc)[2][2][4][2], const Unit& u, int wr, int wc, int fr, int fq) const {
        const int row0 = u.pm * BM + wr * 64 + fr, col = u.aux * HALF + wc * 32 + fq * 8;
#pragma unroll
        for (int ai = 0; ai < 2; ++ai)
#pragma unroll
            for (int m = 0; m < 4; ++m) { f32x4 r0, r1;
#pragma unroll
                for (int k = 0; k < 4; ++k) { const float g0 = acc[ai][0][m][0][k] * sc, g1 = acc[ai][0][m][1][k] * sc;
                    r0[k] = __builtin_amdgcn_fmed3f(g0 * __builtin_amdgcn_rcpf(1.0f + __builtin_amdgcn_exp2f(-1.4426950408889634f * g0)) * (acc[ai][1][m][0][k] * (sc * H8_SCALE)), -448.f, 448.f);
                    r1[k] = __builtin_amdgcn_fmed3f(g1 * __builtin_amdgcn_rcpf(1.0f + __builtin_amdgcn_exp2f(-1.4426950408889634f * g1)) * (acc[ai][1][m][1][k] * (sc * H8_SCALE)), -448.f, 448.f); }
                u32x2 w; w.x = pk_fp8x4(r0[0], r0[1], r0[2], r0[3]); w.y = pk_fp8x4(r1[0], r1[1], r1[2], r1[3]);
                *(u32x2*)(h + (size_t)(row0 + ai * HALF + m * 16) * ldh + col) = w; }
    }
};
struct EpiSwiglu6 {
    static constexpr bool PERM = true, PROBE2 = false; static constexpr int MID_T = -1;
    unsigned char* h; int ldh;
    __device__ __forceinline__ void operator()(const f32x4 (&acc)[2][2][4][2], const Unit& u, int wr, int wc, int fr, int fq) const {
#pragma unroll
        for (int ai = 0; ai < 2; ++ai) {
            float v[4][8];
#pragma unroll
            for (int m = 0; m < 4; ++m)
#pragma unroll
                for (int c = 0; c < 8; ++c) { const float g = acc[ai][0][m][c >> 2][c & 3], uu = acc[ai][1][m][c >> 2][c & 3];
                    v[m][c] = g * __builtin_amdgcn_rcpf(1.0f + __builtin_amdgcn_exp2f(-1.4426950408889634f * g)) * uu; }
            float s1[2][2][8];
#pragma unroll
            for (int mm = 0; mm < 2; ++mm)
#pragma unroll
                for (int c = 0; c < 8; ++c) { auto r = __builtin_amdgcn_permlane32_swap(__float_as_uint(v[mm][c]), __float_as_uint(v[mm + 2][c]), false, false);
                    s1[mm][0][c] = __uint_as_float(r[0]); s1[mm][1][c] = __uint_as_float(r[1]); }
            f32x16 lo, hi;
#pragma unroll
            for (int hh = 0; hh < 2; ++hh)
#pragma unroll
                for (int c = 0; c < 8; ++c) { auto r = __builtin_amdgcn_permlane16_swap(__float_as_uint(s1[0][hh][c]), __float_as_uint(s1[1][hh][c]), false, false);
                    if (hh == 0) { lo[c] = __uint_as_float(r[0]); lo[8 + c] = __uint_as_float(r[1]); } else { hi[c] = __uint_as_float(r[0]); hi[8 + c] = __uint_as_float(r[1]); } }
            unsigned sb; const u32x6 q = mx6_block(lo, hi, sb);
            unsigned char* o = h + (size_t)(u.pm * BM + ai * HALF + wr * 64 + fq * 16 + fr) * ldh + u.aux * 128 + 16 * wc;
            *(u32x4*)o = (u32x4){q[0], q[1], q[2], q[3]}; *(u32x4*)(o + 64) = (u32x4){q[4], q[5], sb, 0u};
        }
    }
};
struct EpiBf16Out {
    static constexpr int MID_T = -1;
    static constexpr bool PERM = true;
    bf16_t* o; int ld; float sc;
    __device__ __forceinline__ void operator()(const f32x4 (&acc)[2][2][4][2], const Unit& u, int wr, int wc, int fr, int fq) const {
        const int row0 = u.pm * BM + wr * 64 + fr;
#pragma unroll
        for (int ai = 0; ai < 2; ++ai)
#pragma unroll
            for (int m = 0; m < 4; ++m)
#pragma unroll
                for (int bj = 0; bj < 2; ++bj) *(u32x4*)(o + (size_t)(row0 + ai * HALF + m * 16) * ld + u.aux * BM + bj * HALF + wc * 32 + fq * 8) = pack8(acc[ai][bj][m][0] * sc, acc[ai][bj][m][1] * sc);
    }
};
struct EpiBf16OutK {
    static constexpr int MID_T = -1;
    static constexpr bool PERM = true;
    bf16_t* o; bf16_t* yp;
    __device__ __forceinline__ void operator()(const f32x4 (&acc)[2][2][4][2], const Unit& u, int wr, int wc, int fr, int fq) const {
        bf16_t* base; int ld;
        if (u.kx) { base = yp + ((size_t)(((u.kx >> 8) & 255) * 128 + (u.kx & 255) - 1) * 256 + wr * 64 + fr) * 256; ld = 256; }
        else { base = o + (size_t)(u.pm * BM + wr * 64 + fr) * D + u.aux * BM; ld = D; }
#pragma unroll
        for (int ai = 0; ai < 2; ++ai)
#pragma unroll
            for (int m = 0; m < 4; ++m)
#pragma unroll
                for (int bj = 0; bj < 2; ++bj) *(u32x4*)(base + (size_t)(ai * HALF + m * 16) * ld + bj * HALF + wc * 32 + fq * 8) = pack8(acc[ai][bj][m][0], acc[ai][bj][m][1]);
    }
};
}

namespace att {
constexpr int NW = 8, QBLK = 32, KVBLK = 64;
constexpr float THR = 8.f;
constexpr int PPITCH = 80;
constexpr int VPITCH = 80;
constexpr float THR8 = 3.f;
constexpr float PK8 = 4.f;
constexpr int SHM_V = KVBLK * 128 * 2, SHM_K = KVBLK * 272, SHM_P = KVBLK * PPITCH;
constexpr int OFF_V = 0, OFF_K = 3 * SHM_V, OFF_P = OFF_K + 2 * SHM_K,     OFF_WS = OFF_P + 2 * SHM_P, OFF_QP = OFF_WS + NW * 64 * 4, SHM_ATTN = OFF_QP + NW * 4096;
typedef LAS const char* lptr;
typedef short v4i16_t __attribute__((ext_vector_type(4)));
#define SBAR() __builtin_amdgcn_sched_barrier(0)
#define PIN(x) asm volatile("" : "+v"(x))
__device__ __forceinline__ int crow(int r, int hi) { return (r & 3) + 8 * (r >> 2) + 4 * hi; }
__device__ __forceinline__ bf16x8 ldk(lptr p) { return *(const LAS bf16x8*)p; }
__device__ __forceinline__ s16x4 vtr(lptr p) { return __builtin_bit_cast(s16x4, __builtin_amdgcn_ds_read_tr16_b64_v4i16((LAS v4i16_t*)p)); }
__device__ __forceinline__ int v_st(int k, int c) { const int kk = (k & ~0xC) | ((k & 4) << 1) | ((k & 8) >> 1); return ((kk >> 3) * 4 + (c >> 5)) * 512 + ((kk & 7) * 32 + (c & 31)) * 2; }
__device__ __forceinline__ int v_rd_base(int lane) { return ((lane & 3) << 3) | (((lane >> 2) & 3) << 6) | (((lane >> 4) & 1) << 5) | (((lane >> 5) & 1) << 8); }
__device__ __forceinline__ bf16x8 pk4(float a0, float a1, float a2, float a3, float a4, float a5, float a6, float a7) {
  const unsigned x0 = cvt_pk_bf16(a0, a1), x1 = cvt_pk_bf16(a2, a3), y0 = cvt_pk_bf16(a4, a5), y1 = cvt_pk_bf16(a6, a7);
  auto r0 = __builtin_amdgcn_permlane32_swap(x0, y0, false, false); auto r1 = __builtin_amdgcn_permlane32_swap(x1, y1, false, false);
  u32x4 w = {r0[0], r1[0], r0[1], r1[1]}; return __builtin_bit_cast(bf16x8, w);
}
constexpr int PD = 3;
constexpr int KP8 = 144;
template <bool R8> __device__ __forceinline__ bf16x8 kfrag(lptr kb, int n) { const int d0 = n >> 1, h = n & 1; return R8 ? ldk(kb + h * (32 * KP8) + d0 * 32) : ldk(kb + h * (32 * 272) + d0 * 32); }
typedef int v8i32_t __attribute__((ext_vector_type(8)));
__device__ __forceinline__ v8i32_t cat8(const bf16x8 a, const bf16x8 b) { return __builtin_bit_cast(v8i32_t, __builtin_shufflevector(__builtin_bit_cast(u32x4, a), __builtin_bit_cast(u32x4, b), 0, 1, 2, 3, 4, 5, 6, 7)); }
template <int NQ, bool DO_QK, bool DO_FIN>
__device__ __forceinline__ void phaseA(f32x16& C0, f32x16& C1, const f32x16& P0, const f32x16& P1, float alphaP, float& l_reg, bf16x8 (&pa)[4],
                                       lptr kb, lptr nb, lptr pb, const bf16x8 (&rqn)[2], const bf16x8 (&rq)[2], const bf16x8 (&qr)[8]) {
  constexpr bool R8 = NQ > 8;
  constexpr int NN = R8 ? 8 : 16, NF = NN + (R8 ? 4 : 0);
  float s0 = 0.f, s1 = 0.f, s2 = 0.f, s3 = 0.f;
  bf16x8 f[NN + PD]; bf16x8 ra[4][2]; u32x4 pw[2] = {};
  if (DO_QK) {
#pragma unroll
    for (int n = 0; n < PD; ++n) f[n] = kfrag<R8>(kb, n);
  }
#pragma unroll
  for (int n = 0; n < NF; ++n) {
    if (DO_QK) {
      if (n < NN) {
        if (n + PD < NN) f[n + PD] = kfrag<R8>(kb, n + PD);
        if (R8) { if (n == 2) { ra[0][0] = ldk(nb); ra[0][1] = ldk(nb + 16); } if (n == 4) { ra[1][0] = ldk(nb + 32 * PPITCH); ra[1][1] = ldk(nb + 32 * PPITCH + 16); }
                  if (n == 6) { ra[2][0] = ldk(pb); ra[2][1] = ldk(pb + 16); } if (n == 7) { ra[3][0] = ldk(pb + 32 * PPITCH); ra[3][1] = ldk(pb + 32 * PPITCH + 16); } }
        const bf16x8 qf = qr[(R8 ? 4 : 0) + (n >> 1)];
        if (n == 0)            C0 = __builtin_amdgcn_mfma_f32_32x32x16_bf16(f[n], qf, f32x16{}, 0, 0, 0);
        else if (n == 1)       C1 = __builtin_amdgcn_mfma_f32_32x32x16_bf16(f[n], qf, f32x16{}, 0, 0, 0);
        else if ((n & 1) == 0) C0 = __builtin_amdgcn_mfma_f32_32x32x16_bf16(f[n], qf, C0, 0, 0, 0);
        else                   C1 = __builtin_amdgcn_mfma_f32_32x32x16_bf16(f[n], qf, C1, 0, 0, 0);
      } else if (R8) {
        const int h = n - NN;
        if (h == 0)      C0 = __builtin_amdgcn_mfma_scale_f32_32x32x64_f8f6f4(cat8(ra[0][0], ra[0][1]), cat8(rqn[0], rqn[1]), C0, 0, 0, 0, 0x7F7F7F7F, 0, 0x7F7F7F7F);
        else if (h == 1) C1 = __builtin_amdgcn_mfma_scale_f32_32x32x64_f8f6f4(cat8(ra[1][0], ra[1][1]), cat8(rqn[0], rqn[1]), C1, 0, 0, 0, 0x7F7F7F7F, 0, 0x7F7F7F7F);
        else if (h == 2) C0 = __builtin_amdgcn_mfma_scale_f32_32x32x64_f8f6f4(cat8(ra[2][0], ra[2][1]), cat8(rq[0], rq[1]), C0, 0, 0, 0, 0x7F7F7F7F, 0, 0x7F7F7F7F);
        else             C1 = __builtin_amdgcn_mfma_scale_f32_32x32x64_f8f6f4(cat8(ra[3][0], ra[3][1]), cat8(rq[0], rq[1]), C1, 0, 0, 0, 0x7F7F7F7F, 0, 0x7F7F7F7F);
      }
    }
    if (DO_FIN) {
#pragma unroll
      for (int e = n * 32 / NF; e < (n + 1) * 32 / NF; ++e) { const float v = e < 16 ? P0[e & 15] : P1[e & 15]; if ((e & 3) == 0) s0 += v; else if ((e & 3) == 1) s1 += v; else if ((e & 3) == 2) s2 += v; else s3 += v; }
      PIN(s0); PIN(s1); PIN(s2); PIN(s3);
      if (R8) {
        if (n == NF / 8 || n == 3 * NF / 8 || n == 5 * NF / 8 || n == 7 * NF / 8) {
          const int m = (n == NF / 8) ? 0 : (n == 3 * NF / 8) ? 1 : (n == 5 * NF / 8) ? 2 : 3;
          const unsigned X = pk_fp8x4(P0[4 * m], P0[4 * m + 1], P0[4 * m + 2], P0[4 * m + 3]), Y = pk_fp8x4(P1[4 * m], P1[4 * m + 1], P1[4 * m + 2], P1[4 * m + 3]);
          auto r = __builtin_amdgcn_permlane32_swap(X, Y, false, false);
          pw[m >> 1][2 * (m & 1)] = r[0]; pw[m >> 1][2 * (m & 1) + 1] = r[1]; PIN(pw[m >> 1]);
          if (m == 1) pa[0] = __builtin_bit_cast(bf16x8, pw[0]);
          if (m == 3) pa[1] = __builtin_bit_cast(bf16x8, pw[1]);
        }
      } else {
      if (n == NF / 8)     { pa[0] = pk4(P0[0], P0[1], P0[2], P0[3], P0[4], P0[5], P0[6], P0[7]); PIN(pa[0]); }
      if (n == 3 * NF / 8) { pa[1] = pk4(P0[8], P0[9], P0[10], P0[11], P0[12], P0[13], P0[14], P0[15]); PIN(pa[1]); }
      if (n == 5 * NF / 8) { pa[2] = pk4(P1[0], P1[1], P1[2], P1[3], P1[4], P1[5], P1[6], P1[7]); PIN(pa[2]); }
      if (n == 7 * NF / 8) { pa[3] = pk4(P1[8], P1[9], P1[10], P1[11], P1[12], P1[13], P1[14], P1[15]); PIN(pa[3]); }
      }
    }
    SBAR();
  }
  if (DO_FIN) { float ps = (s0 + s1) + (s2 + s3); auto rr = __builtin_amdgcn_permlane32_swap(__float_as_uint(ps), __float_as_uint(ps), false, false);
    ps = __uint_as_float(rr[0]) + __uint_as_float(rr[1]); l_reg = l_reg * alphaP + ps; }
}
template <bool R8, bool MASK, bool DO_PV, bool DO_SM>
__device__ __forceinline__ void phaseB(f32x16 (&o)[4], const bf16x8 (&pa)[4], f32x16& C0, f32x16& C1, float& m_reg, float& alpha, lptr vb, float Cs, float thr_raw, int qi, int k0, int hi) {
  s16x4 vl[16 + PD], vh[16 + PD]; bf16x8 fa[4][2];
  if (DO_PV && !R8) {
#pragma unroll
    for (int n = 0; n < PD; ++n) { const int d0 = n & 3, ks = n >> 2; vl[n] = vtr(vb + d0 * 512 + ks * 4096); vh[n] = vtr(vb + d0 * 512 + ks * 4096 + 2048); }
  }
  if (DO_PV && R8) { fa[0][0] = ldk(vb); fa[0][1] = ldk(vb + 16); }
  float mx = -3.0e38f, mnC = 0.f;
#pragma unroll
  for (int n = 0; n < 16; ++n) {
    if (DO_PV && R8) {
      if ((n & 3) == 1 && n < 12) { const int db = (n >> 2) + 1; fa[db][0] = ldk(vb + db * 32 * VPITCH); fa[db][1] = ldk(vb + db * 32 * VPITCH + 16); }
      if ((n & 3) == 0) { const int db = n >> 2; o[db] = __builtin_amdgcn_mfma_scale_f32_32x32x64_f8f6f4(cat8(fa[db][0], fa[db][1]), cat8(pa[0], pa[1]), o[db], 0, 0, 0, 0x7F7F7F7F, 0, 0x7F7F7F7F); }
    }
    if (DO_PV && !R8) {
      const int d0 = n & 3, ks = n >> 2;
      if (n + PD < 16) { const int d1 = (n + PD) & 3, k1 = (n + PD) >> 2; vl[n + PD] = vtr(vb + d1 * 512 + k1 * 4096); vh[n + PD] = vtr(vb + d1 * 512 + k1 * 4096 + 2048); }
      const bf16x8 vf = (bf16x8){vl[n][0], vl[n][1], vl[n][2], vl[n][3], vh[n][0], vh[n][1], vh[n][2], vh[n][3]};
      o[d0] = __builtin_amdgcn_mfma_f32_32x32x16_bf16(pa[ks], vf, o[d0], 0, 0, 0);
    }
    if (DO_SM) {
      if (n < 4) {
#pragma unroll
        for (int e = n * 8; e < n * 8 + 8; ++e) {
          if (MASK) { const int d = qi - (k0 + (e < 16 ? 0 : 32) + crow(e & 15, hi)); if (d > 128 || d < -128) { if (e < 16) C0[e & 15] = -1e30f; else C1[e & 15] = -1e30f; } }
          mx = fmaxf(mx, e < 16 ? C0[e & 15] : C1[e & 15]); }
        PIN(mx);
      } else if (n == 4) {
        auto rr = __builtin_amdgcn_permlane32_swap(__float_as_uint(mx), __float_as_uint(mx), false, false);
        const float pmax = fmaxf(__uint_as_float(rr[0]), __uint_as_float(rr[1]));
        const bool keep = __all(pmax - m_reg <= thr_raw);
        const float mn = keep ? m_reg : fmaxf(m_reg, pmax);
        alpha = __builtin_amdgcn_exp2f((m_reg - mn) * Cs); m_reg = mn; mnC = -mn * Cs + (R8 ? PK8 : 0.f); PIN(alpha); PIN(mnC);
      } else {
#pragma unroll
        for (int e = (n - 5) * 32 / 11; e < (n - 4) * 32 / 11; ++e) {
          if (e < 16) C0[e] = __builtin_amdgcn_exp2f(fmaf(C0[e], Cs, mnC)); else C1[e - 16] = __builtin_amdgcn_exp2f(fmaf(C1[e - 16], Cs, mnC)); }
        if ((n - 5) * 32 / 11 < 16) PIN(C0); if ((n - 4) * 32 / 11 > 16) PIN(C1);
      }
    }
    SBAR();
  }
}

template <int DQK, bool MASK, int LDQ, int LDK, int LDP, int LDV, int LDO>
__device__ __forceinline__ void attn_body(const bf16_t* __restrict__ Qb, const bf16_t* __restrict__ Kb, const unsigned char* __restrict__ Kn8, const bf16_t* __restrict__ Pb, const bf16_t* __restrict__ Vb,
                                          bf16_t* __restrict__ Ob, float* __restrict__ ssq, int q0, int kstart, int NT, float scale, float sink_raw, LAS char* lds) {
  constexpr int NQ = DQK / 16;
  constexpr bool R8 = NQ > 8;
  const float Cs = scale * 1.4426950408889634f, thr_raw = (R8 ? THR8 : THR) / scale;
  const int tid = tid_opaque(), wid = tid >> 6, lane = tid & 63, r32 = lane & 31, hi = lane >> 5;
  LAS char* V_lds = lds + OFF_V; LAS char* K_lds = lds + OFF_K; LAS char* P_lds = lds + OFF_P;
  LAS float* ws = (LAS float*)(lds + OFF_WS) + wid * 64; LAS float* li_l = ws; LAS float* al_l = ws + 32;
  float m_reg = MASK ? sink_raw : -1e30f, l_reg = MASK ? 1.f : 0.f; f32x16 o[4] = {}; bf16x8 qr[8];
  const bf16_t* Qw = Qb + (long)(wid * QBLK + r32) * LDQ + hi * 8;
  LAS char* Qp = lds + OFF_QP + wid * 4096 + lane * 16;
#pragma unroll
  for (int d0 = (NQ > 8 ? 4 : 0); d0 < 8; ++d0) qr[d0] = *reinterpret_cast<const bf16x8*>(Qw + d0 * 16);
  bf16x8 rq[2] = {}, rqn[2] = {};
  if (NQ > 8) {
    const unsigned char* q8 = (const unsigned char*)(Qb + (long)(wid * QBLK + r32) * LDQ + 128) + hi * 32;
    rq[0] = *reinterpret_cast<const bf16x8*>(q8); rq[1] = *reinterpret_cast<const bf16x8*>(q8 + 16);
    rqn[0] = *reinterpret_cast<const bf16x8*>(q8 + 64); rqn[1] = *reinterpret_cast<const bf16x8*>(q8 + 80);
  }
  const int sr = tid >> 4, sc = (tid & 15) * 8, vst0 = v_st(sr, sc), vst1 = v_st(32 + sr, sc);
  const int pr = tid >> 3, pc = (tid & 7) * 8;
  LAS char* N_lds = lds + OFF_QP;
  const lptr kb0 = R8 ? (lptr)K_lds + r32 * KP8 + hi * 16 : (lptr)K_lds + r32 * 272 + hi * 16, nb0 = (lptr)N_lds + r32 * PPITCH + hi * 32, pb0 = (lptr)P_lds + r32 * PPITCH + hi * 32, vb0 = R8 ? (lptr)V_lds + r32 * VPITCH + hi * 32 : (lptr)V_lds + v_rd_base(lane);
  const int qi = q0 + wid * QBLK + r32;
  bf16x8 vs0, vs1, ks0, ks1; u32x2 ps0, kn0;
  const unsigned voff0 = sr * LDV + sc, voff1 = (32 + sr) * LDV + sc, koff0 = sr * LDK + sc, koff1 = (32 + sr) * LDK + sc, poff = pr * LDP + pc, voff8 = (unsigned)(tid >> 2) * LDV + (tid & 3) * 16, koff8 = pr * LDK + 64 + pc;
#define SLOAD(k0) do { const bf16_t* Kt = Kb + (long)(k0) * LDK; \
    if (R8) { vs0 = *reinterpret_cast<const bf16x8*>((const unsigned char*)Vb + (long)(k0) + voff8); } \
    else { const bf16_t* Vt = Vb + (long)(k0) * LDV; vs0 = *reinterpret_cast<const bf16x8*>(Vt + voff0); vs1 = *reinterpret_cast<const bf16x8*>(Vt + voff1); } \
    if (R8) { ks0 = *reinterpret_cast<const bf16x8*>(Kt + koff8); kn0 = *reinterpret_cast<const u32x2*>(Kn8 + (long)((k0) + pr) * 512 + pc); } \
    else { ks0 = *reinterpret_cast<const bf16x8*>(Kt + koff0); ks1 = *reinterpret_cast<const bf16x8*>(Kt + koff1); } \
    if (NQ > 8) { const unsigned char* Pt = (const unsigned char*)Pb + (long)(k0) * LDP; ps0 = *reinterpret_cast<const u32x2*>(Pt + poff); } } while (0)
#define SWRITE(kb_, vo_) do { if (R8) { *(LAS bf16x8*)(V_lds + (vo_) + (tid >> 2) * VPITCH + (tid & 3) * 16) = vs0; } else { *(LAS bf16x8*)(V_lds + (vo_) + vst0) = vs0; *(LAS bf16x8*)(V_lds + (vo_) + vst1) = vs1; } \
    if (R8) { *(LAS bf16x8*)(K_lds + (kb_) * SHM_K + pr * KP8 + pc * 2) = ks0; *(LAS u32x2*)(N_lds + (kb_) * SHM_P + pr * PPITCH + pc) = kn0; } \
    else { *(LAS bf16x8*)(K_lds + (kb_) * SHM_K + sr * 272 + sc * 2) = ks0; *(LAS bf16x8*)(K_lds + (kb_) * SHM_K + (32 + sr) * 272 + sc * 2) = ks1; } \
    if (NQ > 8) *(LAS u32x2*)(P_lds + (kb_) * SHM_P + pr * PPITCH + pc) = ps0; } while (0)
#define SWAIT() asm volatile("s_waitcnt vmcnt(0)" ::: "memory")
#define RESC(a) do { if (__any((a) < 1.f)) { if (R8) { _Pragma("unroll") for (int d = 0; d < 4; ++d) o[d] *= (a); } else { if (hi == 0) al_l[r32] = (a); asm volatile("s_waitcnt lgkmcnt(0)" ::: "memory"); \
    _Pragma("unroll") for (int d = 0; d < 4; ++d) _Pragma("unroll") for (int r = 0; r < 16; ++r) o[d][r] *= al_l[crow(r, hi)]; } } } while (0)
#define ROTV() do { const int t_ = vprev; vprev = vcur; vcur = vnext; vnext = t_; } while (0)
  f32x16 pA0, pA1, pB0, pB1; float alA = 1.f, alB = 1.f; bf16x8 pa[4];
  int vprev = 0, vcur = SHM_V, vnext = 2 * SHM_V;
  SLOAD(kstart); SWAIT(); SWRITE(0, 0); __syncthreads();
  SLOAD(kstart + KVBLK);
  phaseA<NQ, true, false>(pA0, pA1, pA0, pA1, 1.f, l_reg, pa, kb0, nb0, pb0, rqn, rq, qr);
  SWAIT(); SWRITE(1, SHM_V);
  phaseB<R8, MASK, false, true>(o, pa, pA0, pA1, m_reg, alA, vb0, Cs, thr_raw, qi, kstart, hi);
  __syncthreads();
  for (int j = 1; j + 1 < NT; j += 2) {
    SBAR(); SLOAD(kstart + (j + 1) * KVBLK); SBAR();
    phaseA<NQ, true, true>(pB0, pB1, pA0, pA1, alA, l_reg, pa, kb0 + SHM_K, nb0 + SHM_P, pb0 + SHM_P, rqn, rq, qr);
    SWAIT(); SWRITE(0, vnext);
    phaseB<R8, MASK, true, true>(o, pa, pB0, pB1, m_reg, alB, vb0 + vprev, Cs, thr_raw, qi, kstart + j * KVBLK, hi);
    RESC(alB); ROTV(); __syncthreads();
    SBAR(); if (j + 2 < NT) SLOAD(kstart + (j + 2) * KVBLK); SBAR();
    phaseA<NQ, true, true>(pA0, pA1, pB0, pB1, alB, l_reg, pa, kb0, nb0, pb0, rqn, rq, qr);
    if (j + 2 < NT) { SWAIT(); SWRITE(1, vnext); }
    phaseB<R8, MASK, true, true>(o, pa, pA0, pA1, m_reg, alA, vb0 + vprev, Cs, thr_raw, qi, kstart + (j + 1) * KVBLK, hi);
    RESC(alA); ROTV(); __syncthreads();
  }
  SBAR(); phaseA<NQ, true, true>(pB0, pB1, pA0, pA1, alA, l_reg, pa, kb0 + SHM_K, nb0 + SHM_P, pb0 + SHM_P, rqn, rq, qr);
  phaseB<R8, MASK, true, true>(o, pa, pB0, pB1, m_reg, alB, vb0 + vprev, Cs, thr_raw, qi, kstart + (NT - 1) * KVBLK, hi);
  RESC(alB); ROTV();
  phaseA<NQ, false, true>(pA0, pA1, pB0, pB1, alB, l_reg, pa, kb0, nb0, pb0, rqn, rq, qr);
  phaseB<R8, MASK, true, false>(o, pa, pA0, pA1, m_reg, alA, vb0 + vprev, Cs, thr_raw, qi, 0, hi);
  if (R8) {
    const float rl = __builtin_amdgcn_rcpf(l_reg); float sq = 0.f; bf16_t* Orow = Ob + (long)(wid * QBLK + r32) * LDO + 4 * hi;
#pragma unroll
    for (int db = 0; db < 4; ++db)
#pragma unroll
      for (int g = 0; g < 4; ++g) { const float v0 = o[db][4 * g] * rl, v1 = o[db][4 * g + 1] * rl, v2 = o[db][4 * g + 2] * rl, v3 = o[db][4 * g + 3] * rl; sq += (v0 * v0 + v1 * v1) + (v2 * v2 + v3 * v3);
        u32x2 w; w.x = cvt_pk_bf16(v0, v1); w.y = cvt_pk_bf16(v2, v3); *(u32x2*)(Orow + db * 32 + 8 * g) = w; }
    auto rr = __builtin_amdgcn_permlane32_swap(__float_as_uint(sq), __float_as_uint(sq), false, false); sq = __uint_as_float(rr[0]) + __uint_as_float(rr[1]);
    if (hi == 0) ssq[(long)(wid * QBLK + r32) * 16] = sq;
  } else {
  if (hi == 0) li_l[r32] = l_reg; asm volatile("s_waitcnt lgkmcnt(0)" ::: "memory");
  bf16_t* Ow = Ob + (long)(wid * QBLK) * LDO;
#pragma unroll
  for (int r = 0; r < 16; ++r) { const int orow = crow(r, hi); const float rl = __builtin_amdgcn_rcpf(li_l[orow]); float sq = 0.f;
#pragma unroll
    for (int d0 = 0; d0 < 4; ++d0) { const float v = o[d0][r] * rl; sq += v * v; Ow[(long)orow * LDO + d0 * 32 + r32] = (bf16_t)(cvt_pk_bf16(v, v) & 0xffffu); }
#pragma unroll
    for (int s = 1; s < 32; s <<= 1) sq += __shfl_xor(sq, s);
    if (r32 == 0) ssq[(long)(wid * QBLK + orow) * 16] = sq; }
  }
  __syncthreads();
#undef SLOAD
#undef SWRITE
#undef SWAIT
#undef RESC
#undef ROTV
}
#undef SBAR
#undef PIN
}

constexpr int NWAVES = 8;
#ifndef PROBE_ATT
#define PROBE_ATT 1
#endif
#ifndef PROBE_PRO
#define PROBE_PRO 1
#endif
#ifndef PROBE_MOEUP
#define PROBE_MOEUP 1
#endif
constexpr int RING_BYTES = 133120;
constexpr int MISC_OFF = 139264, LDS_BYTES = 147456;
static_assert(att::SHM_ATTN <= MISC_OFF && RING_BYTES <= MISC_OFF, "LDS map");
constexpr int NPHASE = 21;

__device__ const float INVF[64] = {
 1.000000000e+00f, 8.659643531e-01f, 7.498942018e-01f, 6.493816376e-01f, 5.623413324e-01f, 4.869675338e-01f, 4.216965139e-01f, 3.651741147e-01f, 3.162277639e-01f, 2.738419771e-01f, 2.371373773e-01f, 2.053525001e-01f, 1.778279394e-01f, 1.539926529e-01f, 1.333521456e-01f, 1.154781953e-01f,
 1.000000015e-01f, 8.659642935e-02f, 7.498942316e-02f, 6.493816525e-02f, 5.623413250e-02f, 4.869675264e-02f, 4.216964915e-02f, 3.651741147e-02f, 3.162277490e-02f, 2.738419548e-02f, 2.371373773e-02f, 2.053525113e-02f, 1.778279431e-02f, 1.539926510e-02f, 1.333521400e-02f, 1.154781971e-02f,
 9.999999776e-03f, 8.659643121e-03f, 7.498942316e-03f, 6.493816152e-03f, 5.623413250e-03f, 4.869675264e-03f, 4.216964822e-03f, 3.651741194e-03f, 3.162277630e-03f, 2.738419687e-03f, 2.371373819e-03f, 2.053525066e-03f, 1.778279431e-03f, 1.539926510e-03f, 1.333521446e-03f, 1.154782018e-03f,
 1.000000047e-03f, 8.659643354e-04f, 7.498941850e-04f, 6.493816036e-04f, 5.623413017e-04f, 4.869675322e-04f, 4.216965172e-04f, 3.651741135e-04f, 3.162277571e-04f, 2.738419571e-04f, 2.371373703e-04f, 2.053525095e-04f, 1.778279402e-04f, 1.539926598e-04f, 1.333521504e-04f, 1.154782003e-04f };

struct Args { const float* in[21]; float* out; unsigned char* ws; int ph_lo, ph_hi; };

__device__ __forceinline__ float wave_sum(float v) {
#pragma unroll
    for (int o = 1; o < 64; o <<= 1) v += __shfl_xor(v, o);
    return v;
}
__device__ __forceinline__ void sincos_acc(float ang, float& sn, float& cs) {
    const double a = (double)ang;
    const double n = __builtin_rint(a * 0.63661977236758134308);
    double r = __builtin_fma(-n, 1.57079632679489655800, a); r = __builtin_fma(-n, 6.12323399573676603587e-17, r);
    const double r2 = r * r;
    double sp = 1.0 / 6227020800.0; sp = __builtin_fma(sp, r2, -1.0 / 39916800.0); sp = __builtin_fma(sp, r2, 1.0 / 362880.0); sp = __builtin_fma(sp, r2, -1.0 / 5040.0);
    sp = __builtin_fma(sp, r2, 1.0 / 120.0); sp = __builtin_fma(sp, r2, -1.0 / 6.0); sp = __builtin_fma(sp * r2, r, r);
    double cp = 1.0 / 479001600.0; cp = __builtin_fma(cp, r2, -1.0 / 3628800.0); cp = __builtin_fma(cp, r2, 1.0 / 40320.0); cp = __builtin_fma(cp, r2, -1.0 / 720.0);
    cp = __builtin_fma(cp, r2, 1.0 / 24.0); cp = __builtin_fma(cp, r2, -0.5); cp = __builtin_fma(cp, r2, 1.0);
    const int q = ((int)n) & 3;
    const double s_ = (q & 1) ? cp : sp, c_ = (q & 1) ? sp : cp;
    sn = (float)((q & 2) ? -s_ : s_); cs = (float)(((q + 1) & 2) ? -c_ : c_);
}

__device__ __forceinline__ int src_quad(int kind, int n, int coff) {
    if (kind == 0) return coff + n;
    if (kind == 1) {
        if (n < 768 || (n >= 2112 && n < 2368)) return n;
        if (n >= 2368) return -1;
        int base, half, j;
        if (n < 832) { base = 768; half = 32; j = n - 768; } else if (n < 1856) { j = (n - 832) & 127; base = n - j; half = 64; } else { j = (n - 1856) & 127; base = n - j; half = 64; }
        const int g = j >> 3, e = j & 7; return base + (e < 4 ? 4 * g : half + 4 * g);
    }
    { const int head = n / 192, j = n - head * 192; if (j < 128) return n; const int jj = j - 128, g = jj >> 3, e = jj & 7; return head * 192 + 128 + (e < 4 ? 4 * g : 32 + 4 * g); }
}
__device__ __forceinline__ void tr_item(const float* __restrict__ src, int Nsrc, int K, bf16_t* __restrict__ dst, int k0, int n0, int kind, int coff,
                                        const float* __restrict__ gain, const float* __restrict__ gain2, LAS unsigned* scr, int lane) {
    const int nl = 4 * (lane & 15), ks = lane >> 4;
    const int sq = src_quad(kind, n0 + nl, coff);
#pragma unroll 4
    for (int r = 0; r < 16; ++r) {
        const int k = k0 + 8 * r + 2 * ks;
        f32x4 a = (f32x4){0.f, 0.f, 0.f, 0.f}, b = a;
        if (sq >= 0) { a = *(const f32x4*)(src + (size_t)k * Nsrc + sq); b = *(const f32x4*)(src + (size_t)(k + 1) * Nsrc + sq); }
        if (gain) { const float ga = (gain2 && k >= 1024) ? gain2[k - 1024] : gain[k], gb = (gain2 && k + 1 >= 1024) ? gain2[k + 1 - 1024] : gain[k + 1]; a *= ga; b *= gb; }
#pragma unroll
        for (int j = 0; j < 4; ++j) scr[(nl + j) * 65 + 4 * r + ks] = cvt_pk_bf16(a[j], b[j]);
    }
    asm volatile("s_waitcnt lgkmcnt(0)" ::: "memory");
#pragma unroll 4
    for (int it = 0; it < 16; ++it) {
        const int row = it * 4 + (lane >> 4), ch = lane & 15;
        const LAS unsigned* p = scr + row * 65 + 4 * ch;
        u32x4 w; w.x = p[0]; w.y = p[1]; w.z = p[2]; w.w = p[3];
        *(u32x4*)(dst + (size_t)(n0 + row) * K + k0 + 8 * ch) = w;
    }
    asm volatile("s_waitcnt lgkmcnt(0)" ::: "memory");
}
__device__ __forceinline__ void tr_item8(const float* __restrict__ src, int Nsrc, int K, unsigned char* __restrict__ dst, int k0, int n0, int scol, float scale, LAS unsigned* scr, int lane) {
    const int nl = 4 * (lane & 15), ks = lane >> 4;
#pragma unroll 4
    for (int r = 0; r < 16; ++r) {
        const int k = k0 + 16 * r + 4 * ks; const float* p = src + (size_t)k * Nsrc + scol + nl;
        const f32x4 a = *(const f32x4*)p * scale, b = *(const f32x4*)(p + Nsrc) * scale, c = *(const f32x4*)(p + 2 * (size_t)Nsrc) * scale, d = *(const f32x4*)(p + 3 * (size_t)Nsrc) * scale;
#pragma unroll
        for (int j = 0; j < 4; ++j) scr[(nl + j) * 65 + 4 * r + ks] = pk_fp8x4(a[j], b[j], c[j], d[j]);
    }
    asm volatile("s_waitcnt lgkmcnt(0)" ::: "memory");
#pragma unroll 4
    for (int it = 0; it < 16; ++it) {
        const int row = it * 4 + (lane >> 4), ch = lane & 15;
        const LAS unsigned* p = scr + row * 65 + 4 * ch;
        u32x4 w; w.x = p[0]; w.y = p[1]; w.z = p[2]; w.w = p[3];
        *(u32x4*)(dst + (size_t)(n0 + row) * K + k0 + 16 * ch) = w;
    }
    asm volatile("s_waitcnt lgkmcnt(0)" ::: "memory");
}
__device__ __forceinline__ void tr_item6(const float* __restrict__ src, int Nsrc, unsigned char* __restrict__ dst, int t, int n0, int scol, LAS unsigned* scr, int lane) {
    const int nl = 4 * (lane & 15), ks = lane >> 4;
    f32x4 a[16], b[16];
#pragma unroll
    for (int r = 0; r < 16; ++r) {
        const int kk = 8 * r + 2 * ks, k = 16 * t + 256 * (kk >> 4) + (kk & 15); const float* p = src + (size_t)k * Nsrc + scol + nl;
        a[r] = __builtin_nontemporal_load((const f32x4*)p); b[r] = __builtin_nontemporal_load((const f32x4*)(p + Nsrc));
    }
#pragma unroll
    for (int r = 0; r < 16; ++r) {
#pragma unroll
        for (int j = 0; j < 4; ++j) scr[(nl + j) * 65 + 4 * r + ks] = cvt_pk_bf16(a[r][j], b[r][j]);
    }
    asm volatile("s_waitcnt lgkmcnt(0)" ::: "memory");
#pragma unroll 1
    for (int it = 0; it < 4; ++it) {
        const int pidx = it * 64 + lane, n = pidx >> 2, g = pidx & 3;
        const LAS unsigned* p = scr + n * 65 + 2 * g;
        f32x16 lo, hi;
#pragma unroll
        for (int j = 0; j < 8; ++j) { const unsigned d0 = p[8 * j], d1 = p[8 * j + 1];
            const float x0 = __uint_as_float(d0 << 16), x1 = __uint_as_float(d0 & 0xffff0000u), x2 = __uint_as_float(d1 << 16), x3 = __uint_as_float(d1 & 0xffff0000u);
            if (j < 4) { lo[4 * j] = x0; lo[4 * j + 1] = x1; lo[4 * j + 2] = x2; lo[4 * j + 3] = x3; } else { hi[4 * (j - 4)] = x0; hi[4 * (j - 4) + 1] = x1; hi[4 * (j - 4) + 2] = x2; hi[4 * (j - 4) + 3] = x3; } }
        unsigned sb; const u32x6 q = mx6_block(lo, hi, sb);
        unsigned char* o = dst + (size_t)(n0 + n) * 2048 + t * 128 + 16 * g;
        *(u32x4*)o = (u32x4){q[0], q[1], q[2], q[3]}; *(u32x4*)(o + 64) = (u32x4){q[4], q[5], sb, 0u};
    }
    asm volatile("s_waitcnt lgkmcnt(0)" ::: "memory");
}
__device__ __forceinline__ void tr_item6c(const float* __restrict__ src, int Nsrc, int K, unsigned char* __restrict__ dst, int t, int n0, LAS unsigned* scr, int lane) {
    const int nl = 4 * (lane & 15), ks = lane >> 4;
    f32x4 a[16], b[16];
#pragma unroll
    for (int r = 0; r < 16; ++r) {
        const int k = 128 * t + 8 * r + 2 * ks; const float* p = src + (size_t)k * Nsrc + n0 + nl;
        a[r] = __builtin_nontemporal_load((const f32x4*)p); b[r] = __builtin_nontemporal_load((const f32x4*)(p + Nsrc));
    }
#pragma unroll
    for (int r = 0; r < 16; ++r) {
#pragma unroll
        for (int j = 0; j < 4; ++j) scr[(nl + j) * 65 + 4 * r + ks] = cvt_pk_bf16(a[r][j], b[r][j]);
    }
    asm volatile("s_waitcnt lgkmcnt(0)" ::: "memory");
#pragma unroll 1
    for (int it = 0; it < 4; ++it) {
        const int pidx = it * 64 + lane, n = pidx >> 2, g = pidx & 3;
        const LAS unsigned* p = scr + n * 65 + 16 * g;
        f32x16 lo, hi;
#pragma unroll
        for (int j = 0; j < 8; ++j) { const unsigned d0 = p[j], d1 = p[8 + j];
            lo[2 * j] = __uint_as_float(d0 << 16); lo[2 * j + 1] = __uint_as_float(d0 & 0xffff0000u); hi[2 * j] = __uint_as_float(d1 << 16); hi[2 * j + 1] = __uint_as_float(d1 & 0xffff0000u); }
        unsigned sb; const u32x6 q = mx6_block(lo, hi, sb);
        unsigned char* o = dst + (size_t)(n0 + n) * K + t * 128 + 16 * g;
        *(u32x4*)o = (u32x4){q[0], q[1], q[2], q[3]}; *(u32x4*)(o + 64) = (u32x4){q[4], q[5], sb, 0u};
    }
    asm volatile("s_waitcnt lgkmcnt(0)" ::: "memory");
}
__device__ __forceinline__ void tr_matrix6c(const float* src, int Nsrc, int K, unsigned char* dst, int Ndst, LAS unsigned* scr, int lane, int gw, int NGW, int& cursor) {
    const int nb = Ndst / 64, items = (K / 128) * nb;
    int it = (gw - (cursor % NGW) + NGW) % NGW;
    for (; it < items; it += NGW) tr_item6c(src, Nsrc, K, dst, it / nb, (it % nb) * 64, scr, lane);
    cursor += items;
}
__device__ __forceinline__ void tr_matrix6(const float* src, const float* src2, int Nsrc, unsigned char* dst, int Ndst, LAS unsigned* scr, int lane, int gw, int NGW, int& cursor) {
    const int nb = Ndst / 64, items = 16 * nb;
    int it = (gw - (cursor % NGW) + NGW) % NGW;
    for (; it < items; it += NGW) {
        const int t = it / nb, n0 = (it % nb) * 64, tile = n0 >> 8, j0 = n0 & 255;
        tr_item6(j0 < 128 ? src : src2, Nsrc, dst, t, n0, 128 * tile + (j0 & 127), scr, lane);
    }
    cursor += items;
}
__device__ __forceinline__ void tr_matrix8(const float* src, const float* src2, int Nsrc, int K, unsigned char* dst, int Ndst, int inter, float scale, LAS unsigned* scr, int lane, int gw, int NGW, int& cursor) {
    const int nb = Ndst / 64, items = (K / 256) * nb;
    int it = (gw - (cursor % NGW) + NGW) % NGW;
    for (; it < items; it += NGW) {
        const int kb = it / nb, n0 = (it % nb) * 64;
        if (inter) { const int tile = n0 >> 8, j0 = n0 & 255; tr_item8(j0 < 128 ? src : src2, Nsrc, K, dst, kb * 256, n0, 128 * tile + (j0 & 127), scale, scr, lane); }
        else tr_item8(src, Nsrc, K, dst, kb * 256, n0, n0, scale, scr, lane);
    }
    cursor += items;
}
__device__ __forceinline__ void tr_matrix(const float* src, const float* src2, int Nsrc, int K, bf16_t* dst, int Ndst, int kind, const float* gain, const float* gain2,
                                          LAS unsigned* scr, int lane, int gw, int NGW, int& cursor) {
    const int nb = Ndst / 64, items = (K / 128) * nb;
    int it = (gw - (cursor % NGW) + NGW) % NGW;
    for (; it < items; it += NGW) {
        const int kb = it / nb, n0 = (it % nb) * 64;
        if (kind == 3) { const int tile = n0 >> 8, j0 = n0 & 255; tr_item(j0 < 128 ? src : src2, Nsrc, K, dst, kb * 128, n0, 0, 128 * tile + (j0 & 127) - n0, nullptr, nullptr, scr, lane); }
        else tr_item(src, Nsrc, K, dst, kb * 128, n0, kind, 0, gain, gain2, scr, lane);
    }
    cursor += items;
}

constexpr int MOE_GU_ITEMS = 16 * (2 * FFE / 64), MOE_D_ITEMS = (FFE / 128) * (D / 64), MOE_E_ITEMS = MOE_GU_ITEMS + MOE_D_ITEMS, MOE_ITEMS = NE * MOE_E_ITEMS;
__device__ __forceinline__ void moe_conv_item(const Args& args, int j, LAS unsigned* scr, int lane) {
    const int e = j / MOE_E_ITEMS, r = j - e * MOE_E_ITEMS;
    if (r < MOE_GU_ITEMS) {
        constexpr int nb = 2 * FFE / 64;
        const int t = r / nb, n0 = (r % nb) * 64, tile = n0 >> 8, j0 = n0 & 255;
        tr_item6((j0 < 128 ? args.in[16] : args.in[17]) + (size_t)e * D * FFE, FFE, args.ws + WS_WMGU + (size_t)e * 2 * FFE * D, t, n0, 128 * tile + (j0 & 127), scr, lane);
    } else {
        const int r2 = r - MOE_GU_ITEMS, t = r2 / (D / 64), n0 = (r2 % (D / 64)) * 64;
        tr_item6c(args.in[18] + (size_t)e * FFE * D, D, FFE, args.ws + WS_WMD + (size_t)e * D * FFE, t, n0, scr, lane);
    }
}
__device__ __forceinline__ void moe_conv_burst(const Args& args, LAS unsigned char* lds, int part, int nparts) {
    const int tid = tid_opaque(), lane = tid & 63, wave = tid >> 6, gw = blockIdx.x * NWAVES + wave, NGW = gridDim.x * NWAVES;
    LAS unsigned* scr = (LAS unsigned*)(lds + wave * 16640);
    const int per = (MOE_ITEMS + NGW - 1) / NGW, i0 = per * part / nparts, i1 = per * (part + 1) / nparts;
    __syncthreads();
    for (int i = i0; i < i1; ++i) { const int j = gw + i * NGW; if (j < MOE_ITEMS) moe_conv_item(args, j, scr, lane); }
    __syncthreads();
}

__device__ __forceinline__ void ln_row(f32x4 (&v)[8], const float* __restrict__ g, const float* __restrict__ b, int lane, float& mean_o, float& rstd_o) {
    float s = 0.f;
#pragma unroll
    for (int j = 0; j < 8; ++j) s += (v[j][0] + v[j][1]) + (v[j][2] + v[j][3]);
    const float mean = wave_sum(s) * (1.f / D); float s2 = 0.f;
#pragma unroll
    for (int j = 0; j < 8; ++j) { v[j] = v[j] - mean; s2 += (v[j][0] * v[j][0] + v[j][1] * v[j][1]) + (v[j][2] * v[j][2] + v[j][3] * v[j][3]); }
    const float rstd = 1.f / sqrtf(wave_sum(s2) * (1.f / D) + LN_EPS); mean_o = mean; rstd_o = rstd;
#pragma unroll
    for (int j = 0; j < 8; ++j) { const f32x4 gg = *((const f32x4*)g + lane + 64 * j), bb = *((const f32x4*)b + lane + 64 * j); v[j] = v[j] * rstd * gg + bb; }
}

#define WSP(T, off) ((T*)(args.ws + (off)))
#define IN(k) (lo <= (k) && (k) < hi)
#define SEAM(k) do { if (IN(k) && IN((k) + 1)) { XcdBarrier b_; b_.bar = WSP(unsigned, WS_CTL) + CW_BAR; b_.x = xb_xcc_id(); b_.st = (volatile LAS unsigned*)(lds + MISC_OFF) + 8; xcd_barrier(b_); } } while (0)

__device__ __forceinline__ int moe_unit_table(const int* moemeta, int NT, LAS int* utab) {
    const int tid = tid_opaque();
    pg8::MoeOrder Mo;
#pragma unroll
    for (int e = 0; e <= NE; ++e) Mo.pb[e] = moemeta[e];
    Mo.NT = NT; Mo.G = gridDim.x; Mo.c = blockIdx.x; Mo.nwg = Mo.pb[NE] * NT;
    if (tid < 64) { pg8::Unit u; u.pm = 0; u.pn = 0; u.aux = 0; Mo.next(tid, u); utab[4 * tid] = u.pm; utab[4 * tid + 1] = u.pn; utab[4 * tid + 2] = u.aux; }
    __syncthreads();
    const int left = Mo.nwg - Mo.c; int n = left <= 0 ? 0 : (left + Mo.G - 1) / Mo.G;
    return __builtin_amdgcn_readfirstlane(n < 64 ? n : 64);
}
__device__ __forceinline__ f32x4 tail_sum(const bf16_t* yp, int t, int d, int lane, int SK) {
    f32x4 acc = {0.f, 0.f, 0.f, 0.f};
    for (int q = 0; q < SK; ++q) { const u32x2 a = *((const u32x2*)(yp + ((size_t)(q * 128 + t - 1) * 256 + (d & 255)) * 256) + lane);
        acc += (f32x4){__uint_as_float(a.x << 16), __uint_as_float(a.x & 0xffff0000u), __uint_as_float(a.y << 16), __uint_as_float(a.y & 0xffff0000u)}; }
    return acc;
}
__device__ __forceinline__ int moe_tail_split(int nwg, int G, int& Rf, int& Tn) {
    Rf = nwg / G; Tn = nwg - Rf * G;
    return Tn == 0 ? 1 : (Tn * 7 <= G ? 7 : (Tn * 4 <= G ? 4 : (Tn * 2 <= G ? 2 : 1)));
}
__device__ __forceinline__ int moe_unit_table_k(const int* moemeta, int NT, LAS int* utab, unsigned char* tailmap) {
    const int tid = tid_opaque();
    pg8::MoeOrder Mo;
#pragma unroll
    for (int e = 0; e <= NE; ++e) Mo.pb[e] = moemeta[e];
    Mo.NT = NT; Mo.G = gridDim.x; Mo.c = blockIdx.x; Mo.nwg = Mo.pb[NE] * NT;
    int Rf, Tn; const int SK = moe_tail_split(Mo.nwg, Mo.G, Rf, Tn);
    const int R = Rf < 63 ? Rf : 63;
    const bool piece = SK > 1 ? (Mo.c < Tn * SK) : (Mo.c < Tn);
    if (tid < 64) {
        long Lq = -1; int kx = 0, mark = 0;
        if (tid < R) Lq = (long)tid * Mo.G + Mo.c;
        else if (tid == R && piece) {
            if (SK == 1) Lq = (long)Rf * Mo.G + Mo.c;
            else { const int j = Mo.c / SK, q = Mo.c - j * SK; Lq = (long)Rf * Mo.G + j; kx = (1 + j) | (q << 8) | (SK << 16); mark = (q == 0) ? 1 + j : 0; }
        }
        pg8::Unit u; u.pm = 0; u.pn = 0; u.aux = 0; u.kx = 0;
        if (Lq >= 0) Mo.at(Lq, u);
        if (mark) tailmap[u.pm * 8 + u.aux] = (unsigned char)mark;
        utab[4 * tid] = u.pm; utab[4 * tid + 1] = u.pn; utab[4 * tid + 2] = u.aux; utab[4 * tid + 3] = kx;
    }
    __syncthreads();
    return __builtin_amdgcn_readfirstlane(R + (piece ? 1 : 0));
}
template <int L>
__device__ __forceinline__ void layer_phases(const Args& args, LAS unsigned char* lds, char* lds_gen, int lo, int hi) {
    constexpr int pb = 1 + 10 * L;
    if (IN(pb + 0)) {
        const int G = gridDim.x, bx = blockIdx.x;
        pg8::Gemm g{WSP(const bf16_t, WS_XB), WSP(const bf16_t, WS_WIN + L * SZ_WIN), D}; pg8::StaticOrder So; So.init(S, 2048, G, bx);
        pg8::EpiInProj E{WSP(bf16_t, WS_CQ), WSP(bf16_t, WS_CKV), WSP(bf16_t, WS_KPE), WSP(bf16_t, WS_QS), WSP(bf16_t, WS_KS), WSP(bf16_t, WS_VS), WSP(float, WS_PARTQ), WSP(float, WS_PARTKV),
                         WSP(const float, WS_COSM), WSP(const float, WS_SINM), WSP(const float, WS_COSS), WSP(const float, WS_SINS)};
        pg8::gemm_phase<pg8::EpiInProj, pg8::StaticOrder, true, true>(lds, g, So, E);
    }
    SEAM(pb + 0);
    if (IN(pb + 1)) {
        const int G = gridDim.x, bx = blockIdx.x;
        LAS int* utab = (LAS int*)(lds + MISC_OFF + 1024);
        LAS int* ucnt = (LAS int*)(lds + MISC_OFF + 1024 + 3072);
        if (tid_opaque() == 0) {
            int nl = 0, nq = 0, nk = 0;
            if (G == 256) {
                if (bx < 128) { utab[0] = bx >> 1; utab[1] = 8 + (bx & 1); utab[2] = 8 + (bx & 1); nl = 1; utab[128] = bx >> 3; utab[129] = bx & 7; utab[130] = bx & 7; nk = 1; }
                else { const int c = bx - 128;
                    for (int i = 0; i < 3; ++i) { const int u = 3 * c + i; utab[64 + 4 * i] = u / 6; utab[65 + 4 * i] = u % 6; utab[66 + 4 * i] = u % 6; }
                    nq = 3;
                    for (int i = 0; i < 3; ++i) { const int u = 128 + 3 * c + i; utab[128 + 4 * i] = u >> 3; utab[129 + 4 * i] = u & 7; utab[130 + 4 * i] = u & 7; }
                    nk = 3; }
            } else {
                for (int u = bx; u < 128 && nl < 16; u += G, ++nl) { utab[4 * nl] = u >> 1; utab[4 * nl + 1] = 8 + (u & 1); utab[4 * nl + 2] = 8 + (u & 1); }
                for (int u = bx; u < 384 && nq < 16; u += G, ++nq) { utab[64 + 4 * nq] = u / 6; utab[65 + 4 * nq] = u % 6; utab[66 + 4 * nq] = u % 6; }
                for (int u = bx; u < 512 && nk < 16; u += G, ++nk) { utab[128 + 4 * nk] = u >> 3; utab[129 + 4 * nk] = u & 7; utab[130 + 4 * nk] = u & 7; }
            }
            ucnt[0] = nl; ucnt[1] = nq; ucnt[2] = nk;
        }
        __syncthreads();
        { pg8::TableOrder To{utab, __builtin_amdgcn_readfirstlane(ucnt[0])};
          pg8::Gemm g{WSP(const bf16_t, WS_XB), WSP(const bf16_t, WS_WIN + L * SZ_WIN), D};
          pg8::EpiInProj E{WSP(bf16_t, WS_CQ), WSP(bf16_t, WS_CKV), WSP(bf16_t, WS_KPE), WSP(bf16_t, WS_QS), WSP(bf16_t, WS_KS), WSP(bf16_t, WS_VS), WSP(float, WS_PARTQ), WSP(float, WS_PARTKV),
                           WSP(const float, WS_COSM), WSP(const float, WS_SINM), WSP(const float, WS_COSS), WSP(const float, WS_SINS)};
          pg8::gemm_phase<pg8::EpiInProj, pg8::TableOrder, true, true>(lds, g, To, E); }
        { pg8::TableOrder To{utab + 64, __builtin_amdgcn_readfirstlane(ucnt[1])};
          pg8::Gemm g{WSP(const bf16_t, WS_CQ), WSP(const bf16_t, WS_WQ + L * SZ_WQ), QLORA};
          pg8::EpiQ E{WSP(bf16_t, WS_Q), WSP(const float, WS_PARTQ), WSP(const float, WS_COSM), WSP(const float, WS_SINM)};
          pg8::gemm_phase<pg8::EpiQ, pg8::TableOrder, true, true>(lds, g, To, E); }
        { pg8::TableOrder To{utab + 128, __builtin_amdgcn_readfirstlane(ucnt[2])};
          pg8::Gemm g{WSP(const bf16_t, WS_CKV), WSP(const bf16_t, WS_WKV + L * SZ_WKV), KVLORA};
          pg8::EpiKV E{WSP(bf16_t, WS_KV), WSP(const float, WS_PARTKV), WSP(unsigned char, WS_VT), WSP(unsigned char, WS_KN8)};
          pg8::gemm_phase<pg8::EpiKV, pg8::TableOrder, true, true>(lds, g, To, E); }
    }
    SEAM(pb + 1);
    if (IN(pb + 2)) {
        const int G = gridDim.x, bx = blockIdx.x;
        const int slot = bx % 3; bool pending = true;
        for (int step = 0; ; ++step) {
            const int u = bx + step * G; const bool more = u < 512;
            if (pending && (step == slot || !more)) { moe_conv_burst(args, lds, L, DEPTH); pending = false; }
            if (!more) break;
            const int r = u / 256, c = u % 256, head = 4 * r + ((c & 7) >> 1), qblk = (c >> 3) + 32 * (c & 1);
            att::attn_body<192, false, QCOLS, KVCOLS, 64, S, D>(WSP(const bf16_t, WS_Q) + (size_t)qblk * 256 * QCOLS + head * 192, WSP(const bf16_t, WS_KV) + head * 256, WSP(const unsigned char, WS_KN8) + head * 64, WSP(const bf16_t, WS_KPE),
                (const bf16_t*)(args.ws + WS_VT + (size_t)head * 128 * S), WSP(bf16_t, WS_OBUF) + (size_t)qblk * 256 * D + head * 128, WSP(float, WS_PARTO) + (size_t)qblk * 256 * 16 + head, qblk * 256, 0, S / 64, SCALE_MLA, 0.f, (LAS char*)lds);
        }
        for (int u = bx; u < 512; u += G) {
            const int head = u >> 6, qblk = u & 63;
            int t0 = 4 * qblk - 2, t1 = 4 * qblk + 5; if (t0 < 0) t0 = 0; if (t1 > S / 64 - 1) t1 = S / 64 - 1;
            const float sk = (args.in[6] + L * 8)[head];
            att::attn_body<128, true, 1024, 256, 64, 256, D>(WSP(const bf16_t, WS_QS) + (size_t)qblk * 256 * 1024 + head * 128, WSP(const bf16_t, WS_KS) + (head >> 2) * 128, nullptr, nullptr, WSP(const bf16_t, WS_VS) + (head >> 2) * 128,
                WSP(bf16_t, WS_OBUF) + (size_t)qblk * 256 * D + 1024 + head * 128, WSP(float, WS_PARTO) + (size_t)qblk * 256 * 16 + 8 + head, qblk * 256, t0 * 64, t1 - t0 + 1, SCALE_SWA, sk / SCALE_SWA, (LAS char*)lds);
        }
    }
    SEAM(pb + 2);
    if (IN(pb + 4)) {
        const int G = gridDim.x, bx = blockIdx.x;
        pg8::Gemm g{WSP(const bf16_t, WS_OBUF), WSP(const bf16_t, WS_WOUT + L * SZ_WOUT), D}; pg8::StaticOrder So; So.init(S, D, G, bx);
        if constexpr (L == 0) { pg8::EpiOutProj<false> E{args.in[0], WSP(float, WS_XA), WSP(const float, WS_PARTO), nullptr, nullptr, nullptr}; pg8::gemm_phase<pg8::EpiOutProj<false>, pg8::StaticOrder, true, true>(lds, g, So, E); }
        else { pg8::EpiOutProj<true> E{WSP(const float, WS_XA), WSP(float, WS_XA), WSP(const float, WS_PARTO), WSP(const float, WS_ST2), args.in[19] + (L - 1) * D, args.in[20] + (L - 1) * D};
               pg8::gemm_phase<pg8::EpiOutProj<true>, pg8::StaticOrder, true, true>(lds, g, So, E); }
    }
    SEAM(pb + 4);
    if (IN(pb + 5)) {
        const int tid = tid_opaque(), lane = tid & 63, wave = tid >> 6, G = gridDim.x, bx = blockIdx.x;
        const float* lg = args.in[10] + L * D; const float* lb = args.in[11] + L * D;
        float* XA = WSP(float, WS_XA); unsigned* X8 = WSP(unsigned, WS_X8);
        const int RPW = (S + G - 1) / G, r0 = bx * RPW, r1 = (r0 + RPW < S) ? r0 + RPW : S;
        LAS float* wr_l = (LAS float*)lds; LAS int* hist = (LAS int*)(lds + 65536);
        if (L == 1) { const float* wrg = args.in[15]; for (int i = tid; i < D * NE; i += 512) wr_l[i] = wrg[i]; if (tid < NE) hist[tid] = 0; __syncthreads(); }
        for (int row = r0 + wave; row < r1; row += NWAVES) {
            f32x4 v[8]; float* xr = XA + (size_t)row * D;
#pragma unroll
            for (int j = 0; j < 8; ++j) v[j] = *((const f32x4*)xr + lane + 64 * j);
            float mu_, rs_; ln_row(v, lg, lb, lane, mu_, rs_);
            if (lane == 0) { float* st = WSP(float, WS_ST1); st[2 * row] = mu_; st[2 * row + 1] = rs_; }
            { f32x16 lo, hi;
#pragma unroll
              for (int j = 0; j < 4; ++j)
#pragma unroll
                  for (int c = 0; c < 4; ++c) { lo[4 * j + c] = v[j][c]; hi[4 * j + c] = v[4 + j][c]; }
              unsigned sb; const u32x6 q = mx6_block(lo, hi, sb);
              unsigned char* o = (unsigned char*)X8 + (size_t)row * D + (lane >> 2) * 128 + 16 * (lane & 3);
              *(u32x4*)o = (u32x4){q[0], q[1], q[2], q[3]}; *(u32x4*)(o + 64) = (u32x4){q[4], q[5], sb, 0u}; }
            if (L == 1) {
                float q0 = 0.f, q1 = 0.f, q2 = 0.f, q3 = 0.f, q4 = 0.f, q5 = 0.f, q6 = 0.f, q7 = 0.f;
#pragma unroll
                for (int j = 0; j < 8; ++j)
#pragma unroll
                    for (int k = 0; k < 4; ++k) { const LAS f32x4* w = (const LAS f32x4*)(wr_l + (size_t)(4 * (lane + 64 * j) + k) * NE); const f32x4 w0 = w[0], w1 = w[1]; const float xv = v[j][k];
                        q0 += xv * w0[0]; q1 += xv * w0[1]; q2 += xv * w0[2]; q3 += xv * w0[3]; q4 += xv * w1[0]; q5 += xv * w1[1]; q6 += xv * w1[2]; q7 += xv * w1[3]; }
                q0 = wave_sum(q0); q1 = wave_sum(q1); q2 = wave_sum(q2); q3 = wave_sum(q3); q4 = wave_sum(q4); q5 = wave_sum(q5); q6 = wave_sum(q6); q7 = wave_sum(q7);
                int e0 = 0; float l0 = q0;
                if (q1 > l0) { l0 = q1; e0 = 1; } if (q2 > l0) { l0 = q2; e0 = 2; } if (q3 > l0) { l0 = q3; e0 = 3; } if (q4 > l0) { l0 = q4; e0 = 4; } if (q5 > l0) { l0 = q5; e0 = 5; } if (q6 > l0) { l0 = q6; e0 = 6; } if (q7 > l0) { l0 = q7; e0 = 7; }
                int e1 = -1; float l1 = -3.0e38f;
                if (e0 != 0 && q0 > l1) { l1 = q0; e1 = 0; } if (e0 != 1 && q1 > l1) { l1 = q1; e1 = 1; } if (e0 != 2 && q2 > l1) { l1 = q2; e1 = 2; } if (e0 != 3 && q3 > l1) { l1 = q3; e1 = 3; }
                if (e0 != 4 && q4 > l1) { l1 = q4; e1 = 4; } if (e0 != 5 && q5 > l1) { l1 = q5; e1 = 5; } if (e0 != 6 && q6 > l1) { l1 = q6; e1 = 6; } if (e0 != 7 && q7 > l1) { l1 = q7; e1 = 7; }
                const float t = __expf(l1 - l0), g0 = 1.0f / (1.0f + t), g1 = t / (1.0f + t);
                if (lane == 0) { int* sel = WSP(int, WS_SEL); float* gate = WSP(float, WS_GATE); sel[2 * row] = e0; sel[2 * row + 1] = e1; gate[2 * row] = g0; gate[2 * row + 1] = g1;
                    __hip_atomic_fetch_add(hist + e0, 1, __ATOMIC_RELAXED, __HIP_MEMORY_SCOPE_WORKGROUP); __hip_atomic_fetch_add(hist + e1, 1, __ATOMIC_RELAXED, __HIP_MEMORY_SCOPE_WORKGROUP); }
            }
        }
        if (L == 1) { __syncthreads(); if (tid < NE) WSP(int, WS_WGCNT)[bx * NE + tid] = hist[tid]; }
    }
    SEAM(pb + 5);
    if constexpr (L == 0) {
        if (IN(pb + 7)) {
            const int G = gridDim.x, bx = blockIdx.x;
            pg8::Gemm g{WSP(const bf16_t, WS_X8), WSP(const bf16_t, WS_WGU), D}; pg8::StaticOrder So; So.init(S, 2 * FF, G, bx);
            pg8::EpiSwiglu6 E{WSP(unsigned char, WS_H), FF};
            pg8::gemm_phase<pg8::EpiSwiglu6, pg8::StaticOrder, true, true, 2>(lds, g, So, E);
        }
        SEAM(pb + 7);
        if (IN(pb + 8)) {
            const int G = gridDim.x, bx = blockIdx.x;
            pg8::Gemm g{WSP(const bf16_t, WS_H), WSP(const bf16_t, WS_WD), FF}; pg8::StaticOrder So; So.init(S, D, G, bx);
            pg8::EpiResidLN E{WSP(const float, WS_XA), WSP(float, WS_XA), 1.0f, WSP(const float, WS_ST1), args.in[10] + L * D, args.in[11] + L * D};
            pg8::gemm_phase<pg8::EpiResidLN, pg8::StaticOrder, true, true, 2>(lds, g, So, E);
        }
        SEAM(pb + 8);
        if (IN(pb + 9)) {
            const int tid = tid_opaque(), lane = tid & 63, gw = blockIdx.x * NWAVES + (tid >> 6), NGW = gridDim.x * NWAVES;
            const float* lg = args.in[19] + L * D; const float* lb = args.in[20] + L * D; float* XA = WSP(float, WS_XA); bf16_t* XB = WSP(bf16_t, WS_XB);
            for (int row = gw; row < S; row += NGW) {
                f32x4 v[8]; float* xr = XA + (size_t)row * D;
#pragma unroll
                for (int j = 0; j < 8; ++j) v[j] = *((const f32x4*)xr + lane + 64 * j);
                float mu_, rs_; ln_row(v, lg, lb, lane, mu_, rs_);
                if (lane == 0) { float* st = WSP(float, WS_ST2); st[2 * row] = mu_; st[2 * row + 1] = rs_; }
#pragma unroll
                for (int j = 0; j < 8; ++j) *((u32x2*)(XB + (size_t)row * D) + lane + 64 * j) = pg8::pack4(v[j]);
            }
        }
        SEAM(pb + 9);
    } else {
        if (IN(pb + 6)) {
            const int tid = tid_opaque(), lane = tid & 63, wave = tid >> 6, G = gridDim.x, bx = blockIdx.x;
            const int RPW = (S + G - 1) / G, r0 = bx * RPW, r1 = (r0 + RPW < S) ? r0 + RPW : S, na = 2 * (r1 - r0);
            LAS int* tab = (LAS int*)lds;
            LAS int* basee = (LAS int*)(lds + 32768);
            LAS int* asel = (LAS int*)(lds + 33024);
            LAS int* adst = (LAS int*)(lds + 35072);
            const int* wgcnt = WSP(const int, WS_WGCNT); const int* sel = WSP(const int, WS_SEL);
            for (int i = tid; i < G * NE; i += 512) tab[i] = wgcnt[i];
            for (int i = tid; i < na; i += 512) asel[i] = sel[2 * r0 + i];
            __syncthreads();
            if (tid < NE) { int tot = 0, pre = 0; for (int w = 0; w < G; ++w) { const int c = tab[w * NE + tid]; pre += (w < bx) ? c : 0; tot += c; } basee[32 + tid] = tot; basee[40 + tid] = pre; }
            __syncthreads();
            if (tid == 0) { int p = 0; for (int e = 0; e < NE; ++e) { basee[8 + e] = p; basee[e] = 256 * p + basee[40 + e]; p += (basee[32 + e] + 255) >> 8; } basee[16] = p;
                if (bx == 0) { int* moemeta = WSP(int, WS_MOEMETA); for (int e = 0; e <= NE; ++e) moemeta[e] = basee[8 + e]; } }
            __syncthreads();
            if (tid < NE) { int rk = basee[tid]; for (int i = 0; i < na; ++i) if (asel[i] == tid) adst[i] = rk++; }
            __syncthreads();
            int* dest = WSP(int, WS_DEST); const unsigned char* X8 = WSP(const unsigned char, WS_X8); unsigned char* xs = WSP(unsigned char, WS_XS);
            for (int i = tid; i < na; i += 512) dest[2 * r0 + i] = adst[i];
            if (bx < NE) {
                const int rb = 256 * basee[8 + bx] + basee[32 + bx], re = 256 * basee[9 + bx];
                for (int i = rb * 128 + tid; i < re * 128; i += 512) ((u32x4*)xs)[i] = (u32x4){0u, 0u, 0u, 0u};
            }
            for (int a = wave; a < na; a += NWAVES) { const u32x4* s4 = (const u32x4*)(X8 + (size_t)(r0 + (a >> 1)) * D); u32x4* d4 = (u32x4*)(xs + (size_t)adst[a] * D);
#pragma unroll
                for (int j = 0; j < 2; ++j) d4[lane + 64 * j] = s4[lane + 64 * j]; }
        }
        SEAM(pb + 6);
        if (IN(pb + 7)) {
            LAS int* utab = (LAS int*)(lds + MISC_OFF + 1024);
            const int nun = moe_unit_table(WSP(const int, WS_MOEMETA), 2 * FFE / 256, utab);
            pg8::TableOrder To{utab, nun};
            pg8::Gemm g{WSP(const bf16_t, WS_XS), WSP(const bf16_t, WS_WMGU), D};
            pg8::EpiSwiglu6 E{WSP(unsigned char, WS_H), FFE};
            for (int rep = 0; rep < PROBE_MOEUP; ++rep) pg8::gemm_phase<pg8::EpiSwiglu6, pg8::TableOrder, true, true, 2>(lds, g, To, E);
        }
        SEAM(pb + 7);
        if (IN(pb + 8)) {
            LAS int* utab = (LAS int*)(lds + MISC_OFF + 1024);
            const int nun = moe_unit_table_k(WSP(const int, WS_MOEMETA), D / 256, utab, WSP(unsigned char, WS_TAILMAP));
            pg8::TableOrderK To{utab, nun};
            pg8::Gemm g{WSP(const bf16_t, WS_H), WSP(const bf16_t, WS_WMD), FFE};
            pg8::EpiBf16OutK E{WSP(bf16_t, WS_XS), WSP(bf16_t, WS_YP)};
            pg8::gemm_phase<pg8::EpiBf16OutK, pg8::TableOrderK, true, true, 2>(lds, g, To, E);
        }
        SEAM(pb + 8);
        if (IN(pb + 9)) {
            const int tid = tid_opaque(), lane = tid & 63, gw = blockIdx.x * NWAVES + (tid >> 6), NGW = gridDim.x * NWAVES;
            const float* lg = args.in[19] + L * D; const float* lb = args.in[20] + L * D;
            const int* dest = WSP(const int, WS_DEST); const float* gate = WSP(const float, WS_GATE); const float* XA = WSP(const float, WS_XA); const bf16_t* ys = WSP(const bf16_t, WS_XS);
            const float* st1 = WSP(const float, WS_ST1); const float* g1p = args.in[10] + L * D; const float* b1p = args.in[11] + L * D;
            for (int row = gw; row < S; row += NGW) {
                const int d0 = dest[2 * row], d1 = dest[2 * row + 1]; const float g0 = gate[2 * row], g1 = gate[2 * row + 1]; const float mu1 = st1[2 * row], rs1 = st1[2 * row + 1];
                f32x4 v[8]; const float* xr = XA + (size_t)row * D; const u32x2* y0 = (const u32x2*)(ys + (size_t)d0 * D); const u32x2* y1 = (const u32x2*)(ys + (size_t)d1 * D);
                const u32x2 m0 = *(const u32x2*)(WSP(const unsigned char, WS_TAILMAP) + (d0 >> 8) * 8), m1 = *(const u32x2*)(WSP(const unsigned char, WS_TAILMAP) + (d1 >> 8) * 8);
                const bool anyt = (m0.x | m0.y | m1.x | m1.y) != 0u;
#pragma unroll
                for (int j = 0; j < 8; ++j) { const f32x4 yv = *((const f32x4*)xr + lane + 64 * j); const f32x4 x = (yv - mu1) * rs1 * *((const f32x4*)g1p + lane + 64 * j) + *((const f32x4*)b1p + lane + 64 * j); const u32x2 a = y0[lane + 64 * j], b = y1[lane + 64 * j];
                    f32x4 fa = {__uint_as_float(a.x << 16), __uint_as_float(a.x & 0xffff0000u), __uint_as_float(a.y << 16), __uint_as_float(a.y & 0xffff0000u)};
                    f32x4 fb = {__uint_as_float(b.x << 16), __uint_as_float(b.x & 0xffff0000u), __uint_as_float(b.y << 16), __uint_as_float(b.y & 0xffff0000u)};
                    if (anyt) {
                        const int t0 = (int)(((j < 4 ? m0.x : m0.y) >> (8 * (j & 3))) & 255u), t1 = (int)(((j < 4 ? m1.x : m1.y) >> (8 * (j & 3))) & 255u);
                        if (t0 | t1) {
                            const int nwg_ = WSP(const int, WS_MOEMETA)[NE] * (D / 256), G_ = gridDim.x, Tn_ = nwg_ - (nwg_ / G_) * G_, SK = Tn_ * 7 <= G_ ? 7 : (Tn_ * 4 <= G_ ? 4 : 2);
                            if (t0) fa = tail_sum(WSP(const bf16_t, WS_YP), t0, d0, lane, SK);
                            if (t1) fb = tail_sum(WSP(const bf16_t, WS_YP), t1, d1, lane, SK);
                        }
                    }
                    v[j] = x * ALPHA + (fa * g0 + fb * g1); }
                float mu_, rs_; ln_row(v, lg, lb, lane, mu_, rs_);
#pragma unroll
                for (int j = 0; j < 8; ++j) *((f32x4*)(args.out + (size_t)row * D) + lane + 64 * j) = v[j];
            }
        }
    }
}

__global__ void __launch_bounds__(NWAVES * 64, 2) fwd(Args args) {
    extern __shared__ __attribute__((aligned(16))) unsigned char lds_raw[];
    LAS unsigned char* lds = (LAS unsigned char*)lds_raw;
    volatile LAS unsigned* MISC = (volatile LAS unsigned*)(lds + MISC_OFF);
    for (int u = tid_opaque(); u < (LDS_BYTES - MISC_OFF) / 4; u += NWAVES * 64) MISC[u] = 0u;
    __syncthreads();
    (void)xcd_barrier_post(WSP(unsigned, WS_CTL) + CW_BAR, MISC + 8);
    const int lo = args.ph_lo, hi = args.ph_hi;

    if (IN(0)) {
        const int tid = tid_opaque(), lane = tid & 63, wave = tid >> 6, G = gridDim.x, bx = blockIdx.x, gw = bx * NWAVES + wave, NGW = G * NWAVES;
        unsigned char* ws = args.ws;
        LAS unsigned* scr = (LAS unsigned*)(lds + wave * 16640);
        for (int rep = 0; rep < PROBE_PRO; ++rep) {
        int cursor = 0;
        for (int l = 0; l < DEPTH; ++l) {
            tr_matrix(args.in[1] + (size_t)l * D * IN_COLS, nullptr, IN_COLS, D, (bf16_t*)(ws + WS_WIN + l * SZ_WIN), IN_PAD, 1, nullptr, nullptr, scr, lane, gw, NGW, cursor);
            tr_matrix(args.in[3] + (size_t)l * QLORA * QCOLS, nullptr, QCOLS, QLORA, (bf16_t*)(ws + WS_WQ + l * SZ_WQ), QCOLS, 2, args.in[2] + l * QLORA, nullptr, scr, lane, gw, NGW, cursor);
            tr_matrix(args.in[5] + (size_t)l * KVLORA * KVCOLS, nullptr, KVCOLS, KVLORA, (bf16_t*)(ws + WS_WKV + l * SZ_WKV), KVCOLS, 0, args.in[4] + l * KVLORA, nullptr, scr, lane, gw, NGW, cursor);
            tr_matrix(args.in[9] + (size_t)l * D * D, nullptr, D, D, (bf16_t*)(ws + WS_WOUT + l * SZ_WOUT), D, 0, args.in[7] + l * 1024, args.in[8] + l * 1024, scr, lane, gw, NGW, cursor);
        }
        tr_matrix6(args.in[12], args.in[13], FF, ws + WS_WGU, 2 * FF, scr, lane, gw, NGW, cursor);
        tr_matrix6c(args.in[14], D, FF, ws + WS_WD, D, scr, lane, gw, NGW, cursor);
        { const f32x4* x4 = (const f32x4*)args.in[0]; u32x2* o2 = (u32x2*)(ws + WS_XB);
          for (size_t i = (size_t)bx * 512 + tid; i < (size_t)S * D / 4; i += (size_t)G * 512) o2[i] = pg8::pack4(x4[i]); }
        { float* coss = (float*)(ws + WS_COSS); float* sins = (float*)(ws + WS_SINS); float* cosm = (float*)(ws + WS_COSM); float* sinm = (float*)(ws + WS_SINM);
          for (int i = bx * 512 + tid; i < S * 64; i += G * 512) { const int pos = i >> 6, k = i & 63; float sn, cs; sincos_acc((float)pos * INVF[k], sn, cs); coss[i] = cs; sins[i] = sn; }
          for (int i = bx * 512 + tid; i < S * 32; i += G * 512) { const int pos = i >> 5, k = i & 31; float sn, cs; sincos_acc((float)pos * INVF[2 * k], sn, cs); cosm[i] = cs; sinm[i] = sn; } }
        }
    }
    SEAM(0);
    layer_phases<0>(args, lds, (char*)lds_raw, lo, hi);
    layer_phases<1>(args, lds, (char*)lds_raw, lo, hi);
}
#undef IN
#undef SEAM

#ifndef MK_SPLIT
#define MK_SPLIT 0
#endif
extern "C" void kernel_launch(void* const* d_in, const int* in_sizes, int n_in, void* d_out, int out_size, void* d_ws, size_t ws_size, hipStream_t stream) {
    static int grid = 0;
    if (grid == 0) {
        if (n_in != 21 || out_size != S * D || ws_size < WS_END4) { fprintf(stderr, "kernel_launch: unexpected shapes: n_in %d out %d ws %zu (need %zu)\n", n_in, out_size, ws_size, (size_t)WS_END4); grid = -1; return; }
        int dev = 0, cus = 0, per_cu = 0;
        if (hipGetDevice(&dev) != hipSuccess || hipDeviceGetAttribute(&cus, hipDeviceAttributeMultiprocessorCount, dev) != hipSuccess) { grid = -1; return; }
        if (hipFuncSetAttribute((const void*)fwd, hipFuncAttributeMaxDynamicSharedMemorySize, LDS_BYTES) != hipSuccess) { fprintf(stderr, "kernel_launch: hipFuncSetAttribute failed\n"); grid = -1; return; }
        if (hipOccupancyMaxActiveBlocksPerMultiprocessor(&per_cu, (const void*)fwd, NWAVES * 64, LDS_BYTES) != hipSuccess || per_cu < 1) fprintf(stderr, "kernel_launch: occupancy query says %d\n", per_cu);
        (void)hipGetLastError();
        grid = cus;
    }
    if (grid < 0) return;
    (void)hipMemsetAsync((char*)d_ws + WS_CTL, 0, CTL_ZERO_BYTES, stream);
    Args a{};
    for (int i = 0; i < 21; ++i) a.in[i] = (const float*)d_in[i];
    a.out = (float*)d_out; a.ws = (unsigned char*)d_ws;
#if MK_SPLIT
    for (int p = 0; p < NPHASE; ++p) { a.ph_lo = p; a.ph_hi = p + 1; hipLaunchKernelGGL(fwd, dim3(grid), dim3(NWAVES * 64), LDS_BYTES, stream, a); }
#else
    a.ph_lo = 0; a.ph_hi = NPHASE; hipLaunchKernelGGL(fwd, dim3(grid), dim3(NWAVES * 64), LDS_BYTES, stream, a);
#endif
    const hipError_t le = hipPeekAtLastError();
    if (le != hipSuccess) fprintf(stderr, "kernel_launch: launch failed: %s\n", hipGetErrorName(le));
}
```

```cpp
#include <hip/hip_runtime.h>
#include <cstdio>
#include <cstdint>

#define LAS __attribute__((address_space(3)))
#define GAS __attribute__((address_space(1)))
typedef unsigned short bf16_t;
typedef short bf16x8 __attribute__((ext_vector_type(8)));
typedef short s16x4 __attribute__((ext_vector_type(4)));
typedef float f32x4 __attribute__((ext_vector_type(4)));
typedef float f32x16 __attribute__((ext_vector_type(16)));
typedef unsigned u32x4 __attribute__((ext_vector_type(4)));
typedef unsigned u32x2 __attribute__((ext_vector_type(2)));

constexpr int S = 16384, D = 2048, DEPTH = 2;
constexpr int IN_COLS = 2368, IN_PAD = 2560, QCOLS = 1536, KVCOLS = 2048, QLORA = 512, KVLORA = 256;
constexpr int FF = 5632, FFE = 7168, NE = 8;
constexpr int MOE_ROWS = 34816;
constexpr float ALPHA = 1.41421356237309515f, LN_EPS = 1e-5f, RMS_EPS = 1e-6f;
constexpr float SCALE_MLA = 0.07216878364870322f, SCALE_SWA = 0.08838834764831845f;

__device__ __forceinline__ unsigned cvt_pk_bf16(float lo, float hi) { unsigned r; asm volatile("v_cvt_pk_bf16_f32 %0, %1, %2" : "=v"(r) : "v"(lo), "v"(hi)); return r; }

__device__ __forceinline__ unsigned pk_fp8x4(float a, float b, float c, float d) { int w = 0; w = __builtin_amdgcn_cvt_pk_fp8_f32(a, b, w, false); w = __builtin_amdgcn_cvt_pk_fp8_f32(c, d, w, true); return (unsigned)w; }
typedef int v6i32 __attribute__((ext_vector_type(6)));
typedef unsigned u32x6 __attribute__((ext_vector_type(6)));
__device__ __forceinline__ u32x6 mx6_block(const f32x16 lo, const f32x16 hi, unsigned& sb) {
    float am = 0.f;
#pragma unroll
    for (int i = 0; i < 16; ++i) am = fmaxf(am, fmaxf(fabsf(lo[i]), fabsf(hi[i])));
    const unsigned bits = __float_as_uint(am);
    int e = (int)((bits >> 23) & 255u) - 126 - (((bits & 0x7fffffu) <= 0x700000u) ? 3 : 2);
    e = e < -120 ? -120 : e;
    const float scale = __uint_as_float((unsigned)(e + 127) << 23);
    sb = (unsigned)(e + 127) * 0x01010101u;
    u32x6 q;
    asm("v_cvt_scalef32_2xpk16_fp6_f32 %0, %1, %2, %3" : "=&v"(q) : "v"(lo), "v"(hi), "v"(scale));
    return q;
}
constexpr float X8_SCALE = 4.f, W8UP_SCALE = 64.f, W8DN_SCALE = 128.f, H8_SCALE = 16.f;
__device__ __forceinline__ int tid_opaque() { int t = threadIdx.x; asm volatile("" : "+v"(t)); return t; }

constexpr size_t MiB = 1u << 20;
constexpr size_t WS_CTL = 0, CTL_ZERO_BYTES = 1 * MiB;
constexpr size_t WS_COSM = 1 * MiB, WS_SINM = 3 * MiB, WS_COSS = 5 * MiB, WS_SINS = 9 * MiB;
constexpr size_t WS_PARTQ = 13 * MiB, WS_PARTKV = 14 * MiB, WS_PARTO = 15 * MiB;
constexpr size_t WS_SEL = 16 * MiB, WS_GATE = WS_SEL + 128 * 1024, WS_DEST = WS_GATE + 128 * 1024, WS_WGCNT = WS_DEST + 128 * 1024, WS_MOEMETA = WS_WGCNT + 32 * 1024, WS_ST1 = WS_MOEMETA + 4096, WS_ST2 = WS_ST1 + 128 * 1024;
constexpr size_t WS_W = 17 * MiB;
constexpr size_t SZ_WIN = (size_t)IN_PAD * D * 2, SZ_WQ = (size_t)QCOLS * QLORA * 2, SZ_WKV = (size_t)KVCOLS * KVLORA * 2, SZ_WOUT = (size_t)D * D * 2;
constexpr size_t WS_WIN = WS_W, WS_WQ = WS_WIN + 2 * SZ_WIN, WS_WKV = WS_WQ + 2 * SZ_WQ, WS_WOUT = WS_WKV + 2 * SZ_WKV;
constexpr size_t WS_WGU = WS_WOUT + 2 * SZ_WOUT, WS_WD = WS_WGU + (size_t)2 * FF * D, WS_WMGU = WS_WD + (size_t)D * FF;
constexpr size_t WS_WMD = WS_WMGU + (size_t)NE * 2 * FFE * D, WS_XA = WS_WMD + (size_t)NE * D * FFE;
constexpr size_t WS_XB = WS_XA + (size_t)S * D * 4, WS_X8 = WS_XB + (size_t)S * D * 2, WS_SCR = WS_X8 + (size_t)S * D;
constexpr size_t WS_CQ = WS_SCR, WS_CKV = WS_CQ + (size_t)S * 512 * 2, WS_KPE = WS_CKV + (size_t)S * 256 * 2, WS_QS = WS_KPE + (size_t)S * 64 * 2;
constexpr size_t WS_KS = WS_QS + (size_t)S * 1024 * 2, WS_VS = WS_KS + (size_t)S * 256 * 2, WS_Q = WS_VS + (size_t)S * 256 * 2, WS_KV = WS_Q + (size_t)S * QCOLS * 2;
constexpr size_t WS_OBUF = WS_KV + (size_t)S * KVCOLS * 2, WS_ATT_END = WS_OBUF + (size_t)S * D * 2;
constexpr size_t WS_XS = WS_SCR, WS_H = WS_XS + (size_t)MOE_ROWS * D * 2, WS_END0 = WS_H + (size_t)MOE_ROWS * FFE, WS_END = WS_END0 > WS_ATT_END ? WS_END0 : WS_ATT_END;
constexpr size_t WS_YP = (WS_END + 255) / 256 * 256, WS_END2 = WS_YP + (size_t)7 * 128 * 65536 * 2;
constexpr size_t WS_VT = (WS_END2 + 255) / 256 * 256, WS_END3 = WS_VT + (size_t)8 * 128 * S;
constexpr size_t WS_KN8 = (WS_END3 + 255) / 256 * 256, WS_END4 = WS_KN8 + (size_t)S * 1024;
constexpr size_t WS_TAILMAP = WS_CTL + 512 * 1024;
static_assert(WS_H + (size_t)S * FF <= WS_END, "scratch union");
static_assert(WS_WIN % 256 == 0 && WS_XA % 256 == 0 && WS_H % 256 == 0 && WS_Q % 256 == 0, "alignment");
constexpr int CW_TMO = 0, CW_BAR = 4096;

#define XB_TMO      128
#define XB_XCNT(j)  (256  + 64 * (j))
#define XB_XSUB(j)  (1280 + 64 * (j))
#define XB_XGEN(j)  (2304 + 64 * (j))
#define XB_TOP      3328
#define XB_TOPGEN   3392
#define XCD_BAR_WORDS 3456
#define XB_SPIN_CAP (1u << 18)
__device__ __forceinline__ unsigned xb_ld(unsigned* p)              { return __hip_atomic_load(p, __ATOMIC_RELAXED, __HIP_MEMORY_SCOPE_AGENT); }
__device__ __forceinline__ unsigned xb_add(unsigned* p, unsigned v) { return __hip_atomic_fetch_add(p, v, __ATOMIC_RELAXED, __HIP_MEMORY_SCOPE_AGENT); }
__device__ __forceinline__ unsigned xb_xcc_id() { return (unsigned)__builtin_amdgcn_s_getreg((3 << 11) | 20) & 0xFu; }
#define XB_SPIN(cond, bar) do { unsigned _sp = 0; while (cond) { __builtin_amdgcn_s_sleep(1); \
    if ((++_sp & 255u) == 0u) { if (xb_ld(&(bar)[XB_TMO])) break; if (_sp > XB_SPIN_CAP) { atomicAdd(&(bar)[XB_TMO], 1u); break; } } } } while (0)
struct XcdBarrier { unsigned* bar; unsigned x; volatile LAS unsigned* st; };
__device__ __forceinline__ XcdBarrier xcd_barrier_post(unsigned* bar, volatile LAS unsigned* st) {
    XcdBarrier b; b.bar = bar; b.x = xb_xcc_id(); b.st = st;
    if (threadIdx.x == 0) (void)xb_add(&bar[XB_XCNT(b.x)], 1u);
    return b;
}
__device__ __forceinline__ void xcd_barrier_complete(unsigned* bar, unsigned x, unsigned& nloc, unsigned& nx) {
    const unsigned G = gridDim.x * gridDim.y * gridDim.z;
    unsigned sum, cnt, mine, sp = 0u;
    for (;;) {
        sum = 0u; cnt = 0u; mine = 0u;
#pragma unroll
        for (unsigned j = 0; j < 16; ++j) { const unsigned c = xb_ld(&bar[XB_XCNT(j)]); sum += c; cnt += (c > 0u) ? 1u : 0u; mine = (j == x) ? c : mine; }
        if (sum == G) break;
        __builtin_amdgcn_s_sleep(1);
        if ((++sp & 255u) == 0u) { if (xb_ld(&bar[XB_TMO])) break; if (sp > XB_SPIN_CAP) { atomicAdd(&bar[XB_TMO], 1u); break; } }
    }
    nloc = mine > 0u ? mine : 1u; nx = cnt > 0u ? cnt : 1u;
}
__device__ __forceinline__ void xcd_barrier(const XcdBarrier& b) {
    asm volatile("s_waitcnt vmcnt(0)" ::: "memory");
    __syncthreads();
    if (threadIdx.x == 0) {
        unsigned* bar = b.bar;
        __builtin_amdgcn_s_waitcnt(0);
        unsigned nloc = b.st[0], nx = b.st[1];
        if (nloc == 0u) { xcd_barrier_complete(bar, b.x, nloc, nx); b.st[0] = nloc; b.st[1] = nx; }
        const unsigned old = xb_add(&bar[XB_XSUB(b.x)], 1u);
        const unsigned gen = old / nloc;
        if (old + 1u == (gen + 1u) * nloc) {
            __builtin_amdgcn_fence(__ATOMIC_RELEASE, "agent");
            asm volatile("s_waitcnt vmcnt(0)" ::: "memory");
            const unsigned og = xb_add(&bar[XB_TOP], 1u);
            const unsigned tg = og / nx;
            if (og + 1u == (tg + 1u) * nx) xb_add(&bar[XB_TOPGEN], 1u);
            else XB_SPIN(xb_ld(&bar[XB_TOPGEN]) == tg, bar);
            __builtin_amdgcn_fence(__ATOMIC_ACQUIRE, "agent");
            xb_add(&bar[XB_XGEN(b.x)], 1u);
            asm volatile("s_waitcnt vmcnt(0)" ::: "memory");
        } else {
            XB_SPIN(xb_ld(&bar[XB_XGEN(b.x)]) == gen, bar);
            __builtin_amdgcn_fence(__ATOMIC_ACQUIRE, "agent");
            asm volatile("s_waitcnt vmcnt(0)" ::: "memory");
        }
    }
    __syncthreads();
}

namespace pg8 {
constexpr int BM = 256, BK = 64, HALF = 128, HTB = HALF * BK * 2, STAGE_BYTES = 8 * HTB, NXCD = 8, WGM = 8;
__host__ __device__ __forceinline__ int lds_byte(int r, int c) { const int st = (r >> 4) * 2 + (c >> 5), rr = r & 15, cc = c & 31, ob = rr * 64 + cc * 2; return st * 1024 + (ob ^ (((ob >> 9) & 1) << 5)); }
__host__ __device__ __forceinline__ void stage_rc(int b, int& R, int& C) { const int st = b / 1024, sb = b % 1024, swz = sb ^ (((sb >> 9) & 1) << 5); R = (st >> 1) * 16 + swz / 64; C = (st & 1) * 32 + (swz % 64) / 2; }
__host__ __device__ __forceinline__ int perm32(int rho) { const int n = rho >> 4, i = rho & 15; return 8 * (i >> 2) + 4 * n + (i & 3); }
struct Unit { int pm, pn, aux, kx; };
struct Gemm { const bf16_t* A; const bf16_t* Bt; int K; };
struct StaticOrder {
    static constexpr bool KSPLIT = false;
    int nM, nN, nwg, G, c;
    __device__ void init(int M, int N, int G_, int c_) { nM = M / BM; nN = N / BM; nwg = nM * nN; G = G_; c = c_; }
    __device__ bool next(int i, Unit& u) const {
        const long L = (long)i * G + c; if (L >= nwg) return false;
        int wgid = (int)L; { const int q = nwg / NXCD, r = nwg % NXCD, xcd = wgid % NXCD, off = wgid / NXCD; wgid = (xcd < r ? xcd * (q + 1) : r * (q + 1) + (xcd - r) * q) + off; }
        const int nig = WGM * nN, gid = wgid / nig, fm = gid * WGM, gsz = (nM - fm) < WGM ? (nM - fm) : WGM;
        u.pm = fm + ((wgid % nig) % gsz); u.pn = (wgid % nig) / gsz; u.aux = u.pn; return true;
    }
};
struct MoeOrder {
    static constexpr bool KSPLIT = false;
    int pb[9], NT, G, c, nwg;
    __device__ __forceinline__ bool next(int i, Unit& u) const { return at((long)i * G + c, u); }
    __device__ __forceinline__ bool at(long L, Unit& u) const {
        if (L >= nwg) return false;
        int wgid = (int)L; { const int q = nwg / NXCD, r = nwg % NXCD, xcd = wgid % NXCD, off = wgid / NXCD; wgid = (xcd < r ? xcd * (q + 1) : r * (q + 1) + (xcd - r) * q) + off; }
        int e = 0;
#pragma unroll
        for (int k = 1; k < 8; ++k) e += (wgid >= pb[k] * NT) ? 1 : 0;
        int pbe = pb[0], pbn = pb[1];
#pragma unroll
        for (int k = 1; k < 8; ++k) { if (e == k) { pbe = pb[k]; pbn = pb[k + 1]; } }
        const int l = wgid - pbe * NT, Pe = pbn - pbe;
        const int nig = WGM * NT, gid = l / nig, fm = gid * WGM, gsz = (Pe - fm) < WGM ? (Pe - fm) : WGM;
        u.pm = pbe + fm + ((l % nig) % gsz); const int pn = (l % nig) / gsz; u.pn = e * NT + pn; u.aux = pn; return true;
    }
};

struct TableOrder {
    static constexpr bool KSPLIT = false;
    const LAS int* tab; int n;
    __device__ __forceinline__ bool next(int i, Unit& u) const {
        if (i >= n) return false;
        u.pm = __builtin_amdgcn_readfirstlane(tab[4 * i]); u.pn = __builtin_amdgcn_readfirstlane(tab[4 * i + 1]); u.aux = __builtin_amdgcn_readfirstlane(tab[4 * i + 2]); return true;
    }
};
struct TableOrderK {
    static constexpr bool KSPLIT = true;
    const LAS int* tab; int n;
    __device__ __forceinline__ bool next(int i, Unit& u) const {
        if (i >= n) return false;
        u.pm = __builtin_amdgcn_readfirstlane(tab[4 * i]); u.pn = __builtin_amdgcn_readfirstlane(tab[4 * i + 1]); u.aux = __builtin_amdgcn_readfirstlane(tab[4 * i + 2]); u.kx = __builtin_amdgcn_readfirstlane(tab[4 * i + 3]); return true;
    }
};
typedef int v8i32 __attribute__((ext_vector_type(8)));
template <class Epi, class Sched, bool ALIGN_EPI, bool SP2, int FMT = 0>
__device__ __forceinline__ void gemm_phase(LAS unsigned char* lds, const Gemm g, const Sched& S, const Epi& E) {
    const int tid = tid_opaque(), wid = __builtin_amdgcn_readfirstlane(tid >> 6), lane = tid & 63, wr = wid >> 2, wc = wid & 3, fr = lane & 15, fq = lane >> 4;
    constexpr bool F8 = (FMT != 0);
    const int K = g.K, RB = F8 ? K : 2 * K, nt = RB / 128;
    unsigned voffA, voffB;
    { int R, C; stage_rc(tid * 16, R, C); const int Rb = Epi::PERM ? ((R & ~31) + perm32(R & 31)) : R; voffA = (unsigned)(R * RB + C * 2); voffB = (unsigned)(Rb * RB + C * 2); }
    const size_t rstep = (size_t)64 * RB;
    const size_t kstep = (size_t)(BK * 2);
    const size_t hstep = (size_t)HALF * RB;
    const size_t tstep = 2 * hstep;
    const unsigned ldsw = (unsigned)wid * 1024u;
    const int aoff = lds_byte(wr * 64 + fr, fq * 8), boff = lds_byte(wc * 32 + fr, fq * 8);
#define PG8_SA(b, h) (((b) * 2 + (h)) * HTB)
#define PG8_SB(b, h) ((4 + (b) * 2 + (h)) * HTB)
#define PG8_STAGE(bufoff, gbase, voff) do { _Pragma("unroll") for (int _i = 0; _i < 2; ++_i) \
        __builtin_amdgcn_global_load_lds((const unsigned*)((const char*)(gbase) + _i * rstep + (voff)), (LAS unsigned*)(lds + (bufoff) + ldsw + _i * 8192), 16, 0, 0); } while (0)
#define PG8_LDA(dst, b, h) do { _Pragma("unroll") for (int m = 0; m < 4; ++m) _Pragma("unroll") for (int k = 0; k < 2; ++k) dst[m][k] = *(const LAS bf16x8*)(lds + PG8_SA(b, h) + aoff + m * 2048 + k * 1024); } while (0)
#define PG8_LDB(dst, b, h) do { _Pragma("unroll") for (int n = 0; n < 2; ++n) _Pragma("unroll") for (int k = 0; k < 2; ++k) dst[n][k] = *(const LAS bf16x8*)(lds + PG8_SB(b, h) + boff + n * 2048 + k * 1024); } while (0)
#define PG8_CAT(x) __builtin_shufflevector(__builtin_bit_cast(u32x4, x[0]), __builtin_bit_cast(u32x4, x[1]), 0, 1, 2, 3, 4, 5, 6, 7)
#define PG8_D6(x) __builtin_bit_cast(v6i32, __builtin_shufflevector(__builtin_bit_cast(u32x4, x[0]), __builtin_bit_cast(u32x4, x[1]), 0, 1, 2, 3, 4, 5))
#define PG8_S6(x) ((int)__builtin_bit_cast(u32x4, x[1])[2])
#define PG8_MMA(ai, bj, At, Bt) do { __builtin_amdgcn_s_setprio(1); if constexpr (FMT == 1) { _Pragma("unroll") for (int m = 0; m < 4; ++m) _Pragma("unroll") for (int n = 0; n < 2; ++n) \
        asm volatile("v_mfma_f32_16x16x128_f8f6f4 %0, %1, %2, %0" : "+v"(acc[ai][bj][m][n]) : "v"(__builtin_bit_cast(v8i32, PG8_CAT(Bt[n]))), "v"(__builtin_bit_cast(v8i32, PG8_CAT(At[m])))); } \
        else if constexpr (FMT == 2) { _Pragma("unroll") for (int m = 0; m < 4; ++m) _Pragma("unroll") for (int n = 0; n < 2; ++n) \
        acc[ai][bj][m][n] = __builtin_amdgcn_mfma_scale_f32_16x16x128_f8f6f4(__builtin_bit_cast(v8i32, PG8_CAT(Bt[n])), __builtin_bit_cast(v8i32, PG8_CAT(At[m])), acc[ai][bj][m][n], 2, 2, 0, PG8_S6(Bt[n]), 0, PG8_S6(At[m])); } \
        else { _Pragma("unroll") for (int m = 0; m < 4; ++m) _Pragma("unroll") for (int n = 0; n < 2; ++n) _Pragma("unroll") for (int k = 0; k < 2; ++k) \
        acc[ai][bj][m][n] = __builtin_amdgcn_mfma_f32_16x16x32_bf16(Bt[n][k], At[m][k], acc[ai][bj][m][n], 0, 0, 0); } __builtin_amdgcn_s_setprio(0); } while (0)
#define PG8_WAIT_V(n) asm volatile("s_waitcnt vmcnt(" #n ")" ::: "memory")
#define PG8_WAIT_L(n) asm volatile("s_waitcnt lgkmcnt(" #n ")" ::: "memory")
#define PG8_BAR __builtin_amdgcn_s_barrier()
#define PG8_SCHED __builtin_amdgcn_sched_barrier(0)
    Unit cur, nxt; int ui = 0;
    if (!S.next(0, cur)) return;
    constexpr bool KS = Sched::KSPLIT;
    auto k_off = [&](const Unit& u) -> size_t { if constexpr (KS) { if (u.kx) return (size_t)((u.kx >> 8) & 255) * (size_t)(nt / (u.kx >> 16)) * 128; } return 0; };
    auto k_cnt = [&](const Unit& u) -> int { if constexpr (KS) { if (u.kx) return nt / (u.kx >> 16); } return nt; };
    int ntc = k_cnt(cur);
    f32x4 acc[2][2][4][2];
#pragma unroll
    for (int a = 0; a < 2; ++a)
#pragma unroll
        for (int b = 0; b < 2; ++b)
#pragma unroll
            for (int m = 0; m < 4; ++m)
#pragma unroll
                for (int n = 0; n < 2; ++n) acc[a][b][m][n] = (f32x4){0.f, 0.f, 0.f, 0.f};
    bf16x8 At[4][2], B0[2][2], B1[2][2];
    const char* cA = (const char*)g.A + (size_t)cur.pm * tstep + k_off(cur); const char* cB = (const char*)g.Bt + (size_t)cur.pn * tstep + k_off(cur);
    if constexpr (SP2) {
        PG8_STAGE(PG8_SB(0, 0), cB, voffB); PG8_STAGE(PG8_SB(0, 1), cB + hstep, voffB); PG8_STAGE(PG8_SA(0, 0), cA, voffA); PG8_STAGE(PG8_SA(0, 1), cA + hstep, voffA);
        if (wr == 1) PG8_BAR;
        PG8_WAIT_V(2); PG8_BAR;
        PG8_STAGE(PG8_SB(1, 0), cB + kstep, voffB); PG8_STAGE(PG8_SA(1, 0), cA + kstep, voffA); PG8_STAGE(PG8_SB(1, 1), cB + hstep + kstep, voffB);
        PG8_WAIT_V(6); PG8_BAR;
    } else {
        PG8_STAGE(PG8_SB(0, 0), cB, voffB); PG8_STAGE(PG8_SA(0, 0), cA, voffA); PG8_STAGE(PG8_SB(0, 1), cB + hstep, voffB); PG8_STAGE(PG8_SA(0, 1), cA + hstep, voffA);
        if (wr == 1) PG8_BAR;
        PG8_WAIT_V(4); PG8_BAR;
        PG8_STAGE(PG8_SB(1, 0), cB + kstep, voffB); PG8_STAGE(PG8_SA(1, 0), cA + kstep, voffA); PG8_STAGE(PG8_SB(1, 1), cB + hstep + kstep, voffB);
        PG8_WAIT_V(6); PG8_BAR;
    }
    for (;;) {
        const bool has_next = S.next(ui + 1, nxt);
        const char* nA = has_next ? (const char*)g.A + (size_t)nxt.pm * tstep + k_off(nxt) : cA; const char* nB = has_next ? (const char*)g.Bt + (size_t)nxt.pn * tstep + k_off(nxt) : cB;
        for (int t = 0; t < ntc; t += 2) {
            if constexpr (Epi::MID_T >= 0) { if (t == Epi::MID_T) { const int l2 = tid_opaque() & 63; E.mid(acc, cur, wr, wc, l2 & 15, l2 >> 4); } }
            const bool last = (t == ntc - 2);
            const char* a1 = cA + (size_t)(t + 1) * kstep;
            const char* a2 = last ? nA : cA + (size_t)(t + 2) * kstep; const char* b2 = last ? nB : cB + (size_t)(t + 2) * kstep;
            const char* a3 = a2 + kstep; const char* b3 = b2 + kstep;
            if constexpr (SP2) {
            PG8_LDB(B0, 0, 0); PG8_LDB(B1, 0, 1); PG8_SCHED; PG8_LDA(At, 0, 0); PG8_STAGE(PG8_SA(1, 1), a1 + hstep, voffA);
            PG8_WAIT_V(8); PG8_WAIT_L(0); PG8_BAR; PG8_MMA(0, 0, At, B0); PG8_MMA(0, 1, At, B1); PG8_BAR; PG8_SCHED;
            PG8_LDA(At, 0, 1); PG8_STAGE(PG8_SB(0, 0), b2, voffB); PG8_STAGE(PG8_SB(0, 1), b2 + hstep, voffB); PG8_STAGE(PG8_SA(0, 0), a2, voffA);
            PG8_WAIT_V(8); PG8_WAIT_L(0); PG8_BAR; PG8_MMA(1, 0, At, B0); PG8_MMA(1, 1, At, B1); PG8_BAR; PG8_SCHED;
            PG8_LDB(B0, 1, 0); PG8_LDB(B1, 1, 1); PG8_SCHED; PG8_LDA(At, 1, 0); PG8_STAGE(PG8_SA(0, 1), a2 + hstep, voffA);
            PG8_WAIT_V(8); PG8_WAIT_L(0); PG8_BAR; PG8_MMA(0, 0, At, B0); PG8_MMA(0, 1, At, B1); PG8_BAR; PG8_SCHED;
            PG8_LDA(At, 1, 1); PG8_STAGE(PG8_SB(1, 0), b3, voffB); PG8_STAGE(PG8_SB(1, 1), b3 + hstep, voffB); PG8_STAGE(PG8_SA(1, 0), a3, voffA);
            PG8_WAIT_V(8); PG8_WAIT_L(0); PG8_BAR; PG8_MMA(1, 0, At, B0); PG8_MMA(1, 1, At, B1); PG8_BAR; PG8_SCHED;
            } else {
            PG8_LDB(B0, 0, 0); PG8_SCHED; PG8_LDA(At, 0, 0); PG8_STAGE(PG8_SA(1, 1), a1 + hstep, voffA);
            PG8_WAIT_L(8); PG8_BAR; PG8_WAIT_L(0); PG8_MMA(0, 0, At, B0); PG8_BAR; PG8_SCHED;
            PG8_LDB(B1, 0, 1); PG8_STAGE(PG8_SB(0, 0), b2, voffB);
            PG8_BAR; PG8_WAIT_L(0); PG8_MMA(0, 1, At, B1); PG8_BAR;
            PG8_LDA(At, 0, 1); PG8_STAGE(PG8_SA(0, 0), a2, voffA);
            PG8_BAR; PG8_WAIT_L(0); PG8_MMA(1, 0, At, B0); PG8_BAR; PG8_SCHED;
            PG8_STAGE(PG8_SB(0, 1), b2 + hstep, voffB);
            PG8_WAIT_V(6); PG8_BAR; PG8_MMA(1, 1, At, B1); PG8_BAR;
            PG8_LDB(B0, 1, 0); PG8_SCHED; PG8_LDA(At, 1, 0); PG8_STAGE(PG8_SA(0, 1), a2 + hstep, voffA);
            PG8_WAIT_L(8); PG8_BAR; PG8_WAIT_L(0); PG8_MMA(0, 0, At, B0); PG8_BAR; PG8_SCHED;
            PG8_LDB(B1, 1, 1); PG8_STAGE(PG8_SB(1, 0), b3, voffB);
            PG8_BAR; PG8_WAIT_L(0); PG8_MMA(0, 1, At, B1); PG8_BAR;
            PG8_LDA(At, 1, 1); PG8_STAGE(PG8_SA(1, 0), a3, voffA);
            PG8_BAR; PG8_WAIT_L(0); PG8_MMA(1, 0, At, B0); PG8_BAR; PG8_SCHED;
            PG8_STAGE(PG8_SB(1, 1), b3 + hstep, voffB);
            PG8_WAIT_V(6); PG8_BAR; PG8_MMA(1, 1, At, B1); PG8_BAR;
            }
        }
        if constexpr (ALIGN_EPI) { if (wr == 0) PG8_BAR; }
        if constexpr (F8) asm volatile("s_nop 15\n\ts_nop 15" ::: "memory");
        { const int l2 = tid_opaque() & 63; E(acc, cur, wr, wc, l2 & 15, l2 >> 4); }
        if (!has_next) break;
#pragma unroll
        for (int a = 0; a < 2; ++a)
#pragma unroll
            for (int b = 0; b < 2; ++b)
#pragma unroll
                for (int m = 0; m < 4; ++m)
#pragma unroll
                    for (int n = 0; n < 2; ++n) acc[a][b][m][n] = (f32x4){0.f, 0.f, 0.f, 0.f};
        cur = nxt; cA = nA; cB = nB; ++ui; ntc = k_cnt(cur);
        if constexpr (ALIGN_EPI) { if (wr == 1) PG8_BAR; }
    }
    PG8_WAIT_V(0);
    if constexpr (!ALIGN_EPI) { if (wr == 0) PG8_BAR; }
    PG8_BAR;
#undef PG8_SA
#undef PG8_SB
#undef PG8_STAGE
#undef PG8_LDA
#undef PG8_LDB
#undef PG8_MMA
#undef PG8_CAT
#undef PG8_D6
#undef PG8_S6
#undef PG8_WAIT_V
#undef PG8_WAIT_L
#undef PG8_BAR
#undef PG8_SCHED
}

__device__ __forceinline__ u32x4 pack8(const f32x4 a, const f32x4 b) { u32x4 w; w.x = cvt_pk_bf16(a[0], a[1]); w.y = cvt_pk_bf16(a[2], a[3]); w.z = cvt_pk_bf16(b[0], b[1]); w.w = cvt_pk_bf16(b[2], b[3]); return w; }
__device__ __forceinline__ u32x2 pack4(const f32x4 a) { u32x2 w; w.x = cvt_pk_bf16(a[0], a[1]); w.y = cvt_pk_bf16(a[2], a[3]); return w; }

constexpr int RM_BITS = 5;
template <int B = RM_BITS>
__device__ __forceinline__ f32x4 rmant(const f32x4 v) {
    f32x4 r;
#pragma unroll
    for (int i = 0; i < 4; ++i) r[i] = __uint_as_float((__float_as_uint(v[i]) + (1u << (22 - B))) & ~((1u << (23 - B)) - 1u));
    return r;
}

struct EpiInProj {
    static constexpr int MID_T = -1;
    static constexpr bool PERM = true;
    bf16_t *cq, *ckv, *kpe, *qs, *ks, *vs; float *partq, *partkv; const float *cosm, *sinm, *coss, *sins;
    __device__ __forceinline__ void operator()(const f32x4 (&acc)[2][2][4][2], const Unit& u, int wr, int wc, int fr, int fq) const {
        const int row0 = u.pm * BM + wr * 64 + fr;
#pragma unroll
        for (int bj = 0; bj < 2; ++bj) {
            const int tc0 = u.aux * BM + bj * HALF + wc * 32 + fq * 8;
            if (tc0 < 768) {
                bf16_t* base; float* part; int ld, col, ps;
                if (tc0 < 512) { base = cq; ld = 512; col = tc0; part = partq; ps = 16; } else { base = ckv; ld = 256; col = tc0 - 512; part = partkv; ps = 8; }
#pragma unroll
                for (int ai = 0; ai < 2; ++ai)
#pragma unroll
                    for (int m = 0; m < 4; ++m) { const int row = row0 + ai * HALF + m * 16; const f32x4 v0 = acc[ai][bj][m][0], v1 = acc[ai][bj][m][1];
                        *(u32x4*)(base + (size_t)row * ld + col) = pack8(v0, v1);
                        float ss = (v0[0] * v0[0] + v0[1] * v0[1]) + (v0[2] * v0[2] + v0[3] * v0[3]) + (v1[0] * v1[0] + v1[1] * v1[1]) + (v1[2] * v1[2] + v1[3] * v1[3]);
                        ss += __shfl_xor(ss, 16); ss += __shfl_xor(ss, 32);
                        if (fq == 0) part[(size_t)row * ps + (col >> 5)] = ss; }
            } else if (tc0 < 2112) {
                bf16_t* base; const float *ct, *st; int ld, col, half, tw, g;
                if (tc0 < 832) { g = (tc0 - 768) >> 3; base = kpe; ld = 64; col = 4 * g; half = 32; ct = cosm; st = sinm; tw = 32; }
                else if (tc0 < 1856) { const int j = tc0 - 832; g = (j & 127) >> 3; base = qs; ld = 1024; col = (j >> 7) * 128 + 4 * g; half = 64; ct = coss; st = sins; tw = 64; }
                else { const int j = tc0 - 1856; g = (j & 127) >> 3; base = ks; ld = 256; col = (j >> 7) * 128 + 4 * g; half = 64; ct = coss; st = sins; tw = 64; }
#pragma unroll
                for (int ai = 0; ai < 2; ++ai)
#pragma unroll
                    for (int m = 0; m < 4; ++m) { const int row = row0 + ai * HALF + m * 16; const f32x4 x1 = acc[ai][bj][m][0], x2 = acc[ai][bj][m][1];
                        const f32x4 c = *(const f32x4*)(ct + (size_t)row * tw + 4 * g), s = *(const f32x4*)(st + (size_t)row * tw + 4 * g);
                        const f32x4 o1 = x1 * c - x2 * s, o2 = x2 * c + x1 * s;
                        if (tc0 < 832) { unsigned char* kp = (unsigned char*)kpe + (size_t)row * 64 + col;
                            *(unsigned*)kp = pk_fp8x4(o1[0], o1[1], o1[2], o1[3]); *(unsigned*)(kp + 32) = pk_fp8x4(o2[0], o2[1], o2[2], o2[3]); }
                        else { *(u32x2*)(base + (size_t)row * ld + col) = pack4(o1); *(u32x2*)(base + (size_t)row * ld + col + half) = pack4(o2); } }
            } else if (tc0 < 2368) {
                const int col = tc0 - 2112;
#pragma unroll
                for (int ai = 0; ai < 2; ++ai)
#pragma unroll
                    for (int m = 0; m < 4; ++m) { const int row = row0 + ai * HALF + m * 16; *(u32x4*)(vs + (size_t)row * 256 + col) = pack8(acc[ai][bj][m][0], acc[ai][bj][m][1]); }
            }
        }
    }
};
struct EpiQ {
    static constexpr int MID_T = -1;
    static constexpr bool PERM = true;
    bf16_t* q; const float *partq, *cosm, *sinm;
    __device__ __forceinline__ void operator()(const f32x4 (&acc)[2][2][4][2], const Unit& u, int wr, int wc, int fr, int fq) const {
        const int row0 = u.pm * BM + wr * 64 + fr;
        float rs[2][4];
#pragma unroll
        for (int ai = 0; ai < 2; ++ai)
#pragma unroll
            for (int m = 0; m < 4; ++m) { const f32x4* p = (const f32x4*)(partq + (size_t)(row0 + ai * HALF + m * 16) * 16); const f32x4 s = (p[0] + p[1]) + (p[2] + p[3]);
                rs[ai][m] = 1.0f / sqrtf(((s[0] + s[1]) + (s[2] + s[3])) * (1.0f / 512.0f) + RMS_EPS); }
#pragma unroll
        for (int bj = 0; bj < 2; ++bj) {
            const int tc0 = u.aux * BM + bj * HALF + wc * 32 + fq * 8, head = tc0 / 192, j = tc0 - head * 192;
            if (j < 128) {
#pragma unroll
                for (int ai = 0; ai < 2; ++ai)
#pragma unroll
                    for (int m = 0; m < 4; ++m) { const int row = row0 + ai * HALF + m * 16; const f32x4 qa = acc[ai][bj][m][0] * rs[ai][m], qb = acc[ai][bj][m][1] * rs[ai][m];
                        { u32x2 w; w.x = pk_fp8x4(qa[0], qa[1], qa[2], qa[3]); w.y = pk_fp8x4(qb[0], qb[1], qb[2], qb[3]);
                          unsigned char* slot = (unsigned char*)(q + (size_t)row * QCOLS + head * 192); const int jj = j & 63;
                          *(u32x2*)(slot + (j < 64 ? 320 : 128) + jj) = w;
                          const f32x4 da = {__builtin_amdgcn_cvt_f32_fp8((int)w.x, 0), __builtin_amdgcn_cvt_f32_fp8((int)w.x, 1), __builtin_amdgcn_cvt_f32_fp8((int)w.x, 2), __builtin_amdgcn_cvt_f32_fp8((int)w.x, 3)};
                          const f32x4 db = {__builtin_amdgcn_cvt_f32_fp8((int)w.y, 0), __builtin_amdgcn_cvt_f32_fp8((int)w.y, 1), __builtin_amdgcn_cvt_f32_fp8((int)w.y, 2), __builtin_amdgcn_cvt_f32_fp8((int)w.y, 3)};
                          const f32x4 ea = qa + qa - da, eb = qb + qb - db; u32x2 w2; w2.x = pk_fp8x4(ea[0], ea[1], ea[2], ea[3]); w2.y = pk_fp8x4(eb[0], eb[1], eb[2], eb[3]);
                          *(u32x2*)(slot + (j < 64 ? 0 : 64) + jj) = w2; } }
            } else {
                const int g = (j - 128) >> 3, col = head * 192 + 128 + 4 * g;
#pragma unroll
                for (int ai = 0; ai < 2; ++ai)
#pragma unroll
                    for (int m = 0; m < 4; ++m) { const int row = row0 + ai * HALF + m * 16; const f32x4 x1 = acc[ai][bj][m][0] * rs[ai][m], x2 = acc[ai][bj][m][1] * rs[ai][m];
                        const f32x4 c = *(const f32x4*)(cosm + (size_t)row * 32 + 4 * g), s = *(const f32x4*)(sinm + (size_t)row * 32 + 4 * g);
                        const f32x4 r1 = x1 * c - x2 * s, r2 = x2 * c + x1 * s; unsigned char* q8 = (unsigned char*)(q + (size_t)row * QCOLS + head * 192 + 128) + 4 * g;
                        *(unsigned*)q8 = pk_fp8x4(r1[0], r1[1], r1[2], r1[3]); *(unsigned*)(q8 + 32) = pk_fp8x4(r2[0], r2[1], r2[2], r2[3]); }
            }
        }
    }
};
struct EpiKV {
    static constexpr int MID_T = -1;
    static constexpr bool PERM = true;
    bf16_t* kv; const float* partkv; unsigned char* vt; unsigned char* kn8;
    __device__ __forceinline__ void operator()(const f32x4 (&acc)[2][2][4][2], const Unit& u, int wr, int wc, int fr, int fq) const {
        const int row0 = u.pm * BM + wr * 64 + fr;
#pragma unroll
        for (int ai = 0; ai < 2; ++ai)
#pragma unroll
            for (int m = 0; m < 4; ++m) { const int row = row0 + ai * HALF + m * 16; const f32x4* p = (const f32x4*)(partkv + (size_t)row * 8); const f32x4 s = p[0] + p[1];
                const float rs = 1.0f / sqrtf(((s[0] + s[1]) + (s[2] + s[3])) * (1.0f / 256.0f) + RMS_EPS);
                { const f32x4 ka = acc[ai][0][m][0] * rs, kb_ = acc[ai][0][m][1] * rs; const int c = wc * 32 + fq * 8;
                  u32x2 w; w.x = pk_fp8x4(ka[0], ka[1], ka[2], ka[3]); w.y = pk_fp8x4(kb_[0], kb_[1], kb_[2], kb_[3]); *(u32x2*)(kn8 + (size_t)row * 1024 + u.aux * 128 + c) = w; }
                { const f32x4 v0 = acc[ai][1][m][0] * rs, v1 = acc[ai][1][m][1] * rs; const unsigned w0 = pk_fp8x4(v0[0], v0[1], v0[2], v0[3]), w1 = pk_fp8x4(v1[0], v1[1], v1[2], v1[3]);
                  unsigned char* o = vt + ((size_t)(u.aux * 128 + wc * 32 + fq * 8)) * S + row;
#pragma unroll
                  for (int i = 0; i < 4; ++i) { o[(size_t)i * S] = (unsigned char)(w0 >> (8 * i)); o[(size_t)(4 + i) * S] = (unsigned char)(w1 >> (8 * i)); } } }
    }
};
struct EpiResid {
    static constexpr int MID_T = -1;
    static constexpr bool PERM = true;
    const float* xin; float* y; float sc;
    __device__ __forceinline__ void operator()(const f32x4 (&acc)[2][2][4][2], const Unit& u, int wr, int wc, int fr, int fq) const {
        const int row0 = u.pm * BM + wr * 64 + fr;
#pragma unroll
        for (int ai = 0; ai < 2; ++ai)
#pragma unroll
            for (int m = 0; m < 4; ++m) { const size_t ro = (size_t)(row0 + ai * HALF + m * 16) * D;
#pragma unroll
                for (int bj = 0; bj < 2; ++bj) { const size_t o = ro + u.aux * BM + bj * HALF + wc * 32 + fq * 8;
                    const f32x4 a0 = *(const f32x4*)(xin + o), a1 = *(const f32x4*)(xin + o + 4);
                    *(f32x4*)(y + o) = a0 * ALPHA + acc[ai][bj][m][0] * sc; *(f32x4*)(y + o + 4) = a1 * ALPHA + acc[ai][bj][m][1] * sc; }
                asm volatile("" ::: "memory"); }
    }
};
struct EpiResidLN {
    static constexpr int MID_T = -1;
    static constexpr bool PERM = true, PROBE2 = false;
    const float* yin; float* y; float sc; const float* st; const float* g; const float* b;
    __device__ __forceinline__ void operator()(const f32x4 (&acc)[2][2][4][2], const Unit& u, int wr, int wc, int fr, int fq) const {
        const int row0 = u.pm * BM + wr * 64 + fr, col0 = u.aux * BM + wc * 32 + fq * 8;
        f32x4 gg[2][2], bb[2][2];
#pragma unroll
        for (int bj = 0; bj < 2; ++bj)
#pragma unroll
            for (int n = 0; n < 2; ++n) { gg[bj][n] = *(const f32x4*)(g + col0 + bj * HALF + 4 * n); bb[bj][n] = *(const f32x4*)(b + col0 + bj * HALF + 4 * n); }
#pragma unroll
        for (int ai = 0; ai < 2; ++ai)
#pragma unroll
            for (int m = 0; m < 4; ++m) { const int row = row0 + ai * HALF + m * 16; const size_t ro = (size_t)row * D; const float mu = st[2 * row], rs = st[2 * row + 1];
#pragma unroll
                for (int bj = 0; bj < 2; ++bj) { const size_t o = ro + col0 + bj * HALF;
                    const f32x4 a0 = *(const f32x4*)(yin + o), a1 = *(const f32x4*)(yin + o + 4);
                    const f32x4 x0 = (a0 - mu) * rs * gg[bj][0] + bb[bj][0], x1 = (a1 - mu) * rs * gg[bj][1] + bb[bj][1];
                    *(f32x4*)(y + o) = x0 * ALPHA + acc[ai][bj][m][0] * sc; *(f32x4*)(y + o + 4) = x1 * ALPHA + acc[ai][bj][m][1] * sc; }
                asm volatile("" ::: "memory"); }
    }
};
template <bool LNIN> struct EpiOutProj {
    static constexpr bool PERM = true, PROBE2 = false; static constexpr int MID_T = 16;
    const float* xin; float* y; const float* parto; const float* st; const float* g; const float* b;
    __device__ __forceinline__ void sums(int row, float& a, float& c) const { const f32x4* p = (const f32x4*)(parto + (size_t)row * 16); const f32x4 u = p[0] + p[1], v = p[2] + p[3];
        a = ((u[0] + u[1]) + (u[2] + u[3])) * (1.0f / 1024.0f) + RMS_EPS; c = ((v[0] + v[1]) + (v[2] + v[3])) * (1.0f / 1024.0f) + RMS_EPS; }
    __device__ __forceinline__ void mid(f32x4 (&acc)[2][2][4][2], const Unit& u, int wr, int wc, int fr, int fq) const {
        const int row0 = u.pm * BM + wr * 64 + fr;
#pragma unroll
        for (int ai = 0; ai < 2; ++ai)
#pragma unroll
            for (int m = 0; m < 4; ++m) { float a, c; sums(row0 + ai * HALF + m * 16, a, c); const float r = sqrtf(c / a);
#pragma unroll
                for (int bj = 0; bj < 2; ++bj) { acc[ai][bj][m][0] *= r; acc[ai][bj][m][1] *= r; } }
    }
    __device__ __forceinline__ void operator()(const f32x4 (&acc)[2][2][4][2], const Unit& u, int wr, int wc, int fr, int fq) const {
        const int row0 = u.pm * BM + wr * 64 + fr, col0 = u.aux * BM + wc * 32 + fq * 8;
        f32x4 gg[2][2], bb[2][2];
        if (LNIN) {
#pragma unroll
            for (int bj = 0; bj < 2; ++bj)
#pragma unroll
                for (int n = 0; n < 2; ++n) { gg[bj][n] = *(const f32x4*)(g + col0 + bj * HALF + 4 * n); bb[bj][n] = *(const f32x4*)(b + col0 + bj * HALF + 4 * n); }
        }
#pragma unroll
        for (int ai = 0; ai < 2; ++ai)
#pragma unroll
            for (int m = 0; m < 4; ++m) { const int row = row0 + ai * HALF + m * 16; const size_t ro = (size_t)row * D; float a, c; sums(row, a, c); const float rsw = 1.0f / sqrtf(c);
                float mu = 0.f, rs = 1.f; if (LNIN) { mu = st[2 * row]; rs = st[2 * row + 1]; }
#pragma unroll
                for (int bj = 0; bj < 2; ++bj) { const size_t o = ro + col0 + bj * HALF;
                    f32x4 x0 = *(const f32x4*)(xin + o), x1 = *(const f32x4*)(xin + o + 4);
                    if (LNIN) { x0 = (x0 - mu) * rs * gg[bj][0] + bb[bj][0]; x1 = (x1 - mu) * rs * gg[bj][1] + bb[bj][1]; }
                    *(f32x4*)(y + o) = x0 * ALPHA + acc[ai][bj][m][0] * rsw; *(f32x4*)(y + o + 4) = x1 * ALPHA + acc[ai][bj][m][1] * rsw; }
                asm volatile("" ::: "memory"); }
    }
};
struct EpiSwiglu8 {
    static constexpr int MID_T = -1;
    static constexpr bool PERM = true;
    unsigned char* h; int ldh; float sc;
    __device__ __forceinline__ void operator()(const f32x4 (&acc)[2][2][4][2], const Unit& u, int wr, int wc, int fr, int fq) const {
        const int row0 = u.pm * BM + wr * 64 + fr, col = u.aux * HALF + wc * 32 + fq * 8;
#pragma unroll
        for (int ai = 0; ai < 2; ++ai)
#pragma unroll
            for (int m = 0; m < 4; ++m) { f32x4 r0, r1;
#pragma unroll
                for (int k = 0; k < 4; ++k) { const float g0 = acc[ai][0][m][0][k] * sc, g1 = acc[ai][0][m][1][k] * sc;
                    r0[k] = __builtin_amdgcn_fmed3f(g0 * __builtin_amdgcn_rcpf(1.0f + __builtin_amdgcn_exp2f(-1.4426950408889634f * g0)) * (acc[ai][1][m][0][k] * (sc * H8_SCALE)), -448.f, 448.f);
                    r1[k] = __builtin_amdgcn_fmed3f(g1 * __builtin_amdgcn_rcpf(1.0f + __builtin_amdgcn_exp2f(-1.4426950408889634f * g1)) * (acc[ai][1][m][1][k] * (sc * H8_SCALE)), -448.f, 448.f); }
                u32x2 w; w.x = pk_fp8x4(r0[0], r0[1], r0[2], r0[3]); w.y = pk_fp8x4(r1[0], r1[1], r1[2], r1[3]);
                *(u32x2*)(h + (size_t)(row0 + ai * HALF + m * 16) * ldh + col) = w; }
    }
};
struct EpiSwiglu6 {
    static constexpr bool PERM = true, PROBE2 = false; static constexpr int MID_T = -1;
    unsigned char* h; int ldh;
    __device__ __forceinline__ void operator()(const f32x4 (&acc)[2][2][4][2], const Unit& u, int wr, int wc, int fr, int fq) const {
#pragma unroll
        for (int ai = 0; ai < 2; ++ai) {
            float v[4][8];
#pragma unroll
            for (int m = 0; m < 4; ++m)
#pragma unroll
                for (int c = 0; c < 8; ++c) { const float g = acc[ai][0][m][c >> 2][c & 3], uu = acc[ai][1][m][c >> 2][c & 3];
                    v[m][c] = g * __builtin_amdgcn_rcpf(1.0f + __builtin_amdgcn_exp2f(-1.4426950408889634f * g)) * uu; }
            float s1[2][2][8];
#pragma unroll
            for (int mm = 0; mm < 2; ++mm)
#pragma unroll
                for (int c = 0; c < 8; ++c) { auto r = __builtin_amdgcn_permlane32_swap(__float_as_uint(v[mm][c]), __float_as_uint(v[mm + 2][c]), false, false);
                    s1[mm][0][c] = __uint_as_float(r[0]); s1[mm][1][c] = __uint_as_float(r[1]); }
            f32x16 lo, hi;
#pragma unroll
            for (int hh = 0; hh < 2; ++hh)
#pragma unroll
                for (int c = 0; c < 8; ++c) { auto r = __builtin_amdgcn_permlane16_swap(__float_as_uint(s1[0][hh][c]), __float_as_uint(s1[1][hh][c]), false, false);
                    if (hh == 0) { lo[c] = __uint_as_float(r[0]); lo[8 + c] = __uint_as_float(r[1]); } else { hi[c] = __uint_as_float(r[0]); hi[8 + c] = __uint_as_float(r[1]); } }
            unsigned sb; const u32x6 q = mx6_block(lo, hi, sb);
            unsigned char* o = h + (size_t)(u.pm * BM + ai * HALF + wr * 64 + fq * 16 + fr) * ldh + u.aux * 128 + 16 * wc;
            *(u32x4*)o = (u32x4){q[0], q[1], q[2], q[3]}; *(u32x4*)(o + 64) = (u32x4){q[4], q[5], sb, 0u};
        }
    }
};
struct EpiBf16Out {
    static constexpr int MID_T = -1;
    static constexpr bool PERM = true;
    bf16_t* o; int ld; float sc;
    __device__ __forceinline__ void operator()(const f32x4 (&acc)[2][2][4][2], const Unit& u, int wr, int wc, int fr, int fq) const {
        const int row0 = u.pm * BM + wr * 64 + fr;
#pragma unroll
        for (int ai = 0; ai < 2; ++ai)
#pragma unroll
            for (int m = 0; m < 4; ++m)
#pragma unroll
                for (int bj = 0; bj < 2; ++bj) *(u32x4*)(o + (size_t)(row0 + ai * HALF + m * 16) * ld + u.aux * BM + bj * HALF + wc * 32 + fq * 8) = pack8(acc[ai][bj][m][0] * sc, acc[ai][bj][m][1] * sc);
    }
};
struct EpiBf16OutK {
    static constexpr int MID_T = -1;
    static constexpr bool PERM = true;
    bf16_t* o; bf16_t* yp;
    __device__ __forceinline__ void operator()(const f32x4 (&acc)[2][2][4][2], const Unit& u, int wr, int wc, int fr, int fq) const {
        bf16_t* base; int ld;
        if (u.kx) { base = yp + ((size_t)(((u.kx >> 8) & 255) * 128 + (u.kx & 255) - 1) * 256 + wr * 64 + fr) * 256; ld = 256; }
        else { base = o + (size_t)(u.pm * BM + wr * 64 + fr) * D + u.aux * BM; ld = D; }
#pragma unroll
        for (int ai = 0; ai < 2; ++ai)
#pragma unroll
            for (int m = 0; m < 4; ++m)
#pragma unroll
                for (int bj = 0; bj < 2; ++bj) *(u32x4*)(base + (size_t)(ai * HALF + m * 16) * ld + bj * HALF + wc * 32 + fq * 8) = pack8(acc[ai][bj][m][0], acc[ai][bj][m][1]);
    }
};
}

namespace att {
constexpr int NW = 8, QBLK = 32, KVBLK = 64;
constexpr float THR = 8.f;
constexpr int PPITCH = 80;
constexpr int VPITCH = 80;
constexpr float THR8 = 3.f;
constexpr float PK8 = 4.f;
constexpr int SHM_V = KVBLK * 128 * 2, SHM_K = KVBLK * 272, SHM_P = KVBLK * PPITCH;
constexpr int OFF_V = 0, OFF_K = 3 * SHM_V, OFF_P = OFF_K + 2 * SHM_K,     OFF_WS = OFF_P + 2 * SHM_P, OFF_QP = OFF_WS + NW * 64 * 4, SHM_ATTN = OFF_QP + NW * 4096;
typedef LAS const char* lptr;
typedef short v4i16_t __attribute__((ext_vector_type(4)));
#define SBAR() __builtin_amdgcn_sched_barrier(0)
#define PIN(x) asm volatile("" : "+v"(x))
__device__ __forceinline__ int crow(int r, int hi) { return (r & 3) + 8 * (r >> 2) + 4 * hi; }
__device__ __forceinline__ bf16x8 ldk(lptr p) { return *(const LAS bf16x8*)p; }
__device__ __forceinline__ s16x4 vtr(lptr p) { return __builtin_bit_cast(s16x4, __builtin_amdgcn_ds_read_tr16_b64_v4i16((LAS v4i16_t*)p)); }
__device__ __forceinline__ int v_st(int k, int c) { const int kk = (k & ~0xC) | ((k & 4) << 1) | ((k & 8) >> 1); return ((kk >> 3) * 4 + (c >> 5)) * 512 + ((kk & 7) * 32 + (c & 31)) * 2; }
__device__ __forceinline__ int v_rd_base(int lane) { return ((lane & 3) << 3) | (((lane >> 2) & 3) << 6) | (((lane >> 4) & 1) << 5) | (((lane >> 5) & 1) << 8); }
__device__ __forceinline__ bf16x8 pk4(float a0, float a1, float a2, float a3, float a4, float a5, float a6, float a7) {
  const unsigned x0 = cvt_pk_bf16(a0, a1), x1 = cvt_pk_bf16(a2, a3), y0 = cvt_pk_bf16(a4, a5), y1 = cvt_pk_bf16(a6, a7);
  auto r0 = __builtin_amdgcn_permlane32_swap(x0, y0, false, false); auto r1 = __builtin_amdgcn_permlane32_swap(x1, y1, false, false);
  u32x4 w = {r0[0], r1[0], r0[1], r1[1]}; return __builtin_bit_cast(bf16x8, w);
}
constexpr int PD = 2;
constexpr int KP8 = 144;
template <bool R8> __device__ __forceinline__ bf16x8 kfrag(lptr kb, int n) { const int d0 = n >> 1, h = n & 1; return R8 ? ldk(kb + h * (32 * KP8) + d0 * 32) : ldk(kb + h * (32 * 272) + d0 * 32); }
typedef int v8i32_t __attribute__((ext_vector_type(8)));
__device__ __forceinline__ v8i32_t cat8(const bf16x8 a, const bf16x8 b) { return __builtin_bit_cast(v8i32_t, __builtin_shufflevector(__builtin_bit_cast(u32x4, a), __builtin_bit_cast(u32x4, b), 0, 1, 2, 3, 4, 5, 6, 7)); }
template <int NQ, bool DO_QK, bool DO_FIN>
__device__ __forceinline__ void phaseA(f32x16& C0, f32x16& C1, const f32x16& P0, const f32x16& P1, float alphaP, float& l_reg, bf16x8 (&pa)[4],
                                       lptr kb, lptr pb, const bf16x8 (&q0)[2], const bf16x8 (&q1)[2], const bf16x8 (&rq)[2], const bf16x8 (&qr)[8]) {
  constexpr bool R8 = NQ > 8;
  constexpr int NN = R8 ? 0 : 16, NF = R8 ? 6 : 16;
  float s0 = 0.f, s1 = 0.f, s2 = 0.f, s3 = 0.f;
  bf16x8 f[NN + PD]; bf16x8 fa[6][2]; u32x4 pw[2] = {};
  auto afrag = [&](int i, bf16x8 (&d)[2]) { const int blk = i >> 1, h = i & 1; const lptr p = blk < 2 ? kb + h * (32 * KP8) + blk * 64 : pb + h * (32 * PPITCH); d[0] = ldk(p); d[1] = ldk(p + 16); };
  if (DO_QK) {
    if (R8) { afrag(0, fa[0]); afrag(1, fa[1]); }
    else {
#pragma unroll
      for (int n = 0; n < PD; ++n) f[n] = kfrag<false>(kb, n);
    }
  }
#pragma unroll
  for (int n = 0; n < NF; ++n) {
    if (DO_QK) {
      if (R8) {
        if (n + 2 < 6) afrag(n + 2, fa[n + 2]);
        const int blk = n >> 1;
        const v8i32_t b = blk == 0 ? cat8(q0[0], q0[1]) : blk == 1 ? cat8(q1[0], q1[1]) : cat8(rq[0], rq[1]);
        const v8i32_t a = cat8(fa[n][0], fa[n][1]);
        if (n == 0)            C0 = __builtin_amdgcn_mfma_scale_f32_32x32x64_f8f6f4(a, b, f32x16{}, 0, 0, 0, 0x7F7F7F7F, 0, 0x7F7F7F7F);
        else if (n == 1)       C1 = __builtin_amdgcn_mfma_scale_f32_32x32x64_f8f6f4(a, b, f32x16{}, 0, 0, 0, 0x7F7F7F7F, 0, 0x7F7F7F7F);
        else if ((n & 1) == 0) C0 = __builtin_amdgcn_mfma_scale_f32_32x32x64_f8f6f4(a, b, C0, 0, 0, 0, 0x7F7F7F7F, 0, 0x7F7F7F7F);
        else                   C1 = __builtin_amdgcn_mfma_scale_f32_32x32x64_f8f6f4(a, b, C1, 0, 0, 0, 0x7F7F7F7F, 0, 0x7F7F7F7F);
      } else {
        if (n + PD < NN) f[n + PD] = kfrag<false>(kb, n + PD);
        const bf16x8 qf = qr[n >> 1];
        if (n == 0)            C0 = __builtin_amdgcn_mfma_f32_32x32x16_bf16(f[n], qf, f32x16{}, 0, 0, 0);
        else if (n == 1)       C1 = __builtin_amdgcn_mfma_f32_32x32x16_bf16(f[n], qf, f32x16{}, 0, 0, 0);
        else if ((n & 1) == 0) C0 = __builtin_amdgcn_mfma_f32_32x32x16_bf16(f[n], qf, C0, 0, 0, 0);
        else                   C1 = __builtin_amdgcn_mfma_f32_32x32x16_bf16(f[n], qf, C1, 0, 0, 0);
      }
    }
    if (DO_FIN) {
#pragma unroll
      for (int e = n * 32 / NF; e < (n + 1) * 32 / NF; ++e) { const float v = e < 16 ? P0[e & 15] : P1[e & 15]; if ((e & 3) == 0) s0 += v; else if ((e & 3) == 1) s1 += v; else if ((e & 3) == 2) s2 += v; else s3 += v; }
      PIN(s0); PIN(s1); PIN(s2); PIN(s3);
      if (R8) {
        if (n == NF / 8 || n == 3 * NF / 8 || n == 5 * NF / 8 || n == 7 * NF / 8) {
          const int m = (n == NF / 8) ? 0 : (n == 3 * NF / 8) ? 1 : (n == 5 * NF / 8) ? 2 : 3;
          const unsigned X = pk_fp8x4(P0[4 * m], P0[4 * m + 1], P0[4 * m + 2], P0[4 * m + 3]), Y = pk_fp8x4(P1[4 * m], P1[4 * m + 1], P1[4 * m + 2], P1[4 * m + 3]);
          auto r = __builtin_amdgcn_permlane32_swap(X, Y, false, false);
          pw[m >> 1][2 * (m & 1)] = r[0]; pw[m >> 1][2 * (m & 1) + 1] = r[1]; PIN(pw[m >> 1]);
          if (m == 1) pa[0] = __builtin_bit_cast(bf16x8, pw[0]);
          if (m == 3) pa[1] = __builtin_bit_cast(bf16x8, pw[1]);
        }
      } else {
      if (n == NF / 8)     { pa[0] = pk4(P0[0], P0[1], P0[2], P0[3], P0[4], P0[5], P0[6], P0[7]); PIN(pa[0]); }
      if (n == 3 * NF / 8) { pa[1] = pk4(P0[8], P0[9], P0[10], P0[11], P0[12], P0[13], P0[14], P0[15]); PIN(pa[1]); }
      if (n == 5 * NF / 8) { pa[2] = pk4(P1[0], P1[1], P1[2], P1[3], P1[4], P1[5], P1[6], P1[7]); PIN(pa[2]); }
      if (n == 7 * NF / 8) { pa[3] = pk4(P1[8], P1[9], P1[10], P1[11], P1[12], P1[13], P1[14], P1[15]); PIN(pa[3]); }
      }
    }
    SBAR();
  }
  if (DO_FIN) { float ps = (s0 + s1) + (s2 + s3); auto rr = __builtin_amdgcn_permlane32_swap(__float_as_uint(ps), __float_as_uint(ps), false, false);
    ps = __uint_as_float(rr[0]) + __uint_as_float(rr[1]); l_reg = l_reg * alphaP + ps; }
}
template <bool R8, bool MASK, bool DO_PV, bool DO_SM>
__device__ __forceinline__ void phaseB(f32x16 (&o)[4], const bf16x8 (&pa)[4], f32x16& C0, f32x16& C1, float& m_reg, float& alpha, lptr vb, float Cs, float thr_raw, int qi, int k0, int hi) {
  s16x4 vl[16 + PD], vh[16 + PD]; bf16x8 fa[4][2];
  if (DO_PV && !R8) {
#pragma unroll
    for (int n = 0; n < PD; ++n) { const int d0 = n & 3, ks = n >> 2; vl[n] = vtr(vb + d0 * 512 + ks * 4096); vh[n] = vtr(vb + d0 * 512 + ks * 4096 + 2048); }
  }
  if (DO_PV && R8) { fa[0][0] = ldk(vb); fa[0][1] = ldk(vb + 16); }
  float mx = -3.0e38f, mnC = 0.f;
#pragma unroll
  for (int n = 0; n < 16; ++n) {
    if (DO_PV && R8) {
      if ((n & 3) == 1 && n < 12) { const int db = (n >> 2) + 1; fa[db][0] = ldk(vb + db * 32 * VPITCH); fa[db][1] = ldk(vb + db * 32 * VPITCH + 16); }
      if ((n & 3) == 0) { const int db = n >> 2; o[db] = __builtin_amdgcn_mfma_scale_f32_32x32x64_f8f6f4(cat8(fa[db][0], fa[db][1]), cat8(pa[0], pa[1]), o[db], 0, 0, 0, 0x7F7F7F7F, 0, 0x7F7F7F7F); }
    }
    if (DO_PV && !R8) {
      const int d0 = n & 3, ks = n >> 2;
      if (n + PD < 16) { const int d1 = (n + PD) & 3, k1 = (n + PD) >> 2; vl[n + PD] = vtr(vb + d1 * 512 + k1 * 4096); vh[n + PD] = vtr(vb + d1 * 512 + k1 * 4096 + 2048); }
      const bf16x8 vf = (bf16x8){vl[n][0], vl[n][1], vl[n][2], vl[n][3], vh[n][0], vh[n][1], vh[n][2], vh[n][3]};
      o[d0] = __builtin_amdgcn_mfma_f32_32x32x16_bf16(pa[ks], vf, o[d0], 0, 0, 0);
    }
    if (DO_SM) {
      if (n < 4) {
#pragma unroll
        for (int e = n * 8; e < n * 8 + 8; ++e) {
          if (MASK) { const int d = qi - (k0 + (e < 16 ? 0 : 32) + crow(e & 15, hi)); if (d > 128 || d < -128) { if (e < 16) C0[e & 15] = -1e30f; else C1[e & 15] = -1e30f; } }
          mx = fmaxf(mx, e < 16 ? C0[e & 15] : C1[e & 15]); }
        PIN(mx);
      } else if (n == 4) {
        auto rr = __builtin_amdgcn_permlane32_swap(__float_as_uint(mx), __float_as_uint(mx), false, false);
        const float pmax = fmaxf(__uint_as_float(rr[0]), __uint_as_float(rr[1]));
        const bool keep = __all(pmax - m_reg <= thr_raw);
        const float mn = keep ? m_reg : fmaxf(m_reg, pmax);
        alpha = __builtin_amdgcn_exp2f((m_reg - mn) * Cs); m_reg = mn; mnC = -mn * Cs + (R8 ? PK8 : 0.f); PIN(alpha); PIN(mnC);
      } else {
#pragma unroll
        for (int e = (n - 5) * 32 / 11; e < (n - 4) * 32 / 11; ++e) {
          if (e < 16) C0[e] = __builtin_amdgcn_exp2f(fmaf(C0[e], Cs, mnC)); else C1[e - 16] = __builtin_amdgcn_exp2f(fmaf(C1[e - 16], Cs, mnC)); }
        if ((n - 5) * 32 / 11 < 16) PIN(C0); if ((n - 4) * 32 / 11 > 16) PIN(C1);
      }
    }
    SBAR();
  }
}

template <int DQK, bool MASK, int LDQ, int LDK, int LDP, int LDV, int LDO>
__device__ __forceinline__ void attn_body(const bf16_t* __restrict__ Qb, const bf16_t* __restrict__ Kb, const unsigned char* __restrict__ Kn8, const bf16_t* __restrict__ Pb, const bf16_t* __restrict__ Vb,
                                          bf16_t* __restrict__ Ob, float* __restrict__ ssq, int q0, int kstart, int NT, float scale, float sink_raw, LAS char* lds) {
  constexpr int NQ = DQK / 16;
  constexpr bool R8 = NQ > 8;
  const float Cs = scale * 1.4426950408889634f, thr_raw = (R8 ? THR8 : THR) / scale;
  const int tid = tid_opaque(), wid = tid >> 6, lane = tid & 63, r32 = lane & 31, hi = lane >> 5;
  LAS char* V_lds = lds + OFF_V; LAS char* K_lds = lds + OFF_K; LAS char* P_lds = lds + OFF_P;
  LAS float* ws = (LAS float*)(lds + OFF_WS) + wid * 64; LAS float* li_l = ws; LAS float* al_l = ws + 32;
  float m_reg = MASK ? sink_raw : -1e30f, l_reg = MASK ? 1.f : 0.f; f32x16 o[4] = {}; bf16x8 qr[8];
  const bf16_t* Qw = Qb + (long)(wid * QBLK + r32) * LDQ + hi * 8;
  LAS char* Qp = lds + OFF_QP + wid * 4096 + lane * 16;
  if (NQ <= 8) {
#pragma unroll
    for (int d0 = 0; d0 < 8; ++d0) qr[d0] = *reinterpret_cast<const bf16x8*>(Qw + d0 * 16);
  }
  bf16x8 rq[2] = {}, qa0[2] = {}, qa1[2] = {}, qb0[2] = {}, qb1[2] = {};
  if (NQ > 8) {
    const unsigned char* q8 = (const unsigned char*)(Qb + (long)(wid * QBLK + r32) * LDQ) + hi * 32;
    rq[0]  = *reinterpret_cast<const bf16x8*>(q8 + 256); rq[1]  = *reinterpret_cast<const bf16x8*>(q8 + 272);
    qa0[0] = *reinterpret_cast<const bf16x8*>(q8 + 320); qa0[1] = *reinterpret_cast<const bf16x8*>(q8 + 336);
    qa1[0] = *reinterpret_cast<const bf16x8*>(q8 + 128); qa1[1] = *reinterpret_cast<const bf16x8*>(q8 + 144);
    qb0[0] = *reinterpret_cast<const bf16x8*>(q8);       qb0[1] = *reinterpret_cast<const bf16x8*>(q8 + 16);
    qb1[0] = *reinterpret_cast<const bf16x8*>(q8 + 64);  qb1[1] = *reinterpret_cast<const bf16x8*>(q8 + 80);
  }
  const int sr = tid >> 4, sc = (tid & 15) * 8, vst0 = v_st(sr, sc), vst1 = v_st(32 + sr, sc);
  const int pr = tid >> 3, pc = (tid & 7) * 8;
  const lptr kb0 = R8 ? (lptr)K_lds + r32 * KP8 + hi * 32 : (lptr)K_lds + r32 * 272 + hi * 16, pb0 = (lptr)P_lds + r32 * PPITCH + hi * 32, vb0 = R8 ? (lptr)V_lds + r32 * VPITCH + hi * 32 : (lptr)V_lds + v_rd_base(lane);
  const int qi = q0 + wid * QBLK + r32;
  bf16x8 vs0, vs1, ks0, ks1; u32x2 ps0;
  const unsigned voff0 = sr * LDV + sc, voff1 = (32 + sr) * LDV + sc, koff0 = sr * LDK + sc, koff1 = (32 + sr) * LDK + sc, poff = pr * LDP + pc, voff8 = (unsigned)(tid >> 2) * LDV + (tid & 3) * 16, koff8 = pr * LDK + 64 + pc;
#define SLOAD(k0) do { const bf16_t* Kt = Kb + (long)(k0) * LDK; \
    if (R8) { vs0 = *reinterpret_cast<const bf16x8*>((const unsigned char*)Vb + (long)(k0) + voff8); } \
    else { const bf16_t* Vt = Vb + (long)(k0) * LDV; vs0 = *reinterpret_cast<const bf16x8*>(Vt + voff0); vs1 = *reinterpret_cast<const bf16x8*>(Vt + voff1); } \
    if (R8) { ks0 = *reinterpret_cast<const bf16x8*>(Kn8 + (long)((k0) + pr) * 1024 + pc * 2); } \
    else { ks0 = *reinterpret_cast<const bf16x8*>(Kt + koff0); ks1 = *reinterpret_cast<const bf16x8*>(Kt + koff1); } \
    if (NQ > 8) { const unsigned char* Pt = (const unsigned char*)Pb + (long)(k0) * LDP; ps0 = *reinterpret_cast<const u32x2*>(Pt + poff); } } while (0)
#define SWRITE(kb_, vo_) do { if (R8) { *(LAS bf16x8*)(V_lds + (vo_) + (tid >> 2) * VPITCH + (tid & 3) * 16) = vs0; } else { *(LAS bf16x8*)(V_lds + (vo_) + vst0) = vs0; *(LAS bf16x8*)(V_lds + (vo_) + vst1) = vs1; } \
    if (R8) { *(LAS bf16x8*)(K_lds + (kb_) * SHM_K + pr * KP8 + pc * 2) = ks0; } \
    else { *(LAS bf16x8*)(K_lds + (kb_) * SHM_K + sr * 272 + sc * 2) = ks0; *(LAS bf16x8*)(K_lds + (kb_) * SHM_K + (32 + sr) * 272 + sc * 2) = ks1; } \
    if (NQ > 8) *(LAS u32x2*)(P_lds + (kb_) * SHM_P + pr * PPITCH + pc) = ps0; } while (0)
#define SWAIT() asm volatile("s_waitcnt vmcnt(0)" ::: "memory")
#define RESC(a) do { if (__any((a) < 1.f)) { if (R8) { _Pragma("unroll") for (int d = 0; d < 4; ++d) o[d] *= (a); } else { if (hi == 0) al_l[r32] = (a); asm volatile("s_waitcnt lgkmcnt(0)" ::: "memory"); \
    _Pragma("unroll") for (int d = 0; d < 4; ++d) _Pragma("unroll") for (int r = 0; r < 16; ++r) o[d][r] *= al_l[crow(r, hi)]; } } } while (0)
#define ROTV() do { const int t_ = vprev; vprev = vcur; vcur = vnext; vnext = t_; } while (0)
  f32x16 pA0, pA1, pB0, pB1; float alA = 1.f, alB = 1.f; bf16x8 pa[4];
  int vprev = 0, vcur = SHM_V, vnext = 2 * SHM_V;
  SLOAD(kstart); SWAIT(); SWRITE(0, 0); __syncthreads();
  SLOAD(kstart + KVBLK);
  phaseA<NQ, true, false>(pA0, pA1, pA0, pA1, 1.f, l_reg, pa, kb0, pb0, qa0, qa1, rq, qr);
  SWAIT(); SWRITE(1, SHM_V);
  phaseB<R8, MASK, false, true>(o, pa, pA0, pA1, m_reg, alA, vb0, Cs, thr_raw, qi, kstart, hi);
  __syncthreads();
  for (int j = 1; j + 1 < NT; j += 2) {
    SBAR(); SLOAD(kstart + (j + 1) * KVBLK); SBAR();
    phaseA<NQ, true, true>(pB0, pB1, pA0, pA1, alA, l_reg, pa, kb0 + SHM_K, pb0 + SHM_P, qb0, qb1, rq, qr);
    SWAIT(); SWRITE(0, vnext);
    phaseB<R8, MASK, true, true>(o, pa, pB0, pB1, m_reg, alB, vb0 + vprev, Cs, thr_raw, qi, kstart + j * KVBLK, hi);
    RESC(alB); ROTV(); __syncthreads();
    SBAR(); if (j + 2 < NT) SLOAD(kstart + (j + 2) * KVBLK); SBAR();
    phaseA<NQ, true, true>(pA0, pA1, pB0, pB1, alB, l_reg, pa, kb0, pb0, qa0, qa1, rq, qr);
    if (j + 2 < NT) { SWAIT(); SWRITE(1, vnext); }
    phaseB<R8, MASK, true, true>(o, pa, pA0, pA1, m_reg, alA, vb0 + vprev, Cs, thr_raw, qi, kstart + (j + 1) * KVBLK, hi);
    RESC(alA); ROTV(); __syncthreads();
  }
  SBAR(); phaseA<NQ, true, true>(pB0, pB1, pA0, pA1, alA, l_reg, pa, kb0 + SHM_K, pb0 + SHM_P, qb0, qb1, rq, qr);
  phaseB<R8, MASK, true, true>(o, pa, pB0, pB1, m_reg, alB, vb0 + vprev, Cs, thr_raw, qi, kstart + (NT - 1) * KVBLK, hi);
  RESC(alB); ROTV();
  phaseA<NQ, false, true>(pA0, pA1, pB0, pB1, alB, l_reg, pa, kb0, pb0, qa0, qa1, rq, qr);
  phaseB<R8, MASK, true, false>(o, pa, pA0, pA1, m_reg, alA, vb0 + vprev, Cs, thr_raw, qi, 0, hi);
  if (R8) {
    const float rl = __builtin_amdgcn_rcpf(l_reg); float sq = 0.f; bf16_t* Orow = Ob + (long)(wid * QBLK + r32) * LDO + 4 * hi;
#pragma unroll
    for (int db = 0; db < 4; ++db)
#pragma unroll
      for (int g = 0; g < 4; ++g) { const float v0 = o[db][4 * g] * rl, v1 = o[db][4 * g + 1] * rl, v2 = o[db][4 * g + 2] * rl, v3 = o[db][4 * g + 3] * rl; sq += (v0 * v0 + v1 * v1) + (v2 * v2 + v3 * v3);
        u32x2 w; w.x = cvt_pk_bf16(v0, v1); w.y = cvt_pk_bf16(v2, v3); *(u32x2*)(Orow + db * 32 + 8 * g) = w; }
    auto rr = __builtin_amdgcn_permlane32_swap(__float_as_uint(sq), __float_as_uint(sq), false, false); sq = __uint_as_float(rr[0]) + __uint_as_float(rr[1]);
    if (hi == 0) ssq[(long)(wid * QBLK + r32) * 16] = sq;
  } else {
  if (hi == 0) li_l[r32] = l_reg; asm volatile("s_waitcnt lgkmcnt(0)" ::: "memory");
  bf16_t* Ow = Ob + (long)(wid * QBLK) * LDO;
#pragma unroll
  for (int r = 0; r < 16; ++r) { const int orow = crow(r, hi); const float rl = __builtin_amdgcn_rcpf(li_l[orow]); float sq = 0.f;
#pragma unroll
    for (int d0 = 0; d0 < 4; ++d0) { const float v = o[d0][r] * rl; sq += v * v; Ow[(long)orow * LDO + d0 * 32 + r32] = (bf16_t)(cvt_pk_bf16(v, v) & 0xffffu); }
#pragma unroll
    for (int s = 1; s < 32; s <<= 1) sq += __shfl_xor(sq, s);
    if (r32 == 0) ssq[(long)(wid * QBLK + orow) * 16] = sq; }
  }
  __syncthreads();
#undef SLOAD
#undef SWRITE
#undef SWAIT
#undef RESC
#undef ROTV
}
#undef SBAR
#undef PIN
}

constexpr int NWAVES = 8;
#ifndef PROBE_ATT
#define PROBE_ATT 1
#endif
#ifndef PROBE_PRO
#define PROBE_PRO 1
#endif
#ifndef PROBE_MOEUP
#define PROBE_MOEUP 1
#endif
constexpr int RING_BYTES = 133120;
constexpr int MISC_OFF = 139264, LDS_BYTES = 147456;
static_assert(att::SHM_ATTN <= MISC_OFF && RING_BYTES <= MISC_OFF, "LDS map");
constexpr int NPHASE = 21;

__device__ const float INVF[64] = {
 1.000000000e+00f, 8.659643531e-01f, 7.498942018e-01f, 6.493816376e-01f, 5.623413324e-01f, 4.869675338e-01f, 4.216965139e-01f, 3.651741147e-01f, 3.162277639e-01f, 2.738419771e-01f, 2.371373773e-01f, 2.053525001e-01f, 1.778279394e-01f, 1.539926529e-01f, 1.333521456e-01f, 1.154781953e-01f,
 1.000000015e-01f, 8.659642935e-02f, 7.498942316e-02f, 6.493816525e-02f, 5.623413250e-02f, 4.869675264e-02f, 4.216964915e-02f, 3.651741147e-02f, 3.162277490e-02f, 2.738419548e-02f, 2.371373773e-02f, 2.053525113e-02f, 1.778279431e-02f, 1.539926510e-02f, 1.333521400e-02f, 1.154781971e-02f,
 9.999999776e-03f, 8.659643121e-03f, 7.498942316e-03f, 6.493816152e-03f, 5.623413250e-03f, 4.869675264e-03f, 4.216964822e-03f, 3.651741194e-03f, 3.162277630e-03f, 2.738419687e-03f, 2.371373819e-03f, 2.053525066e-03f, 1.778279431e-03f, 1.539926510e-03f, 1.333521446e-03f, 1.154782018e-03f,
 1.000000047e-03f, 8.659643354e-04f, 7.498941850e-04f, 6.493816036e-04f, 5.623413017e-04f, 4.869675322e-04f, 4.216965172e-04f, 3.651741135e-04f, 3.162277571e-04f, 2.738419571e-04f, 2.371373703e-04f, 2.053525095e-04f, 1.778279402e-04f, 1.539926598e-04f, 1.333521504e-04f, 1.154782003e-04f };

struct Args { const float* in[21]; float* out; unsigned char* ws; int ph_lo, ph_hi; };

__device__ __forceinline__ float wave_sum(float v) {
#pragma unroll
    for (int o = 1; o < 64; o <<= 1) v += __shfl_xor(v, o);
    return v;
}
__device__ __forceinline__ void sincos_acc(float ang, float& sn, float& cs) {
    const double a = (double)ang;
    const double n = __builtin_rint(a * 0.63661977236758134308);
    double r = __builtin_fma(-n, 1.57079632679489655800, a); r = __builtin_fma(-n, 6.12323399573676603587e-17, r);
    const double r2 = r * r;
    double sp = 1.0 / 6227020800.0; sp = __builtin_fma(sp, r2, -1.0 / 39916800.0); sp = __builtin_fma(sp, r2, 1.0 / 362880.0); sp = __builtin_fma(sp, r2, -1.0 / 5040.0);
    sp = __builtin_fma(sp, r2, 1.0 / 120.0); sp = __builtin_fma(sp, r2, -1.0 / 6.0); sp = __builtin_fma(sp * r2, r, r);
    double cp = 1.0 / 479001600.0; cp = __builtin_fma(cp, r2, -1.0 / 3628800.0); cp = __builtin_fma(cp, r2, 1.0 / 40320.0); cp = __builtin_fma(cp, r2, -1.0 / 720.0);
    cp = __builtin_fma(cp, r2, 1.0 / 24.0); cp = __builtin_fma(cp, r2, -0.5); cp = __builtin_fma(cp, r2, 1.0);
    const int q = ((int)n) & 3;
    const double s_ = (q & 1) ? cp : sp, c_ = (q & 1) ? sp : cp;
    sn = (float)((q & 2) ? -s_ : s_); cs = (float)(((q + 1) & 2) ? -c_ : c_);
}

__device__ __forceinline__ int src_quad(int kind, int n, int coff) {
    if (kind == 0) return coff + n;
    if (kind == 1) {
        if (n < 768 || (n >= 2112 && n < 2368)) return n;
        if (n >= 2368) return -1;
        int base, half, j;
        if (n < 832) { base = 768; half = 32; j = n - 768; } else if (n < 1856) { j = (n - 832) & 127; base = n - j; half = 64; } else { j = (n - 1856) & 127; base = n - j; half = 64; }
        const int g = j >> 3, e = j & 7; return base + (e < 4 ? 4 * g : half + 4 * g);
    }
    { const int head = n / 192, j = n - head * 192; if (j < 128) return n; const int jj = j - 128, g = jj >> 3, e = jj & 7; return head * 192 + 128 + (e < 4 ? 4 * g : 32 + 4 * g); }
}
__device__ __forceinline__ void tr_item(const float* __restrict__ src, int Nsrc, int K, bf16_t* __restrict__ dst, int k0, int n0, int kind, int coff,
                                        const float* __restrict__ gain, const float* __restrict__ gain2, LAS unsigned* scr, int lane) {
    const int nl = 4 * (lane & 15), ks = lane >> 4;
    const int sq = src_quad(kind, n0 + nl, coff);
#pragma unroll 4
    for (int r = 0; r < 16; ++r) {
        const int k = k0 + 8 * r + 2 * ks;
        f32x4 a = (f32x4){0.f, 0.f, 0.f, 0.f}, b = a;
        if (sq >= 0) { a = *(const f32x4*)(src + (size_t)k * Nsrc + sq); b = *(const f32x4*)(src + (size_t)(k + 1) * Nsrc + sq); }
        if (gain) { const float ga = (gain2 && k >= 1024) ? gain2[k - 1024] : gain[k], gb = (gain2 && k + 1 >= 1024) ? gain2[k + 1 - 1024] : gain[k + 1]; a *= ga; b *= gb; }
#pragma unroll
        for (int j = 0; j < 4; ++j) scr[(nl + j) * 65 + 4 * r + ks] = cvt_pk_bf16(a[j], b[j]);
    }
    asm volatile("s_waitcnt lgkmcnt(0)" ::: "memory");
#pragma unroll 4
    for (int it = 0; it < 16; ++it) {
        const int row = it * 4 + (lane >> 4), ch = lane & 15;
        const LAS unsigned* p = scr + row * 65 + 4 * ch;
        u32x4 w; w.x = p[0]; w.y = p[1]; w.z = p[2]; w.w = p[3];
        *(u32x4*)(dst + (size_t)(n0 + row) * K + k0 + 8 * ch) = w;
    }
    asm volatile("s_waitcnt lgkmcnt(0)" ::: "memory");
}
__device__ __forceinline__ void tr_item8(const float* __restrict__ src, int Nsrc, int K, unsigned char* __restrict__ dst, int k0, int n0, int scol, float scale, LAS unsigned* scr, int lane) {
    const int nl = 4 * (lane & 15), ks = lane >> 4;
#pragma unroll 4
    for (int r = 0; r < 16; ++r) {
        const int k = k0 + 16 * r + 4 * ks; const float* p = src + (size_t)k * Nsrc + scol + nl;
        const f32x4 a = *(const f32x4*)p * scale, b = *(const f32x4*)(p + Nsrc) * scale, c = *(const f32x4*)(p + 2 * (size_t)Nsrc) * scale, d = *(const f32x4*)(p + 3 * (size_t)Nsrc) * scale;
#pragma unroll
        for (int j = 0; j < 4; ++j) scr[(nl + j) * 65 + 4 * r + ks] = pk_fp8x4(a[j], b[j], c[j], d[j]);
    }
    asm volatile("s_waitcnt lgkmcnt(0)" ::: "memory");
#pragma unroll 4
    for (int it = 0; it < 16; ++it) {
        const int row = it * 4 + (lane >> 4), ch = lane & 15;
        const LAS unsigned* p = scr + row * 65 + 4 * ch;
        u32x4 w; w.x = p[0]; w.y = p[1]; w.z = p[2]; w.w = p[3];
        *(u32x4*)(dst + (size_t)(n0 + row) * K + k0 + 16 * ch) = w;
    }
    asm volatile("s_waitcnt lgkmcnt(0)" ::: "memory");
}
__device__ __forceinline__ void tr_item6(const float* __restrict__ src, int Nsrc, unsigned char* __restrict__ dst, int t, int n0, int scol, LAS unsigned* scr, int lane) {
    const int nl = 4 * (lane & 15), ks = lane >> 4;
    f32x4 a[16], b[16];
#pragma unroll
    for (int r = 0; r < 16; ++r) {
        const int kk = 8 * r + 2 * ks, k = 16 * t + 256 * (kk >> 4) + (kk & 15); const float* p = src + (size_t)k * Nsrc + scol + nl;
        a[r] = __builtin_nontemporal_load((const f32x4*)p); b[r] = __builtin_nontemporal_load((const f32x4*)(p + Nsrc));
    }
#pragma unroll
    for (int r = 0; r < 16; ++r) {
#pragma unroll
        for (int j = 0; j < 4; ++j) scr[(nl + j) * 65 + 4 * r + ks] = cvt_pk_bf16(a[r][j], b[r][j]);
    }
    asm volatile("s_waitcnt lgkmcnt(0)" ::: "memory");
#pragma unroll 1
    for (int it = 0; it < 4; ++it) {
        const int pidx = it * 64 + lane, n = pidx >> 2, g = pidx & 3;
        const LAS unsigned* p = scr + n * 65 + 2 * g;
        f32x16 lo, hi;
#pragma unroll
        for (int j = 0; j < 8; ++j) { const unsigned d0 = p[8 * j], d1 = p[8 * j + 1];
            const float x0 = __uint_as_float(d0 << 16), x1 = __uint_as_float(d0 & 0xffff0000u), x2 = __uint_as_float(d1 << 16), x3 = __uint_as_float(d1 & 0xffff0000u);
            if (j < 4) { lo[4 * j] = x0; lo[4 * j + 1] = x1; lo[4 * j + 2] = x2; lo[4 * j + 3] = x3; } else { hi[4 * (j - 4)] = x0; hi[4 * (j - 4) + 1] = x1; hi[4 * (j - 4) + 2] = x2; hi[4 * (j - 4) + 3] = x3; } }
        unsigned sb; const u32x6 q = mx6_block(lo, hi, sb);
        unsigned char* o = dst + (size_t)(n0 + n) * 2048 + t * 128 + 16 * g;
        *(u32x4*)o = (u32x4){q[0], q[1], q[2], q[3]}; *(u32x4*)(o + 64) = (u32x4){q[4], q[5], sb, 0u};
    }
    asm volatile("s_waitcnt lgkmcnt(0)" ::: "memory");
}
__device__ __forceinline__ void tr_item6c(const float* __restrict__ src, int Nsrc, int K, unsigned char* __restrict__ dst, int t, int n0, LAS unsigned* scr, int lane) {
    const int nl = 4 * (lane & 15), ks = lane >> 4;
    f32x4 a[16], b[16];
#pragma unroll
    for (int r = 0; r < 16; ++r) {
        const int k = 128 * t + 8 * r + 2 * ks; const float* p = src + (size_t)k * Nsrc + n0 + nl;
        a[r] = __builtin_nontemporal_load((const f32x4*)p); b[r] = __builtin_nontemporal_load((const f32x4*)(p + Nsrc));
    }
#pragma unroll
    for (int r = 0; r < 16; ++r) {
#pragma unroll
        for (int j = 0; j < 4; ++j) scr[(nl + j) * 65 + 4 * r + ks] = cvt_pk_bf16(a[r][j], b[r][j]);
    }
    asm volatile("s_waitcnt lgkmcnt(0)" ::: "memory");
#pragma unroll 1
    for (int it = 0; it < 4; ++it) {
        const int pidx = it * 64 + lane, n = pidx >> 2, g = pidx & 3;
        const LAS unsigned* p = scr + n * 65 + 16 * g;
        f32x16 lo, hi;
#pragma unroll
        for (int j = 0; j < 8; ++j) { const unsigned d0 = p[j], d1 = p[8 + j];
            lo[2 * j] = __uint_as_float(d0 << 16); lo[2 * j + 1] = __uint_as_float(d0 & 0xffff0000u); hi[2 * j] = __uint_as_float(d1 << 16); hi[2 * j + 1] = __uint_as_float(d1 & 0xffff0000u); }
        unsigned sb; const u32x6 q = mx6_block(lo, hi, sb);
        unsigned char* o = dst + (size_t)(n0 + n) * K + t * 128 + 16 * g;
        *(u32x4*)o = (u32x4){q[0], q[1], q[2], q[3]}; *(u32x4*)(o + 64) = (u32x4){q[4], q[5], sb, 0u};
    }
    asm volatile("s_waitcnt lgkmcnt(0)" ::: "memory");
}
__device__ __forceinline__ void tr_matrix6c(const float* src, int Nsrc, int K, unsigned char* dst, int Ndst, LAS unsigned* scr, int lane, int gw, int NGW, int& cursor) {
    const int nb = Ndst / 64, items = (K / 128) * nb;
    int it = (gw - (cursor % NGW) + NGW) % NGW;
    for (; it < items; it += NGW) tr_item6c(src, Nsrc, K, dst, it / nb, (it % nb) * 64, scr, lane);
    cursor += items;
}
__device__ __forceinline__ void tr_matrix6(const float* src, const float* src2, int Nsrc, unsigned char* dst, int Ndst, LAS unsigned* scr, int lane, int gw, int NGW, int& cursor) {
    const int nb = Ndst / 64, items = 16 * nb;
    int it = (gw - (cursor % NGW) + NGW) % NGW;
    for (; it < items; it += NGW) {
        const int t = it / nb, n0 = (it % nb) * 64, tile = n0 >> 8, j0 = n0 & 255;
        tr_item6(j0 < 128 ? src : src2, Nsrc, dst, t, n0, 128 * tile + (j0 & 127), scr, lane);
    }
    cursor += items;
}
__device__ __forceinline__ void tr_matrix8(const float* src, const float* src2, int Nsrc, int K, unsigned char* dst, int Ndst, int inter, float scale, LAS unsigned* scr, int lane, int gw, int NGW, int& cursor) {
    const int nb = Ndst / 64, items = (K / 256) * nb;
    int it = (gw - (cursor % NGW) + NGW) % NGW;
    for (; it < items; it += NGW) {
        const int kb = it / nb, n0 = (it % nb) * 64;
        if (inter) { const int tile = n0 >> 8, j0 = n0 & 255; tr_item8(j0 < 128 ? src : src2, Nsrc, K, dst, kb * 256, n0, 128 * tile + (j0 & 127), scale, scr, lane); }
        else tr_item8(src, Nsrc, K, dst, kb * 256, n0, n0, scale, scr, lane);
    }
    cursor += items;
}
__device__ __forceinline__ void tr_matrix(const float* src, const float* src2, int Nsrc, int K, bf16_t* dst, int Ndst, int kind, const float* gain, const float* gain2,
                                          LAS unsigned* scr, int lane, int gw, int NGW, int& cursor) {
    const int nb = Ndst / 64, items = (K / 128) * nb;
    int it = (gw - (cursor % NGW) + NGW) % NGW;
    for (; it < items; it += NGW) {
        const int kb = it / nb, n0 = (it % nb) * 64;
        if (kind == 3) { const int tile = n0 >> 8, j0 = n0 & 255; tr_item(j0 < 128 ? src : src2, Nsrc, K, dst, kb * 128, n0, 0, 128 * tile + (j0 & 127) - n0, nullptr, nullptr, scr, lane); }
        else tr_item(src, Nsrc, K, dst, kb * 128, n0, kind, 0, gain, gain2, scr, lane);
    }
    cursor += items;
}

constexpr int MOE_GU_ITEMS = 16 * (2 * FFE / 64), MOE_D_ITEMS = (FFE / 128) * (D / 64), MOE_E_ITEMS = MOE_GU_ITEMS + MOE_D_ITEMS, MOE_ITEMS = NE * MOE_E_ITEMS;
__device__ __forceinline__ void moe_conv_item(const Args& args, int j, LAS unsigned* scr, int lane) {
    const int e = j / MOE_E_ITEMS, r = j - e * MOE_E_ITEMS;
    if (r < MOE_GU_ITEMS) {
        constexpr int nb = 2 * FFE / 64;
        const int t = r / nb, n0 = (r % nb) * 64, tile = n0 >> 8, j0 = n0 & 255;
        tr_item6((j0 < 128 ? args.in[16] : args.in[17]) + (size_t)e * D * FFE, FFE, args.ws + WS_WMGU + (size_t)e * 2 * FFE * D, t, n0, 128 * tile + (j0 & 127), scr, lane);
    } else {
        const int r2 = r - MOE_GU_ITEMS, t = r2 / (D / 64), n0 = (r2 % (D / 64)) * 64;
        tr_item6c(args.in[18] + (size_t)e * FFE * D, D, FFE, args.ws + WS_WMD + (size_t)e * D * FFE, t, n0, scr, lane);
    }
}
__device__ __forceinline__ void moe_conv_burst(const Args& args, LAS unsigned char* lds, int part, int nparts) {
    const int tid = tid_opaque(), lane = tid & 63, wave = tid >> 6, gw = blockIdx.x * NWAVES + wave, NGW = gridDim.x * NWAVES;
    LAS unsigned* scr = (LAS unsigned*)(lds + wave * 16640);
    const int per = (MOE_ITEMS + NGW - 1) / NGW, i0 = per * part / nparts, i1 = per * (part + 1) / nparts;
    __syncthreads();
    for (int i = i0; i < i1; ++i) { const int j = gw + i * NGW; if (j < MOE_ITEMS) moe_conv_item(args, j, scr, lane); }
    __syncthreads();
}

__device__ __forceinline__ void ln_row(f32x4 (&v)[8], const float* __restrict__ g, const float* __restrict__ b, int lane, float& mean_o, float& rstd_o) {
    float s = 0.f;
#pragma unroll
    for (int j = 0; j < 8; ++j) s += (v[j][0] + v[j][1]) + (v[j][2] + v[j][3]);
    const float mean = wave_sum(s) * (1.f / D); float s2 = 0.f;
#pragma unroll
    for (int j = 0; j < 8; ++j) { v[j] = v[j] - mean; s2 += (v[j][0] * v[j][0] + v[j][1] * v[j][1]) + (v[j][2] * v[j][2] + v[j][3] * v[j][3]); }
    const float rstd = 1.f / sqrtf(wave_sum(s2) * (1.f / D) + LN_EPS); mean_o = mean; rstd_o = rstd;
#pragma unroll
    for (int j = 0; j < 8; ++j) { const f32x4 gg = *((const f32x4*)g + lane + 64 * j), bb = *((const f32x4*)b + lane + 64 * j); v[j] = v[j] * rstd * gg + bb; }
}

#define WSP(T, off) ((T*)(args.ws + (off)))
#define IN(k) (lo <= (k) && (k) < hi)
#define SEAM(k) do { if (IN(k) && IN((k) + 1)) { XcdBarrier b_; b_.bar = WSP(unsigned, WS_CTL) + CW_BAR; b_.x = xb_xcc_id(); b_.st = (volatile LAS unsigned*)(lds + MISC_OFF) + 8; xcd_barrier(b_); } } while (0)

__device__ __forceinline__ int moe_unit_table(const int* moemeta, int NT, LAS int* utab) {
    const int tid = tid_opaque();
    pg8::MoeOrder Mo;
#pragma unroll
    for (int e = 0; e <= NE; ++e) Mo.pb[e] = moemeta[e];
    Mo.NT = NT; Mo.G = gridDim.x; Mo.c = blockIdx.x; Mo.nwg = Mo.pb[NE] * NT;
    if (tid < 64) { pg8::Unit u; u.pm = 0; u.pn = 0; u.aux = 0; Mo.next(tid, u); utab[4 * tid] = u.pm; utab[4 * tid + 1] = u.pn; utab[4 * tid + 2] = u.aux; }
    __syncthreads();
    const int left = Mo.nwg - Mo.c; int n = left <= 0 ? 0 : (left + Mo.G - 1) / Mo.G;
    return __builtin_amdgcn_readfirstlane(n < 64 ? n : 64);
}
__device__ __forceinline__ f32x4 tail_sum(const bf16_t* yp, int t, int d, int lane, int SK) {
    f32x4 acc = {0.f, 0.f, 0.f, 0.f};
    for (int q = 0; q < SK; ++q) { const u32x2 a = *((const u32x2*)(yp + ((size_t)(q * 128 + t - 1) * 256 + (d & 255)) * 256) + lane);
        acc += (f32x4){__uint_as_float(a.x << 16), __uint_as_float(a.x & 0xffff0000u), __uint_as_float(a.y << 16), __uint_as_float(a.y & 0xffff0000u)}; }
    return acc;
}
__device__ __forceinline__ int moe_tail_split(int nwg, int G, int& Rf, int& Tn) {
    Rf = nwg / G; Tn = nwg - Rf * G;
    return Tn == 0 ? 1 : (Tn * 7 <= G ? 7 : (Tn * 4 <= G ? 4 : (Tn * 2 <= G ? 2 : 1)));
}
__device__ __forceinline__ int moe_unit_table_k(const int* moemeta, int NT, LAS int* utab, unsigned char* tailmap) {
    const int tid = tid_opaque();
    pg8::MoeOrder Mo;
#pragma unroll
    for (int e = 0; e <= NE; ++e) Mo.pb[e] = moemeta[e];
    Mo.NT = NT; Mo.G = gridDim.x; Mo.c = blockIdx.x; Mo.nwg = Mo.pb[NE] * NT;
    int Rf, Tn; const int SK = moe_tail_split(Mo.nwg, Mo.G, Rf, Tn);
    const int R = Rf < 63 ? Rf : 63;
    const bool piece = SK > 1 ? (Mo.c < Tn * SK) : (Mo.c < Tn);
    if (tid < 64) {
        long Lq = -1; int kx = 0, mark = 0;
        if (tid < R) Lq = (long)tid * Mo.G + Mo.c;
        else if (tid == R && piece) {
            if (SK == 1) Lq = (long)Rf * Mo.G + Mo.c;
            else { const int j = Mo.c / SK, q = Mo.c - j * SK; Lq = (long)Rf * Mo.G + j; kx = (1 + j) | (q << 8) | (SK << 16); mark = (q == 0) ? 1 + j : 0; }
        }
        pg8::Unit u; u.pm = 0; u.pn = 0; u.aux = 0; u.kx = 0;
        if (Lq >= 0) Mo.at(Lq, u);
        if (mark) tailmap[u.pm * 8 + u.aux] = (unsigned char)mark;
        utab[4 * tid] = u.pm; utab[4 * tid + 1] = u.pn; utab[4 * tid + 2] = u.aux; utab[4 * tid + 3] = kx;
    }
    __syncthreads();
    return __builtin_amdgcn_readfirstlane(R + (piece ? 1 : 0));
}
template <int L>
__device__ __forceinline__ void layer_phases(const Args& args, LAS unsigned char* lds, char* lds_gen, int lo, int hi) {
    constexpr int pb = 1 + 10 * L;
    if (IN(pb + 0)) {
        const int G = gridDim.x, bx = blockIdx.x;
        pg8::Gemm g{WSP(const bf16_t, WS_XB), WSP(const bf16_t, WS_WIN + L * SZ_WIN), D}; pg8::StaticOrder So; So.init(S, 2048, G, bx);
        pg8::EpiInProj E{WSP(bf16_t, WS_CQ), WSP(bf16_t, WS_CKV), WSP(bf16_t, WS_KPE), WSP(bf16_t, WS_QS), WSP(bf16_t, WS_KS), WSP(bf16_t, WS_VS), WSP(float, WS_PARTQ), WSP(float, WS_PARTKV),
                         WSP(const float, WS_COSM), WSP(const float, WS_SINM), WSP(const float, WS_COSS), WSP(const float, WS_SINS)};
        pg8::gemm_phase<pg8::EpiInProj, pg8::StaticOrder, true, true>(lds, g, So, E);
    }
    SEAM(pb + 0);
    if (IN(pb + 1)) {
        const int G = gridDim.x, bx = blockIdx.x;
        LAS int* utab = (LAS int*)(lds + MISC_OFF + 1024);
        LAS int* ucnt = (LAS int*)(lds + MISC_OFF + 1024 + 3072);
        if (tid_opaque() == 0) {
            int nl = 0, nq = 0, nk = 0;
            if (G == 256) {
                if (bx < 128) { utab[0] = bx >> 1; utab[1] = 8 + (bx & 1); utab[2] = 8 + (bx & 1); nl = 1; utab[128] = bx >> 3; utab[129] = bx & 7; utab[130] = bx & 7; nk = 1; }
                else { const int c = bx - 128;
                    for (int i = 0; i < 3; ++i) { const int u = 3 * c + i; utab[64 + 4 * i] = u / 6; utab[65 + 4 * i] = u % 6; utab[66 + 4 * i] = u % 6; }
                    nq = 3;
                    for (int i = 0; i < 3; ++i) { const int u = 128 + 3 * c + i; utab[128 + 4 * i] = u >> 3; utab[129 + 4 * i] = u & 7; utab[130 + 4 * i] = u & 7; }
                    nk = 3; }
            } else {
                for (int u = bx; u < 128 && nl < 16; u += G, ++nl) { utab[4 * nl] = u >> 1; utab[4 * nl + 1] = 8 + (u & 1); utab[4 * nl + 2] = 8 + (u & 1); }
                for (int u = bx; u < 384 && nq < 16; u += G, ++nq) { utab[64 + 4 * nq] = u / 6; utab[65 + 4 * nq] = u % 6; utab[66 + 4 * nq] = u % 6; }
                for (int u = bx; u < 512 && nk < 16; u += G, ++nk) { utab[128 + 4 * nk] = u >> 3; utab[129 + 4 * nk] = u & 7; utab[130 + 4 * nk] = u & 7; }
            }
            ucnt[0] = nl; ucnt[1] = nq; ucnt[2] = nk;
        }
        __syncthreads();
        { pg8::TableOrder To{utab, __builtin_amdgcn_readfirstlane(ucnt[0])};
          pg8::Gemm g{WSP(const bf16_t, WS_XB), WSP(const bf16_t, WS_WIN + L * SZ_WIN), D};
          pg8::EpiInProj E{WSP(bf16_t, WS_CQ), WSP(bf16_t, WS_CKV), WSP(bf16_t, WS_KPE), WSP(bf16_t, WS_QS), WSP(bf16_t, WS_KS), WSP(bf16_t, WS_VS), WSP(float, WS_PARTQ), WSP(float, WS_PARTKV),
                           WSP(const float, WS_COSM), WSP(const float, WS_SINM), WSP(const float, WS_COSS), WSP(const float, WS_SINS)};
          pg8::gemm_phase<pg8::EpiInProj, pg8::TableOrder, true, true>(lds, g, To, E); }
        { pg8::TableOrder To{utab + 64, __builtin_amdgcn_readfirstlane(ucnt[1])};
          pg8::Gemm g{WSP(const bf16_t, WS_CQ), WSP(const bf16_t, WS_WQ + L * SZ_WQ), QLORA};
          pg8::EpiQ E{WSP(bf16_t, WS_Q), WSP(const float, WS_PARTQ), WSP(const float, WS_COSM), WSP(const float, WS_SINM)};
          pg8::gemm_phase<pg8::EpiQ, pg8::TableOrder, true, true>(lds, g, To, E); }
        { pg8::TableOrder To{utab + 128, __builtin_amdgcn_readfirstlane(ucnt[2])};
          pg8::Gemm g{WSP(const bf16_t, WS_CKV), WSP(const bf16_t, WS_WKV + L * SZ_WKV), KVLORA};
          pg8::EpiKV E{WSP(bf16_t, WS_KV), WSP(const float, WS_PARTKV), WSP(unsigned char, WS_VT), WSP(unsigned char, WS_KN8)};
          pg8::gemm_phase<pg8::EpiKV, pg8::TableOrder, true, true>(lds, g, To, E); }
    }
    SEAM(pb + 1);
    if (IN(pb + 2)) {
        const int G = gridDim.x, bx = blockIdx.x;
        const int slot = bx % 3; bool pending = true;
        for (int step = 0; ; ++step) {
            const int u = bx + step * G; const bool more = u < 512;
            if (pending && (step == slot || !more)) { moe_conv_burst(args, lds, L, DEPTH); pending = false; }
            if (!more) break;
            const int r = u / 256, c = u % 256, head = 4 * r + ((c & 7) >> 1), qblk = (c >> 3) + 32 * (c & 1);
            att::attn_body<192, false, QCOLS, KVCOLS, 64, S, D>(WSP(const bf16_t, WS_Q) + (size_t)qblk * 256 * QCOLS + head * 192, WSP(const bf16_t, WS_KV) + head * 256, WSP(const unsigned char, WS_KN8) + head * 128, WSP(const bf16_t, WS_KPE),
                (const bf16_t*)(args.ws + WS_VT + (size_t)head * 128 * S), WSP(bf16_t, WS_OBUF) + (size_t)qblk * 256 * D + head * 128, WSP(float, WS_PARTO) + (size_t)qblk * 256 * 16 + head, qblk * 256, 0, S / 64, SCALE_MLA, 0.f, (LAS char*)lds);
        }
        for (int u = bx; u < 512; u += G) {
            const int head = u >> 6, qblk = u & 63;
            int t0 = 4 * qblk - 2, t1 = 4 * qblk + 5; if (t0 < 0) t0 = 0; if (t1 > S / 64 - 1) t1 = S / 64 - 1;
            const float sk = (args.in[6] + L * 8)[head];
            att::attn_body<128, true, 1024, 256, 64, 256, D>(WSP(const bf16_t, WS_QS) + (size_t)qblk * 256 * 1024 + head * 128, WSP(const bf16_t, WS_KS) + (head >> 2) * 128, nullptr, nullptr, WSP(const bf16_t, WS_VS) + (head >> 2) * 128,
                WSP(bf16_t, WS_OBUF) + (size_t)qblk * 256 * D + 1024 + head * 128, WSP(float, WS_PARTO) + (size_t)qblk * 256 * 16 + 8 + head, qblk * 256, t0 * 64, t1 - t0 + 1, SCALE_SWA, sk / SCALE_SWA, (LAS char*)lds);
        }
    }
    SEAM(pb + 2);
    if (IN(pb + 4)) {
        const int G = gridDim.x, bx = blockIdx.x;
        pg8::Gemm g{WSP(const bf16_t, WS_OBUF), WSP(const bf16_t, WS_WOUT + L * SZ_WOUT), D}; pg8::StaticOrder So; So.init(S, D, G, bx);
        if constexpr (L == 0) { pg8::EpiOutProj<false> E{args.in[0], WSP(float, WS_XA), WSP(const float, WS_PARTO), nullptr, nullptr, nullptr}; pg8::gemm_phase<pg8::EpiOutProj<false>, pg8::StaticOrder, true, true>(lds, g, So, E); }
        else { pg8::EpiOutProj<true> E{WSP(const float, WS_XA), WSP(float, WS_XA), WSP(const float, WS_PARTO), WSP(const float, WS_ST2), args.in[19] + (L - 1) * D, args.in[20] + (L - 1) * D};
               pg8::gemm_phase<pg8::EpiOutProj<true>, pg8::StaticOrder, true, true>(lds, g, So, E); }
    }
    SEAM(pb + 4);
    if (IN(pb + 5)) {
        const int tid = tid_opaque(), lane = tid & 63, wave = tid >> 6, G = gridDim.x, bx = blockIdx.x;
        const float* lg = args.in[10] + L * D; const float* lb = args.in[11] + L * D;
        float* XA = WSP(float, WS_XA); unsigned* X8 = WSP(unsigned, WS_X8);
        const int RPW = (S + G - 1) / G, r0 = bx * RPW, r1 = (r0 + RPW < S) ? r0 + RPW : S;
        LAS float* wr_l = (LAS float*)lds; LAS int* hist = (LAS int*)(lds + 65536);
        if (L == 1) { const float* wrg = args.in[15]; for (int i = tid; i < D * NE; i += 512) wr_l[i] = wrg[i]; if (tid < NE) hist[tid] = 0; __syncthreads(); }
        for (int row = r0 + wave; row < r1; row += NWAVES) {
            f32x4 v[8]; float* xr = XA + (size_t)row * D;
#pragma unroll
            for (int j = 0; j < 8; ++j) v[j] = *((const f32x4*)xr + lane + 64 * j);
            float mu_, rs_; ln_row(v, lg, lb, lane, mu_, rs_);
            if (lane == 0) { float* st = WSP(float, WS_ST1); st[2 * row] = mu_; st[2 * row + 1] = rs_; }
            { f32x16 lo, hi;
#pragma unroll
              for (int j = 0; j < 4; ++j)
#pragma unroll
                  for (int c = 0; c < 4; ++c) { lo[4 * j + c] = v[j][c]; hi[4 * j + c] = v[4 + j][c]; }
              unsigned sb; const u32x6 q = mx6_block(lo, hi, sb);
              unsigned char* o = (unsigned char*)X8 + (size_t)row * D + (lane >> 2) * 128 + 16 * (lane & 3);
              *(u32x4*)o = (u32x4){q[0], q[1], q[2], q[3]}; *(u32x4*)(o + 64) = (u32x4){q[4], q[5], sb, 0u}; }
            if (L == 1) {
                float q0 = 0.f, q1 = 0.f, q2 = 0.f, q3 = 0.f, q4 = 0.f, q5 = 0.f, q6 = 0.f, q7 = 0.f;
#pragma unroll
                for (int j = 0; j < 8; ++j)
#pragma unroll
                    for (int k = 0; k < 4; ++k) { const LAS f32x4* w = (const LAS f32x4*)(wr_l + (size_t)(4 * (lane + 64 * j) + k) * NE); const f32x4 w0 = w[0], w1 = w[1]; const float xv = v[j][k];
                        q0 += xv * w0[0]; q1 += xv * w0[1]; q2 += xv * w0[2]; q3 += xv * w0[3]; q4 += xv * w1[0]; q5 += xv * w1[1]; q6 += xv * w1[2]; q7 += xv * w1[3]; }
                q0 = wave_sum(q0); q1 = wave_sum(q1); q2 = wave_sum(q2); q3 = wave_sum(q3); q4 = wave_sum(q4); q5 = wave_sum(q5); q6 = wave_sum(q6); q7 = wave_sum(q7);
                int e0 = 0; float l0 = q0;
                if (q1 > l0) { l0 = q1; e0 = 1; } if (q2 > l0) { l0 = q2; e0 = 2; } if (q3 > l0) { l0 = q3; e0 = 3; } if (q4 > l0) { l0 = q4; e0 = 4; } if (q5 > l0) { l0 = q5; e0 = 5; } if (q6 > l0) { l0 = q6; e0 = 6; } if (q7 > l0) { l0 = q7; e0 = 7; }
                int e1 = -1; float l1 = -3.0e38f;
                if (e0 != 0 && q0 > l1) { l1 = q0; e1 = 0; } if (e0 != 1 && q1 > l1) { l1 = q1; e1 = 1; } if (e0 != 2 && q2 > l1) { l1 = q2; e1 = 2; } if (e0 != 3 && q3 > l1) { l1 = q3; e1 = 3; }
                if (e0 != 4 && q4 > l1) { l1 = q4; e1 = 4; } if (e0 != 5 && q5 > l1) { l1 = q5; e1 = 5; } if (e0 != 6 && q6 > l1) { l1 = q6; e1 = 6; } if (e0 != 7 && q7 > l1) { l1 = q7; e1 = 7; }
                const float t = __expf(l1 - l0), g0 = 1.0f / (1.0f + t), g1 = t / (1.0f + t);
                if (lane == 0) { int* sel = WSP(int, WS_SEL); float* gate = WSP(float, WS_GATE); sel[2 * row] = e0; sel[2 * row + 1] = e1; gate[2 * row] = g0; gate[2 * row + 1] = g1;
                    __hip_atomic_fetch_add(hist + e0, 1, __ATOMIC_RELAXED, __HIP_MEMORY_SCOPE_WORKGROUP); __hip_atomic_fetch_add(hist + e1, 1, __ATOMIC_RELAXED, __HIP_MEMORY_SCOPE_WORKGROUP); }
            }
        }
        if (L == 1) { __syncthreads(); if (tid < NE) WSP(int, WS_WGCNT)[bx * NE + tid] = hist[tid]; }
    }
    SEAM(pb + 5);
    if constexpr (L == 0) {
        if (IN(pb + 7)) {
            const int G = gridDim.x, bx = blockIdx.x;
            pg8::Gemm g{WSP(const bf16_t, WS_X8), WSP(const bf16_t, WS_WGU), D}; pg8::StaticOrder So; So.init(S, 2 * FF, G, bx);
            pg8::EpiSwiglu6 E{WSP(unsigned char, WS_H), FF};
            pg8::gemm_phase<pg8::EpiSwiglu6, pg8::StaticOrder, true, true, 2>(lds, g, So, E);
        }
        SEAM(pb + 7);
        if (IN(pb + 8)) {
            const int G = gridDim.x, bx = blockIdx.x;
            pg8::Gemm g{WSP(const bf16_t, WS_H), WSP(const bf16_t, WS_WD), FF}; pg8::StaticOrder So; So.init(S, D, G, bx);
            pg8::EpiResidLN E{WSP(const float, WS_XA), WSP(float, WS_XA), 1.0f, WSP(const float, WS_ST1), args.in[10] + L * D, args.in[11] + L * D};
            pg8::gemm_phase<pg8::EpiResidLN, pg8::StaticOrder, true, true, 2>(lds, g, So, E);
        }
        SEAM(pb + 8);
        if (IN(pb + 9)) {
            const int tid = tid_opaque(), lane = tid & 63, gw = blockIdx.x * NWAVES + (tid >> 6), NGW = gridDim.x * NWAVES;
            const float* lg = args.in[19] + L * D; const float* lb = args.in[20] + L * D; float* XA = WSP(float, WS_XA); bf16_t* XB = WSP(bf16_t, WS_XB);
            for (int row = gw; row < S; row += NGW) {
                f32x4 v[8]; float* xr = XA + (size_t)row * D;
#pragma unroll
                for (int j = 0; j < 8; ++j) v[j] = *((const f32x4*)xr + lane + 64 * j);
                float mu_, rs_; ln_row(v, lg, lb, lane, mu_, rs_);
                if (lane == 0) { float* st = WSP(float, WS_ST2); st[2 * row] = mu_; st[2 * row + 1] = rs_; }
#pragma unroll
                for (int j = 0; j < 8; ++j) *((u32x2*)(XB + (size_t)row * D) + lane + 64 * j) = pg8::pack4(v[j]);
            }
        }
        SEAM(pb + 9);
    } else {
        if (IN(pb + 6)) {
            const int tid = tid_opaque(), lane = tid & 63, wave = tid >> 6, G = gridDim.x, bx = blockIdx.x;
            const int RPW = (S + G - 1) / G, r0 = bx * RPW, r1 = (r0 + RPW < S) ? r0 + RPW : S, na = 2 * (r1 - r0);
            LAS int* tab = (LAS int*)lds;
            LAS int* basee = (LAS int*)(lds + 32768);
            LAS int* asel = (LAS int*)(lds + 33024);
            LAS int* adst = (LAS int*)(lds + 35072);
            const int* wgcnt = WSP(const int, WS_WGCNT); const int* sel = WSP(const int, WS_SEL);
            for (int i = tid; i < G * NE; i += 512) tab[i] = wgcnt[i];
            for (int i = tid; i < na; i += 512) asel[i] = sel[2 * r0 + i];
            __syncthreads();
            if (tid < NE) { int tot = 0, pre = 0; for (int w = 0; w < G; ++w) { const int c = tab[w * NE + tid]; pre += (w < bx) ? c : 0; tot += c; } basee[32 + tid] = tot; basee[40 + tid] = pre; }
            __syncthreads();
            if (tid == 0) { int p = 0; for (int e = 0; e < NE; ++e) { basee[8 + e] = p; basee[e] = 256 * p + basee[40 + e]; p += (basee[32 + e] + 255) >> 8; } basee[16] = p;
                if (bx == 0) { int* moemeta = WSP(int, WS_MOEMETA); for (int e = 0; e <= NE; ++e) moemeta[e] = basee[8 + e]; } }
            __syncthreads();
            if (tid < NE) { int rk = basee[tid]; for (int i = 0; i < na; ++i) if (asel[i] == tid) adst[i] = rk++; }
            __syncthreads();
            int* dest = WSP(int, WS_DEST); const unsigned char* X8 = WSP(const unsigned char, WS_X8); unsigned char* xs = WSP(unsigned char, WS_XS);
            for (int i = tid; i < na; i += 512) dest[2 * r0 + i] = adst[i];
            if (bx < NE) {
                const int rb = 256 * basee[8 + bx] + basee[32 + bx], re = 256 * basee[9 + bx];
                for (int i = rb * 128 + tid; i < re * 128; i += 512) ((u32x4*)xs)[i] = (u32x4){0u, 0u, 0u, 0u};
            }
            for (int a = wave; a < na; a += NWAVES) { const u32x4* s4 = (const u32x4*)(X8 + (size_t)(r0 + (a >> 1)) * D); u32x4* d4 = (u32x4*)(xs + (size_t)adst[a] * D);
#pragma unroll
                for (int j = 0; j < 2; ++j) d4[lane + 64 * j] = s4[lane + 64 * j]; }
        }
        SEAM(pb + 6);
        if (IN(pb + 7)) {
            LAS int* utab = (LAS int*)(lds + MISC_OFF + 1024);
            const int nun = moe_unit_table(WSP(const int, WS_MOEMETA), 2 * FFE / 256, utab);
            pg8::TableOrder To{utab, nun};
            pg8::Gemm g{WSP(const bf16_t, WS_XS), WSP(const bf16_t, WS_WMGU), D};
            pg8::EpiSwiglu6 E{WSP(unsigned char, WS_H), FFE};
            for (int rep = 0; rep < PROBE_MOEUP; ++rep) pg8::gemm_phase<pg8::EpiSwiglu6, pg8::TableOrder, true, true, 2>(lds, g, To, E);
        }
        SEAM(pb + 7);
        if (IN(pb + 8)) {
            LAS int* utab = (LAS int*)(lds + MISC_OFF + 1024);
            const int nun = moe_unit_table_k(WSP(const int, WS_MOEMETA), D / 256, utab, WSP(unsigned char, WS_TAILMAP));
            pg8::TableOrderK To{utab, nun};
            pg8::Gemm g{WSP(const bf16_t, WS_H), WSP(const bf16_t, WS_WMD), FFE};
            pg8::EpiBf16OutK E{WSP(bf16_t, WS_XS), WSP(bf16_t, WS_YP)};
            pg8::gemm_phase<pg8::EpiBf16OutK, pg8::TableOrderK, true, true, 2>(lds, g, To, E);
        }
        SEAM(pb + 8);
        if (IN(pb + 9)) {
            const int tid = tid_opaque(), lane = tid & 63, gw = blockIdx.x * NWAVES + (tid >> 6), NGW = gridDim.x * NWAVES;
            const float* lg = args.in[19] + L * D; const float* lb = args.in[20] + L * D;
            const int* dest = WSP(const int, WS_DEST); const float* gate = WSP(const float, WS_GATE); const float* XA = WSP(const float, WS_XA); const bf16_t* ys = WSP(const bf16_t, WS_XS);
            const float* st1 = WSP(const float, WS_ST1); const float* g1p = args.in[10] + L * D; const float* b1p = args.in[11] + L * D;
            for (int row = gw; row < S; row += NGW) {
                const int d0 = dest[2 * row], d1 = dest[2 * row + 1]; const float g0 = gate[2 * row], g1 = gate[2 * row + 1]; const float mu1 = st1[2 * row], rs1 = st1[2 * row + 1];
                f32x4 v[8]; const float* xr = XA + (size_t)row * D; const u32x2* y0 = (const u32x2*)(ys + (size_t)d0 * D); const u32x2* y1 = (const u32x2*)(ys + (size_t)d1 * D);
                const u32x2 m0 = *(const u32x2*)(WSP(const unsigned char, WS_TAILMAP) + (d0 >> 8) * 8), m1 = *(const u32x2*)(WSP(const unsigned char, WS_TAILMAP) + (d1 >> 8) * 8);
                const bool anyt = (m0.x | m0.y | m1.x | m1.y) != 0u;
#pragma unroll
                for (int j = 0; j < 8; ++j) { const f32x4 yv = *((const f32x4*)xr + lane + 64 * j); const f32x4 x = (yv - mu1) * rs1 * *((const f32x4*)g1p + lane + 64 * j) + *((const f32x4*)b1p + lane + 64 * j); const u32x2 a = y0[lane + 64 * j], b = y1[lane + 64 * j];
                    f32x4 fa = {__uint_as_float(a.x << 16), __uint_as_float(a.x & 0xffff0000u), __uint_as_float(a.y << 16), __uint_as_float(a.y & 0xffff0000u)};
                    f32x4 fb = {__uint_as_float(b.x << 16), __uint_as_float(b.x & 0xffff0000u), __uint_as_float(b.y << 16), __uint_as_float(b.y & 0xffff0000u)};
                    if (anyt) {
                        const int t0 = (int)(((j < 4 ? m0.x : m0.y) >> (8 * (j & 3))) & 255u), t1 = (int)(((j < 4 ? m1.x : m1.y) >> (8 * (j & 3))) & 255u);
                        if (t0 | t1) {
                            const int nwg_ = WSP(const int, WS_MOEMETA)[NE] * (D / 256), G_ = gridDim.x, Tn_ = nwg_ - (nwg_ / G_) * G_, SK = Tn_ * 7 <= G_ ? 7 : (Tn_ * 4 <= G_ ? 4 : 2);
                            if (t0) fa = tail_sum(WSP(const bf16_t, WS_YP), t0, d0, lane, SK);
                            if (t1) fb = tail_sum(WSP(const bf16_t, WS_YP), t1, d1, lane, SK);
                        }
                    }
                    v[j] = x * ALPHA + (fa * g0 + fb * g1); }
                float mu_, rs_; ln_row(v, lg, lb, lane, mu_, rs_);
#pragma unroll
                for (int j = 0; j < 8; ++j) *((f32x4*)(args.out + (size_t)row * D) + lane + 64 * j) = v[j];
            }
        }
    }
}

__global__ void __launch_bounds__(NWAVES * 64, 2) fwd(Args args) {
    extern __shared__ __attribute__((aligned(16))) unsigned char lds_raw[];
    LAS unsigned char* lds = (LAS unsigned char*)lds_raw;
    volatile LAS unsigned* MISC = (volatile LAS unsigned*)(lds + MISC_OFF);
    for (int u = tid_opaque(); u < (LDS_BYTES - MISC_OFF) / 4; u += NWAVES * 64) MISC[u] = 0u;
    __syncthreads();
    (void)xcd_barrier_post(WSP(unsigned, WS_CTL) + CW_BAR, MISC + 8);
    const int lo = args.ph_lo, hi = args.ph_hi;

    if (IN(0)) {
        const int tid = tid_opaque(), lane = tid & 63, wave = tid >> 6, G = gridDim.x, bx = blockIdx.x, gw = bx * NWAVES + wave, NGW = G * NWAVES;
        unsigned char* ws = args.ws;
        LAS unsigned* scr = (LAS unsigned*)(lds + wave * 16640);
        for (int rep = 0; rep < PROBE_PRO; ++rep) {
        int cursor = 0;
        for (int l = 0; l < DEPTH; ++l) {
            tr_matrix(args.in[1] + (size_t)l * D * IN_COLS, nullptr, IN_COLS, D, (bf16_t*)(ws + WS_WIN + l * SZ_WIN), IN_PAD, 1, nullptr, nullptr, scr, lane, gw, NGW, cursor);
            tr_matrix(args.in[3] + (size_t)l * QLORA * QCOLS, nullptr, QCOLS, QLORA, (bf16_t*)(ws + WS_WQ + l * SZ_WQ), QCOLS, 2, args.in[2] + l * QLORA, nullptr, scr, lane, gw, NGW, cursor);
            tr_matrix(args.in[5] + (size_t)l * KVLORA * KVCOLS, nullptr, KVCOLS, KVLORA, (bf16_t*)(ws + WS_WKV + l * SZ_WKV), KVCOLS, 0, args.in[4] + l * KVLORA, nullptr, scr, lane, gw, NGW, cursor);
            tr_matrix(args.in[9] + (size_t)l * D * D, nullptr, D, D, (bf16_t*)(ws + WS_WOUT + l * SZ_WOUT), D, 0, args.in[7] + l * 1024, args.in[8] + l * 1024, scr, lane, gw, NGW, cursor);
        }
        tr_matrix6(args.in[12], args.in[13], FF, ws + WS_WGU, 2 * FF, scr, lane, gw, NGW, cursor);
        tr_matrix6c(args.in[14], D, FF, ws + WS_WD, D, scr, lane, gw, NGW, cursor);
        { const f32x4* x4 = (const f32x4*)args.in[0]; u32x2* o2 = (u32x2*)(ws + WS_XB);
          for (size_t i = (size_t)bx * 512 + tid; i < (size_t)S * D / 4; i += (size_t)G * 512) o2[i] = pg8::pack4(x4[i]); }
        { float* coss = (float*)(ws + WS_COSS); float* sins = (float*)(ws + WS_SINS); float* cosm = (float*)(ws + WS_COSM); float* sinm = (float*)(ws + WS_SINM);
          for (int i = bx * 512 + tid; i < S * 64; i += G * 512) { const int pos = i >> 6, k = i & 63; float sn, cs; sincos_acc((float)pos * INVF[k], sn, cs); coss[i] = cs; sins[i] = sn; }
          for (int i = bx * 512 + tid; i < S * 32; i += G * 512) { const int pos = i >> 5, k = i & 31; float sn, cs; sincos_acc((float)pos * INVF[2 * k], sn, cs); cosm[i] = cs; sinm[i] = sn; } }
        }
    }
    SEAM(0);
    layer_phases<0>(args, lds, (char*)lds_raw, lo, hi);
    layer_phases<1>(args, lds, (char*)lds_raw, lo, hi);
}
#undef IN
#undef SEAM

#ifndef MK_SPLIT
#define MK_SPLIT 0
#endif
extern "C" void kernel_launch(void* const* d_in, const int* in_sizes, int n_in, void* d_out, int out_size, void* d_ws, size_t ws_size, hipStream_t stream) {
    static int grid = 0;
    if (grid == 0) {
        if (n_in != 21 || out_size != S * D || ws_size < WS_END4) { fprintf(stderr, "kernel_launch: unexpected shapes: n_in %d out %d ws %zu (need %zu)\n", n_in, out_size, ws_size, (size_t)WS_END4); grid = -1; return; }
        int dev = 0, cus = 0, per_cu = 0;
        if (hipGetDevice(&dev) != hipSuccess || hipDeviceGetAttribute(&cus, hipDeviceAttributeMultiprocessorCount, dev) != hipSuccess) { grid = -1; return; }
        if (hipFuncSetAttribute((const void*)fwd, hipFuncAttributeMaxDynamicSharedMemorySize, LDS_BYTES) != hipSuccess) { fprintf(stderr, "kernel_launch: hipFuncSetAttribute failed\n"); grid = -1; return; }
        if (hipOccupancyMaxActiveBlocksPerMultiprocessor(&per_cu, (const void*)fwd, NWAVES * 64, LDS_BYTES) != hipSuccess || per_cu < 1) fprintf(stderr, "kernel_launch: occupancy query says %d\n", per_cu);
        (void)hipGetLastError();
        grid = cus;
    }
    if (grid < 0) return;
    (void)hipMemsetAsync((char*)d_ws + WS_CTL, 0, CTL_ZERO_BYTES, stream);
    Args a{};
    for (int i = 0; i < 21; ++i) a.in[i] = (const float*)d_in[i];
    a.out = (float*)d_out; a.ws = (unsigned char*)d_ws;
#if MK_SPLIT
    for (int p = 0; p < NPHASE; ++p) { a.ph_lo = p; a.ph_hi = p + 1; hipLaunchKernelGGL(fwd, dim3(grid), dim3(NWAVES * 64), LDS_BYTES, stream, a); }
#else
    a.ph_lo = 0; a.ph_hi = NPHASE; hipLaunchKernelGGL(fwd, dim3(grid), dim3(NWAVES * 64), LDS_BYTES, stream, a);
#endif
    const hipError_t le = hipPeekAtLastError();
    if (le != hipSuccess) fprintf(stderr, "kernel_launch: launch failed: %s\n", hipGetErrorName(le));
}
```

```cpp
#include <hip/hip_runtime.h>
#include <cstdio>
#include <cstdint>

#define LAS __attribute__((address_space(3)))
#define GAS __attribute__((address_space(1)))
typedef unsigned short bf16_t;
typedef short bf16x8 __attribute__((ext_vector_type(8)));
typedef short s16x4 __attribute__((ext_vector_type(4)));
typedef float f32x4 __attribute__((ext_vector_type(4)));
typedef float f32x16 __attribute__((ext_vector_type(16)));
typedef unsigned u32x4 __attribute__((ext_vector_type(4)));
typedef unsigned u32x2 __attribute__((ext_vector_type(2)));

constexpr int S = 16384, D = 2048, DEPTH = 2;
constexpr int IN_COLS = 2368, IN_PAD = 2560, QCOLS = 1536, KVCOLS = 2048, QLORA = 512, KVLORA = 256;
constexpr int FF = 5632, FFE = 7168, NE = 8;
constexpr int MOE_ROWS = 34816;
constexpr float ALPHA = 1.41421356237309515f, LN_EPS = 1e-5f, RMS_EPS = 1e-6f;
constexpr float SCALE_MLA = 0.07216878364870322f, SCALE_SWA = 0.08838834764831845f;

__device__ __forceinline__ unsigned cvt_pk_bf16(float lo, float hi) { unsigned r; asm volatile("v_cvt_pk_bf16_f32 %0, %1, %2" : "=v"(r) : "v"(lo), "v"(hi)); return r; }

__device__ __forceinline__ unsigned pk_fp8x4(float a, float b, float c, float d) { int w = 0; w = __builtin_amdgcn_cvt_pk_fp8_f32(a, b, w, false); w = __builtin_amdgcn_cvt_pk_fp8_f32(c, d, w, true); return (unsigned)w; }
typedef int v6i32 __attribute__((ext_vector_type(6)));
typedef unsigned u32x6 __attribute__((ext_vector_type(6)));
__device__ __forceinline__ u32x6 mx6_block(const f32x16 lo, const f32x16 hi, unsigned& sb) {
    float am = 0.f;
#pragma unroll
    for (int i = 0; i < 16; ++i) am = fmaxf(am, fmaxf(fabsf(lo[i]), fabsf(hi[i])));
    const unsigned bits = __float_as_uint(am);
    int e = (int)((bits >> 23) & 255u) - 126 - (((bits & 0x7fffffu) <= 0x700000u) ? 3 : 2);
    e = e < -120 ? -120 : e;
    const float scale = __uint_as_float((unsigned)(e + 127) << 23);
    sb = (unsigned)(e + 127) * 0x01010101u;
    u32x6 q;
    asm("v_cvt_scalef32_2xpk16_fp6_f32 %0, %1, %2, %3" : "=&v"(q) : "v"(lo), "v"(hi), "v"(scale));
    return q;
}
constexpr float X8_SCALE = 4.f, W8UP_SCALE = 64.f, W8DN_SCALE = 128.f, H8_SCALE = 16.f;
__device__ __forceinline__ int tid_opaque() { int t = threadIdx.x; asm volatile("" : "+v"(t)); return t; }

constexpr size_t MiB = 1u << 20;
constexpr size_t WS_CTL = 0, CTL_ZERO_BYTES = 1 * MiB;
constexpr size_t WS_COSM = 1 * MiB, WS_SINM = 3 * MiB, WS_COSS = 5 * MiB, WS_SINS = 9 * MiB;
constexpr size_t WS_PARTQ = 13 * MiB, WS_PARTKV = 14 * MiB, WS_PARTO = 15 * MiB;
constexpr size_t WS_SEL = 16 * MiB, WS_GATE = WS_SEL + 128 * 1024, WS_DEST = WS_GATE + 128 * 1024, WS_WGCNT = WS_DEST + 128 * 1024, WS_MOEMETA = WS_WGCNT + 32 * 1024, WS_ST1 = WS_MOEMETA + 4096, WS_ST2 = WS_ST1 + 128 * 1024;
constexpr size_t WS_W = 17 * MiB;
constexpr size_t SZ_WIN = (size_t)IN_PAD * D * 2, SZ_WQ = (size_t)QCOLS * QLORA * 2, SZ_WKV = (size_t)KVCOLS * KVLORA * 2, SZ_WOUT = (size_t)D * D * 2;
constexpr size_t WS_WIN = WS_W, WS_WQ = WS_WIN + 2 * SZ_WIN, WS_WKV = WS_WQ + 2 * SZ_WQ, WS_WOUT = WS_WKV + 2 * SZ_WKV;
constexpr size_t WS_WGU = WS_WOUT + 2 * SZ_WOUT, WS_WD = WS_WGU + (size_t)2 * FF * D, WS_WMGU = WS_WD + (size_t)D * FF;
constexpr size_t WS_WMD = WS_WMGU + (size_t)NE * 2 * FFE * D, WS_XA = WS_WMD + (size_t)NE * D * FFE;
constexpr size_t WS_XB = WS_XA + (size_t)S * D * 4, WS_X8 = WS_XB + (size_t)S * D * 2, WS_SCR = WS_X8 + (size_t)S * D;
constexpr size_t WS_CQ = WS_SCR, WS_CKV = WS_CQ + (size_t)S * 512 * 2, WS_KPE = WS_CKV + (size_t)S * 256 * 2, WS_QS = WS_KPE + (size_t)S * 64 * 2;
constexpr size_t WS_KS = WS_QS + (size_t)S * 1024 * 2, WS_VS = WS_KS + (size_t)S * 256 * 2, WS_Q = WS_VS + (size_t)S * 256 * 2, WS_KV = WS_Q + (size_t)S * QCOLS * 2;
constexpr size_t WS_OBUF = WS_KV + (size_t)S * KVCOLS * 2, WS_ATT_END = WS_OBUF + (size_t)S * D * 2;
constexpr size_t WS_XS = WS_SCR, WS_H = WS_XS + (size_t)MOE_ROWS * D * 2, WS_END0 = WS_H + (size_t)MOE_ROWS * FFE, WS_END = WS_END0 > WS_ATT_END ? WS_END0 : WS_ATT_END;
constexpr size_t WS_YP = (WS_END + 255) / 256 * 256, WS_END2 = WS_YP + (size_t)7 * 128 * 65536 * 2;
constexpr size_t WS_VT = (WS_END2 + 255) / 256 * 256, WS_END3 = WS_VT + (size_t)8 * 128 * S;
constexpr size_t WS_KN8 = (WS_END3 + 255) / 256 * 256, WS_END4 = WS_KN8 + (size_t)S * 1024;
constexpr size_t WS_TAILMAP = WS_CTL + 512 * 1024;
static_assert(WS_H + (size_t)S * FF <= WS_END, "scratch union");
static_assert(WS_WIN % 256 == 0 && WS_XA % 256 == 0 && WS_H % 256 == 0 && WS_Q % 256 == 0, "alignment");
constexpr int CW_TMO = 0, CW_BAR = 4096;

#define XB_TMO      128
#define XB_XCNT(j)  (256  + 64 * (j))
#define XB_XSUB(j)  (1280 + 64 * (j))
#define XB_XGEN(j)  (2304 + 64 * (j))
#define XB_TOP      3328
#define XB_TOPGEN   3392
#define XCD_BAR_WORDS 3456
#define XB_SPIN_CAP (1u << 18)
__device__ __forceinline__ unsigned xb_ld(unsigned* p)              { return __hip_atomic_load(p, __ATOMIC_RELAXED, __HIP_MEMORY_SCOPE_AGENT); }
__device__ __forceinline__ unsigned xb_add(unsigned* p, unsigned v) { return __hip_atomic_fetch_add(p, v, __ATOMIC_RELAXED, __HIP_MEMORY_SCOPE_AGENT); }
__device__ __forceinline__ unsigned xb_xcc_id() { return (unsigned)__builtin_amdgcn_s_getreg((3 << 11) | 20) & 0xFu; }
#define XB_SPIN(cond, bar) do { unsigned _sp = 0; while (cond) { __builtin_amdgcn_s_sleep(1); \
    if ((++_sp & 255u) == 0u) { if (xb_ld(&(bar)[XB_TMO])) break; if (_sp > XB_SPIN_CAP) { atomicAdd(&(bar)[XB_TMO], 1u); break; } } } } while (0)
struct XcdBarrier { unsigned* bar; unsigned x; volatile LAS unsigned* st; };
__device__ __forceinline__ XcdBarrier xcd_barrier_post(unsigned* bar, volatile LAS unsigned* st) {
    XcdBarrier b; b.bar = bar; b.x = xb_xcc_id(); b.st = st;
    if (threadIdx.x == 0) (void)xb_add(&bar[XB_XCNT(b.x)], 1u);
    return b;
}
__device__ __forceinline__ void xcd_barrier_complete(unsigned* bar, unsigned x, unsigned& nloc, unsigned& nx) {
    const unsigned G = gridDim.x * gridDim.y * gridDim.z;
    unsigned sum, cnt, mine, sp = 0u;
    for (;;) {
        sum = 0u; cnt = 0u; mine = 0u;
#pragma unroll
        for (unsigned j = 0; j < 16; ++j) { const unsigned c = xb_ld(&bar[XB_XCNT(j)]); sum += c; cnt += (c > 0u) ? 1u : 0u; mine = (j == x) ? c : mine; }
        if (sum == G) break;
        __builtin_amdgcn_s_sleep(1);
        if ((++sp & 255u) == 0u) { if (xb_ld(&bar[XB_TMO])) break; if (sp > XB_SPIN_CAP) { atomicAdd(&bar[XB_TMO], 1u); break; } }
    }
    nloc = mine > 0u ? mine : 1u; nx = cnt > 0u ? cnt : 1u;
}
__device__ __forceinline__ void xcd_barrier(const XcdBarrier& b) {
    asm volatile("s_waitcnt vmcnt(0)" ::: "memory");
    __syncthreads();
    if (threadIdx.x == 0) {
        unsigned* bar = b.bar;
        __builtin_amdgcn_s_waitcnt(0);
        unsigned nloc = b.st[0], nx = b.st[1];
        if (nloc == 0u) { xcd_barrier_complete(bar, b.x, nloc, nx); b.st[0] = nloc; b.st[1] = nx; }
        const unsigned old = xb_add(&bar[XB_XSUB(b.x)], 1u);
        const unsigned gen = old / nloc;
        if (old + 1u == (gen + 1u) * nloc) {
            __builtin_amdgcn_fence(__ATOMIC_RELEASE, "agent");
            asm volatile("s_waitcnt vmcnt(0)" ::: "memory");
            const unsigned og = xb_add(&bar[XB_TOP], 1u);
            const unsigned tg = og / nx;
            if (og + 1u == (tg + 1u) * nx) xb_add(&bar[XB_TOPGEN], 1u);
            else XB_SPIN(xb_ld(&bar[XB_TOPGEN]) == tg, bar);
            __builtin_amdgcn_fence(__ATOMIC_ACQUIRE, "agent");
            xb_add(&bar[XB_XGEN(b.x)], 1u);
            asm volatile("s_waitcnt vmcnt(0)" ::: "memory");
        } else {
            XB_SPIN(xb_ld(&bar[XB_XGEN(b.x)]) == gen, bar);
            __builtin_amdgcn_fence(__ATOMIC_ACQUIRE, "agent");
            asm volatile("s_waitcnt vmcnt(0)" ::: "memory");
        }
    }
    __syncthreads();
}

namespace pg8 {
constexpr int BM = 256, BK = 64, HALF = 128, HTB = HALF * BK * 2, STAGE_BYTES = 8 * HTB, NXCD = 8, WGM = 8;
__host__ __device__ __forceinline__ int lds_byte(int r, int c) { const int st = (r >> 4) * 2 + (c >> 5), rr = r & 15, cc = c & 31, ob = rr * 64 + cc * 2; return st * 1024 + (ob ^ (((ob >> 9) & 1) << 5)); }
__host__ __device__ __forceinline__ void stage_rc(int b, int& R, int& C) { const int st = b / 1024, sb = b % 1024, swz = sb ^ (((sb >> 9) & 1) << 5); R = (st >> 1) * 16 + swz / 64; C = (st & 1) * 32 + (swz % 64) / 2; }
__host__ __device__ __forceinline__ int perm32(int rho) { const int n = rho >> 4, i = rho & 15; return 8 * (i >> 2) + 4 * n + (i & 3); }
struct Unit { int pm, pn, aux, kx; };
struct Gemm { const bf16_t* A; const bf16_t* Bt; int K; };
struct StaticOrder {
    static constexpr bool KSPLIT = false;
    int nM, nN, nwg, G, c;
    __device__ void init(int M, int N, int G_, int c_) { nM = M / BM; nN = N / BM; nwg = nM * nN; G = G_; c = c_; }
    __device__ bool next(int i, Unit& u) const {
        const long L = (long)i * G + c; if (L >= nwg) return false;
        int wgid = (int)L; { const int q = nwg / NXCD, r = nwg % NXCD, xcd = wgid % NXCD, off = wgid / NXCD; wgid = (xcd < r ? xcd * (q + 1) : r * (q + 1) + (xcd - r) * q) + off; }
        const int nig = WGM * nN, gid = wgid / nig, fm = gid * WGM, gsz = (nM - fm) < WGM ? (nM - fm) : WGM;
        u.pm = fm + ((wgid % nig) % gsz); u.pn = (wgid % nig) / gsz; u.aux = u.pn; return true;
    }
};
struct MoeOrder {
    static constexpr bool KSPLIT = false;
    int pb[9], NT, G, c, nwg;
    __device__ __forceinline__ bool next(int i, Unit& u) const { return at((long)i * G + c, u); }
    __device__ __forceinline__ bool at(long L, Unit& u) const {
        if (L >= nwg) return false;
        int wgid = (int)L; { const int q = nwg / NXCD, r = nwg % NXCD, xcd = wgid % NXCD, off = wgid / NXCD; wgid = (xcd < r ? xcd * (q + 1) : r * (q + 1) + (xcd - r) * q) + off; }
        int e = 0;
#pragma unroll
        for (int k = 1; k < 8; ++k) e += (wgid >= pb[k] * NT) ? 1 : 0;
        int pbe = pb[0], pbn = pb[1];
#pragma unroll
        for (int k = 1; k < 8; ++k) { if (e == k) { pbe = pb[k]; pbn = pb[k + 1]; } }
        const int l = wgid - pbe * NT, Pe = pbn - pbe;
        const int nig = WGM * NT, gid = l / nig, fm = gid * WGM, gsz = (Pe - fm) < WGM ? (Pe - fm) : WGM;
        u.pm = pbe + fm + ((l % nig) % gsz); const int pn = (l % nig) / gsz; u.pn = e * NT + pn; u.aux = pn; return true;
    }
};

struct TableOrder {
    static constexpr bool KSPLIT = false;
    const LAS int* tab; int n;
    __device__ __forceinline__ bool next(int i, Unit& u) const {
        if (i >= n) return false;
        u.pm = __builtin_amdgcn_readfirstlane(tab[4 * i]); u.pn = __builtin_amdgcn_readfirstlane(tab[4 * i + 1]); u.aux = __builtin_amdgcn_readfirstlane(tab[4 * i + 2]); return true;
    }
};
struct TableOrderK {
    static constexpr bool KSPLIT = true;
    const LAS int* tab; int n;
    __device__ __forceinline__ bool next(int i, Unit& u) const {
        if (i >= n) return false;
        u.pm = __builtin_amdgcn_readfirstlane(tab[4 * i]); u.pn = __builtin_amdgcn_readfirstlane(tab[4 * i + 1]); u.aux = __builtin_amdgcn_readfirstlane(tab[4 * i + 2]); u.kx = __builtin_amdgcn_readfirstlane(tab[4 * i + 3]); return true;
    }
};
typedef int v8i32 __attribute__((ext_vector_type(8)));
template <class Epi, class Sched, bool ALIGN_EPI, bool SP2, int FMT = 0>
__device__ __forceinline__ void gemm_phase(LAS unsigned char* lds, const Gemm g, const Sched& S, const Epi& E) {
    const int tid = tid_opaque(), wid = __builtin_amdgcn_readfirstlane(tid >> 6), lane = tid & 63, wr = wid >> 2, wc = wid & 3, fr = lane & 15, fq = lane >> 4;
    constexpr bool F8 = (FMT != 0);
    const int K = g.K, RB = F8 ? K : 2 * K, nt = RB / 128;
    unsigned voffA, voffB;
    { int R, C; stage_rc(tid * 16, R, C); const int Rb = Epi::PERM ? ((R & ~31) + perm32(R & 31)) : R; voffA = (unsigned)(R * RB + C * 2); voffB = (unsigned)(Rb * RB + C * 2); }
    const size_t rstep = (size_t)64 * RB;
    const size_t kstep = (size_t)(BK * 2);
    const size_t hstep = (size_t)HALF * RB;
    const size_t tstep = 2 * hstep;
    const unsigned ldsw = (unsigned)wid * 1024u;
    const int aoff = lds_byte(wr * 64 + fr, fq * 8), boff = lds_byte(wc * 32 + fr, fq * 8);
#define PG8_SA(b, h) (((b) * 2 + (h)) * HTB)
#define PG8_SB(b, h) ((4 + (b) * 2 + (h)) * HTB)
#define PG8_STAGE(bufoff, gbase, voff) do { _Pragma("unroll") for (int _i = 0; _i < 2; ++_i) \
        __builtin_amdgcn_global_load_lds((const unsigned*)((const char*)(gbase) + _i * rstep + (voff)), (LAS unsigned*)(lds + (bufoff) + ldsw + _i * 8192), 16, 0, 0); } while (0)
#define PG8_LDA(dst, b, h) do { _Pragma("unroll") for (int m = 0; m < 4; ++m) _Pragma("unroll") for (int k = 0; k < 2; ++k) dst[m][k] = *(const LAS bf16x8*)(lds + PG8_SA(b, h) + aoff + m * 2048 + k * 1024); } while (0)
#define PG8_LDB(dst, b, h) do { _Pragma("unroll") for (int n = 0; n < 2; ++n) _Pragma("unroll") for (int k = 0; k < 2; ++k) dst[n][k] = *(const LAS bf16x8*)(lds + PG8_SB(b, h) + boff + n * 2048 + k * 1024); } while (0)
#define PG8_CAT(x) __builtin_shufflevector(__builtin_bit_cast(u32x4, x[0]), __builtin_bit_cast(u32x4, x[1]), 0, 1, 2, 3, 4, 5, 6, 7)
#define PG8_D6(x) __builtin_bit_cast(v6i32, __builtin_shufflevector(__builtin_bit_cast(u32x4, x[0]), __builtin_bit_cast(u32x4, x[1]), 0, 1, 2, 3, 4, 5))
#define PG8_S6(x) ((int)__builtin_bit_cast(u32x4, x[1])[2])
#define PG8_MMA(ai, bj, At, Bt) do { __builtin_amdgcn_s_setprio(1); if constexpr (FMT == 1) { _Pragma("unroll") for (int m = 0; m < 4; ++m) _Pragma("unroll") for (int n = 0; n < 2; ++n) \
        asm volatile("v_mfma_f32_16x16x128_f8f6f4 %0, %1, %2, %0" : "+v"(acc[ai][bj][m][n]) : "v"(__builtin_bit_cast(v8i32, PG8_CAT(Bt[n]))), "v"(__builtin_bit_cast(v8i32, PG8_CAT(At[m])))); } \
        else if constexpr (FMT == 2) { _Pragma("unroll") for (int m = 0; m < 4; ++m) _Pragma("unroll") for (int n = 0; n < 2; ++n) \
        acc[ai][bj][m][n] = __builtin_amdgcn_mfma_scale_f32_16x16x128_f8f6f4(__builtin_bit_cast(v8i32, PG8_CAT(Bt[n])), __builtin_bit_cast(v8i32, PG8_CAT(At[m])), acc[ai][bj][m][n], 2, 2, 0, PG8_S6(Bt[n]), 0, PG8_S6(At[m])); } \
        else { _Pragma("unroll") for (int m = 0; m < 4; ++m) _Pragma("unroll") for (int n = 0; n < 2; ++n) _Pragma("unroll") for (int k = 0; k < 2; ++k) \
        acc[ai][bj][m][n] = __builtin_amdgcn_mfma_f32_16x16x32_bf16(Bt[n][k], At[m][k], acc[ai][bj][m][n], 0, 0, 0); } __builtin_amdgcn_s_setprio(0); } while (0)
#define PG8_WAIT_V(n) asm volatile("s_waitcnt vmcnt(" #n ")" ::: "memory")
#define PG8_WAIT_L(n) asm volatile("s_waitcnt lgkmcnt(" #n ")" ::: "memory")
#define PG8_BAR __builtin_amdgcn_s_barrier()
#define PG8_SCHED __builtin_amdgcn_sched_barrier(0)
    Unit cur, nxt; int ui = 0;
    if (!S.next(0, cur)) return;
    constexpr bool KS = Sched::KSPLIT;
    auto k_off = [&](const Unit& u) -> size_t { if constexpr (KS) { if (u.kx) return (size_t)((u.kx >> 8) & 255) * (size_t)(nt / (u.kx >> 16)) * 128; } return 0; };
    auto k_cnt = [&](const Unit& u) -> int { if constexpr (KS) { if (u.kx) return nt / (u.kx >> 16); } return nt; };
    int ntc = k_cnt(cur);
    f32x4 acc[2][2][4][2];
#pragma unroll
    for (int a = 0; a < 2; ++a)
#pragma unroll
        for (int b = 0; b < 2; ++b)
#pragma unroll
            for (int m = 0; m < 4; ++m)
#pragma unroll
                for (int n = 0; n < 2; ++n) acc[a][b][m][n] = (f32x4){0.f, 0.f, 0.f, 0.f};
    bf16x8 At[4][2], B0[2][2], B1[2][2];
    const char* cA = (const char*)g.A + (size_t)cur.pm * tstep + k_off(cur); const char* cB = (const char*)g.Bt + (size_t)cur.pn * tstep + k_off(cur);
    if constexpr (SP2) {
        PG8_STAGE(PG8_SB(0, 0), cB, voffB); PG8_STAGE(PG8_SB(0, 1), cB + hstep, voffB); PG8_STAGE(PG8_SA(0, 0), cA, voffA); PG8_STAGE(PG8_SA(0, 1), cA + hstep, voffA);
        if (wr == 1) PG8_BAR;
        PG8_WAIT_V(2); PG8_BAR;
        PG8_STAGE(PG8_SB(1, 0), cB + kstep, voffB); PG8_STAGE(PG8_SA(1, 0), cA + kstep, voffA); PG8_STAGE(PG8_SB(1, 1), cB + hstep + kstep, voffB);
        PG8_WAIT_V(6); PG8_BAR;
    } else {
        PG8_STAGE(PG8_SB(0, 0), cB, voffB); PG8_STAGE(PG8_SA(0, 0), cA, voffA); PG8_STAGE(PG8_SB(0, 1), cB + hstep, voffB); PG8_STAGE(PG8_SA(0, 1), cA + hstep, voffA);
        if (wr == 1) PG8_BAR;
        PG8_WAIT_V(4); PG8_BAR;
        PG8_STAGE(PG8_SB(1, 0), cB + kstep, voffB); PG8_STAGE(PG8_SA(1, 0), cA + kstep, voffA); PG8_STAGE(PG8_SB(1, 1), cB + hstep + kstep, voffB);
        PG8_WAIT_V(6); PG8_BAR;
    }
    for (;;) {
        const bool has_next = S.next(ui + 1, nxt);
        const char* nA = has_next ? (const char*)g.A + (size_t)nxt.pm * tstep + k_off(nxt) : cA; const char* nB = has_next ? (const char*)g.Bt + (size_t)nxt.pn * tstep + k_off(nxt) : cB;
        for (int t = 0; t < ntc; t += 2) {
            if constexpr (Epi::MID_T >= 0) { if (t == Epi::MID_T) { const int l2 = tid_opaque() & 63; E.mid(acc, cur, wr, wc, l2 & 15, l2 >> 4); } }
            const bool last = (t == ntc - 2);
            const char* a1 = cA + (size_t)(t + 1) * kstep;
            const char* a2 = last ? nA : cA + (size_t)(t + 2) * kstep; const char* b2 = last ? nB : cB + (size_t)(t + 2) * kstep;
            const char* a3 = a2 + kstep; const char* b3 = b2 + kstep;
            if constexpr (SP2) {
            PG8_LDB(B0, 0, 0); PG8_LDB(B1, 0, 1); PG8_SCHED; PG8_LDA(At, 0, 0); PG8_STAGE(PG8_SA(1, 1), a1 + hstep, voffA);
            PG8_WAIT_V(8); PG8_WAIT_L(0); PG8_BAR; PG8_MMA(0, 0, At, B0); PG8_MMA(0, 1, At, B1); PG8_BAR; PG8_SCHED;
            PG8_LDA(At, 0, 1); PG8_STAGE(PG8_SB(0, 0), b2, voffB); PG8_STAGE(PG8_SB(0, 1), b2 + hstep, voffB); PG8_STAGE(PG8_SA(0, 0), a2, voffA);
            PG8_WAIT_V(8); PG8_WAIT_L(0); PG8_BAR; PG8_MMA(1, 0, At, B0); PG8_MMA(1, 1, At, B1); PG8_BAR; PG8_SCHED;
            PG8_LDB(B0, 1, 0); PG8_LDB(B1, 1, 1); PG8_SCHED; PG8_LDA(At, 1, 0); PG8_STAGE(PG8_SA(0, 1), a2 + hstep, voffA);
            PG8_WAIT_V(8); PG8_WAIT_L(0); PG8_BAR; PG8_MMA(0, 0, At, B0); PG8_MMA(0, 1, At, B1); PG8_BAR; PG8_SCHED;
            PG8_LDA(At, 1, 1); PG8_STAGE(PG8_SB(1, 0), b3, voffB); PG8_STAGE(PG8_SB(1, 1), b3 + hstep, voffB); PG8_STAGE(PG8_SA(1, 0), a3, voffA);
            PG8_WAIT_V(8); PG8_WAIT_L(0); PG8_BAR; PG8_MMA(1, 0, At, B0); PG8_MMA(1, 1, At, B1); PG8_BAR; PG8_SCHED;
            } else {
            PG8_LDB(B0, 0, 0); PG8_SCHED; PG8_LDA(At, 0, 0); PG8_STAGE(PG8_SA(1, 1), a1 + hstep, voffA);
            PG8_WAIT_L(8); PG8_BAR; PG8_WAIT_L(0); PG8_MMA(0, 0, At, B0); PG8_BAR; PG8_SCHED;
            PG8_LDB(B1, 0, 1); PG8_STAGE(PG8_SB(0, 0), b2, voffB);
            PG8_BAR; PG8_WAIT_L(0); PG8_MMA(0, 1, At, B1); PG8_BAR;
            PG8_LDA(At, 0, 1); PG8_STAGE(PG8_SA(0, 0), a2, voffA);
            PG8_BAR; PG8_WAIT_L(0); PG8_MMA(1, 0, At, B0); PG8_BAR; PG8_SCHED;
            PG8_STAGE(PG8_SB(0, 1), b2 + hstep, voffB);
            PG8_WAIT_V(6); PG8_BAR; PG8_MMA(1, 1, At, B1); PG8_BAR;
            PG8_LDB(B0, 1, 0); PG8_SCHED; PG8_LDA(At, 1, 0); PG8_STAGE(PG8_SA(0, 1), a2 + hstep, voffA);
            PG8_WAIT_L(8); PG8_BAR; PG8_WAIT_L(0); PG8_MMA(0, 0, At, B0); PG8_BAR; PG8_SCHED;
            PG8_LDB(B1, 1, 1); PG8_STAGE(PG8_SB(1, 0), b3, voffB);
            PG8_BAR; PG8_WAIT_L(0); PG8_MMA(0, 1, At, B1); PG8_BAR;
            PG8_LDA(At, 1, 1); PG8_STAGE(PG8_SA(1, 0), a3, voffA);
            PG8_BAR; PG8_WAIT_L(0); PG8_MMA(1, 0, At, B0); PG8_BAR; PG8_SCHED;
            PG8_STAGE(PG8_SB(1, 1), b3 + hstep, voffB);
            PG8_WAIT_V(6); PG8_BAR; PG8_MMA(1, 1, At, B1); PG8_BAR;
            }
        }
        if constexpr (ALIGN_EPI) { if (wr == 0) PG8_BAR; }
        if constexpr (F8) asm volatile("s_nop 15\n\ts_nop 15" ::: "memory");
        { const int l2 = tid_opaque() & 63; E(acc, cur, wr, wc, l2 & 15, l2 >> 4); }
        if (!has_next) break;
#pragma unroll
        for (int a = 0; a < 2; ++a)
#pragma unroll
            for (int b = 0; b < 2; ++b)
#pragma unroll
                for (int m = 0; m < 4; ++m)
#pragma unroll
                    for (int n = 0; n < 2; ++n) acc[a][b][m][n] = (f32x4){0.f, 0.f, 0.f, 0.f};
        cur = nxt; cA = nA; cB = nB; ++ui; ntc = k_cnt(cur);
        if constexpr (ALIGN_EPI) { if (wr == 1) PG8_BAR; }
    }
    PG8_WAIT_V(0);
    if constexpr (!ALIGN_EPI) { if (wr == 0) PG8_BAR; }
    PG8_BAR;
#undef PG8_SA
#undef PG8_SB
#undef PG8_STAGE
#undef PG8_LDA
#undef PG8_LDB
#undef PG8_MMA
#undef PG8_CAT
#undef PG8_D6
#undef PG8_S6
#undef PG8_WAIT_V
#undef PG8_WAIT_L
#undef PG8_BAR
#undef PG8_SCHED
}

__device__ __forceinline__ u32x4 pack8(const f32x4 a, const f32x4 b) { u32x4 w; w.x = cvt_pk_bf16(a[0], a[1]); w.y = cvt_pk_bf16(a[2], a[3]); w.z = cvt_pk_bf16(b[0], b[1]); w.w = cvt_pk_bf16(b[2], b[3]); return w; }
__device__ __forceinline__ u32x2 pack4(const f32x4 a) { u32x2 w; w.x = cvt_pk_bf16(a[0], a[1]); w.y = cvt_pk_bf16(a[2], a[3]); return w; }

constexpr int RM_BITS = 5;
template <int B = RM_BITS>
__device__ __forceinline__ f32x4 rmant(const f32x4 v) {
    f32x4 r;
#pragma unroll
    for (int i = 0; i < 4; ++i) r[i] = __uint_as_float((__float_as_uint(v[i]) + (1u << (22 - B))) & ~((1u << (23 - B)) - 1u));
    return r;
}

struct EpiInProj {
    static constexpr int MID_T = -1;
    static constexpr bool PERM = true;
    bf16_t *cq, *ckv, *kpe, *qs, *ks, *vs; float *partq, *partkv; const float *cosm, *sinm, *coss, *sins;
    __device__ __forceinline__ void operator()(const f32x4 (&acc)[2][2][4][2], const Unit& u, int wr, int wc, int fr, int fq) const {
        const int row0 = u.pm * BM + wr * 64 + fr;
#pragma unroll
        for (int bj = 0; bj < 2; ++bj) {
            const int tc0 = u.aux * BM + bj * HALF + wc * 32 + fq * 8;
            if (tc0 < 768) {
                bf16_t* base; float* part; int ld, col, ps;
                if (tc0 < 512) { base = cq; ld = 512; col = tc0; part = partq; ps = 16; } else { base = ckv; ld = 256; col = tc0 - 512; part = partkv; ps = 8; }
#pragma unroll
                for (int ai = 0; ai < 2; ++ai)
#pragma unroll
                    for (int m = 0; m < 4; ++m) { const int row = row0 + ai * HALF + m * 16; const f32x4 v0 = acc[ai][bj][m][0], v1 = acc[ai][bj][m][1];
                        *(u32x4*)(base + (size_t)row * ld + col) = pack8(v0, v1);
                        float ss = (v0[0] * v0[0] + v0[1] * v0[1]) + (v0[2] * v0[2] + v0[3] * v0[3]) + (v1[0] * v1[0] + v1[1] * v1[1]) + (v1[2] * v1[2] + v1[3] * v1[3]);
                        ss += __shfl_xor(ss, 16); ss += __shfl_xor(ss, 32);
                        if (fq == 0) part[(size_t)row * ps + (col >> 5)] = ss; }
            } else if (tc0 < 2112) {
                bf16_t* base; const float *ct, *st; int ld, col, half, tw, g;
                if (tc0 < 832) { g = (tc0 - 768) >> 3; base = kpe; ld = 64; col = 4 * g; half = 32; ct = cosm; st = sinm; tw = 32; }
                else if (tc0 < 1856) { const int j = tc0 - 832; g = (j & 127) >> 3; base = qs; ld = 1024; col = (j >> 7) * 128 + 4 * g; half = 64; ct = coss; st = sins; tw = 64; }
                else { const int j = tc0 - 1856; g = (j & 127) >> 3; base = ks; ld = 256; col = (j >> 7) * 128 + 4 * g; half = 64; ct = coss; st = sins; tw = 64; }
#pragma unroll
                for (int ai = 0; ai < 2; ++ai)
#pragma unroll
                    for (int m = 0; m < 4; ++m) { const int row = row0 + ai * HALF + m * 16; const f32x4 x1 = acc[ai][bj][m][0], x2 = acc[ai][bj][m][1];
                        const f32x4 c = *(const f32x4*)(ct + (size_t)row * tw + 4 * g), s = *(const f32x4*)(st + (size_t)row * tw + 4 * g);
                        const f32x4 o1 = x1 * c - x2 * s, o2 = x2 * c + x1 * s;
                        if (tc0 < 832) { unsigned char* kp = (unsigned char*)kpe + (size_t)row * 64 + col;
                            *(unsigned*)kp = pk_fp8x4(o1[0], o1[1], o1[2], o1[3]); *(unsigned*)(kp + 32) = pk_fp8x4(o2[0], o2[1], o2[2], o2[3]); }
                        else { *(u32x2*)(base + (size_t)row * ld + col) = pack4(o1); *(u32x2*)(base + (size_t)row * ld + col + half) = pack4(o2); } }
            } else if (tc0 < 2368) {
                const int col = tc0 - 2112;
#pragma unroll
                for (int ai = 0; ai < 2; ++ai)
#pragma unroll
                    for (int m = 0; m < 4; ++m) { const int row = row0 + ai * HALF + m * 16; *(u32x4*)(vs + (size_t)row * 256 + col) = pack8(acc[ai][bj][m][0], acc[ai][bj][m][1]); }
            }
        }
    }
};
constexpr float QPRE = SCALE_MLA * 1.4426950408889634f * 8.f;
struct EpiQ {
    static constexpr int MID_T = -1;
    static constexpr bool PERM = true;
    bf16_t* q; const float *partq, *cosm, *sinm;
    __device__ __forceinline__ void operator()(const f32x4 (&acc)[2][2][4][2], const Unit& u, int wr, int wc, int fr, int fq) const {
        const int row0 = u.pm * BM + wr * 64 + fr;
        float rs[2][4];
#pragma unroll
        for (int ai = 0; ai < 2; ++ai)
#pragma unroll
            for (int m = 0; m < 4; ++m) { const f32x4* p = (const f32x4*)(partq + (size_t)(row0 + ai * HALF + m * 16) * 16); const f32x4 s = (p[0] + p[1]) + (p[2] + p[3]);
                rs[ai][m] = 1.0f / sqrtf(((s[0] + s[1]) + (s[2] + s[3])) * (1.0f / 512.0f) + RMS_EPS); }
#pragma unroll
        for (int bj = 0; bj < 2; ++bj) {
            const int tc0 = u.aux * BM + bj * HALF + wc * 32 + fq * 8, head = tc0 / 192, j = tc0 - head * 192;
            if (j < 128) {
#pragma unroll
                for (int ai = 0; ai < 2; ++ai)
#pragma unroll
                    for (int m = 0; m < 4; ++m) { const int row = row0 + ai * HALF + m * 16; const f32x4 qa = acc[ai][bj][m][0] * (rs[ai][m] * QPRE), qb = acc[ai][bj][m][1] * (rs[ai][m] * QPRE);
                        { u32x2 w; w.x = pk_fp8x4(qa[0], qa[1], qa[2], qa[3]); w.y = pk_fp8x4(qb[0], qb[1], qb[2], qb[3]);
                          unsigned char* slot = (unsigned char*)(q + (size_t)row * QCOLS + head * 192); const int jj = j & 63;
                          *(u32x2*)(slot + (j < 64 ? 320 : 128) + jj) = w;
                          const f32x4 da = {__builtin_amdgcn_cvt_f32_fp8((int)w.x, 0), __builtin_amdgcn_cvt_f32_fp8((int)w.x, 1), __builtin_amdgcn_cvt_f32_fp8((int)w.x, 2), __builtin_amdgcn_cvt_f32_fp8((int)w.x, 3)};
                          const f32x4 db = {__builtin_amdgcn_cvt_f32_fp8((int)w.y, 0), __builtin_amdgcn_cvt_f32_fp8((int)w.y, 1), __builtin_amdgcn_cvt_f32_fp8((int)w.y, 2), __builtin_amdgcn_cvt_f32_fp8((int)w.y, 3)};
                          const f32x4 ea = qa + qa - da, eb = qb + qb - db; u32x2 w2; w2.x = pk_fp8x4(ea[0], ea[1], ea[2], ea[3]); w2.y = pk_fp8x4(eb[0], eb[1], eb[2], eb[3]);
                          *(u32x2*)(slot + (j < 64 ? 0 : 64) + jj) = w2; } }
            } else {
                const int g = (j - 128) >> 3, col = head * 192 + 128 + 4 * g;
#pragma unroll
                for (int ai = 0; ai < 2; ++ai)
#pragma unroll
                    for (int m = 0; m < 4; ++m) { const int row = row0 + ai * HALF + m * 16; const f32x4 x1 = acc[ai][bj][m][0] * (rs[ai][m] * QPRE), x2 = acc[ai][bj][m][1] * (rs[ai][m] * QPRE);
                        const f32x4 c = *(const f32x4*)(cosm + (size_t)row * 32 + 4 * g), s = *(const f32x4*)(sinm + (size_t)row * 32 + 4 * g);
                        const f32x4 r1 = x1 * c - x2 * s, r2 = x2 * c + x1 * s; unsigned char* q8 = (unsigned char*)(q + (size_t)row * QCOLS + head * 192 + 128) + 4 * g;
                        *(unsigned*)q8 = pk_fp8x4(r1[0], r1[1], r1[2], r1[3]); *(unsigned*)(q8 + 32) = pk_fp8x4(r2[0], r2[1], r2[2], r2[3]); }
            }
        }
    }
};
struct EpiKV {
    static constexpr int MID_T = -1;
    static constexpr bool PERM = true;
    bf16_t* kv; const float* partkv; unsigned char* vt; unsigned char* kn8;
    __device__ __forceinline__ void operator()(const f32x4 (&acc)[2][2][4][2], const Unit& u, int wr, int wc, int fr, int fq) const {
        const int row0 = u.pm * BM + wr * 64 + fr;
#pragma unroll
        for (int ai = 0; ai < 2; ++ai)
#pragma unroll
            for (int m = 0; m < 4; ++m) { const int row = row0 + ai * HALF + m * 16; const f32x4* p = (const f32x4*)(partkv + (size_t)row * 8); const f32x4 s = p[0] + p[1];
                const float rs = 1.0f / sqrtf(((s[0] + s[1]) + (s[2] + s[3])) * (1.0f / 256.0f) + RMS_EPS);
                { const f32x4 ka = acc[ai][0][m][0] * rs, kb_ = acc[ai][0][m][1] * rs; const int c = wc * 32 + fq * 8;
                  u32x2 w; w.x = pk_fp8x4(ka[0], ka[1], ka[2], ka[3]); w.y = pk_fp8x4(kb_[0], kb_[1], kb_[2], kb_[3]); *(u32x2*)(kn8 + (size_t)row * 1024 + u.aux * 128 + c) = w; }
                { const f32x4 v0 = acc[ai][1][m][0] * rs, v1 = acc[ai][1][m][1] * rs; const unsigned w0 = pk_fp8x4(v0[0], v0[1], v0[2], v0[3]), w1 = pk_fp8x4(v1[0], v1[1], v1[2], v1[3]);
                  unsigned char* o = vt + ((size_t)(u.aux * 128 + wc * 32 + fq * 8)) * S + row;
#pragma unroll
                  for (int i = 0; i < 4; ++i) { o[(size_t)i * S] = (unsigned char)(w0 >> (8 * i)); o[(size_t)(4 + i) * S] = (unsigned char)(w1 >> (8 * i)); } } }
    }
};
struct EpiResid {
    static constexpr int MID_T = -1;
    static constexpr bool PERM = true;
    const float* xin; float* y; float sc;
    __device__ __forceinline__ void operator()(const f32x4 (&acc)[2][2][4][2], const Unit& u, int wr, int wc, int fr, int fq) const {
        const int row0 = u.pm * BM + wr * 64 + fr;
#pragma unroll
        for (int ai = 0; ai < 2; ++ai)
#pragma unroll
            for (int m = 0; m < 4; ++m) { const size_t ro = (size_t)(row0 + ai * HALF + m * 16) * D;
#pragma unroll
                for (int bj = 0; bj < 2; ++bj) { const size_t o = ro + u.aux * BM + bj * HALF + wc * 32 + fq * 8;
                    const f32x4 a0 = *(const f32x4*)(xin + o), a1 = *(const f32x4*)(xin + o + 4);
                    *(f32x4*)(y + o) = a0 * ALPHA + acc[ai][bj][m][0] * sc; *(f32x4*)(y + o + 4) = a1 * ALPHA + acc[ai][bj][m][1] * sc; }
                asm volatile("" ::: "memory"); }
    }
};
struct EpiResidLN {
    static constexpr int MID_T = -1;
    static constexpr bool PERM = true, PROBE2 = false;
    const float* yin; float* y; float sc; const float* st; const float* g; const float* b;
    __device__ __forceinline__ void operator()(const f32x4 (&acc)[2][2][4][2], const Unit& u, int wr, int wc, int fr, int fq) const {
        const int row0 = u.pm * BM + wr * 64 + fr, col0 = u.aux * BM + wc * 32 + fq * 8;
        f32x4 gg[2][2], bb[2][2];
#pragma unroll
        for (int bj = 0; bj < 2; ++bj)
#pragma unroll
            for (int n = 0; n < 2; ++n) { gg[bj][n] = *(const f32x4*)(g + col0 + bj * HALF + 4 * n); bb[bj][n] = *(const f32x4*)(b + col0 + bj * HALF + 4 * n); }
#pragma unroll
        for (int ai = 0; ai < 2; ++ai)
#pragma unroll
            for (int m = 0; m < 4; ++m) { const int row = row0 + ai * HALF + m * 16; const size_t ro = (size_t)row * D; const float mu = st[2 * row], rs = st[2 * row + 1];
#pragma unroll
                for (int bj = 0; bj < 2; ++bj) { const size_t o = ro + col0 + bj * HALF;
                    const f32x4 a0 = *(const f32x4*)(yin + o), a1 = *(const f32x4*)(yin + o + 4);
                    const f32x4 x0 = (a0 - mu) * rs * gg[bj][0] + bb[bj][0], x1 = (a1 - mu) * rs * gg[bj][1] + bb[bj][1];
                    *(f32x4*)(y + o) = x0 * ALPHA + acc[ai][bj][m][0] * sc; *(f32x4*)(y + o + 4) = x1 * ALPHA + acc[ai][bj][m][1] * sc; }
                asm volatile("" ::: "memory"); }
    }
};
template <bool LNIN> struct EpiOutProj {
    static constexpr bool PERM = true, PROBE2 = false; static constexpr int MID_T = 16;
    const float* xin; float* y; const float* parto; const float* st; const float* g; const float* b;
    __device__ __forceinline__ void sums(int row, float& a, float& c) const { const f32x4* p = (const f32x4*)(parto + (size_t)row * 16); const f32x4 u = p[0] + p[1], v = p[2] + p[3];
        a = ((u[0] + u[1]) + (u[2] + u[3])) * (1.0f / 1024.0f) + RMS_EPS; c = ((v[0] + v[1]) + (v[2] + v[3])) * (1.0f / 1024.0f) + RMS_EPS; }
    __device__ __forceinline__ void mid(f32x4 (&acc)[2][2][4][2], const Unit& u, int wr, int wc, int fr, int fq) const {
        const int row0 = u.pm * BM + wr * 64 + fr;
#pragma unroll
        for (int ai = 0; ai < 2; ++ai)
#pragma unroll
            for (int m = 0; m < 4; ++m) { float a, c; sums(row0 + ai * HALF + m * 16, a, c); const float r = sqrtf(c / a);
#pragma unroll
                for (int bj = 0; bj < 2; ++bj) { acc[ai][bj][m][0] *= r; acc[ai][bj][m][1] *= r; } }
    }
    __device__ __forceinline__ void operator()(const f32x4 (&acc)[2][2][4][2], const Unit& u, int wr, int wc, int fr, int fq) const {
        const int row0 = u.pm * BM + wr * 64 + fr, col0 = u.aux * BM + wc * 32 + fq * 8;
        f32x4 gg[2][2], bb[2][2];
        if (LNIN) {
#pragma unroll
            for (int bj = 0; bj < 2; ++bj)
#pragma unroll
                for (int n = 0; n < 2; ++n) { gg[bj][n] = *(const f32x4*)(g + col0 + bj * HALF + 4 * n); bb[bj][n] = *(const f32x4*)(b + col0 + bj * HALF + 4 * n); }
        }
#pragma unroll
        for (int ai = 0; ai < 2; ++ai)
#pragma unroll
            for (int m = 0; m < 4; ++m) { const int row = row0 + ai * HALF + m * 16; const size_t ro = (size_t)row * D; float a, c; sums(row, a, c); const float rsw = 1.0f / sqrtf(c);
                float mu = 0.f, rs = 1.f; if (LNIN) { mu = st[2 * row]; rs = st[2 * row + 1]; }
#pragma unroll
                for (int bj = 0; bj < 2; ++bj) { const size_t o = ro + col0 + bj * HALF;
                    f32x4 x0 = *(const f32x4*)(xin + o), x1 = *(const f32x4*)(xin + o + 4);
                    if (LNIN) { x0 = (x0 - mu) * rs * gg[bj][0] + bb[bj][0]; x1 = (x1 - mu) * rs * gg[bj][1] + bb[bj][1]; }
                    *(f32x4*)(y + o) = x0 * ALPHA + acc[ai][bj][m][0] * rsw; *(f32x4*)(y + o + 4) = x1 * ALPHA + acc[ai][bj][m][1] * rsw; }
                asm volatile("" ::: "memory"); }
    }
};
struct EpiSwiglu8 {
    static constexpr int MID_T = -1;
    static constexpr bool PERM = true;
    unsigned char* h; int ldh; float sc;
    __device__ __forceinline__ void operator()(const f32x4 (&acc)[2][2][4][2], const Unit& u, int wr, int wc, int fr, int fq) const {
        const int row0 = u.pm * BM + wr * 64 + fr, col = u.aux * HALF + wc * 32 + fq * 8;
#pragma unroll
        for (int ai = 0; ai < 2; ++ai)
#pragma unroll
            for (int m = 0; m < 4; ++m) { f32x4 r0, r1;
#pragma unroll
                for (int k = 0; k < 4; ++k) { const float g0 = acc[ai][0][m][0][k] * sc, g1 = acc[ai][0][m][1][k] * sc;
                    r0[k] = __builtin_amdgcn_fmed3f(g0 * __builtin_amdgcn_rcpf(1.0f + __builtin_amdgcn_exp2f(-1.4426950408889634f * g0)) * (acc[ai][1][m][0][k] * (sc * H8_SCALE)), -448.f, 448.f);
                    r1[k] = __builtin_amdgcn_fmed3f(g1 * __builtin_amdgcn_rcpf(1.0f + __builtin_amdgcn_exp2f(-1.4426950408889634f * g1)) * (acc[ai][1][m][1][k] * (sc * H8_SCALE)), -448.f, 448.f); }
                u32x2 w; w.x = pk_fp8x4(r0[0], r0[1], r0[2], r0[3]); w.y = pk_fp8x4(r1[0], r1[1], r1[2], r1[3]);
                *(u32x2*)(h + (size_t)(row0 + ai * HALF + m * 16) * ldh + col) = w; }
    }
};
struct EpiSwiglu6 {
    static constexpr bool PERM = true, PROBE2 = false; static constexpr int MID_T = -1;
    unsigned char* h; int ldh;
    __device__ __forceinline__ void operator()(const f32x4 (&acc)[2][2][4][2], const Unit& u, int wr, int wc, int fr, int fq) const {
#pragma unroll
        for (int ai = 0; ai < 2; ++ai) {
            float v[4][8];
#pragma unroll
            for (int m = 0; m < 4; ++m)
#pragma unroll
                for (int c = 0; c < 8; ++c) { const float g = acc[ai][0][m][c >> 2][c & 3], uu = acc[ai][1][m][c >> 2][c & 3];
                    v[m][c] = g * __builtin_amdgcn_rcpf(1.0f + __builtin_amdgcn_exp2f(-1.4426950408889634f * g)) * uu; }
            float s1[2][2][8];
#pragma unroll
            for (int mm = 0; mm < 2; ++mm)
#pragma unroll
                for (int c = 0; c < 8; ++c) { auto r = __builtin_amdgcn_permlane32_swap(__float_as_uint(v[mm][c]), __float_as_uint(v[mm + 2][c]), false, false);
                    s1[mm][0][c] = __uint_as_float(r[0]); s1[mm][1][c] = __uint_as_float(r[1]); }
            f32x16 lo, hi;
#pragma unroll
            for (int hh = 0; hh < 2; ++hh)
#pragma unroll
                for (int c = 0; c < 8; ++c) { auto r = __builtin_amdgcn_permlane16_swap(__float_as_uint(s1[0][hh][c]), __float_as_uint(s1[1][hh][c]), false, false);
                    if (hh == 0) { lo[c] = __uint_as_float(r[0]); lo[8 + c] = __uint_as_float(r[1]); } else { hi[c] = __uint_as_float(r[0]); hi[8 + c] = __uint_as_float(r[1]); } }
            unsigned sb; const u32x6 q = mx6_block(lo, hi, sb);
            unsigned char* o = h + (size_t)(u.pm * BM + ai * HALF + wr * 64 + fq * 16 + fr) * ldh + u.aux * 128 + 16 * wc;
            *(u32x4*)o = (u32x4){q[0], q[1], q[2], q[3]}; *(u32x4*)(o + 64) = (u32x4){q[4], q[5], sb, 0u};
        }
    }
};
struct EpiBf16Out {
    static constexpr int MID_T = -1;
    static constexpr bool PERM = true;
    bf16_t* o; int ld; float sc;
    __device__ __forceinline__ void operator()(const f32x4 (&acc)[2][2][4][2], const Unit& u, int wr, int wc, int fr, int fq) const {
        const int row0 = u.pm * BM + wr * 64 + fr;
#pragma unroll
        for (int ai = 0; ai < 2; ++ai)
#pragma unroll
            for (int m = 0; m < 4; ++m)
#pragma unroll
                for (int bj = 0; bj < 2; ++bj) *(u32x4*)(o + (size_t)(row0 + ai * HALF + m * 16) * ld + u.aux * BM + bj * HALF + wc * 32 + fq * 8) = pack8(acc[ai][bj][m][0] * sc, acc[ai][bj][m][1] * sc);
    }
};
struct EpiBf16OutK {
    static constexpr int MID_T = -1;
    static constexpr bool PERM = true;
    bf16_t* o; bf16_t* yp;
    __device__ __forceinline__ void operator()(const f32x4 (&acc)[2][2][4][2], const Unit& u, int wr, int wc, int fr, int fq) const {
        bf16_t* base; int ld;
        if (u.kx) { base = yp + ((size_t)(((u.kx >> 8) & 255) * 128 + (u.kx & 255) - 1) * 256 + wr * 64 + fr) * 256; ld = 256; }
        else { base = o + (size_t)(u.pm * BM + wr * 64 + fr) * D + u.aux * BM; ld = D; }
#pragma unroll
        for (int ai = 0; ai < 2; ++ai)
#pragma unroll
            for (int m = 0; m < 4; ++m)
#pragma unroll
                for (int bj = 0; bj < 2; ++bj) *(u32x4*)(base + (size_t)(ai * HALF + m * 16) * ld + bj * HALF + wc * 32 + fq * 8) = pack8(acc[ai][bj][m][0], acc[ai][bj][m][1]);
    }
};
}

namespace att {
constexpr int NW = 8, QBLK = 32, KVBLK = 64;
constexpr float THR = 8.f;
constexpr int PPITCH = 80;
constexpr int VPITCH = 80;
constexpr float THR8 = 3.f;
constexpr float PK8 = 4.f;
constexpr int SHM_V = KVBLK * 128 * 2, SHM_K = KVBLK * 272, SHM_P = KVBLK * PPITCH;
constexpr int OFF_V = 0, OFF_K = 3 * SHM_V, OFF_P = OFF_K + 2 * SHM_K,     OFF_WS = OFF_P + 2 * SHM_P, OFF_QP = OFF_WS + NW * 64 * 4, SHM_ATTN = OFF_QP + NW * 4096;
typedef LAS const char* lptr;
typedef short v4i16_t __attribute__((ext_vector_type(4)));
#define SBAR() __builtin_amdgcn_sched_barrier(0)
#define PIN(x) asm volatile("" : "+v"(x))
__device__ __forceinline__ int crow(int r, int hi) { return (r & 3) + 8 * (r >> 2) + 4 * hi; }
__device__ __forceinline__ bf16x8 ldk(lptr p) { return *(const LAS bf16x8*)p; }
__device__ __forceinline__ s16x4 vtr(lptr p) { return __builtin_bit_cast(s16x4, __builtin_amdgcn_ds_read_tr16_b64_v4i16((LAS v4i16_t*)p)); }
__device__ __forceinline__ int v_st(int k, int c) { const int kk = (k & ~0xC) | ((k & 4) << 1) | ((k & 8) >> 1); return ((kk >> 3) * 4 + (c >> 5)) * 512 + ((kk & 7) * 32 + (c & 31)) * 2; }
__device__ __forceinline__ int v_rd_base(int lane) { return ((lane & 3) << 3) | (((lane >> 2) & 3) << 6) | (((lane >> 4) & 1) << 5) | (((lane >> 5) & 1) << 8); }
__device__ __forceinline__ bf16x8 pk4(float a0, float a1, float a2, float a3, float a4, float a5, float a6, float a7) {
  const unsigned x0 = cvt_pk_bf16(a0, a1), x1 = cvt_pk_bf16(a2, a3), y0 = cvt_pk_bf16(a4, a5), y1 = cvt_pk_bf16(a6, a7);
  auto r0 = __builtin_amdgcn_permlane32_swap(x0, y0, false, false); auto r1 = __builtin_amdgcn_permlane32_swap(x1, y1, false, false);
  u32x4 w = {r0[0], r1[0], r0[1], r1[1]}; return __builtin_bit_cast(bf16x8, w);
}
constexpr int PD = 2;
constexpr int KP8 = 144;
template <bool R8> __device__ __forceinline__ bf16x8 kfrag(lptr kb, int n) { const int d0 = n >> 1, h = n & 1; return R8 ? ldk(kb + h * (32 * KP8) + d0 * 32) : ldk(kb + h * (32 * 272) + d0 * 32); }
typedef int v8i32_t __attribute__((ext_vector_type(8)));
__device__ __forceinline__ v8i32_t cat8(const bf16x8 a, const bf16x8 b) { return __builtin_bit_cast(v8i32_t, __builtin_shufflevector(__builtin_bit_cast(u32x4, a), __builtin_bit_cast(u32x4, b), 0, 1, 2, 3, 4, 5, 6, 7)); }
template <int NQ, bool DO_QK, bool DO_FIN>
__device__ __forceinline__ void phaseA(f32x16& C0, f32x16& C1, const f32x16& P0, const f32x16& P1, float alphaP, float& l_reg, bf16x8 (&pa)[4],
                                       lptr kb, lptr pb, const bf16x8 (&q0)[2], const bf16x8 (&q1)[2], const bf16x8 (&rq)[2], const bf16x8 (&qr)[8], const f32x16& Ci) {
  constexpr bool R8 = NQ > 8;
  constexpr int NN = R8 ? 0 : 16, NF = R8 ? 6 : 16;
  float s0 = 0.f, s1 = 0.f, s2 = 0.f, s3 = 0.f;
  bf16x8 f[NN + PD]; bf16x8 fa[6][2]; u32x4 pw[2] = {};
  auto afrag = [&](int i, bf16x8 (&d)[2]) { const int blk = i >> 1, h = i & 1; const lptr p = blk < 2 ? kb + h * (32 * KP8) + blk * 64 : pb + h * (32 * PPITCH); d[0] = ldk(p); d[1] = ldk(p + 16); };
  if (DO_QK) {
    if (R8) { afrag(0, fa[0]); afrag(1, fa[1]); }
    else {
#pragma unroll
      for (int n = 0; n < PD; ++n) f[n] = kfrag<false>(kb, n);
    }
  }
#pragma unroll
  for (int n = 0; n < NF; ++n) {
    if (DO_QK) {
      if (R8) {
        if (n + 2 < 6) afrag(n + 2, fa[n + 2]);
        const int blk = n >> 1;
        const v8i32_t b = blk == 0 ? cat8(q0[0], q0[1]) : blk == 1 ? cat8(q1[0], q1[1]) : cat8(rq[0], rq[1]);
        const v8i32_t a = cat8(fa[n][0], fa[n][1]);
        if (n == 0)            C0 = __builtin_amdgcn_mfma_scale_f32_32x32x64_f8f6f4(a, b, Ci, 0, 0, 0, 0x7F7F7F7F, 0, 0x7C7C7C7C);
        else if (n == 1)       C1 = __builtin_amdgcn_mfma_scale_f32_32x32x64_f8f6f4(a, b, Ci, 0, 0, 0, 0x7F7F7F7F, 0, 0x7C7C7C7C);
        else if ((n & 1) == 0) C0 = __builtin_amdgcn_mfma_scale_f32_32x32x64_f8f6f4(a, b, C0, 0, 0, 0, 0x7F7F7F7F, 0, 0x7C7C7C7C);
        else                   C1 = __builtin_amdgcn_mfma_scale_f32_32x32x64_f8f6f4(a, b, C1, 0, 0, 0, 0x7F7F7F7F, 0, 0x7C7C7C7C);
      } else {
        if (n + PD < NN) f[n + PD] = kfrag<false>(kb, n + PD);
        const bf16x8 qf = qr[n >> 1];
        if (n == 0)            C0 = __builtin_amdgcn_mfma_f32_32x32x16_bf16(f[n], qf, f32x16{}, 0, 0, 0);
        else if (n == 1)       C1 = __builtin_amdgcn_mfma_f32_32x32x16_bf16(f[n], qf, f32x16{}, 0, 0, 0);
        else if ((n & 1) == 0) C0 = __builtin_amdgcn_mfma_f32_32x32x16_bf16(f[n], qf, C0, 0, 0, 0);
        else                   C1 = __builtin_amdgcn_mfma_f32_32x32x16_bf16(f[n], qf, C1, 0, 0, 0);
      }
    }
    if (DO_FIN) {
#pragma unroll
      for (int e = n * 32 / NF; e < (n + 1) * 32 / NF; ++e) { const float v = e < 16 ? P0[e & 15] : P1[e & 15]; if ((e & 3) == 0) s0 += v; else if ((e & 3) == 1) s1 += v; else if ((e & 3) == 2) s2 += v; else s3 += v; }
      PIN(s0); PIN(s1); PIN(s2); PIN(s3);
      if (R8) {
        if (n == NF / 8 || n == 3 * NF / 8 || n == 5 * NF / 8 || n == 7 * NF / 8) {
          const int m = (n == NF / 8) ? 0 : (n == 3 * NF / 8) ? 1 : (n == 5 * NF / 8) ? 2 : 3;
          const unsigned X = pk_fp8x4(P0[4 * m], P0[4 * m + 1], P0[4 * m + 2], P0[4 * m + 3]), Y = pk_fp8x4(P1[4 * m], P1[4 * m + 1], P1[4 * m + 2], P1[4 * m + 3]);
          auto r = __builtin_amdgcn_permlane32_swap(X, Y, false, false);
          pw[m >> 1][2 * (m & 1)] = r[0]; pw[m >> 1][2 * (m & 1) + 1] = r[1]; PIN(pw[m >> 1]);
          if (m == 1) pa[0] = __builtin_bit_cast(bf16x8, pw[0]);
          if (m == 3) pa[1] = __builtin_bit_cast(bf16x8, pw[1]);
        }
      } else {
      if (n == NF / 8)     { pa[0] = pk4(P0[0], P0[1], P0[2], P0[3], P0[4], P0[5], P0[6], P0[7]); PIN(pa[0]); }
      if (n == 3 * NF / 8) { pa[1] = pk4(P0[8], P0[9], P0[10], P0[11], P0[12], P0[13], P0[14], P0[15]); PIN(pa[1]); }
      if (n == 5 * NF / 8) { pa[2] = pk4(P1[0], P1[1], P1[2], P1[3], P1[4], P1[5], P1[6], P1[7]); PIN(pa[2]); }
      if (n == 7 * NF / 8) { pa[3] = pk4(P1[8], P1[9], P1[10], P1[11], P1[12], P1[13], P1[14], P1[15]); PIN(pa[3]); }
      }
    }
    SBAR();
  }
  if (DO_FIN) { float ps = (s0 + s1) + (s2 + s3); auto rr = __builtin_amdgcn_permlane32_swap(__float_as_uint(ps), __float_as_uint(ps), false, false);
    ps = __uint_as_float(rr[0]) + __uint_as_float(rr[1]); l_reg = l_reg * alphaP + ps; }
}
template <bool R8, bool MASK, bool DO_PV, bool DO_SM>
__device__ __forceinline__ void phaseB(f32x16 (&o)[4], const bf16x8 (&pa)[4], f32x16& C0, f32x16& C1, float& m_reg, float& alpha, lptr vb, float Cs, float thr_raw, int qi, int k0, int hi, f32x16& Ci) {
  s16x4 vl[16 + PD], vh[16 + PD]; bf16x8 fa[4][2];
  if (DO_PV && !R8) {
#pragma unroll
    for (int n = 0; n < PD; ++n) { const int d0 = n & 3, ks = n >> 2; vl[n] = vtr(vb + d0 * 512 + ks * 4096); vh[n] = vtr(vb + d0 * 512 + ks * 4096 + 2048); }
  }
  if (DO_PV && R8) { fa[0][0] = ldk(vb); fa[0][1] = ldk(vb + 16); }
  float mx = -3.0e38f, mnC = 0.f;
#pragma unroll
  for (int n = 0; n < 16; ++n) {
    if (DO_PV && R8) {
      if ((n & 3) == 1 && n < 12) { const int db = (n >> 2) + 1; fa[db][0] = ldk(vb + db * 32 * VPITCH); fa[db][1] = ldk(vb + db * 32 * VPITCH + 16); }
      if ((n & 3) == 0) { const int db = n >> 2; o[db] = __builtin_amdgcn_mfma_scale_f32_32x32x64_f8f6f4(cat8(fa[db][0], fa[db][1]), cat8(pa[0], pa[1]), o[db], 0, 0, 0, 0x7F7F7F7F, 0, 0x7F7F7F7F); }
    }
    if (DO_PV && !R8) {
      const int d0 = n & 3, ks = n >> 2;
      if (n + PD < 16) { const int d1 = (n + PD) & 3, k1 = (n + PD) >> 2; vl[n + PD] = vtr(vb + d1 * 512 + k1 * 4096); vh[n + PD] = vtr(vb + d1 * 512 + k1 * 4096 + 2048); }
      const bf16x8 vf = (bf16x8){vl[n][0], vl[n][1], vl[n][2], vl[n][3], vh[n][0], vh[n][1], vh[n][2], vh[n][3]};
      o[d0] = __builtin_amdgcn_mfma_f32_32x32x16_bf16(pa[ks], vf, o[d0], 0, 0, 0);
    }
    if (DO_SM) {
      if (n < 4) {
#pragma unroll
        for (int e = n * 8; e < n * 8 + 8; ++e) {
          if (MASK) { const int d = qi - (k0 + (e < 16 ? 0 : 32) + crow(e & 15, hi)); if (d > 128 || d < -128) { if (e < 16) C0[e & 15] = -1e30f; else C1[e & 15] = -1e30f; } }
          mx = fmaxf(mx, e < 16 ? C0[e & 15] : C1[e & 15]); }
        PIN(mx);
      } else if (n == 4 && R8) {
        auto rr = __builtin_amdgcn_permlane32_swap(__float_as_uint(mx), __float_as_uint(mx), false, false);
        const float pmax = fmaxf(__uint_as_float(rr[0]), __uint_as_float(rr[1]));
        const bool keep = DO_PV ? __all(pmax <= PK8 + THR8 * 1.4426950408889634f) : false;
        alpha = 1.f;
        if (!keep) { const float d = DO_PV ? fmaxf(pmax - PK8, 0.f) : pmax - PK8; alpha = DO_PV ? __builtin_amdgcn_exp2f(-d) : 1.f; C0 -= d; C1 -= d; Ci -= d; }
        PIN(alpha);
      } else if (n == 4) {
        auto rr = __builtin_amdgcn_permlane32_swap(__float_as_uint(mx), __float_as_uint(mx), false, false);
        const float pmax = fmaxf(__uint_as_float(rr[0]), __uint_as_float(rr[1]));
        const bool keep = __all(pmax - m_reg <= thr_raw);
        const float mn = keep ? m_reg : fmaxf(m_reg, pmax);
        alpha = __builtin_amdgcn_exp2f((m_reg - mn) * Cs); m_reg = mn; mnC = -mn * Cs + (R8 ? PK8 : 0.f); PIN(alpha); PIN(mnC);
      } else {
#pragma unroll
        for (int e = (n - 5) * 32 / 11; e < (n - 4) * 32 / 11; ++e) {
          if (R8) { if (e < 16) C0[e] = __builtin_amdgcn_exp2f(C0[e]); else C1[e - 16] = __builtin_amdgcn_exp2f(C1[e - 16]); }
          else { if (e < 16) C0[e] = __builtin_amdgcn_exp2f(fmaf(C0[e], Cs, mnC)); else C1[e - 16] = __builtin_amdgcn_exp2f(fmaf(C1[e - 16], Cs, mnC)); } }
        if ((n - 5) * 32 / 11 < 16) PIN(C0); if ((n - 4) * 32 / 11 > 16) PIN(C1);
      }
    }
    SBAR();
  }
}

template <int DQK, bool MASK, int LDQ, int LDK, int LDP, int LDV, int LDO>
__device__ __forceinline__ void attn_body(const bf16_t* __restrict__ Qb, const bf16_t* __restrict__ Kb, const unsigned char* __restrict__ Kn8, const bf16_t* __restrict__ Pb, const bf16_t* __restrict__ Vb,
                                          bf16_t* __restrict__ Ob, float* __restrict__ ssq, int q0, int kstart, int NT, float scale, float sink_raw, LAS char* lds) {
  constexpr int NQ = DQK / 16;
  constexpr bool R8 = NQ > 8;
  const float Cs = scale * 1.4426950408889634f, thr_raw = (R8 ? THR8 : THR) / scale;
  const int tid = tid_opaque(), wid = tid >> 6, lane = tid & 63, r32 = lane & 31, hi = lane >> 5;
  LAS char* V_lds = lds + OFF_V; LAS char* K_lds = lds + OFF_K; LAS char* P_lds = lds + OFF_P;
  LAS float* ws = (LAS float*)(lds + OFF_WS) + wid * 64; LAS float* li_l = ws; LAS float* al_l = ws + 32;
  float m_reg = MASK ? sink_raw : -1e30f, l_reg = MASK ? 1.f : 0.f; f32x16 o[4] = {}; bf16x8 qr[8];
  const bf16_t* Qw = Qb + (long)(wid * QBLK + r32) * LDQ + hi * 8;
  LAS char* Qp = lds + OFF_QP + wid * 4096 + lane * 16;
  if (NQ <= 8) {
#pragma unroll
    for (int d0 = 0; d0 < 8; ++d0) qr[d0] = *reinterpret_cast<const bf16x8*>(Qw + d0 * 16);
  }
  bf16x8 rq[2] = {}, qa0[2] = {}, qa1[2] = {}, qb0[2] = {}, qb1[2] = {};
  if (NQ > 8) {
    const unsigned char* q8 = (const unsigned char*)(Qb + (long)(wid * QBLK + r32) * LDQ) + hi * 32;
    rq[0]  = *reinterpret_cast<const bf16x8*>(q8 + 256); rq[1]  = *reinterpret_cast<const bf16x8*>(q8 + 272);
    qa0[0] = *reinterpret_cast<const bf16x8*>(q8 + 320); qa0[1] = *reinterpret_cast<const bf16x8*>(q8 + 336);
    qa1[0] = *reinterpret_cast<const bf16x8*>(q8 + 128); qa1[1] = *reinterpret_cast<const bf16x8*>(q8 + 144);
    qb0[0] = *reinterpret_cast<const bf16x8*>(q8);       qb0[1] = *reinterpret_cast<const bf16x8*>(q8 + 16);
    qb1[0] = *reinterpret_cast<const bf16x8*>(q8 + 64);  qb1[1] = *reinterpret_cast<const bf16x8*>(q8 + 80);
  }
  const int sr = tid >> 4, sc = (tid & 15) * 8, vst0 = v_st(sr, sc), vst1 = v_st(32 + sr, sc);
  const int pr = tid >> 3, pc = (tid & 7) * 8;
  const lptr kb0 = R8 ? (lptr)K_lds + r32 * KP8 + hi * 32 : (lptr)K_lds + r32 * 272 + hi * 16, pb0 = (lptr)P_lds + r32 * PPITCH + hi * 32, vb0 = R8 ? (lptr)V_lds + r32 * VPITCH + hi * 32 : (lptr)V_lds + v_rd_base(lane);
  const int qi = q0 + wid * QBLK + r32;
  bf16x8 vs0, vs1, ks0, ks1; u32x2 ps0;
  const unsigned voff0 = sr * LDV + sc, voff1 = (32 + sr) * LDV + sc, koff0 = sr * LDK + sc, koff1 = (32 + sr) * LDK + sc, poff = pr * LDP + pc, voff8 = (unsigned)(tid >> 2) * LDV + (tid & 3) * 16, koff8 = pr * LDK + 64 + pc;
#define SLOAD(k0) do { const bf16_t* Kt = Kb + (long)(k0) * LDK; \
    if (R8) { vs0 = *reinterpret_cast<const bf16x8*>((const unsigned char*)Vb + (long)(k0) + voff8); } \
    else { const bf16_t* Vt = Vb + (long)(k0) * LDV; vs0 = *reinterpret_cast<const bf16x8*>(Vt + voff0); vs1 = *reinterpret_cast<const bf16x8*>(Vt + voff1); } \
    if (R8) { ks0 = *reinterpret_cast<const bf16x8*>(Kn8 + (long)((k0) + pr) * 1024 + pc * 2); } \
    else { ks0 = *reinterpret_cast<const bf16x8*>(Kt + koff0); ks1 = *reinterpret_cast<const bf16x8*>(Kt + koff1); } \
    if (NQ > 8) { const unsigned char* Pt = (const unsigned char*)Pb + (long)(k0) * LDP; ps0 = *reinterpret_cast<const u32x2*>(Pt + poff); } } while (0)
#define SWRITE(kb_, vo_) do { if (R8) { *(LAS bf16x8*)(V_lds + (vo_) + (tid >> 2) * VPITCH + (tid & 3) * 16) = vs0; } else { *(LAS bf16x8*)(V_lds + (vo_) + vst0) = vs0; *(LAS bf16x8*)(V_lds + (vo_) + vst1) = vs1; } \
    if (R8) { *(LAS bf16x8*)(K_lds + (kb_) * SHM_K + pr * KP8 + pc * 2) = ks0; } \
    else { *(LAS bf16x8*)(K_lds + (kb_) * SHM_K + sr * 272 + sc * 2) = ks0; *(LAS bf16x8*)(K_lds + (kb_) * SHM_K + (32 + sr) * 272 + sc * 2) = ks1; } \
    if (NQ > 8) *(LAS u32x2*)(P_lds + (kb_) * SHM_P + pr * PPITCH + pc) = ps0; } while (0)
#define SWAIT() asm volatile("s_waitcnt vmcnt(0)" ::: "memory")
#define RESC(a) do { if (__any((a) < 1.f)) { if (R8) { _Pragma("unroll") for (int d = 0; d < 4; ++d) o[d] *= (a); } else { if (hi == 0) al_l[r32] = (a); asm volatile("s_waitcnt lgkmcnt(0)" ::: "memory"); \
    _Pragma("unroll") for (int d = 0; d < 4; ++d) _Pragma("unroll") for (int r = 0; r < 16; ++r) o[d][r] *= al_l[crow(r, hi)]; } } } while (0)
#define ROTV() do { const int t_ = vprev; vprev = vcur; vcur = vnext; vnext = t_; } while (0)
  f32x16 pA0, pA1, pB0, pB1; float alA = 1.f, alB = 1.f; bf16x8 pa[4]; f32x16 Ci = {};
  int vprev = 0, vcur = SHM_V, vnext = 2 * SHM_V;
  SLOAD(kstart); SWAIT(); SWRITE(0, 0); __syncthreads();
  SLOAD(kstart + KVBLK);
  phaseA<NQ, true, false>(pA0, pA1, pA0, pA1, 1.f, l_reg, pa, kb0, pb0, qa0, qa1, rq, qr, Ci);
  SWAIT(); SWRITE(1, SHM_V);
  phaseB<R8, MASK, false, true>(o, pa, pA0, pA1, m_reg, alA, vb0, Cs, thr_raw, qi, kstart, hi, Ci);
  __syncthreads();
  for (int j = 1; j + 1 < NT; j += 2) {
    SBAR(); SLOAD(kstart + (j + 1) * KVBLK); SBAR();
    phaseA<NQ, true, true>(pB0, pB1, pA0, pA1, alA, l_reg, pa, kb0 + SHM_K, pb0 + SHM_P, qb0, qb1, rq, qr, Ci);
    SWAIT(); SWRITE(0, vnext);
    phaseB<R8, MASK, true, true>(o, pa, pB0, pB1, m_reg, alB, vb0 + vprev, Cs, thr_raw, qi, kstart + j * KVBLK, hi, Ci);
    RESC(alB); ROTV(); __syncthreads();
    SBAR(); if (j + 2 < NT) SLOAD(kstart + (j + 2) * KVBLK); SBAR();
    phaseA<NQ, true, true>(pA0, pA1, pB0, pB1, alB, l_reg, pa, kb0, pb0, qa0, qa1, rq, qr, Ci);
    if (j + 2 < NT) { SWAIT(); SWRITE(1, vnext); }
    phaseB<R8, MASK, true, true>(o, pa, pA0, pA1, m_reg, alA, vb0 + vprev, Cs, thr_raw, qi, kstart + (j + 1) * KVBLK, hi, Ci);
    RESC(alA); ROTV(); __syncthreads();
  }
  SBAR(); phaseA<NQ, true, true>(pB0, pB1, pA0, pA1, alA, l_reg, pa, kb0 + SHM_K, pb0 + SHM_P, qb0, qb1, rq, qr, Ci);
  phaseB<R8, MASK, true, true>(o, pa, pB0, pB1, m_reg, alB, vb0 + vprev, Cs, thr_raw, qi, kstart + (NT - 1) * KVBLK, hi, Ci);
  RESC(alB); ROTV();
  phaseA<NQ, false, true>(pA0, pA1, pB0, pB1, alB, l_reg, pa, kb0, pb0, qa0, qa1, rq, qr, Ci);
  phaseB<R8, MASK, true, false>(o, pa, pA0, pA1, m_reg, alA, vb0 + vprev, Cs, thr_raw, qi, 0, hi, Ci);
  if (R8) {
    const float rl = __builtin_amdgcn_rcpf(l_reg); float sq = 0.f; bf16_t* Orow = Ob + (long)(wid * QBLK + r32) * LDO + 4 * hi;
#pragma unroll
    for (int db = 0; db < 4; ++db)
#pragma unroll
      for (int g = 0; g < 4; ++g) { const float v0 = o[db][4 * g] * rl, v1 = o[db][4 * g + 1] * rl, v2 = o[db][4 * g + 2] * rl, v3 = o[db][4 * g + 3] * rl; sq += (v0 * v0 + v1 * v1) + (v2 * v2 + v3 * v3);
        u32x2 w; w.x = cvt_pk_bf16(v0, v1); w.y = cvt_pk_bf16(v2, v3); *(u32x2*)(Orow + db * 32 + 8 * g) = w; }
    auto rr = __builtin_amdgcn_permlane32_swap(__float_as_uint(sq), __float_as_uint(sq), false, false); sq = __uint_as_float(rr[0]) + __uint_as_float(rr[1]);
    if (hi == 0) ssq[(long)(wid * QBLK + r32) * 16] = sq;
  } else {
  if (hi == 0) li_l[r32] = l_reg; asm volatile("s_waitcnt lgkmcnt(0)" ::: "memory");
  bf16_t* Ow = Ob + (long)(wid * QBLK) * LDO;
#pragma unroll
  for (int r = 0; r < 16; ++r) { const int orow = crow(r, hi); const float rl = __builtin_amdgcn_rcpf(li_l[orow]); float sq = 0.f;
#pragma unroll
    for (int d0 = 0; d0 < 4; ++d0) { const float v = o[d0][r] * rl; sq += v * v; Ow[(long)orow * LDO + d0 * 32 + r32] = (bf16_t)(cvt_pk_bf16(v, v) & 0xffffu); }
#pragma unroll
    for (int s = 1; s < 32; s <<= 1) sq += __shfl_xor(sq, s);
    if (r32 == 0) ssq[(long)(wid * QBLK + orow) * 16] = sq; }
  }
  __syncthreads();
#undef SLOAD
#undef SWRITE
#undef SWAIT
#undef RESC
#undef ROTV
}
#undef SBAR
#undef PIN
}

constexpr int NWAVES = 8;
#ifndef PROBE_ATT
#define PROBE_ATT 1
#endif
#ifndef PROBE_PRO
#define PROBE_PRO 1
#endif
#ifndef PROBE_MOEUP
#define PROBE_MOEUP 1
#endif
constexpr int RING_BYTES = 133120;
constexpr int MISC_OFF = 139264, LDS_BYTES = 147456;
static_assert(att::SHM_ATTN <= MISC_OFF && RING_BYTES <= MISC_OFF, "LDS map");
constexpr int NPHASE = 21;

__device__ const float INVF[64] = {
 1.000000000e+00f, 8.659643531e-01f, 7.498942018e-01f, 6.493816376e-01f, 5.623413324e-01f, 4.869675338e-01f, 4.216965139e-01f, 3.651741147e-01f, 3.162277639e-01f, 2.738419771e-01f, 2.371373773e-01f, 2.053525001e-01f, 1.778279394e-01f, 1.539926529e-01f, 1.333521456e-01f, 1.154781953e-01f,
 1.000000015e-01f, 8.659642935e-02f, 7.498942316e-02f, 6.493816525e-02f, 5.623413250e-02f, 4.869675264e-02f, 4.216964915e-02f, 3.651741147e-02f, 3.162277490e-02f, 2.738419548e-02f, 2.371373773e-02f, 2.053525113e-02f, 1.778279431e-02f, 1.539926510e-02f, 1.333521400e-02f, 1.154781971e-02f,
 9.999999776e-03f, 8.659643121e-03f, 7.498942316e-03f, 6.493816152e-03f, 5.623413250e-03f, 4.869675264e-03f, 4.216964822e-03f, 3.651741194e-03f, 3.162277630e-03f, 2.738419687e-03f, 2.371373819e-03f, 2.053525066e-03f, 1.778279431e-03f, 1.539926510e-03f, 1.333521446e-03f, 1.154782018e-03f,
 1.000000047e-03f, 8.659643354e-04f, 7.498941850e-04f, 6.493816036e-04f, 5.623413017e-04f, 4.869675322e-04f, 4.216965172e-04f, 3.651741135e-04f, 3.162277571e-04f, 2.738419571e-04f, 2.371373703e-04f, 2.053525095e-04f, 1.778279402e-04f, 1.539926598e-04f, 1.333521504e-04f, 1.154782003e-04f };

struct Args { const float* in[21]; float* out; unsigned char* ws; int ph_lo, ph_hi; };

__device__ __forceinline__ float wave_sum(float v) {
#pragma unroll
    for (int o = 1; o < 64; o <<= 1) v += __shfl_xor(v, o);
    return v;
}
__device__ __forceinline__ void sincos_acc(float ang, float& sn, float& cs) {
    const double a = (double)ang;
    const double n = __builtin_rint(a * 0.63661977236758134308);
    double r = __builtin_fma(-n, 1.57079632679489655800, a); r = __builtin_fma(-n, 6.12323399573676603587e-17, r);
    const double r2 = r * r;
    double sp = 1.0 / 6227020800.0; sp = __builtin_fma(sp, r2, -1.0 / 39916800.0); sp = __builtin_fma(sp, r2, 1.0 / 362880.0); sp = __builtin_fma(sp, r2, -1.0 / 5040.0);
    sp = __builtin_fma(sp, r2, 1.0 / 120.0); sp = __builtin_fma(sp, r2, -1.0 / 6.0); sp = __builtin_fma(sp * r2, r, r);
    double cp = 1.0 / 479001600.0; cp = __builtin_fma(cp, r2, -1.0 / 3628800.0); cp = __builtin_fma(cp, r2, 1.0 / 40320.0); cp = __builtin_fma(cp, r2, -1.0 / 720.0);
    cp = __builtin_fma(cp, r2, 1.0 / 24.0); cp = __builtin_fma(cp, r2, -0.5); cp = __builtin_fma(cp, r2, 1.0);
    const int q = ((int)n) & 3;
    const double s_ = (q & 1) ? cp : sp, c_ = (q & 1) ? sp : cp;
    sn = (float)((q & 2) ? -s_ : s_); cs = (float)(((q + 1) & 2) ? -c_ : c_);
}

__device__ __forceinline__ int src_quad(int kind, int n, int coff) {
    if (kind == 0) return coff + n;
    if (kind == 1) {
        if (n < 768 || (n >= 2112 && n < 2368)) return n;
        if (n >= 2368) return -1;
        int base, half, j;
        if (n < 832) { base = 768; half = 32; j = n - 768; } else if (n < 1856) { j = (n - 832) & 127; base = n - j; half = 64; } else { j = (n - 1856) & 127; base = n - j; half = 64; }
        const int g = j >> 3, e = j & 7; return base + (e < 4 ? 4 * g : half + 4 * g);
    }
    { const int head = n / 192, j = n - head * 192; if (j < 128) return n; const int jj = j - 128, g = jj >> 3, e = jj & 7; return head * 192 + 128 + (e < 4 ? 4 * g : 32 + 4 * g); }
}
__device__ __forceinline__ void tr_item(const float* __restrict__ src, int Nsrc, int K, bf16_t* __restrict__ dst, int k0, int n0, int kind, int coff,
                                        const float* __restrict__ gain, const float* __restrict__ gain2, LAS unsigned* scr, int lane) {
    const int nl = 4 * (lane & 15), ks = lane >> 4;
    const int sq = src_quad(kind, n0 + nl, coff);
#pragma unroll 4
    for (int r = 0; r < 16; ++r) {
        const int k = k0 + 8 * r + 2 * ks;
        f32x4 a = (f32x4){0.f, 0.f, 0.f, 0.f}, b = a;
        if (sq >= 0) { a = *(const f32x4*)(src + (size_t)k * Nsrc + sq); b = *(const f32x4*)(src + (size_t)(k + 1) * Nsrc + sq); }
        if (gain) { const float ga = (gain2 && k >= 1024) ? gain2[k - 1024] : gain[k], gb = (gain2 && k + 1 >= 1024) ? gain2[k + 1 - 1024] : gain[k + 1]; a *= ga; b *= gb; }
#pragma unroll
        for (int j = 0; j < 4; ++j) scr[(nl + j) * 65 + 4 * r + ks] = cvt_pk_bf16(a[j], b[j]);
    }
    asm volatile("s_waitcnt lgkmcnt(0)" ::: "memory");
#pragma unroll 4
    for (int it = 0; it < 16; ++it) {
        const int row = it * 4 + (lane >> 4), ch = lane & 15;
        const LAS unsigned* p = scr + row * 65 + 4 * ch;
        u32x4 w; w.x = p[0]; w.y = p[1]; w.z = p[2]; w.w = p[3];
        *(u32x4*)(dst + (size_t)(n0 + row) * K + k0 + 8 * ch) = w;
    }
    asm volatile("s_waitcnt lgkmcnt(0)" ::: "memory");
}
__device__ __forceinline__ void tr_item8(const float* __restrict__ src, int Nsrc, int K, unsigned char* __restrict__ dst, int k0, int n0, int scol, float scale, LAS unsigned* scr, int lane) {
    const int nl = 4 * (lane & 15), ks = lane >> 4;
#pragma unroll 4
    for (int r = 0; r < 16; ++r) {
        const int k = k0 + 16 * r + 4 * ks; const float* p = src + (size_t)k * Nsrc + scol + nl;
        const f32x4 a = *(const f32x4*)p * scale, b = *(const f32x4*)(p + Nsrc) * scale, c = *(const f32x4*)(p + 2 * (size_t)Nsrc) * scale, d = *(const f32x4*)(p + 3 * (size_t)Nsrc) * scale;
#pragma unroll
        for (int j = 0; j < 4; ++j) scr[(nl + j) * 65 + 4 * r + ks] = pk_fp8x4(a[j], b[j], c[j], d[j]);
    }
    asm volatile("s_waitcnt lgkmcnt(0)" ::: "memory");
#pragma unroll 4
    for (int it = 0; it < 16; ++it) {
        const int row = it * 4 + (lane >> 4), ch = lane & 15;
        const LAS unsigned* p = scr + row * 65 + 4 * ch;
        u32x4 w; w.x = p[0]; w.y = p[1]; w.z = p[2]; w.w = p[3];
        *(u32x4*)(dst + (size_t)(n0 + row) * K + k0 + 16 * ch) = w;
    }
    asm volatile("s_waitcnt lgkmcnt(0)" ::: "memory");
}
__device__ __forceinline__ void tr_item6(const float* __restrict__ src, int Nsrc, unsigned char* __restrict__ dst, int t, int n0, int scol, LAS unsigned* scr, int lane) {
    const int nl = 4 * (lane & 15), ks = lane >> 4;
    f32x4 a[16], b[16];
#pragma unroll
    for (int r = 0; r < 16; ++r) {
        const int kk = 8 * r + 2 * ks, k = 16 * t + 256 * (kk >> 4) + (kk & 15); const float* p = src + (size_t)k * Nsrc + scol + nl;
        a[r] = __builtin_nontemporal_load((const f32x4*)p); b[r] = __builtin_nontemporal_load((const f32x4*)(p + Nsrc));
    }
#pragma unroll
    for (int r = 0; r < 16; ++r) {
#pragma unroll
        for (int j = 0; j < 4; ++j) scr[(nl + j) * 65 + 4 * r + ks] = cvt_pk_bf16(a[r][j], b[r][j]);
    }
    asm volatile("s_waitcnt lgkmcnt(0)" ::: "memory");
#pragma unroll 1
    for (int it = 0; it < 4; ++it) {
        const int pidx = it * 64 + lane, n = pidx >> 2, g = pidx & 3;
        const LAS unsigned* p = scr + n * 65 + 2 * g;
        f32x16 lo, hi;
#pragma unroll
        for (int j = 0; j < 8; ++j) { const unsigned d0 = p[8 * j], d1 = p[8 * j + 1];
            const float x0 = __uint_as_float(d0 << 16), x1 = __uint_as_float(d0 & 0xffff0000u), x2 = __uint_as_float(d1 << 16), x3 = __uint_as_float(d1 & 0xffff0000u);
            if (j < 4) { lo[4 * j] = x0; lo[4 * j + 1] = x1; lo[4 * j + 2] = x2; lo[4 * j + 3] = x3; } else { hi[4 * (j - 4)] = x0; hi[4 * (j - 4) + 1] = x1; hi[4 * (j - 4) + 2] = x2; hi[4 * (j - 4) + 3] = x3; } }
        unsigned sb; const u32x6 q = mx6_block(lo, hi, sb);
        unsigned char* o = dst + (size_t)(n0 + n) * 2048 + t * 128 + 16 * g;
        *(u32x4*)o = (u32x4){q[0], q[1], q[2], q[3]}; *(u32x4*)(o + 64) = (u32x4){q[4], q[5], sb, 0u};
    }
    asm volatile("s_waitcnt lgkmcnt(0)" ::: "memory");
}
__device__ __forceinline__ void tr_item6c(const float* __restrict__ src, int Nsrc, int K, unsigned char* __restrict__ dst, int t, int n0, LAS unsigned* scr, int lane) {
    const int nl = 4 * (lane & 15), ks = lane >> 4;
    f32x4 a[16], b[16];
#pragma unroll
    for (int r = 0; r < 16; ++r) {
        const int k = 128 * t + 8 * r + 2 * ks; const float* p = src + (size_t)k * Nsrc + n0 + nl;
        a[r] = __builtin_nontemporal_load((const f32x4*)p); b[r] = __builtin_nontemporal_load((const f32x4*)(p + Nsrc));
    }
#pragma unroll
    for (int r = 0; r < 16; ++r) {
#pragma unroll
        for (int j = 0; j < 4; ++j) scr[(nl + j) * 65 + 4 * r + ks] = cvt_pk_bf16(a[r][j], b[r][j]);
    }
    asm volatile("s_waitcnt lgkmcnt(0)" ::: "memory");
#pragma unroll 1
    for (int it = 0; it < 4; ++it) {
        const int pidx = it * 64 + lane, n = pidx >> 2, g = pidx & 3;
        const LAS unsigned* p = scr + n * 65 + 16 * g;
        f32x16 lo, hi;
#pragma unroll
        for (int j = 0; j < 8; ++j) { const unsigned d0 = p[j], d1 = p[8 + j];
            lo[2 * j] = __uint_as_float(d0 << 16); lo[2 * j + 1] = __uint_as_float(d0 & 0xffff0000u); hi[2 * j] = __uint_as_float(d1 << 16); hi[2 * j + 1] = __uint_as_float(d1 & 0xffff0000u); }
        unsigned sb; const u32x6 q = mx6_block(lo, hi, sb);
        unsigned char* o = dst + (size_t)(n0 + n) * K + t * 128 + 16 * g;
        *(u32x4*)o = (u32x4){q[0], q[1], q[2], q[3]}; *(u32x4*)(o + 64) = (u32x4){q[4], q[5], sb, 0u};
    }
    asm volatile("s_waitcnt lgkmcnt(0)" ::: "memory");
}
__device__ __forceinline__ void tr_matrix6c(const float* src, int Nsrc, int K, unsigned char* dst, int Ndst, LAS unsigned* scr, int lane, int gw, int NGW, int& cursor) {
    const int nb = Ndst / 64, items = (K / 128) * nb;
    int it = (gw - (cursor % NGW) + NGW) % NGW;
    for (; it < items; it += NGW) tr_item6c(src, Nsrc, K, dst, it / nb, (it % nb) * 64, scr, lane);
    cursor += items;
}
__device__ __forceinline__ void tr_matrix6(const float* src, const float* src2, int Nsrc, unsigned char* dst, int Ndst, LAS unsigned* scr, int lane, int gw, int NGW, int& cursor) {
    const int nb = Ndst / 64, items = 16 * nb;
    int it = (gw - (cursor % NGW) + NGW) % NGW;
    for (; it < items; it += NGW) {
        const int t = it / nb, n0 = (it % nb) * 64, tile = n0 >> 8, j0 = n0 & 255;
        tr_item6(j0 < 128 ? src : src2, Nsrc, dst, t, n0, 128 * tile + (j0 & 127), scr, lane);
    }
    cursor += items;
}
__device__ __forceinline__ void tr_matrix8(const float* src, const float* src2, int Nsrc, int K, unsigned char* dst, int Ndst, int inter, float scale, LAS unsigned* scr, int lane, int gw, int NGW, int& cursor) {
    const int nb = Ndst / 64, items = (K / 256) * nb;
    int it = (gw - (cursor % NGW) + NGW) % NGW;
    for (; it < items; it += NGW) {
        const int kb = it / nb, n0 = (it % nb) * 64;
        if (inter) { const int tile = n0 >> 8, j0 = n0 & 255; tr_item8(j0 < 128 ? src : src2, Nsrc, K, dst, kb * 256, n0, 128 * tile + (j0 & 127), scale, scr, lane); }
        else tr_item8(src, Nsrc, K, dst, kb * 256, n0, n0, scale, scr, lane);
    }
    cursor += items;
}
__device__ __forceinline__ void tr_matrix(const float* src, const float* src2, int Nsrc, int K, bf16_t* dst, int Ndst, int kind, const float* gain, const float* gain2,
                                          LAS unsigned* scr, int lane, int gw, int NGW, int& cursor) {
    const int nb = Ndst / 64, items = (K / 128) * nb;
    int it = (gw - (cursor % NGW) + NGW) % NGW;
    for (; it < items; it += NGW) {
        const int kb = it / nb, n0 = (it % nb) * 64;
        if (kind == 3) { const int tile = n0 >> 8, j0 = n0 & 255; tr_item(j0 < 128 ? src : src2, Nsrc, K, dst, kb * 128, n0, 0, 128 * tile + (j0 & 127) - n0, nullptr, nullptr, scr, lane); }
        else tr_item(src, Nsrc, K, dst, kb * 128, n0, kind, 0, gain, gain2, scr, lane);
    }
    cursor += items;
}

constexpr int MOE_GU_ITEMS = 16 * (2 * FFE / 64), MOE_D_ITEMS = (FFE / 128) * (D / 64), MOE_E_ITEMS = MOE_GU_ITEMS + MOE_D_ITEMS, MOE_ITEMS = NE * MOE_E_ITEMS;
__device__ __forceinline__ void moe_conv_item(const Args& args, int j, LAS unsigned* scr, int lane) {
    const int e = j / MOE_E_ITEMS, r = j - e * MOE_E_ITEMS;
    if (r < MOE_GU_ITEMS) {
        constexpr int nb = 2 * FFE / 64;
        const int t = r / nb, n0 = (r % nb) * 64, tile = n0 >> 8, j0 = n0 & 255;
        tr_item6((j0 < 128 ? args.in[16] : args.in[17]) + (size_t)e * D * FFE, FFE, args.ws + WS_WMGU + (size_t)e * 2 * FFE * D, t, n0, 128 * tile + (j0 & 127), scr, lane);
    } else {
        const int r2 = r - MOE_GU_ITEMS, t = r2 / (D / 64), n0 = (r2 % (D / 64)) * 64;
        tr_item6c(args.in[18] + (size_t)e * FFE * D, D, FFE, args.ws + WS_WMD + (size_t)e * D * FFE, t, n0, scr, lane);
    }
}
__device__ __forceinline__ void moe_conv_burst(const Args& args, LAS unsigned char* lds, int part, int nparts) {
    const int tid = tid_opaque(), lane = tid & 63, wave = tid >> 6, gw = blockIdx.x * NWAVES + wave, NGW = gridDim.x * NWAVES;
    LAS unsigned* scr = (LAS unsigned*)(lds + wave * 16640);
    const int per = (MOE_ITEMS + NGW - 1) / NGW, i0 = per * part / nparts, i1 = per * (part + 1) / nparts;
    __syncthreads();
    for (int i = i0; i < i1; ++i) { const int j = gw + i * NGW; if (j < MOE_ITEMS) moe_conv_item(args, j, scr, lane); }
    __syncthreads();
}

__device__ __forceinline__ void ln_row(f32x4 (&v)[8], const float* __restrict__ g, const float* __restrict__ b, int lane, float& mean_o, float& rstd_o) {
    float s = 0.f;
#pragma unroll
    for (int j = 0; j < 8; ++j) s += (v[j][0] + v[j][1]) + (v[j][2] + v[j][3]);
    const float mean = wave_sum(s) * (1.f / D); float s2 = 0.f;
#pragma unroll
    for (int j = 0; j < 8; ++j) { v[j] = v[j] - mean; s2 += (v[j][0] * v[j][0] + v[j][1] * v[j][1]) + (v[j][2] * v[j][2] + v[j][3] * v[j][3]); }
    const float rstd = 1.f / sqrtf(wave_sum(s2) * (1.f / D) + LN_EPS); mean_o = mean; rstd_o = rstd;
#pragma unroll
    for (int j = 0; j < 8; ++j) { const f32x4 gg = *((const f32x4*)g + lane + 64 * j), bb = *((const f32x4*)b + lane + 64 * j); v[j] = v[j] * rstd * gg + bb; }
}

#define WSP(T, off) ((T*)(args.ws + (off)))
#define IN(k) (lo <= (k) && (k) < hi)
#define SEAM(k) do { if (IN(k) && IN((k) + 1)) { XcdBarrier b_; b_.bar = WSP(unsigned, WS_CTL) + CW_BAR; b_.x = xb_xcc_id(); b_.st = (volatile LAS unsigned*)(lds + MISC_OFF) + 8; xcd_barrier(b_); } } while (0)

__device__ __forceinline__ int moe_unit_table(const int* moemeta, int NT, LAS int* utab) {
    const int tid = tid_opaque();
    pg8::MoeOrder Mo;
#pragma unroll
    for (int e = 0; e <= NE; ++e) Mo.pb[e] = moemeta[e];
    Mo.NT = NT; Mo.G = gridDim.x; Mo.c = blockIdx.x; Mo.nwg = Mo.pb[NE] * NT;
    if (tid < 64) { pg8::Unit u; u.pm = 0; u.pn = 0; u.aux = 0; Mo.next(tid, u); utab[4 * tid] = u.pm; utab[4 * tid + 1] = u.pn; utab[4 * tid + 2] = u.aux; }
    __syncthreads();
    const int left = Mo.nwg - Mo.c; int n = left <= 0 ? 0 : (left + Mo.G - 1) / Mo.G;
    return __builtin_amdgcn_readfirstlane(n < 64 ? n : 64);
}
__device__ __forceinline__ f32x4 tail_sum(const bf16_t* yp, int t, int d, int lane, int SK) {
    f32x4 acc = {0.f, 0.f, 0.f, 0.f};
    for (int q = 0; q < SK; ++q) { const u32x2 a = *((const u32x2*)(yp + ((size_t)(q * 128 + t - 1) * 256 + (d & 255)) * 256) + lane);
        acc += (f32x4){__uint_as_float(a.x << 16), __uint_as_float(a.x & 0xffff0000u), __uint_as_float(a.y << 16), __uint_as_float(a.y & 0xffff0000u)}; }
    return acc;
}
__device__ __forceinline__ int moe_tail_split(int nwg, int G, int& Rf, int& Tn) {
    Rf = nwg / G; Tn = nwg - Rf * G;
    return Tn == 0 ? 1 : (Tn * 7 <= G ? 7 : (Tn * 4 <= G ? 4 : (Tn * 2 <= G ? 2 : 1)));
}
__device__ __forceinline__ int moe_unit_table_k(const int* moemeta, int NT, LAS int* utab, unsigned char* tailmap) {
    const int tid = tid_opaque();
    pg8::MoeOrder Mo;
#pragma unroll
    for (int e = 0; e <= NE; ++e) Mo.pb[e] = moemeta[e];
    Mo.NT = NT; Mo.G = gridDim.x; Mo.c = blockIdx.x; Mo.nwg = Mo.pb[NE] * NT;
    int Rf, Tn; const int SK = moe_tail_split(Mo.nwg, Mo.G, Rf, Tn);
    const int R = Rf < 63 ? Rf : 63;
    const bool piece = SK > 1 ? (Mo.c < Tn * SK) : (Mo.c < Tn);
    if (tid < 64) {
        long Lq = -1; int kx = 0, mark = 0;
        if (tid < R) Lq = (long)tid * Mo.G + Mo.c;
        else if (tid == R && piece) {
            if (SK == 1) Lq = (long)Rf * Mo.G + Mo.c;
            else { const int j = Mo.c / SK, q = Mo.c - j * SK; Lq = (long)Rf * Mo.G + j; kx = (1 + j) | (q << 8) | (SK << 16); mark = (q == 0) ? 1 + j : 0; }
        }
        pg8::Unit u; u.pm = 0; u.pn = 0; u.aux = 0; u.kx = 0;
        if (Lq >= 0) Mo.at(Lq, u);
        if (mark) tailmap[u.pm * 8 + u.aux] = (unsigned char)mark;
        utab[4 * tid] = u.pm; utab[4 * tid + 1] = u.pn; utab[4 * tid + 2] = u.aux; utab[4 * tid + 3] = kx;
    }
    __syncthreads();
    return __builtin_amdgcn_readfirstlane(R + (piece ? 1 : 0));
}
template <int L>
__device__ __forceinline__ void layer_phases(const Args& args, LAS unsigned char* lds, char* lds_gen, int lo, int hi) {
    constexpr int pb = 1 + 10 * L;
    if (IN(pb + 0)) {
        const int G = gridDim.x, bx = blockIdx.x;
        pg8::Gemm g{WSP(const bf16_t, WS_XB), WSP(const bf16_t, WS_WIN + L * SZ_WIN), D}; pg8::StaticOrder So; So.init(S, 2048, G, bx);
        pg8::EpiInProj E{WSP(bf16_t, WS_CQ), WSP(bf16_t, WS_CKV), WSP(bf16_t, WS_KPE), WSP(bf16_t, WS_QS), WSP(bf16_t, WS_KS), WSP(bf16_t, WS_VS), WSP(float, WS_PARTQ), WSP(float, WS_PARTKV),
                         WSP(const float, WS_COSM), WSP(const float, WS_SINM), WSP(const float, WS_COSS), WSP(const float, WS_SINS)};
        pg8::gemm_phase<pg8::EpiInProj, pg8::StaticOrder, true, true>(lds, g, So, E);
    }
    SEAM(pb + 0);
    if (IN(pb + 1)) {
        const int G = gridDim.x, bx = blockIdx.x;
        LAS int* utab = (LAS int*)(lds + MISC_OFF + 1024);
        LAS int* ucnt = (LAS int*)(lds + MISC_OFF + 1024 + 3072);
        if (tid_opaque() == 0) {
            int nl = 0, nq = 0, nk = 0;
            if (G == 256) {
                if (bx < 128) { utab[0] = bx >> 1; utab[1] = 8 + (bx & 1); utab[2] = 8 + (bx & 1); nl = 1; utab[128] = bx >> 3; utab[129] = bx & 7; utab[130] = bx & 7; nk = 1; }
                else { const int c = bx - 128;
                    for (int i = 0; i < 3; ++i) { const int u = 3 * c + i; utab[64 + 4 * i] = u / 6; utab[65 + 4 * i] = u % 6; utab[66 + 4 * i] = u % 6; }
                    nq = 3;
                    for (int i = 0; i < 3; ++i) { const int u = 128 + 3 * c + i; utab[128 + 4 * i] = u >> 3; utab[129 + 4 * i] = u & 7; utab[130 + 4 * i] = u & 7; }
                    nk = 3; }
            } else {
                for (int u = bx; u < 128 && nl < 16; u += G, ++nl) { utab[4 * nl] = u >> 1; utab[4 * nl + 1] = 8 + (u & 1); utab[4 * nl + 2] = 8 + (u & 1); }
                for (int u = bx; u < 384 && nq < 16; u += G, ++nq) { utab[64 + 4 * nq] = u / 6; utab[65 + 4 * nq] = u % 6; utab[66 + 4 * nq] = u % 6; }
                for (int u = bx; u < 512 && nk < 16; u += G, ++nk) { utab[128 + 4 * nk] = u >> 3; utab[129 + 4 * nk] = u & 7; utab[130 + 4 * nk] = u & 7; }
            }
            ucnt[0] = nl; ucnt[1] = nq; ucnt[2] = nk;
        }
        __syncthreads();
        { pg8::TableOrder To{utab, __builtin_amdgcn_readfirstlane(ucnt[0])};
          pg8::Gemm g{WSP(const bf16_t, WS_XB), WSP(const bf16_t, WS_WIN + L * SZ_WIN), D};
          pg8::EpiInProj E{WSP(bf16_t, WS_CQ), WSP(bf16_t, WS_CKV), WSP(bf16_t, WS_KPE), WSP(bf16_t, WS_QS), WSP(bf16_t, WS_KS), WSP(bf16_t, WS_VS), WSP(float, WS_PARTQ), WSP(float, WS_PARTKV),
                           WSP(const float, WS_COSM), WSP(const float, WS_SINM), WSP(const float, WS_COSS), WSP(const float, WS_SINS)};
          pg8::gemm_phase<pg8::EpiInProj, pg8::TableOrder, true, true>(lds, g, To, E); }
        { pg8::TableOrder To{utab + 64, __builtin_amdgcn_readfirstlane(ucnt[1])};
          pg8::Gemm g{WSP(const bf16_t, WS_CQ), WSP(const bf16_t, WS_WQ + L * SZ_WQ), QLORA};
          pg8::EpiQ E{WSP(bf16_t, WS_Q), WSP(const float, WS_PARTQ), WSP(const float, WS_COSM), WSP(const float, WS_SINM)};
          pg8::gemm_phase<pg8::EpiQ, pg8::TableOrder, true, true>(lds, g, To, E); }
        { pg8::TableOrder To{utab + 128, __builtin_amdgcn_readfirstlane(ucnt[2])};
          pg8::Gemm g{WSP(const bf16_t, WS_CKV), WSP(const bf16_t, WS_WKV + L * SZ_WKV), KVLORA};
          pg8::EpiKV E{WSP(bf16_t, WS_KV), WSP(const float, WS_PARTKV), WSP(unsigned char, WS_VT), WSP(unsigned char, WS_KN8)};
          pg8::gemm_phase<pg8::EpiKV, pg8::TableOrder, true, true>(lds, g, To, E); }
    }
    SEAM(pb + 1);
    if (IN(pb + 2)) {
        const int G = gridDim.x, bx = blockIdx.x;
        const int slot = bx % 3; bool pending = true;
        for (int step = 0; ; ++step) {
            const int u = bx + step * G; const bool more = u < 512;
            if (pending && (step == slot || !more)) { moe_conv_burst(args, lds, L, DEPTH); pending = false; }
            if (!more) break;
            const int r = u / 256, c = u % 256, head = 4 * r + ((c & 7) >> 1), qblk = (c >> 3) + 32 * (c & 1);
            att::attn_body<192, false, QCOLS, KVCOLS, 64, S, D>(WSP(const bf16_t, WS_Q) + (size_t)qblk * 256 * QCOLS + head * 192, WSP(const bf16_t, WS_KV) + head * 256, WSP(const unsigned char, WS_KN8) + head * 128, WSP(const bf16_t, WS_KPE),
                (const bf16_t*)(args.ws + WS_VT + (size_t)head * 128 * S), WSP(bf16_t, WS_OBUF) + (size_t)qblk * 256 * D + head * 128, WSP(float, WS_PARTO) + (size_t)qblk * 256 * 16 + head, qblk * 256, 0, S / 64, SCALE_MLA, 0.f, (LAS char*)lds);
        }
        for (int u = bx; u < 512; u += G) {
            const int head = u >> 6, qblk = u & 63;
            int t0 = 4 * qblk - 2, t1 = 4 * qblk + 5; if (t0 < 0) t0 = 0; if (t1 > S / 64 - 1) t1 = S / 64 - 1;
            const float sk = (args.in[6] + L * 8)[head];
            att::attn_body<128, true, 1024, 256, 64, 256, D>(WSP(const bf16_t, WS_QS) + (size_t)qblk * 256 * 1024 + head * 128, WSP(const bf16_t, WS_KS) + (head >> 2) * 128, nullptr, nullptr, WSP(const bf16_t, WS_VS) + (head >> 2) * 128,
                WSP(bf16_t, WS_OBUF) + (size_t)qblk * 256 * D + 1024 + head * 128, WSP(float, WS_PARTO) + (size_t)qblk * 256 * 16 + 8 + head, qblk * 256, t0 * 64, t1 - t0 + 1, SCALE_SWA, sk / SCALE_SWA, (LAS char*)lds);
        }
    }
    SEAM(pb + 2);
    if (IN(pb + 4)) {
        const int G = gridDim.x, bx = blockIdx.x;
        pg8::Gemm g{WSP(const bf16_t, WS_OBUF), WSP(const bf16_t, WS_WOUT + L * SZ_WOUT), D}; pg8::StaticOrder So; So.init(S, D, G, bx);
        if constexpr (L == 0) { pg8::EpiOutProj<false> E{args.in[0], WSP(float, WS_XA), WSP(const float, WS_PARTO), nullptr, nullptr, nullptr}; pg8::gemm_phase<pg8::EpiOutProj<false>, pg8::StaticOrder, true, true>(lds, g, So, E); }
        else { pg8::EpiOutProj<true> E{WSP(const float, WS_XA), WSP(float, WS_XA), WSP(const float, WS_PARTO), WSP(const float, WS_ST2), args.in[19] + (L - 1) * D, args.in[20] + (L - 1) * D};
               pg8::gemm_phase<pg8::EpiOutProj<true>, pg8::StaticOrder, true, true>(lds, g, So, E); }
    }
    SEAM(pb + 4);
    if (IN(pb + 5)) {
        const int tid = tid_opaque(), lane = tid & 63, wave = tid >> 6, G = gridDim.x, bx = blockIdx.x;
        const float* lg = args.in[10] + L * D; const float* lb = args.in[11] + L * D;
        float* XA = WSP(float, WS_XA); unsigned* X8 = WSP(unsigned, WS_X8);
        const int RPW = (S + G - 1) / G, r0 = bx * RPW, r1 = (r0 + RPW < S) ? r0 + RPW : S;
        LAS float* wr_l = (LAS float*)lds; LAS int* hist = (LAS int*)(lds + 65536);
        if (L == 1) { const float* wrg = args.in[15]; for (int i = tid; i < D * NE; i += 512) wr_l[i] = wrg[i]; if (tid < NE) hist[tid] = 0; __syncthreads(); }
        for (int row = r0 + wave; row < r1; row += NWAVES) {
            f32x4 v[8]; float* xr = XA + (size_t)row * D;
#pragma unroll
            for (int j = 0; j < 8; ++j) v[j] = *((const f32x4*)xr + lane + 64 * j);
            float mu_, rs_; ln_row(v, lg, lb, lane, mu_, rs_);
            if (lane == 0) { float* st = WSP(float, WS_ST1); st[2 * row] = mu_; st[2 * row + 1] = rs_; }
            { f32x16 lo, hi;
#pragma unroll
              for (int j = 0; j < 4; ++j)
#pragma unroll
                  for (int c = 0; c < 4; ++c) { lo[4 * j + c] = v[j][c]; hi[4 * j + c] = v[4 + j][c]; }
              unsigned sb; const u32x6 q = mx6_block(lo, hi, sb);
              unsigned char* o = (unsigned char*)X8 + (size_t)row * D + (lane >> 2) * 128 + 16 * (lane & 3);
              *(u32x4*)o = (u32x4){q[0], q[1], q[2], q[3]}; *(u32x4*)(o + 64) = (u32x4){q[4], q[5], sb, 0u}; }
            if (L == 1) {
                float q0 = 0.f, q1 = 0.f, q2 = 0.f, q3 = 0.f, q4 = 0.f, q5 = 0.f, q6 = 0.f, q7 = 0.f;
#pragma unroll
                for (int j = 0; j < 8; ++j)
#pragma unroll
                    for (int k = 0; k < 4; ++k) { const LAS f32x4* w = (const LAS f32x4*)(wr_l + (size_t)(4 * (lane + 64 * j) + k) * NE); const f32x4 w0 = w[0], w1 = w[1]; const float xv = v[j][k];
                        q0 += xv * w0[0]; q1 += xv * w0[1]; q2 += xv * w0[2]; q3 += xv * w0[3]; q4 += xv * w1[0]; q5 += xv * w1[1]; q6 += xv * w1[2]; q7 += xv * w1[3]; }
                q0 = wave_sum(q0); q1 = wave_sum(q1); q2 = wave_sum(q2); q3 = wave_sum(q3); q4 = wave_sum(q4); q5 = wave_sum(q5); q6 = wave_sum(q6); q7 = wave_sum(q7);
                int e0 = 0; float l0 = q0;
                if (q1 > l0) { l0 = q1; e0 = 1; } if (q2 > l0) { l0 = q2; e0 = 2; } if (q3 > l0) { l0 = q3; e0 = 3; } if (q4 > l0) { l0 = q4; e0 = 4; } if (q5 > l0) { l0 = q5; e0 = 5; } if (q6 > l0) { l0 = q6; e0 = 6; } if (q7 > l0) { l0 = q7; e0 = 7; }
                int e1 = -1; float l1 = -3.0e38f;
                if (e0 != 0 && q0 > l1) { l1 = q0; e1 = 0; } if (e0 != 1 && q1 > l1) { l1 = q1; e1 = 1; } if (e0 != 2 && q2 > l1) { l1 = q2; e1 = 2; } if (e0 != 3 && q3 > l1) { l1 = q3; e1 = 3; }
                if (e0 != 4 && q4 > l1) { l1 = q4; e1 = 4; } if (e0 != 5 && q5 > l1) { l1 = q5; e1 = 5; } if (e0 != 6 && q6 > l1) { l1 = q6; e1 = 6; } if (e0 != 7 && q7 > l1) { l1 = q7; e1 = 7; }
                const float t = __expf(l1 - l0), g0 = 1.0f / (1.0f + t), g1 = t / (1.0f + t);
                if (lane == 0) { int* sel = WSP(int, WS_SEL); float* gate = WSP(float, WS_GATE); sel[2 * row] = e0; sel[2 * row + 1] = e1; gate[2 * row] = g0; gate[2 * row + 1] = g1;
                    __hip_atomic_fetch_add(hist + e0, 1, __ATOMIC_RELAXED, __HIP_MEMORY_SCOPE_WORKGROUP); __hip_atomic_fetch_add(hist + e1, 1, __ATOMIC_RELAXED, __HIP_MEMORY_SCOPE_WORKGROUP); }
            }
        }
        if (L == 1) { __syncthreads(); if (tid < NE) WSP(int, WS_WGCNT)[bx * NE + tid] = hist[tid]; }
    }
    SEAM(pb + 5);
    if constexpr (L == 0) {
        if (IN(pb + 7)) {
            const int G = gridDim.x, bx = blockIdx.x;
            pg8::Gemm g{WSP(const bf16_t, WS_X8), WSP(const bf16_t, WS_WGU), D}; pg8::StaticOrder So; So.init(S, 2 * FF, G, bx);
            pg8::EpiSwiglu6 E{WSP(unsigned char, WS_H), FF};
            pg8::gemm_phase<pg8::EpiSwiglu6, pg8::StaticOrder, true, true, 2>(lds, g, So, E);
        }
        SEAM(pb + 7);
        if (IN(pb + 8)) {
            const int G = gridDim.x, bx = blockIdx.x;
            pg8::Gemm g{WSP(const bf16_t, WS_H), WSP(const bf16_t, WS_WD), FF}; pg8::StaticOrder So; So.init(S, D, G, bx);
            pg8::EpiResidLN E{WSP(const float, WS_XA), WSP(float, WS_XA), 1.0f, WSP(const float, WS_ST1), args.in[10] + L * D, args.in[11] + L * D};
            pg8::gemm_phase<pg8::EpiResidLN, pg8::StaticOrder, true, true, 2>(lds, g, So, E);
        }
        SEAM(pb + 8);
        if (IN(pb + 9)) {
            const int tid = tid_opaque(), lane = tid & 63, gw = blockIdx.x * NWAVES + (tid >> 6), NGW = gridDim.x * NWAVES;
            const float* lg = args.in[19] + L * D; const float* lb = args.in[20] + L * D; float* XA = WSP(float, WS_XA); bf16_t* XB = WSP(bf16_t, WS_XB);
            for (int row = gw; row < S; row += NGW) {
                f32x4 v[8]; float* xr = XA + (size_t)row * D;
#pragma unroll
                for (int j = 0; j < 8; ++j) v[j] = *((const f32x4*)xr + lane + 64 * j);
                float mu_, rs_; ln_row(v, lg, lb, lane, mu_, rs_);
                if (lane == 0) { float* st = WSP(float, WS_ST2); st[2 * row] = mu_; st[2 * row + 1] = rs_; }
#pragma unroll
                for (int j = 0; j < 8; ++j) *((u32x2*)(XB + (size_t)row * D) + lane + 64 * j) = pg8::pack4(v[j]);
            }
        }
        SEAM(pb + 9);
    } else {
        if (IN(pb + 6)) {
            const int tid = tid_opaque(), lane = tid & 63, wave = tid >> 6, G = gridDim.x, bx = blockIdx.x;
            const int RPW = (S + G - 1) / G, r0 = bx * RPW, r1 = (r0 + RPW < S) ? r0 + RPW : S, na = 2 * (r1 - r0);
            LAS int* tab = (LAS int*)lds;
            LAS int* basee = (LAS int*)(lds + 32768);
            LAS int* asel = (LAS int*)(lds + 33024);
            LAS int* adst = (LAS int*)(lds + 35072);
            const int* wgcnt = WSP(const int, WS_WGCNT); const int* sel = WSP(const int, WS_SEL);
            for (int i = tid; i < G * NE; i += 512) tab[i] = wgcnt[i];
            for (int i = tid; i < na; i += 512) asel[i] = sel[2 * r0 + i];
            __syncthreads();
            if (tid < NE) { int tot = 0, pre = 0; for (int w = 0; w < G; ++w) { const int c = tab[w * NE + tid]; pre += (w < bx) ? c : 0; tot += c; } basee[32 + tid] = tot; basee[40 + tid] = pre; }
            __syncthreads();
            if (tid == 0) { int p = 0; for (int e = 0; e < NE; ++e) { basee[8 + e] = p; basee[e] = 256 * p + basee[40 + e]; p += (basee[32 + e] + 255) >> 8; } basee[16] = p;
                if (bx == 0) { int* moemeta = WSP(int, WS_MOEMETA); for (int e = 0; e <= NE; ++e) moemeta[e] = basee[8 + e]; } }
            __syncthreads();
            if (tid < NE) { int rk = basee[tid]; for (int i = 0; i < na; ++i) if (asel[i] == tid) adst[i] = rk++; }
            __syncthreads();
            int* dest = WSP(int, WS_DEST); const unsigned char* X8 = WSP(const unsigned char, WS_X8); unsigned char* xs = WSP(unsigned char, WS_XS);
            for (int i = tid; i < na; i += 512) dest[2 * r0 + i] = adst[i];
            if (bx < NE) {
                const int rb = 256 * basee[8 + bx] + basee[32 + bx], re = 256 * basee[9 + bx];
                for (int i = rb * 128 + tid; i < re * 128; i += 512) ((u32x4*)xs)[i] = (u32x4){0u, 0u, 0u, 0u};
            }
            for (int a = wave; a < na; a += NWAVES) { const u32x4* s4 = (const u32x4*)(X8 + (size_t)(r0 + (a >> 1)) * D); u32x4* d4 = (u32x4*)(xs + (size_t)adst[a] * D);
#pragma unroll
                for (int j = 0; j < 2; ++j) d4[lane + 64 * j] = s4[lane + 64 * j]; }
        }
        SEAM(pb + 6);
        if (IN(pb + 7)) {
            LAS int* utab = (LAS int*)(lds + MISC_OFF + 1024);
            const int nun = moe_unit_table(WSP(const int, WS_MOEMETA), 2 * FFE / 256, utab);
            pg8::TableOrder To{utab, nun};
            pg8::Gemm g{WSP(const bf16_t, WS_XS), WSP(const bf16_t, WS_WMGU), D};
            pg8::EpiSwiglu6 E{WSP(unsigned char, WS_H), FFE};
            for (int rep = 0; rep < PROBE_MOEUP; ++rep) pg8::gemm_phase<pg8::EpiSwiglu6, pg8::TableOrder, true, true, 2>(lds, g, To, E);
        }
        SEAM(pb + 7);
        if (IN(pb + 8)) {
            LAS int* utab = (LAS int*)(lds + MISC_OFF + 1024);
            const int nun = moe_unit_table_k(WSP(const int, WS_MOEMETA), D / 256, utab, WSP(unsigned char, WS_TAILMAP));
            pg8::TableOrderK To{utab, nun};
            pg8::Gemm g{WSP(const bf16_t, WS_H), WSP(const bf16_t, WS_WMD), FFE};
            pg8::EpiBf16OutK E{WSP(bf16_t, WS_XS), WSP(bf16_t, WS_YP)};
            pg8::gemm_phase<pg8::EpiBf16OutK, pg8::TableOrderK, true, true, 2>(lds, g, To, E);
        }
        SEAM(pb + 8);
        if (IN(pb + 9)) {
            const int tid = tid_opaque(), lane = tid & 63, gw = blockIdx.x * NWAVES + (tid >> 6), NGW = gridDim.x * NWAVES;
            const float* lg = args.in[19] + L * D; const float* lb = args.in[20] + L * D;
            const int* dest = WSP(const int, WS_DEST); const float* gate = WSP(const float, WS_GATE); const float* XA = WSP(const float, WS_XA); const bf16_t* ys = WSP(const bf16_t, WS_XS);
            const float* st1 = WSP(const float, WS_ST1); const float* g1p = args.in[10] + L * D; const float* b1p = args.in[11] + L * D;
            for (int row = gw; row < S; row += NGW) {
                const int d0 = dest[2 * row], d1 = dest[2 * row + 1]; const float g0 = gate[2 * row], g1 = gate[2 * row + 1]; const float mu1 = st1[2 * row], rs1 = st1[2 * row + 1];
                f32x4 v[8]; const float* xr = XA + (size_t)row * D; const u32x2* y0 = (const u32x2*)(ys + (size_t)d0 * D); const u32x2* y1 = (const u32x2*)(ys + (size_t)d1 * D);
                const u32x2 m0 = *(const u32x2*)(WSP(const unsigned char, WS_TAILMAP) + (d0 >> 8) * 8), m1 = *(const u32x2*)(WSP(const unsigned char, WS_TAILMAP) + (d1 >> 8) * 8);
                const bool anyt = (m0.x | m0.y | m1.x | m1.y) != 0u;
#pragma unroll
                for (int j = 0; j < 8; ++j) { const f32x4 yv = *((const f32x4*)xr + lane + 64 * j); const f32x4 x = (yv - mu1) * rs1 * *((const f32x4*)g1p + lane + 64 * j) + *((const f32x4*)b1p + lane + 64 * j); const u32x2 a = y0[lane + 64 * j], b = y1[lane + 64 * j];
                    f32x4 fa = {__uint_as_float(a.x << 16), __uint_as_float(a.x & 0xffff0000u), __uint_as_float(a.y << 16), __uint_as_float(a.y & 0xffff0000u)};
                    f32x4 fb = {__uint_as_float(b.x << 16), __uint_as_float(b.x & 0xffff0000u), __uint_as_float(b.y << 16), __uint_as_float(b.y & 0xffff0000u)};
                    if (anyt) {
                        const int t0 = (int)(((j < 4 ? m0.x : m0.y) >> (8 * (j & 3))) & 255u), t1 = (int)(((j < 4 ? m1.x : m1.y) >> (8 * (j & 3))) & 255u);
                        if (t0 | t1) {
                            const int nwg_ = WSP(const int, WS_MOEMETA)[NE] * (D / 256), G_ = gridDim.x, Tn_ = nwg_ - (nwg_ / G_) * G_, SK = Tn_ * 7 <= G_ ? 7 : (Tn_ * 4 <= G_ ? 4 : 2);
                            if (t0) fa = tail_sum(WSP(const bf16_t, WS_YP), t0, d0, lane, SK);
                            if (t1) fb = tail_sum(WSP(const bf16_t, WS_YP), t1, d1, lane, SK);
                        }
                    }
                    v[j] = x * ALPHA + (fa * g0 + fb * g1); }
                float mu_, rs_; ln_row(v, lg, lb, lane, mu_, rs_);
#pragma unroll
                for (int j = 0; j < 8; ++j) *((f32x4*)(args.out + (size_t)row * D) + lane + 64 * j) = v[j];
            }
        }
    }
}

__global__ void __launch_bounds__(NWAVES * 64, 2) fwd(Args args) {
    extern __shared__ __attribute__((aligned(16))) unsigned char lds_raw[];
    LAS unsigned char* lds = (LAS unsigned char*)lds_raw;
    volatile LAS unsigned* MISC = (volatile LAS unsigned*)(lds + MISC_OFF);
    for (int u = tid_opaque(); u < (LDS_BYTES - MISC_OFF) / 4; u += NWAVES * 64) MISC[u] = 0u;
    __syncthreads();
    (void)xcd_barrier_post(WSP(unsigned, WS_CTL) + CW_BAR, MISC + 8);
    const int lo = args.ph_lo, hi = args.ph_hi;

    if (IN(0)) {
        const int tid = tid_opaque(), lane = tid & 63, wave = tid >> 6, G = gridDim.x, bx = blockIdx.x, gw = bx * NWAVES + wave, NGW = G * NWAVES;
        unsigned char* ws = args.ws;
        LAS unsigned* scr = (LAS unsigned*)(lds + wave * 16640);
        for (int rep = 0; rep < PROBE_PRO; ++rep) {
        int cursor = 0;
        for (int l = 0; l < DEPTH; ++l) {
            tr_matrix(args.in[1] + (size_t)l * D * IN_COLS, nullptr, IN_COLS, D, (bf16_t*)(ws + WS_WIN + l * SZ_WIN), IN_PAD, 1, nullptr, nullptr, scr, lane, gw, NGW, cursor);
            tr_matrix(args.in[3] + (size_t)l * QLORA * QCOLS, nullptr, QCOLS, QLORA, (bf16_t*)(ws + WS_WQ + l * SZ_WQ), QCOLS, 2, args.in[2] + l * QLORA, nullptr, scr, lane, gw, NGW, cursor);
            tr_matrix(args.in[5] + (size_t)l * KVLORA * KVCOLS, nullptr, KVCOLS, KVLORA, (bf16_t*)(ws + WS_WKV + l * SZ_WKV), KVCOLS, 0, args.in[4] + l * KVLORA, nullptr, scr, lane, gw, NGW, cursor);
            tr_matrix(args.in[9] + (size_t)l * D * D, nullptr, D, D, (bf16_t*)(ws + WS_WOUT + l * SZ_WOUT), D, 0, args.in[7] + l * 1024, args.in[8] + l * 1024, scr, lane, gw, NGW, cursor);
        }
        tr_matrix6(args.in[12], args.in[13], FF, ws + WS_WGU, 2 * FF, scr, lane, gw, NGW, cursor);
        tr_matrix6c(args.in[14], D, FF, ws + WS_WD, D, scr, lane, gw, NGW, cursor);
        { const f32x4* x4 = (const f32x4*)args.in[0]; u32x2* o2 = (u32x2*)(ws + WS_XB);
          for (size_t i = (size_t)bx * 512 + tid; i < (size_t)S * D / 4; i += (size_t)G * 512) o2[i] = pg8::pack4(x4[i]); }
        { float* coss = (float*)(ws + WS_COSS); float* sins = (float*)(ws + WS_SINS); float* cosm = (float*)(ws + WS_COSM); float* sinm = (float*)(ws + WS_SINM);
          for (int i = bx * 512 + tid; i < S * 64; i += G * 512) { const int pos = i >> 6, k = i & 63; float sn, cs; sincos_acc((float)pos * INVF[k], sn, cs); coss[i] = cs; sins[i] = sn; }
          for (int i = bx * 512 + tid; i < S * 32; i += G * 512) { const int pos = i >> 5, k = i & 31; float sn, cs; sincos_acc((float)pos * INVF[2 * k], sn, cs); cosm[i] = cs; sinm[i] = sn; } }
        }
    }
    SEAM(0);
    layer_phases<0>(args, lds, (char*)lds_raw, lo, hi);
    layer_phases<1>(args, lds, (char*)lds_raw, lo, hi);
}
#undef IN
#undef SEAM

#ifndef MK_SPLIT
#define MK_SPLIT 0
#endif
extern "C" void kernel_launch(void* const* d_in, const int* in_sizes, int n_in, void* d_out, int out_size, void* d_ws, size_t ws_size, hipStream_t stream) {
    static int grid = 0;
    if (grid == 0) {
        if (n_in != 21 || out_size != S * D || ws_size < WS_END4) { fprintf(stderr, "kernel_launch: unexpected shapes: n_in %d out %d ws %zu (need %zu)\n", n_in, out_size, ws_size, (size_t)WS_END4); grid = -1; return; }
        int dev = 0, cus = 0, per_cu = 0;
        if (hipGetDevice(&dev) != hipSuccess || hipDeviceGetAttribute(&cus, hipDeviceAttributeMultiprocessorCount, dev) != hipSuccess) { grid = -1; return; }
        if (hipFuncSetAttribute((const void*)fwd, hipFuncAttributeMaxDynamicSharedMemorySize, LDS_BYTES) != hipSuccess) { fprintf(stderr, "kernel_launch: hipFuncSetAttribute failed\n"); grid = -1; return; }
        if (hipOccupancyMaxActiveBlocksPerMultiprocessor(&per_cu, (const void*)fwd, NWAVES * 64, LDS_BYTES) != hipSuccess || per_cu < 1) fprintf(stderr, "kernel_launch: occupancy query says %d\n", per_cu);
        (void)hipGetLastError();
        grid = cus;
    }
    if (grid < 0) return;
    (void)hipMemsetAsync((char*)d_ws + WS_CTL, 0, CTL_ZERO_BYTES, stream);
    Args a{};
    for (int i = 0; i < 21; ++i) a.in[i] = (const float*)d_in[i];
    a.out = (float*)d_out; a.ws = (unsigned char*)d_ws;
#if MK_SPLIT
    for (int p = 0; p < NPHASE; ++p) { a.ph_lo = p; a.ph_hi = p + 1; hipLaunchKernelGGL(fwd, dim3(grid), dim3(NWAVES * 64), LDS_BYTES, stream, a); }
#else
    a.ph_lo = 0; a.ph_hi = NPHASE; hipLaunchKernelGGL(fwd, dim3(grid), dim3(NWAVES * 64), LDS_BYTES, stream, a);
#endif
    const hipError_t le = hipPeekAtLastError();
    if (le != hipSuccess) fprintf(stderr, "kernel_launch: launch failed: %s\n", hipGetErrorName(le));
}
```
